# Optimizing an MI355X kernel written in HIP

```python
import math
import jax, jax.numpy as jnp
from jax import lax
import numpy as np

D_MODEL = 2048
BATCH = 2
SEQ = 4096
DEPTH = 1

DN_HEADS = 8
DN_DK = 128
DN_DV = 128
CONV_W = 4
RET_HEADS = 8
RET_DK = 64
RET_DV = 128
CHUNK = 64
ROPE_BASE = 10000.0
N_KEYS = 128
N_EXPERTS = N_KEYS * N_KEYS
PK_HEADS = 8
PK_DQ = 256
PK_TOPK = 16
TOK_BLOCK = 128
PLE_DIM = 256
EPS = 1e-6

DN_QK = DN_HEADS * DN_DK
DN_V = DN_HEADS * DN_DV
CONV_CH = 2 * DN_QK + DN_V
RET_QK = RET_HEADS * RET_DK
RET_V = RET_HEADS * RET_DV
D_MIX = DN_V + RET_V
SPLIT_SIZES = (CONV_CH, DN_V, DN_HEADS, DN_HEADS, RET_QK, RET_QK, RET_V, RET_V)
IN_COLS = CONV_CH + DN_V + 2 * DN_HEADS + 2 * RET_QK + 2 * RET_V

kernel_name = "hybrid_deltanet_retention_peer_block"


def rms_norm(x, w):
    xf = x.astype(jnp.float32)
    y = xf * lax.rsqrt(jnp.mean(xf * xf, axis=-1, keepdims=True) + EPS)
    return (y * w.astype(jnp.float32)).astype(x.dtype)


def l2norm(x):
    return x * lax.rsqrt(jnp.sum(x * x, axis=-1, keepdims=True) + EPS)


def causal_conv_silu(x, w):
    s = x.shape[1]
    xp = jnp.pad(x, ((0, 0), (CONV_W - 1, 0), (0, 0)))
    y = sum(xp[:, j:j + s, :] * w[:, j] for j in range(CONV_W))
    return jax.nn.silu(y)


def rotary(x, positions):
    half = x.shape[-1] // 2
    inv_freq = ROPE_BASE ** (-jnp.arange(half, dtype=jnp.float32) / half)
    ang = positions.astype(jnp.float32)[..., None] * inv_freq
    cos = jnp.cos(ang)[:, :, None, :]
    sin = jnp.sin(ang)[:, :, None, :]
    x1, x2 = x[..., :half], x[..., half:]
    return jnp.concatenate([x1 * cos - x2 * sin, x1 * sin + x2 * cos], axis=-1)


def _chunks(t, n):
    b, _, h = t.shape[:3]
    t = t.reshape((b, n, CHUNK, h) + t.shape[3:])
    return jnp.moveaxis(t, 3, 1)


def _unchunk(t):
    b, h, n, c = t.shape[:4]
    return jnp.moveaxis(t, 1, 3).reshape((b, n * c, h) + t.shape[4:])


def gated_delta_rule(q, k, v, g, beta):
    b, s, h, dk = q.shape
    dv = v.shape[-1]
    n = s // CHUNK
    q, k, v, g, beta = (_chunks(t, n) for t in (q, k, v, g, beta))
    g = jnp.cumsum(g, axis=-1)
    causal = jnp.tril(jnp.ones((CHUNK, CHUNK), dtype=bool))
    strict = jnp.tril(jnp.ones((CHUNK, CHUNK), dtype=bool), -1)
    decay = jnp.exp(jnp.where(causal, g[..., :, None] - g[..., None, :], -jnp.inf))
    k_beta = k * beta[..., None]
    kk = jnp.einsum('bhncd,bhnmd->bhncm', k_beta, k) * decay
    a_mat = jnp.where(strict, kk, 0.0) + jnp.eye(CHUNK, dtype=q.dtype)
    rhs = jnp.concatenate([v * beta[..., None], k_beta * jnp.exp(g)[..., None]], axis=-1)
    sol = lax.linalg.triangular_solve(a_mat, rhs, left_side=True, lower=True, unit_diagonal=True)
    u, w = sol[..., :dv], sol[..., dv:]
    attn = jnp.einsum('bhncd,bhnmd->bhncm', q, k) * decay

    def step(state, xs):
        q_c, k_c, u_c, w_c, g_c, attn_c = xs
        v_new = u_c - jnp.einsum('bhck,bhkv->bhcv', w_c, state)
        o_c = (jnp.einsum('bhck,bhkv->bhcv', q_c * jnp.exp(g_c)[..., None], state)
               + jnp.einsum('bhcm,bhmv->bhcv', attn_c, v_new))
        g_end = g_c[..., -1:]
        state = (state * jnp.exp(g_end)[..., None]
                 + jnp.einsum('bhck,bhcv->bhkv', k_c * jnp.exp(g_end - g_c)[..., None], v_new))
        return state, o_c

    state0 = jnp.zeros((b, h, dk, dv), q.dtype)
    xs = tuple(jnp.moveaxis(t, 2, 0) for t in (q, k, u, w, g, attn))
    _, out = lax.scan(step, state0, xs)
    return _unchunk(jnp.moveaxis(out, 0, 2))


def retention_chunked(q, k, v):
    b, s, h, dk = q.shape
    dv = v.shape[-1]
    n = s // CHUNK
    q, k, v = (_chunks(t, n) for t in (q, k, v))
    log_gamma = jnp.log1p(-jnp.exp2(-5.0 - jnp.arange(RET_HEADS, dtype=jnp.float32)))
    pos = jnp.arange(CHUNK, dtype=jnp.float32)
    rel = pos[:, None] - pos[None, :]
    d_mat = jnp.exp(jnp.where(rel >= 0, rel * log_gamma[:, None, None], -jnp.inf))
    attn = jnp.einsum('bhncd,bhnmd->bhncm', q, k) * d_mat[None, :, None]
    inner = jnp.einsum('bhncm,bhnmv->bhncv', attn, v)
    xi = jnp.exp((pos + 1.0) * log_gamma[:, None])[None, :, :, None]
    zeta = jnp.exp((CHUNK - 1.0 - pos) * log_gamma[:, None])[None, :, :, None]
    chunk_decay = jnp.exp(CHUNK * log_gamma)[None, :, None, None]

    def step(state, xs):
        q_c, k_c, v_c = xs
        cross = jnp.einsum('bhck,bhkv->bhcv', q_c, state) * xi
        state = state * chunk_decay + jnp.einsum('bhck,bhcv->bhkv', k_c * zeta, v_c)
        return state, cross

    state0 = jnp.zeros((b, h, dk, dv), q.dtype)
    xs = tuple(jnp.moveaxis(t, 2, 0) for t in (q, k, v))
    _, cross = lax.scan(step, state0, xs)
    return _unchunk(inner + jnp.moveaxis(cross, 0, 2))


def peer(xn, w_pq, sub_keys, expert_u, expert_v):
    b, s, d = xn.shape
    t = b * s
    xt = xn.reshape(t, d)
    q = (xt @ w_pq).reshape(t, PK_HEADS, 2, PK_DQ // 2)
    scores = jnp.einsum('thpc,hpnc->thpn', q, sub_keys).astype(jnp.float32)
    s1, i1 = lax.top_k(scores[:, :, 0], PK_TOPK)
    s2, i2 = lax.top_k(scores[:, :, 1], PK_TOPK)
    cand_s = (s1[..., :, None] + s2[..., None, :]).reshape(t, PK_HEADS, PK_TOPK * PK_TOPK)
    cand_i = (i1[..., :, None] * N_KEYS + i2[..., None, :]).reshape(t, PK_HEADS, PK_TOPK * PK_TOPK)
    top_s, sel = lax.top_k(cand_s, PK_TOPK)
    idx = jnp.take_along_axis(cand_i, sel, axis=-1)
    gates = jax.nn.softmax(top_s, axis=-1)
    nb = t // TOK_BLOCK
    idx = idx.reshape(nb, TOK_BLOCK, PK_HEADS * PK_TOPK)
    gates = gates.reshape(nb, TOK_BLOCK, PK_HEADS * PK_TOPK)
    xb = xt.reshape(nb, TOK_BLOCK, d)

    def block(args):
        x_blk, i_blk, g_blk = args
        pre = jnp.einsum('tkd,td->tk', expert_u[i_blk], x_blk).astype(jnp.float32)
        act = jax.nn.gelu(pre, approximate=False) * g_blk
        return jnp.einsum('tk,tkd->td', act.astype(x_blk.dtype), expert_v[i_blk])

    out = lax.map(block, (xb, idx, gates))
    return out.reshape(b, s, d)


def setup_inputs(seed: int = 0) -> dict:
    key = jax.random.key(seed)
    ks = jax.random.split(key, 24)
    f32 = jnp.float32

    def nrm(k, shape, scale):
        return jax.random.normal(k, shape, f32) * scale

    def gain(k, shape):
        return 1.0 + 0.02 * jax.random.normal(k, shape, f32)

    L = DEPTH
    x = nrm(ks[0], (BATCH, SEQ, D_MODEL), 1.0)
    p = nrm(ks[1], (L, BATCH, SEQ, PLE_DIM), 1.0)
    positions = (jax.random.randint(ks[2], (BATCH, 1), 0, 1024, dtype=jnp.int32)
                 + jnp.arange(SEQ, dtype=jnp.int32)[None, :])
    norm_mix = gain(ks[3], (L, D_MODEL))
    w_in = nrm(ks[4], (L, D_MODEL, IN_COLS), D_MODEL ** -0.5)
    conv_w = nrm(ks[5], (L, CONV_CH, CONV_W), CONV_W ** -0.5)
    a_log = jnp.log(jax.random.uniform(ks[6], (L, DN_HEADS), f32, 1.0, 16.0))
    dt = jnp.exp(jax.random.uniform(ks[7], (L, DN_HEADS), f32, math.log(1e-3), math.log(1e-1)))
    dt_bias = dt + jnp.log(-jnp.expm1(-dt))
    dn_norm = gain(ks[8], (L, DN_DV))
    ret_gn_w = gain(ks[9], (L, RET_V))
    ret_gn_b = nrm(ks[10], (L, RET_V), 0.02)
    w_out = nrm(ks[11], (L, D_MIX, D_MODEL), D_MIX ** -0.5)
    norm_ffn = gain(ks[12], (L, D_MODEL))
    w_pq = nrm(ks[13], (L, D_MODEL, PK_HEADS * PK_DQ), D_MODEL ** -0.5)
    sub_keys = nrm(ks[14], (L, PK_HEADS, 2, N_KEYS, PK_DQ // 2), (PK_DQ // 2) ** -0.5)
    expert_u = nrm(ks[15], (L, N_EXPERTS, D_MODEL), D_MODEL ** -0.5)
    expert_v = nrm(ks[16], (L, N_EXPERTS, D_MODEL), PK_HEADS ** -0.5)
    norm_ple = gain(ks[17], (L, D_MODEL))
    w_ple_gate = nrm(ks[18], (L, D_MODEL, D_MODEL), D_MODEL ** -0.5)
    w_ple_proj = nrm(ks[19], (L, PLE_DIM, D_MODEL), PLE_DIM ** -0.5)
    norm_final = gain(ks[20], (D_MODEL,))
    return {"x": x, "p": p, "positions": positions, "norm_mix": norm_mix, "w_in": w_in,
            "conv_w": conv_w, "a_log": a_log, "dt_bias": dt_bias, "dn_norm": dn_norm,
            "ret_gn_w": ret_gn_w, "ret_gn_b": ret_gn_b, "w_out": w_out, "norm_ffn": norm_ffn,
            "w_pq": w_pq, "sub_keys": sub_keys, "expert_u": expert_u, "expert_v": expert_v,
            "norm_ple": norm_ple, "w_ple_gate": w_ple_gate, "w_ple_proj": w_ple_proj,
            "norm_final": norm_final}


def reference(x, p, positions, norm_mix, w_in, conv_w, a_log, dt_bias, dn_norm, ret_gn_w, ret_gn_b,
              w_out, norm_ffn, w_pq, sub_keys, expert_u, expert_v, norm_ple, w_ple_gate, w_ple_proj,
              norm_final):
    f32 = jnp.float32
    b, s, _ = x.shape
    splits = [int(c) for c in np.cumsum(SPLIT_SIZES)[:-1]]
    h = x
    for i in range(DEPTH):
        hn = rms_norm(h, norm_mix[i])
        proj = jnp.einsum('bsd,dc->bsc', hn, w_in[i]).astype(f32)
        conv_in, dn_z, dn_a, dn_b, r_q, r_k, r_v, r_g = jnp.split(proj, splits, axis=-1)

        qkv = causal_conv_silu(conv_in, conv_w[i].astype(f32))
        dq, dk, dv = jnp.split(qkv, [DN_QK, 2 * DN_QK], axis=-1)
        dq = l2norm(dq.reshape(b, s, DN_HEADS, DN_DK)) * (DN_DK ** -0.5)
        dk = l2norm(dk.reshape(b, s, DN_HEADS, DN_DK))
        dv = dv.reshape(b, s, DN_HEADS, DN_DV)
        beta = jax.nn.sigmoid(dn_b)
        g = -jnp.exp(a_log[i].astype(f32)) * jax.nn.softplus(dn_a + dt_bias[i].astype(f32))
        o_dn = gated_delta_rule(dq, dk, dv, g, beta)
        o_dn = rms_norm(o_dn, dn_norm[i]) * jax.nn.silu(dn_z.reshape(b, s, DN_HEADS, DN_DV))
        o_dn = o_dn.reshape(b, s, DN_V)

        rq = rotary(r_q.reshape(b, s, RET_HEADS, RET_DK), positions)
        rk = rotary(r_k.reshape(b, s, RET_HEADS, RET_DK), positions) * (RET_DK ** -0.5)
        rv = r_v.reshape(b, s, RET_HEADS, RET_DV)
        o_r = retention_chunked(rq, rk, rv)
        mu = jnp.mean(o_r, axis=-1, keepdims=True)
        var = jnp.mean(jnp.square(o_r - mu), axis=-1, keepdims=True)
        o_r = ((o_r - mu) * lax.rsqrt(var + EPS)).reshape(b, s, RET_V)
        o_r = (o_r * ret_gn_w[i].astype(f32) + ret_gn_b[i].astype(f32)) * jax.nn.silu(r_g)

        mixed = jnp.concatenate([o_dn, o_r], axis=-1).astype(h.dtype)
        h = h + jnp.einsum('bsc,cd->bsd', mixed, w_out[i])

        hn = rms_norm(h, norm_ffn[i])
        h = h + peer(hn, w_pq[i], sub_keys[i], expert_u[i], expert_v[i])

        gate = jax.nn.sigmoid((rms_norm(h, norm_ple[i]) @ w_ple_gate[i]).astype(f32))
        ple = (p[i] @ w_ple_proj[i]).astype(f32)
        h = h + (gate * ple).astype(h.dtype)
    return rms_norm(h, norm_final)
```

```cpp
#include <hip/hip_runtime.h>
#include <cstdio>
#include <cstdint>

typedef unsigned short bf16_t;
typedef short bf16x8 __attribute__((ext_vector_type(8)));
typedef float f32x16 __attribute__((ext_vector_type(16)));
typedef float f32x4 __attribute__((ext_vector_type(4)));

constexpr int T = 8192, D = 2048, SEQ = 4096;
constexpr int NPROJ = 7296;
constexpr int C_Z = 3072, C_RQ = 4096, C_RK = 4608, C_RV = 5120, C_RG = 6144, C_A = 7168, C_B = 7176;
constexpr int IN_COLS = 7184;
constexpr float EPS = 1e-6f;

constexpr size_t MB = 1024 * 1024;
constexpr size_t WS_HN    = 0;
constexpr size_t WS_WTIN  = WS_HN + (size_t)T * D * 2;
constexpr size_t WS_WTOUT = WS_WTIN + (size_t)NPROJ * D * 2;
constexpr size_t WS_WTPQ  = WS_WTOUT + (size_t)D * D * 2;
constexpr size_t WS_WTG   = WS_WTPQ + (size_t)D * D * 2;
constexpr size_t WS_WTPP  = WS_WTG + (size_t)D * D * 2;
constexpr size_t WS_KEYS  = WS_WTPP + (size_t)D * 256 * 2;
constexpr size_t WS_PBF   = WS_KEYS + (size_t)16 * 128 * 128 * 2;
constexpr size_t WS_PROJ  = WS_PBF + (size_t)T * 256 * 2;
constexpr size_t WS_Q     = WS_PROJ;
constexpr size_t WS_SCORES= WS_PROJ + (size_t)T * D * 2;
constexpr size_t WS_MIXED = WS_PROJ + (size_t)T * NPROJ * 2;
constexpr size_t WS_H     = WS_MIXED + (size_t)T * D * 2;
constexpr size_t WS_IDX   = WS_H + (size_t)T * D * 4;
constexpr size_t WS_GATES = WS_IDX + (size_t)T * 128 * 4;
constexpr size_t WS_QKV   = WS_GATES + (size_t)T * 128 * 4;
constexpr size_t WS_PLE   = WS_QKV;
constexpr size_t WS_GB    = WS_QKV + (size_t)T * 3072 * 4;
constexpr size_t WS_ODN   = WS_GB + (size_t)T * 16 * 4;
constexpr size_t WS_ORET  = WS_ODN + (size_t)T * 1024 * 4;
constexpr size_t WS_END   = WS_ORET + (size_t)T * 1024 * 4;

struct Params {
    const float *x, *p; const int* positions;
    const float *norm_mix, *w_in, *conv_w, *a_log, *dt_bias, *dn_norm, *ret_gn_w, *ret_gn_b, *w_out, *norm_ffn, *w_pq, *sub_keys,
                *expert_u, *expert_v, *norm_ple, *w_ple_gate, *w_ple_proj, *norm_final;
    float* out; unsigned char* ws;
};

__device__ __forceinline__ bf16_t f2bf(float f) { unsigned u = __float_as_uint(f); u += 0x7fffu + ((u >> 16) & 1u); return (bf16_t)(u >> 16); }
__device__ __forceinline__ float bf2f(bf16_t h) { return __uint_as_float(((unsigned)h) << 16); }
__device__ __forceinline__ unsigned pack2(float a, float b) { return (unsigned)f2bf(a) | ((unsigned)f2bf(b) << 16); }
__device__ __forceinline__ float wave_sum(float v) {
#pragma unroll
    for (int o = 32; o >= 1; o >>= 1) v += __shfl_xor(v, o);
    return v;
}
__device__ __forceinline__ float wave_max(float v) {
#pragma unroll
    for (int o = 32; o >= 1; o >>= 1) v = fmaxf(v, __shfl_xor(v, o));
    return v;
}
__device__ __forceinline__ float silu_f(float x) { return x / (1.f + __expf(-x)); }
__device__ __forceinline__ float sigmoid_f(float x) { return 1.f / (1.f + __expf(-x)); }

template <bool MAPIN>
__device__ void transpose_tile(const float* __restrict__ W, int ldw, int K, bf16_t* __restrict__ Wt, int kt, int nt, float* tile  ) {
    const int tid = threadIdx.x;
    __syncthreads();
#pragma unroll
    for (int i = 0; i < 4; ++i) {
        const int idx = tid + 256 * i, kr = idx >> 4, c4 = idx & 15;
        const int n = nt * 64 + c4 * 4;
        int c = n; bool valid = true;
        if (MAPIN) { if (n < 4096) c = n; else if (n < 7168) c = n + 16; else if (n < 7184) c = n - 3072; else valid = false; }
        f32x4 v = {0.f, 0.f, 0.f, 0.f};
        if (valid) v = *(const f32x4*)(W + (size_t)(kt * 64 + kr) * ldw + c);
        float* d = tile + kr * 65 + c4 * 4;
        d[0] = v[0]; d[1] = v[1]; d[2] = v[2]; d[3] = v[3];
    }
    __syncthreads();
#pragma unroll
    for (int i = 0; i < 2; ++i) {
        const int ch = tid + 256 * i, n = ch >> 3, kc = ch & 7;
        unsigned w[4];
#pragma unroll
        for (int j = 0; j < 4; ++j) w[j] = pack2(tile[(kc * 8 + 2 * j) * 65 + n], tile[(kc * 8 + 2 * j + 1) * 65 + n]);
        uint4 o = make_uint4(w[0], w[1], w[2], w[3]);
        *(uint4*)(Wt + (size_t)(nt * 64 + n) * K + kt * 64 + kc * 8) = o;
    }
}

template <bool OUT_BF16>
__device__ __forceinline__ void rmsnorm_row(const float* __restrict__ in, const float* __restrict__ w, void* __restrict__ out, int lane) {
    f32x4 v[8]; float ss = 0.f;
#pragma unroll
    for (int i = 0; i < 8; ++i) { v[i] = *(const f32x4*)(in + (i * 64 + lane) * 4); ss += v[i][0] * v[i][0] + v[i][1] * v[i][1] + v[i][2] * v[i][2] + v[i][3] * v[i][3]; }
    ss = wave_sum(ss);
    const float r = rsqrtf(ss * (1.f / 2048.f) + EPS);
#pragma unroll
    for (int i = 0; i < 8; ++i) {
        const f32x4 g = *(const f32x4*)(w + (i * 64 + lane) * 4);
        const float a = v[i][0] * r * g[0], b = v[i][1] * r * g[1], c = v[i][2] * r * g[2], d = v[i][3] * r * g[3];
        if (OUT_BF16) { uint2 o = make_uint2(pack2(a, b), pack2(c, d)); *(uint2*)((bf16_t*)out + (i * 64 + lane) * 4) = o; }
        else { f32x4 o = {a, b, c, d}; *(f32x4*)((float*)out + (i * 64 + lane) * 4) = o; }
    }
}

__device__ void phase_prep(const Params& P, int bid, int nb, unsigned char* smem) {
    float* tile = (float*)smem;
    const int tid = threadIdx.x;
    const int n_in = 32 * 114, n_sq = 32 * 32, n_pp = 4 * 32;
    const int n_tr = n_in + 3 * n_sq + n_pp;
    for (int u = bid; u < n_tr; u += nb) {
        if (u < n_in) transpose_tile<true>(P.w_in, IN_COLS, D, (bf16_t*)(P.ws + WS_WTIN), u % 32, u / 32, tile);
        else if (u < n_in + n_sq) { const int v = u - n_in; transpose_tile<false>(P.w_out, D, D, (bf16_t*)(P.ws + WS_WTOUT), v % 32, v / 32, tile); }
        else if (u < n_in + 2 * n_sq) { const int v = u - n_in - n_sq; transpose_tile<false>(P.w_pq, D, D, (bf16_t*)(P.ws + WS_WTPQ), v % 32, v / 32, tile); }
        else if (u < n_in + 3 * n_sq) { const int v = u - n_in - 2 * n_sq; transpose_tile<false>(P.w_ple_gate, D, D, (bf16_t*)(P.ws + WS_WTG), v % 32, v / 32, tile); }
        else { const int v = u - n_in - 3 * n_sq; transpose_tile<false>(P.w_ple_proj, D, 256, (bf16_t*)(P.ws + WS_WTPP), v % 4, v / 4, tile); }
    }
    {
        bf16_t* keys = (bf16_t*)(P.ws + WS_KEYS); bf16_t* pbf = (bf16_t*)(P.ws + WS_PBF);
        const int n4a = 262144 / 4, n4b = T * 256 / 4;
        for (int i = bid * 256 + tid; i < n4a + n4b; i += nb * 256) {
            const bool a = i < n4a; const int j = a ? i : i - n4a;
            const f32x4 v = *(const f32x4*)((a ? P.sub_keys : P.p) + (size_t)j * 4);
            *(uint2*)((a ? keys : pbf) + (size_t)j * 4) = make_uint2(pack2(v[0], v[1]), pack2(v[2], v[3]));
        }
    }
    {
        const int wave = tid >> 6, lane = tid & 63;
        bf16_t* hn = (bf16_t*)(P.ws + WS_HN);
        for (int r = bid * 4 + wave; r < T; r += nb * 4) rmsnorm_row<true>(P.x + (size_t)r * D, P.norm_mix, hn + (size_t)r * D, lane);
    }
}

__device__ __forceinline__ int lds_off(int row, int ch) { return row * 128 + ((ch ^ ((row >> 1) & 7)) << 4); }

__device__ __forceinline__ void gemm_mainloop(const bf16_t* __restrict__ A, int lda, const bf16_t* __restrict__ Bt, int ldb, int K,
                                              f32x16 (&acc)[2][2], unsigned char* smem) {
    const int tid = threadIdx.x, wave = tid >> 6, lane = tid & 63, wr = wave >> 1, wc = wave & 1;
    const int nk = K / 64;
    uint4 ra[4], rb[4];
    __syncthreads();
#pragma unroll
    for (int i = 0; i < 4; ++i) { const int c = tid + 256 * i, row = c >> 3, ch = c & 7;
        ra[i] = *(const uint4*)(A + (size_t)row * lda + ch * 8); rb[i] = *(const uint4*)(Bt + (size_t)row * ldb + ch * 8); }
#pragma unroll
    for (int i = 0; i < 4; ++i) { const int c = tid + 256 * i, row = c >> 3, ch = c & 7;
        *(uint4*)(smem + lds_off(row, ch)) = ra[i]; *(uint4*)(smem + 16384 + lds_off(row, ch)) = rb[i]; }
    __syncthreads();
    for (int kt = 0; kt < nk; ++kt) {
        unsigned char* cur = smem + (kt & 1) * 32768;
        unsigned char* nxt = smem + ((kt + 1) & 1) * 32768;
        const bool more = kt + 1 < nk;
        if (more) {
#pragma unroll
            for (int i = 0; i < 4; ++i) { const int c = tid + 256 * i, row = c >> 3, ch = c & 7;
                ra[i] = *(const uint4*)(A + (size_t)row * lda + (kt + 1) * 64 + ch * 8); rb[i] = *(const uint4*)(Bt + (size_t)row * ldb + (kt + 1) * 64 + ch * 8); }
        }
#pragma unroll
        for (int ks = 0; ks < 4; ++ks) {
            bf16x8 af[2], bfr[2];
#pragma unroll
            for (int i = 0; i < 2; ++i) { const int row = wr * 64 + i * 32 + (lane & 31); af[i] = *(const bf16x8*)(cur + lds_off(row, ks * 2 + (lane >> 5))); }
#pragma unroll
            for (int j = 0; j < 2; ++j) { const int row = wc * 64 + j * 32 + (lane & 31); bfr[j] = *(const bf16x8*)(cur + 16384 + lds_off(row, ks * 2 + (lane >> 5))); }
#pragma unroll
            for (int i = 0; i < 2; ++i)
#pragma unroll
                for (int j = 0; j < 2; ++j) acc[i][j] = __builtin_amdgcn_mfma_f32_32x32x16_bf16(af[i], bfr[j], acc[i][j], 0, 0, 0);
        }
        if (more) {
#pragma unroll
            for (int i = 0; i < 4; ++i) { const int c = tid + 256 * i, row = c >> 3, ch = c & 7;
                *(uint4*)(nxt + lds_off(row, ch)) = ra[i]; *(uint4*)(nxt + 16384 + lds_off(row, ch)) = rb[i]; }
        }
        __syncthreads();
    }
}
#define ACC_FOREACH(body)                                                                                   \
    { const int _tid = threadIdx.x, _wave = _tid >> 6, _lane = _tid & 63, _wr = _wave >> 1, _wc = _wave & 1; \
      _Pragma("unroll") for (int i = 0; i < 2; ++i) _Pragma("unroll") for (int j = 0; j < 2; ++j)          \
      _Pragma("unroll") for (int r = 0; r < 16; ++r) {                                                     \
          const int row = _wr * 64 + i * 32 + (r & 3) + 8 * (r >> 2) + 4 * (_lane >> 5);                   \
          const int col = _wc * 64 + j * 32 + (_lane & 31); body } }

__device__ __forceinline__ void zero_acc(f32x16 (&acc)[2][2]) {
#pragma unroll
    for (int i = 0; i < 2; ++i)
#pragma unroll
        for (int j = 0; j < 2; ++j)
#pragma unroll
            for (int r = 0; r < 16; ++r) acc[i][j][r] = 0.f;
}

__device__ void phase_gemm1(const Params& P, int bid, int nb, unsigned char* smem) {
    const bf16_t* A = (const bf16_t*)(P.ws + WS_HN); const bf16_t* Bt = (const bf16_t*)(P.ws + WS_WTIN); bf16_t* C = (bf16_t*)(P.ws + WS_PROJ);
    const int nmt = T / 128, nnt = NPROJ / 128;
    for (int t = bid; t < nmt * nnt; t += nb) {
        const int mt = t % nmt, nt = t / nmt;
        f32x16 acc[2][2]; zero_acc(acc);
        gemm_mainloop(A + (size_t)mt * 128 * D, D, Bt + (size_t)nt * 128 * D, D, D, acc, smem);
        ACC_FOREACH({ C[(size_t)(mt * 128 + row) * NPROJ + nt * 128 + col] = f2bf(acc[i][j][r]); })
    }
}
__device__ void phase_gemm2(const Params& P, int bid, int nb, unsigned char* smem) {
    const bf16_t* A = (const bf16_t*)(P.ws + WS_MIXED); const bf16_t* Bt = (const bf16_t*)(P.ws + WS_WTOUT); float* H = (float*)(P.ws + WS_H);
    const int nmt = T / 128, nnt = D / 128;
    for (int t = bid; t < nmt * nnt; t += nb) {
        const int mt = t % nmt, nt = t / nmt;
        f32x16 acc[2][2]; zero_acc(acc);
        gemm_mainloop(A + (size_t)mt * 128 * D, D, Bt + (size_t)nt * 128 * D, D, D, acc, smem);
        ACC_FOREACH({ const size_t o = (size_t)(mt * 128 + row) * D + nt * 128 + col; H[o] = P.x[o] + acc[i][j][r]; })
    }
}
__device__ void phase_gemm3(const Params& P, int bid, int nb, unsigned char* smem) {
    const bf16_t* A = (const bf16_t*)(P.ws + WS_HN); const bf16_t* Bt = (const bf16_t*)(P.ws + WS_WTPQ); bf16_t* C = (bf16_t*)(P.ws + WS_Q);
    const int nmt = T / 128, nnt = D / 128;
    for (int t = bid; t < nmt * nnt; t += nb) {
        const int mt = t % nmt, nt = t / nmt;
        f32x16 acc[2][2]; zero_acc(acc);
        gemm_mainloop(A + (size_t)mt * 128 * D, D, Bt + (size_t)nt * 128 * D, D, D, acc, smem);
        ACC_FOREACH({ C[(size_t)(mt * 128 + row) * D + nt * 128 + col] = f2bf(acc[i][j][r]); })
    }
}
__device__ void phase_scores(const Params& P, int bid, int nb, unsigned char* smem) {
    const bf16_t* A = (const bf16_t*)(P.ws + WS_Q); const bf16_t* Bt = (const bf16_t*)(P.ws + WS_KEYS); float* C = (float*)(P.ws + WS_SCORES);
    const int nmt = T / 128, nnt = 16;
    for (int t = bid; t < nmt * nnt; t += nb) {
        const int mt = t % nmt, nt = t / nmt;
        f32x16 acc[2][2]; zero_acc(acc);
        gemm_mainloop(A + (size_t)mt * 128 * D + nt * 128, D, Bt + (size_t)nt * 128 * 128, 128, 128, acc, smem);
        ACC_FOREACH({ C[(size_t)(mt * 128 + row) * D + nt * 128 + col] = acc[i][j][r]; })
    }
}
__device__ void phase_ple(const Params& P, int bid, int nb, unsigned char* smem) {
    const bf16_t* A2 = (const bf16_t*)(P.ws + WS_PBF); const bf16_t* Bt2 = (const bf16_t*)(P.ws + WS_WTPP); bf16_t* C = (bf16_t*)(P.ws + WS_PLE);
    const int nmt = T / 128, nnt = D / 128;
    for (int t = bid; t < nmt * nnt; t += nb) {
        const int mt = t % nmt, nt = t / nmt;
        f32x16 acc[2][2]; zero_acc(acc);
        gemm_mainloop(A2 + (size_t)mt * 128 * 256, 256, Bt2 + (size_t)nt * 128 * 256, 256, 256, acc, smem);
        ACC_FOREACH({ C[(size_t)(mt * 128 + row) * D + nt * 128 + col] = f2bf(acc[i][j][r]); })
    }
}
__device__ void phase_gemm4(const Params& P, int bid, int nb, unsigned char* smem) {
    const bf16_t* A = (const bf16_t*)(P.ws + WS_HN); const bf16_t* Bt = (const bf16_t*)(P.ws + WS_WTG);
    const bf16_t* ple = (const bf16_t*)(P.ws + WS_PLE); float* H = (float*)(P.ws + WS_H);
    const int nmt = T / 128, nnt = D / 128;
    for (int t = bid; t < nmt * nnt; t += nb) {
        const int mt = t % nmt, nt = t / nmt;
        f32x16 acc[2][2]; zero_acc(acc);
        gemm_mainloop(A + (size_t)mt * 128 * D, D, Bt + (size_t)nt * 128 * D, D, D, acc, smem);
        ACC_FOREACH({ const size_t o = (size_t)(mt * 128 + row) * D + nt * 128 + col; H[o] = H[o] + sigmoid_f(acc[i][j][r]) * bf2f(ple[o]); })
    }
}

template <bool OUT_BF16>
__device__ void phase_rownorm(const float* in, const float* w, void* out, int bid, int nb) {
    const int wave = threadIdx.x >> 6, lane = threadIdx.x & 63;
    for (int r = bid * 4 + wave; r < T; r += nb * 4) {
        if (OUT_BF16) rmsnorm_row<true>(in + (size_t)r * D, w, (bf16_t*)out + (size_t)r * D, lane);
        else rmsnorm_row<false>(in + (size_t)r * D, w, (float*)out + (size_t)r * D, lane);
    }
}

__device__ void phase_delta_prep(const Params& P, int bid, int nb) {
    const bf16_t* proj = (const bf16_t*)(P.ws + WS_PROJ); float* qkv = (float*)(P.ws + WS_QKV); float* gb = (float*)(P.ws + WS_GB);
    const int tid = threadIdx.x, wave = tid >> 6, lane = tid & 63;
    for (int t = bid; t < T; t += nb) {
        const int s = t % SEQ;
        for (int hd = wave; hd < 24; hd += 4) {
            const int c0 = hd * 128 + lane * 2;
            float y[2] = {0.f, 0.f};
#pragma unroll
            for (int j = 0; j < 4; ++j) {
                const int ss = s - 3 + j;
                if (ss >= 0) {
                    const unsigned pr = *(const unsigned*)(proj + (size_t)(t - 3 + j) * NPROJ + c0);
                    y[0] += bf2f((bf16_t)(pr & 0xffff)) * P.conv_w[(c0) * 4 + j];
                    y[1] += bf2f((bf16_t)(pr >> 16)) * P.conv_w[(c0 + 1) * 4 + j];
                }
            }
            y[0] = silu_f(y[0]); y[1] = silu_f(y[1]);
            if (hd < 16) {
                float ss2 = wave_sum(y[0] * y[0] + y[1] * y[1]);
                float r = rsqrtf(ss2 + EPS);
                if (hd < 8) r *= 0.08838834764831845f;
                y[0] *= r; y[1] *= r;
            }
            *(float2*)(qkv + (size_t)t * 3072 + c0) = make_float2(y[0], y[1]);
        }
        if (tid < 8) {
            const float a = bf2f(proj[(size_t)t * NPROJ + C_A + tid]), b = bf2f(proj[(size_t)t * NPROJ + C_B + tid]);
            const float xs = a + P.dt_bias[tid];
            const float sp = xs > 20.f ? xs : log1pf(expf(xs));
            gb[(size_t)t * 16 + tid] = -expf(P.a_log[tid]) * sp;
            gb[(size_t)t * 16 + 8 + tid] = 1.f / (1.f + expf(-b));
        }
    }
}

__device__ void phase_recur(const Params& P, int bid, int nb, unsigned char* smem) {
    const int tid = threadIdx.x;
    float* sq = (float*)smem;
    float* sk = sq + 16 * 128;
    float* sg = sk + 16 * 128;
    for (int u = bid; u < 32; u += nb) {
        if (u < 16) {
            const int b = u >> 3, h = u & 7;
            const float* qkv = (const float*)(P.ws + WS_QKV); const float* gb = (const float*)(P.ws + WS_GB); float* odn = (float*)(P.ws + WS_ODN);
            float S[64];
            const int colj = tid >> 1, half = tid & 1;
#pragma unroll
            for (int i = 0; i < 64; ++i) S[i] = 0.f;
            for (int t0 = 0; t0 < SEQ; t0 += 16) {
                __syncthreads();
                for (int e = tid; e < 16 * 128; e += 256) { const int tt = e >> 7, i = e & 127; const size_t tok = (size_t)b * SEQ + t0 + tt;
                    sq[e] = qkv[tok * 3072 + h * 128 + i]; sk[e] = qkv[tok * 3072 + 1024 + h * 128 + i]; }
                if (tid < 16) { const size_t tok = (size_t)b * SEQ + t0 + tid; sg[tid * 2] = expf(gb[tok * 16 + h]); sg[tid * 2 + 1] = gb[tok * 16 + 8 + h]; }
                __syncthreads();
                for (int tt = 0; tt < 16; ++tt) {
                    const size_t tok = (size_t)b * SEQ + t0 + tt;
                    const float v = qkv[tok * 3072 + 2048 + h * 128 + colj];
                    const float a = sg[tt * 2], be = sg[tt * 2 + 1];
                    const float* kk = sk + tt * 128 + half * 64; const float* qq = sq + tt * 128 + half * 64;
                    float ks = 0.f;
#pragma unroll
                    for (int i = 0; i < 64; ++i) ks += kk[i] * S[i];
                    ks += __shfl_xor(ks, 1);
                    const float coef = be * (v - a * ks);
                    float o = 0.f;
#pragma unroll
                    for (int i = 0; i < 64; ++i) { S[i] = a * S[i] + kk[i] * coef; o += qq[i] * S[i]; }
                    o += __shfl_xor(o, 1);
                    if (half == 0) odn[tok * 1024 + h * 128 + colj] = o;
                }
            }
        } else {
            const int b = (u - 16) >> 3, h = (u - 16) & 7;
            const bf16_t* proj = (const bf16_t*)(P.ws + WS_PROJ); float* oret = (float*)(P.ws + WS_ORET);
            const float gamma = 1.f - exp2f(-5.f - (float)h);
            float S[64];
#pragma unroll
            for (int i = 0; i < 64; ++i) S[i] = 0.f;
            for (int t0 = 0; t0 < SEQ; t0 += 16) {
                __syncthreads();
                for (int e = tid; e < 16 * 32; e += 256) {
                    const int tt = e >> 5, i = e & 31; const size_t tok = (size_t)b * SEQ + t0 + tt;
                    const float inv = powf(10000.f, -(float)i / 32.f);
                    const float ang = (float)P.positions[tok] * inv;
                    float sn, cs; sincosf(ang, &sn, &cs);
                    const float q1 = bf2f(proj[tok * NPROJ + C_RQ + h * 64 + i]), q2 = bf2f(proj[tok * NPROJ + C_RQ + h * 64 + 32 + i]);
                    const float k1 = bf2f(proj[tok * NPROJ + C_RK + h * 64 + i]) * 0.125f, k2 = bf2f(proj[tok * NPROJ + C_RK + h * 64 + 32 + i]) * 0.125f;
                    sq[tt * 128 + i] = q1 * cs - q2 * sn; sq[tt * 128 + 32 + i] = q1 * sn + q2 * cs;
                    sk[tt * 128 + i] = k1 * cs - k2 * sn; sk[tt * 128 + 32 + i] = k1 * sn + k2 * cs;
                }
                __syncthreads();
                if (tid < 128) {
                    for (int tt = 0; tt < 16; ++tt) {
                        const size_t tok = (size_t)b * SEQ + t0 + tt;
                        const float v = bf2f(proj[tok * NPROJ + C_RV + h * 128 + tid]);
                        const float* kk = sk + tt * 128; const float* qq = sq + tt * 128;
                        float o = 0.f;
#pragma unroll
                        for (int i = 0; i < 64; ++i) { S[i] = gamma * S[i] + kk[i] * v; o += qq[i] * S[i]; }
                        oret[tok * 1024 + h * 128 + tid] = o;
                    }
                }
            }
        }
    }
}

__device__ void phase_mix(const Params& P, int bid, int nb) {
    const bf16_t* proj = (const bf16_t*)(P.ws + WS_PROJ); const float* odn = (const float*)(P.ws + WS_ODN); const float* oret = (const float*)(P.ws + WS_ORET);
    bf16_t* mixed = (bf16_t*)(P.ws + WS_MIXED);
    const int wave = threadIdx.x >> 6, lane = threadIdx.x & 63;
    for (int u = bid * 4 + wave; u < T * 16; u += nb * 4) {
        const int t = u >> 4, gph = u & 15;
        if (gph < 8) {
            const int h = gph, j = h * 128 + lane * 2;
            const float2 o = *(const float2*)(odn + (size_t)t * 1024 + j);
            const float ms = wave_sum(o.x * o.x + o.y * o.y) * (1.f / 128.f);
            const float r = rsqrtf(ms + EPS);
            const unsigned zz = *(const unsigned*)(proj + (size_t)t * NPROJ + C_Z + j);
            const float z0 = bf2f((bf16_t)(zz & 0xffff)), z1 = bf2f((bf16_t)(zz >> 16));
            const float y0 = o.x * r * P.dn_norm[lane * 2] * silu_f(z0), y1 = o.y * r * P.dn_norm[lane * 2 + 1] * silu_f(z1);
            *(unsigned*)(mixed + (size_t)t * D + j) = pack2(y0, y1);
        } else {
            const int h = gph - 8, j = h * 128 + lane * 2;
            const float2 o = *(const float2*)(oret + (size_t)t * 1024 + j);
            const float mu = wave_sum(o.x + o.y) * (1.f / 128.f);
            const float d0 = o.x - mu, d1 = o.y - mu;
            const float var = wave_sum(d0 * d0 + d1 * d1) * (1.f / 128.f);
            const float r = rsqrtf(var + EPS);
            const unsigned gg = *(const unsigned*)(proj + (size_t)t * NPROJ + C_RG + j);
            const float g0 = bf2f((bf16_t)(gg & 0xffff)), g1 = bf2f((bf16_t)(gg >> 16));
            const float y0 = (d0 * r * P.ret_gn_w[j] + P.ret_gn_b[j]) * silu_f(g0), y1 = (d1 * r * P.ret_gn_w[j + 1] + P.ret_gn_b[j + 1]) * silu_f(g1);
            *(unsigned*)(mixed + (size_t)t * D + 1024 + j) = pack2(y0, y1);
        }
    }
}

__device__ void phase_route(const Params& P, int bid, int nb) {
    const float* scores = (const float*)(P.ws + WS_SCORES); int* idx = (int*)(P.ws + WS_IDX); float* gates = (float*)(P.ws + WS_GATES);
    const int wave = threadIdx.x >> 6, lane = threadIdx.x & 63;
    const float NEG = -3.0e38f;
    for (int u = bid * 4 + wave; u < T * 8; u += nb * 4) {
        const int t = u >> 3, h = u & 7;
        float top_s[2]; int top_i[2];
#pragma unroll
        for (int p = 0; p < 2; ++p) {
            const float* sp = scores + (size_t)t * D + (h * 2 + p) * 128;
            float k0 = __uint_as_float((__float_as_uint(sp[lane]) & ~0x7Fu) | (unsigned)lane);
            float k1 = __uint_as_float((__float_as_uint(sp[lane + 64]) & ~0x7Fu) | (unsigned)(lane + 64));
            float mine = 0.f;
            for (int r = 0; r < 16; ++r) {
                const float m = wave_max(fmaxf(k0, k1));
                if (k0 == m) k0 = NEG;
                if (k1 == m) k1 = NEG;
                if (lane == r) mine = m;
            }
            top_i[p] = (int)(__float_as_uint(mine) & 0x7Fu);
            top_s[p] = mine;
        }
        float ck[4];
#pragma unroll
        for (int e = 0; e < 4; ++e) {
            const int cand = lane * 4 + e, i = cand >> 4, j = cand & 15;
            const float s = __shfl(top_s[0], i) + __shfl(top_s[1], j);
            ck[e] = __uint_as_float((__float_as_uint(s) & ~0xFFu) | (unsigned)cand);
        }
        float mine = 0.f;
        for (int r = 0; r < 16; ++r) {
            const float m = wave_max(fmaxf(fmaxf(ck[0], ck[1]), fmaxf(ck[2], ck[3])));
#pragma unroll
            for (int e = 0; e < 4; ++e) if (ck[e] == m) ck[e] = NEG;
            if (lane == r) mine = m;
        }
        const int cand = (int)(__float_as_uint(mine) & 0xFFu);
        const int i1 = __shfl(top_i[0], cand >> 4), i2 = __shfl(top_i[1], cand & 15);
        const float smax = __shfl(mine, 0);
        float e = (lane < 16) ? __expf(mine - smax) : 0.f;
        const float sum = wave_sum(e);
        if (lane < 16) { idx[(size_t)t * 128 + h * 16 + lane] = i1 * 128 + i2; gates[(size_t)t * 128 + h * 16 + lane] = e / sum; }
    }
}

__device__ void phase_peer(const Params& P, int bid, int nb) {
    const bf16_t* hn = (const bf16_t*)(P.ws + WS_HN); const int* idx = (const int*)(P.ws + WS_IDX); const float* gates = (const float*)(P.ws + WS_GATES);
    float* H = (float*)(P.ws + WS_H);
    const int wave = threadIdx.x >> 6, lane = threadIdx.x & 63;
    for (int t = bid * 4 + wave; t < T; t += nb * 4) {
        f32x4 xr[8], acc[8];
#pragma unroll
        for (int i = 0; i < 8; ++i) {
            const uint2 v = *(const uint2*)(hn + (size_t)t * D + (i * 64 + lane) * 4);
            xr[i][0] = bf2f((bf16_t)(v.x & 0xffff)); xr[i][1] = bf2f((bf16_t)(v.x >> 16)); xr[i][2] = bf2f((bf16_t)(v.y & 0xffff)); xr[i][3] = bf2f((bf16_t)(v.y >> 16));
            acc[i] = (f32x4){0.f, 0.f, 0.f, 0.f};
        }
        for (int k = 0; k < 128; ++k) {
            const int e = idx[(size_t)t * 128 + k]; const float g = gates[(size_t)t * 128 + k];
            const f32x4* up = (const f32x4*)(P.expert_u + (size_t)e * D); const f32x4* vp = (const f32x4*)(P.expert_v + (size_t)e * D);
            f32x4 uv[8], vv[8];
#pragma unroll
            for (int i = 0; i < 8; ++i) { uv[i] = up[i * 64 + lane]; vv[i] = vp[i * 64 + lane]; }
            float d = 0.f;
#pragma unroll
            for (int i = 0; i < 8; ++i) d += uv[i][0] * xr[i][0] + uv[i][1] * xr[i][1] + uv[i][2] * xr[i][2] + uv[i][3] * xr[i][3];
            d = wave_sum(d);
            const float a = 0.5f * d * (1.f + erff(d * 0.70710678118654752f)) * g;
#pragma unroll
            for (int i = 0; i < 8; ++i) acc[i] += vv[i] * a;
        }
#pragma unroll
        for (int i = 0; i < 8; ++i) { f32x4* hp = (f32x4*)(H + (size_t)t * D + (i * 64 + lane) * 4); *hp = *hp + acc[i]; }
    }
}

enum { PH_PREP = 0, PH_GEMM1, PH_DPREP, PH_RECUR, PH_MIX, PH_GEMM2, PH_NORM2, PH_GEMM3, PH_SCORES, PH_ROUTE, PH_PEER, PH_NORM3, PH_PLE, PH_GEMM4, PH_FINAL, PH_COUNT };

template <int PH>
__global__ void __launch_bounds__(256, 2) fwd_kernel(Params P) {
    extern __shared__ __attribute__((aligned(16))) unsigned char smem[];
    const int bid = blockIdx.x, nb = gridDim.x;
    if (PH == PH_PREP)   phase_prep(P, bid, nb, smem);
    if (PH == PH_GEMM1)  phase_gemm1(P, bid, nb, smem);
    if (PH == PH_DPREP)  phase_delta_prep(P, bid, nb);
    if (PH == PH_RECUR)  phase_recur(P, bid, nb, smem);
    if (PH == PH_MIX)    phase_mix(P, bid, nb);
    if (PH == PH_GEMM2)  phase_gemm2(P, bid, nb, smem);
    if (PH == PH_NORM2)  phase_rownorm<true>((const float*)(P.ws + WS_H), P.norm_ffn, P.ws + WS_HN, bid, nb);
    if (PH == PH_GEMM3)  phase_gemm3(P, bid, nb, smem);
    if (PH == PH_SCORES) phase_scores(P, bid, nb, smem);
    if (PH == PH_ROUTE)  phase_route(P, bid, nb);
    if (PH == PH_PEER)   phase_peer(P, bid, nb);
    if (PH == PH_NORM3)  phase_rownorm<true>((const float*)(P.ws + WS_H), P.norm_ple, P.ws + WS_HN, bid, nb);
    if (PH == PH_PLE)    phase_ple(P, bid, nb, smem);
    if (PH == PH_GEMM4)  phase_gemm4(P, bid, nb, smem);
    if (PH == PH_FINAL)  phase_rownorm<false>((const float*)(P.ws + WS_H), P.norm_final, P.out, bid, nb);
}

template <int PH> static void launch_phase(const Params& P, int grid, hipStream_t stream) {
    static bool attr = false;
    if (!attr) { (void)hipFuncSetAttribute((const void*)fwd_kernel<PH>, hipFuncAttributeMaxDynamicSharedMemorySize, 65536); attr = true; }
    hipLaunchKernelGGL(fwd_kernel<PH>, dim3(grid), dim3(256), 65536, stream, P);
}

constexpr int LDS_BYTES = 65536;

extern "C" void kernel_launch(void* const* d_in, const int* in_sizes, int n_in, void* d_out, int out_size, void* d_ws, size_t ws_size, hipStream_t stream) {
    static int ready = 0;
    if (!ready) {
        if (n_in != 21 || out_size != T * D || ws_size < WS_END) { fprintf(stderr, "kernel_launch: unexpected shapes: n_in %d out %d ws %zu (need %zu)\n", n_in, out_size, ws_size, (size_t)WS_END); ready = -1; return; }
        ready = 1;
    }
    if (ready < 0) return;
    Params P{};
    P.x = (const float*)d_in[0]; P.p = (const float*)d_in[1]; P.positions = (const int*)d_in[2]; P.norm_mix = (const float*)d_in[3]; P.w_in = (const float*)d_in[4];
    P.conv_w = (const float*)d_in[5]; P.a_log = (const float*)d_in[6]; P.dt_bias = (const float*)d_in[7]; P.dn_norm = (const float*)d_in[8]; P.ret_gn_w = (const float*)d_in[9];
    P.ret_gn_b = (const float*)d_in[10]; P.w_out = (const float*)d_in[11]; P.norm_ffn = (const float*)d_in[12]; P.w_pq = (const float*)d_in[13]; P.sub_keys = (const float*)d_in[14];
    P.expert_u = (const float*)d_in[15]; P.expert_v = (const float*)d_in[16]; P.norm_ple = (const float*)d_in[17]; P.w_ple_gate = (const float*)d_in[18]; P.w_ple_proj = (const float*)d_in[19];
    P.norm_final = (const float*)d_in[20]; P.out = (float*)d_out; P.ws = (unsigned char*)d_ws;
    launch_phase<PH_PREP>(P, 1024, stream);
    launch_phase<PH_GEMM1>(P, 512, stream);
    launch_phase<PH_DPREP>(P, 2048, stream);
    launch_phase<PH_RECUR>(P, 32, stream);
    launch_phase<PH_MIX>(P, 2048, stream);
    launch_phase<PH_GEMM2>(P, 512, stream);
    launch_phase<PH_NORM2>(P, 1024, stream);
    launch_phase<PH_GEMM3>(P, 512, stream);
    launch_phase<PH_SCORES>(P, 512, stream);
    launch_phase<PH_ROUTE>(P, 2048, stream);
    launch_phase<PH_PEER>(P, 1024, stream);
    launch_phase<PH_NORM3>(P, 1024, stream);
    launch_phase<PH_PLE>(P, 512, stream);
    launch_phase<PH_GEMM4>(P, 512, stream);
    launch_phase<PH_FINAL>(P, 1024, stream);
}
```

```cpp
#include <hip/hip_runtime.h>
#include <cstdio>
#include <cstdint>

typedef unsigned short bf16_t;
typedef short bf16x8 __attribute__((ext_vector_type(8)));
typedef float f32x16 __attribute__((ext_vector_type(16)));
typedef float f32x4 __attribute__((ext_vector_type(4)));

constexpr int T = 8192, D = 2048, SEQ = 4096;
constexpr int NPROJ = 7296;
constexpr int C_Z = 3072, C_RQ = 4096, C_RK = 4608, C_RV = 5120, C_RG = 6144, C_A = 7168, C_B = 7176;
constexpr int IN_COLS = 7184;
constexpr float EPS = 1e-6f;

constexpr size_t MB = 1024 * 1024;
constexpr size_t WS_HN    = 0;
constexpr size_t WS_WTIN  = WS_HN + (size_t)T * D * 2;
constexpr size_t WS_WTOUT = WS_WTIN + (size_t)NPROJ * D * 2;
constexpr size_t WS_WTPQ  = WS_WTOUT + (size_t)D * D * 2;
constexpr size_t WS_WTG   = WS_WTPQ + (size_t)D * D * 2;
constexpr size_t WS_WTPP  = WS_WTG + (size_t)D * D * 2;
constexpr size_t WS_KEYS  = WS_WTPP + (size_t)D * 256 * 2;
constexpr size_t WS_PBF   = WS_KEYS + (size_t)16 * 128 * 128 * 2;
constexpr size_t WS_PROJ  = WS_PBF + (size_t)T * 256 * 2;
constexpr size_t WS_Q     = WS_PROJ;
constexpr size_t WS_SCORES= WS_PROJ + (size_t)T * D * 2;
constexpr size_t WS_MIXED = WS_PROJ + (size_t)T * NPROJ * 2;
constexpr size_t WS_H     = WS_MIXED + (size_t)T * D * 2;
constexpr size_t WS_IDX   = WS_H + (size_t)T * D * 4;
constexpr size_t WS_GATES = WS_IDX + (size_t)T * 128 * 4;
constexpr size_t WS_QKV   = WS_GATES + (size_t)T * 128 * 4;
constexpr size_t WS_PLE   = WS_QKV;
constexpr size_t WS_GB    = WS_QKV + (size_t)T * 3072 * 4;
constexpr size_t WS_ODN   = WS_GB + (size_t)T * 16 * 4;
constexpr size_t WS_ORET  = WS_ODN + (size_t)T * 1024 * 4;
constexpr size_t WS_BAR   = WS_ORET + (size_t)T * 1024 * 4;
constexpr size_t WS_END   = WS_BAR + 16384;

struct Params {
    const float *x, *p; const int* positions;
    const float *norm_mix, *w_in, *conv_w, *a_log, *dt_bias, *dn_norm, *ret_gn_w, *ret_gn_b, *w_out, *norm_ffn, *w_pq, *sub_keys,
                *expert_u, *expert_v, *norm_ple, *w_ple_gate, *w_ple_proj, *norm_final;
    float* out; unsigned char* ws;
};

__device__ __forceinline__ bf16_t f2bf(float f) { unsigned u = __float_as_uint(f); u += 0x7fffu + ((u >> 16) & 1u); return (bf16_t)(u >> 16); }
__device__ __forceinline__ float bf2f(bf16_t h) { return __uint_as_float(((unsigned)h) << 16); }
__device__ __forceinline__ unsigned pack2(float a, float b) { return (unsigned)f2bf(a) | ((unsigned)f2bf(b) << 16); }
__device__ __forceinline__ float wave_sum(float v) {
#pragma unroll
    for (int o = 32; o >= 1; o >>= 1) v += __shfl_xor(v, o);
    return v;
}
__device__ __forceinline__ float wave_max(float v) {
#pragma unroll
    for (int o = 32; o >= 1; o >>= 1) v = fmaxf(v, __shfl_xor(v, o));
    return v;
}
__device__ __forceinline__ float silu_f(float x) { return x / (1.f + __expf(-x)); }
__device__ __forceinline__ float sigmoid_f(float x) { return 1.f / (1.f + __expf(-x)); }

template <bool MAPIN>
__device__ void transpose_tile(const float* __restrict__ W, int ldw, int K, bf16_t* __restrict__ Wt, int kt, int nt, float* tile  ) {
    const int tid = threadIdx.x;
    __syncthreads();
#pragma unroll
    for (int i = 0; i < 4; ++i) {
        const int idx = tid + 256 * i, kr = idx >> 4, c4 = idx & 15;
        const int n = nt * 64 + c4 * 4;
        int c = n; bool valid = true;
        if (MAPIN) { if (n < 4096) c = n; else if (n < 7168) c = n + 16; else if (n < 7184) c = n - 3072; else valid = false; }
        f32x4 v = {0.f, 0.f, 0.f, 0.f};
        if (valid) v = *(const f32x4*)(W + (size_t)(kt * 64 + kr) * ldw + c);
        float* d = tile + kr * 65 + c4 * 4;
        d[0] = v[0]; d[1] = v[1]; d[2] = v[2]; d[3] = v[3];
    }
    __syncthreads();
#pragma unroll
    for (int i = 0; i < 2; ++i) {
        const int ch = tid + 256 * i, n = ch >> 3, kc = ch & 7;
        unsigned w[4];
#pragma unroll
        for (int j = 0; j < 4; ++j) w[j] = pack2(tile[(kc * 8 + 2 * j) * 65 + n], tile[(kc * 8 + 2 * j + 1) * 65 + n]);
        uint4 o = make_uint4(w[0], w[1], w[2], w[3]);
        *(uint4*)(Wt + (size_t)(nt * 64 + n) * K + kt * 64 + kc * 8) = o;
    }
}

template <bool OUT_BF16>
__device__ __forceinline__ void rmsnorm_row(const float* __restrict__ in, const float* __restrict__ w, void* __restrict__ out, int lane) {
    f32x4 v[8]; float ss = 0.f;
#pragma unroll
    for (int i = 0; i < 8; ++i) { v[i] = *(const f32x4*)(in + (i * 64 + lane) * 4); ss += v[i][0] * v[i][0] + v[i][1] * v[i][1] + v[i][2] * v[i][2] + v[i][3] * v[i][3]; }
    ss = wave_sum(ss);
    const float r = rsqrtf(ss * (1.f / 2048.f) + EPS);
#pragma unroll
    for (int i = 0; i < 8; ++i) {
        const f32x4 g = *(const f32x4*)(w + (i * 64 + lane) * 4);
        const float a = v[i][0] * r * g[0], b = v[i][1] * r * g[1], c = v[i][2] * r * g[2], d = v[i][3] * r * g[3];
        if (OUT_BF16) { uint2 o = make_uint2(pack2(a, b), pack2(c, d)); *(uint2*)((bf16_t*)out + (i * 64 + lane) * 4) = o; }
        else { f32x4 o = {a, b, c, d}; *(f32x4*)((float*)out + (i * 64 + lane) * 4) = o; }
    }
}

__device__ void phase_prep(const Params& P, int bid, int nb, unsigned char* smem) {
    float* tile = (float*)smem;
    const int tid = threadIdx.x;
    const int n_in = 32 * 114, n_sq = 32 * 32, n_pp = 4 * 32;
    const int n_tr = n_in + 3 * n_sq + n_pp;
    for (int u = bid; u < n_tr; u += nb) {
        if (u < n_in) transpose_tile<true>(P.w_in, IN_COLS, D, (bf16_t*)(P.ws + WS_WTIN), u % 32, u / 32, tile);
        else if (u < n_in + n_sq) { const int v = u - n_in; transpose_tile<false>(P.w_out, D, D, (bf16_t*)(P.ws + WS_WTOUT), v % 32, v / 32, tile); }
        else if (u < n_in + 2 * n_sq) { const int v = u - n_in - n_sq; transpose_tile<false>(P.w_pq, D, D, (bf16_t*)(P.ws + WS_WTPQ), v % 32, v / 32, tile); }
        else if (u < n_in + 3 * n_sq) { const int v = u - n_in - 2 * n_sq; transpose_tile<false>(P.w_ple_gate, D, D, (bf16_t*)(P.ws + WS_WTG), v % 32, v / 32, tile); }
        else { const int v = u - n_in - 3 * n_sq; transpose_tile<false>(P.w_ple_proj, D, 256, (bf16_t*)(P.ws + WS_WTPP), v % 4, v / 4, tile); }
    }
    {
        bf16_t* keys = (bf16_t*)(P.ws + WS_KEYS); bf16_t* pbf = (bf16_t*)(P.ws + WS_PBF);
        const int n4a = 262144 / 4, n4b = T * 256 / 4;
        for (int i = bid * 256 + tid; i < n4a + n4b; i += nb * 256) {
            const bool a = i < n4a; const int j = a ? i : i - n4a;
            const f32x4 v = *(const f32x4*)((a ? P.sub_keys : P.p) + (size_t)j * 4);
            *(uint2*)((a ? keys : pbf) + (size_t)j * 4) = make_uint2(pack2(v[0], v[1]), pack2(v[2], v[3]));
        }
    }
    {
        const int wave = tid >> 6, lane = tid & 63;
        bf16_t* hn = (bf16_t*)(P.ws + WS_HN);
        for (int r = bid * 4 + wave; r < T; r += nb * 4) rmsnorm_row<true>(P.x + (size_t)r * D, P.norm_mix, hn + (size_t)r * D, lane);
    }
}

__device__ __forceinline__ int lds_off(int row, int ch) { return row * 128 + ((ch ^ ((row >> 1) & 7)) << 4); }

__device__ __forceinline__ void gemm_mainloop(const bf16_t* __restrict__ A, int lda, const bf16_t* __restrict__ Bt, int ldb, int K,
                                              f32x16 (&acc)[2][2], unsigned char* smem) {
    const int tid = threadIdx.x, wave = tid >> 6, lane = tid & 63, wr = wave >> 1, wc = wave & 1;
    const int nk = K / 64;
    uint4 ra[4], rb[4];
    __syncthreads();
#pragma unroll
    for (int i = 0; i < 4; ++i) { const int c = tid + 256 * i, row = c >> 3, ch = c & 7;
        ra[i] = *(const uint4*)(A + (size_t)row * lda + ch * 8); rb[i] = *(const uint4*)(Bt + (size_t)row * ldb + ch * 8); }
#pragma unroll
    for (int i = 0; i < 4; ++i) { const int c = tid + 256 * i, row = c >> 3, ch = c & 7;
        *(uint4*)(smem + lds_off(row, ch)) = ra[i]; *(uint4*)(smem + 16384 + lds_off(row, ch)) = rb[i]; }
    __syncthreads();
    for (int kt = 0; kt < nk; ++kt) {
        unsigned char* cur = smem + (kt & 1) * 32768;
        unsigned char* nxt = smem + ((kt + 1) & 1) * 32768;
        const bool more = kt + 1 < nk;
        if (more) {
#pragma unroll
            for (int i = 0; i < 4; ++i) { const int c = tid + 256 * i, row = c >> 3, ch = c & 7;
                ra[i] = *(const uint4*)(A + (size_t)row * lda + (kt + 1) * 64 + ch * 8); rb[i] = *(const uint4*)(Bt + (size_t)row * ldb + (kt + 1) * 64 + ch * 8); }
        }
#pragma unroll
        for (int ks = 0; ks < 4; ++ks) {
            bf16x8 af[2], bfr[2];
#pragma unroll
            for (int i = 0; i < 2; ++i) { const int row = wr * 64 + i * 32 + (lane & 31); af[i] = *(const bf16x8*)(cur + lds_off(row, ks * 2 + (lane >> 5))); }
#pragma unroll
            for (int j = 0; j < 2; ++j) { const int row = wc * 64 + j * 32 + (lane & 31); bfr[j] = *(const bf16x8*)(cur + 16384 + lds_off(row, ks * 2 + (lane >> 5))); }
#pragma unroll
            for (int i = 0; i < 2; ++i)
#pragma unroll
                for (int j = 0; j < 2; ++j) acc[i][j] = __builtin_amdgcn_mfma_f32_32x32x16_bf16(af[i], bfr[j], acc[i][j], 0, 0, 0);
        }
        if (more) {
#pragma unroll
            for (int i = 0; i < 4; ++i) { const int c = tid + 256 * i, row = c >> 3, ch = c & 7;
                *(uint4*)(nxt + lds_off(row, ch)) = ra[i]; *(uint4*)(nxt + 16384 + lds_off(row, ch)) = rb[i]; }
        }
        __syncthreads();
    }
}
#define ACC_FOREACH(body)                                                                                   \
    { const int _tid = threadIdx.x, _wave = _tid >> 6, _lane = _tid & 63, _wr = _wave >> 1, _wc = _wave & 1; \
      _Pragma("unroll") for (int i = 0; i < 2; ++i) _Pragma("unroll") for (int j = 0; j < 2; ++j)          \
      _Pragma("unroll") for (int r = 0; r < 16; ++r) {                                                     \
          const int row = _wr * 64 + i * 32 + (r & 3) + 8 * (r >> 2) + 4 * (_lane >> 5);                   \
          const int col = _wc * 64 + j * 32 + (_lane & 31); body } }

__device__ __forceinline__ void zero_acc(f32x16 (&acc)[2][2]) {
#pragma unroll
    for (int i = 0; i < 2; ++i)
#pragma unroll
        for (int j = 0; j < 2; ++j)
#pragma unroll
            for (int r = 0; r < 16; ++r) acc[i][j][r] = 0.f;
}

__device__ void phase_gemm1(const Params& P, int bid, int nb, unsigned char* smem) {
    const bf16_t* A = (const bf16_t*)(P.ws + WS_HN); const bf16_t* Bt = (const bf16_t*)(P.ws + WS_WTIN); bf16_t* C = (bf16_t*)(P.ws + WS_PROJ);
    const int nmt = T / 128, nnt = NPROJ / 128;
    for (int t = bid; t < nmt * nnt; t += nb) {
        const int mt = t % nmt, nt = t / nmt;
        f32x16 acc[2][2]; zero_acc(acc);
        gemm_mainloop(A + (size_t)mt * 128 * D, D, Bt + (size_t)nt * 128 * D, D, D, acc, smem);
        ACC_FOREACH({ C[(size_t)(mt * 128 + row) * NPROJ + nt * 128 + col] = f2bf(acc[i][j][r]); })
    }
}
__device__ void phase_gemm2(const Params& P, int bid, int nb, unsigned char* smem) {
    const bf16_t* A = (const bf16_t*)(P.ws + WS_MIXED); const bf16_t* Bt = (const bf16_t*)(P.ws + WS_WTOUT); float* H = (float*)(P.ws + WS_H);
    const int nmt = T / 128, nnt = D / 128;
    for (int t = bid; t < nmt * nnt; t += nb) {
        const int mt = t % nmt, nt = t / nmt;
        f32x16 acc[2][2]; zero_acc(acc);
        gemm_mainloop(A + (size_t)mt * 128 * D, D, Bt + (size_t)nt * 128 * D, D, D, acc, smem);
        ACC_FOREACH({ const size_t o = (size_t)(mt * 128 + row) * D + nt * 128 + col; H[o] = P.x[o] + acc[i][j][r]; })
    }
}
__device__ void phase_gemm3(const Params& P, int bid, int nb, unsigned char* smem) {
    const bf16_t* A = (const bf16_t*)(P.ws + WS_HN); const bf16_t* Bt = (const bf16_t*)(P.ws + WS_WTPQ); bf16_t* C = (bf16_t*)(P.ws + WS_Q);
    const int nmt = T / 128, nnt = D / 128;
    for (int t = bid; t < nmt * nnt; t += nb) {
        const int mt = t % nmt, nt = t / nmt;
        f32x16 acc[2][2]; zero_acc(acc);
        gemm_mainloop(A + (size_t)mt * 128 * D, D, Bt + (size_t)nt * 128 * D, D, D, acc, smem);
        ACC_FOREACH({ C[(size_t)(mt * 128 + row) * D + nt * 128 + col] = f2bf(acc[i][j][r]); })
    }
}
__device__ void phase_scores(const Params& P, int bid, int nb, unsigned char* smem) {
    const bf16_t* A = (const bf16_t*)(P.ws + WS_Q); const bf16_t* Bt = (const bf16_t*)(P.ws + WS_KEYS); float* C = (float*)(P.ws + WS_SCORES);
    const int nmt = T / 128, nnt = 16;
    for (int t = bid; t < nmt * nnt; t += nb) {
        const int mt = t % nmt, nt = t / nmt;
        f32x16 acc[2][2]; zero_acc(acc);
        gemm_mainloop(A + (size_t)mt * 128 * D + nt * 128, D, Bt + (size_t)nt * 128 * 128, 128, 128, acc, smem);
        ACC_FOREACH({ C[(size_t)(mt * 128 + row) * D + nt * 128 + col] = acc[i][j][r]; })
    }
}
__device__ void phase_ple(const Params& P, int bid, int nb, unsigned char* smem) {
    const bf16_t* A2 = (const bf16_t*)(P.ws + WS_PBF); const bf16_t* Bt2 = (const bf16_t*)(P.ws + WS_WTPP); bf16_t* C = (bf16_t*)(P.ws + WS_PLE);
    const int nmt = T / 128, nnt = D / 128;
    for (int t = bid; t < nmt * nnt; t += nb) {
        const int mt = t % nmt, nt = t / nmt;
        f32x16 acc[2][2]; zero_acc(acc);
        gemm_mainloop(A2 + (size_t)mt * 128 * 256, 256, Bt2 + (size_t)nt * 128 * 256, 256, 256, acc, smem);
        ACC_FOREACH({ C[(size_t)(mt * 128 + row) * D + nt * 128 + col] = f2bf(acc[i][j][r]); })
    }
}
__device__ void phase_gemm4(const Params& P, int bid, int nb, unsigned char* smem) {
    const bf16_t* A = (const bf16_t*)(P.ws + WS_HN); const bf16_t* Bt = (const bf16_t*)(P.ws + WS_WTG);
    const bf16_t* ple = (const bf16_t*)(P.ws + WS_PLE); float* H = (float*)(P.ws + WS_H);
    const int nmt = T / 128, nnt = D / 128;
    for (int t = bid; t < nmt * nnt; t += nb) {
        const int mt = t % nmt, nt = t / nmt;
        f32x16 acc[2][2]; zero_acc(acc);
        gemm_mainloop(A + (size_t)mt * 128 * D, D, Bt + (size_t)nt * 128 * D, D, D, acc, smem);
        ACC_FOREACH({ const size_t o = (size_t)(mt * 128 + row) * D + nt * 128 + col; H[o] = H[o] + sigmoid_f(acc[i][j][r]) * bf2f(ple[o]); })
    }
}

template <bool OUT_BF16>
__device__ void phase_rownorm(const float* in, const float* w, void* out, int bid, int nb) {
    const int wave = threadIdx.x >> 6, lane = threadIdx.x & 63;
    for (int r = bid * 4 + wave; r < T; r += nb * 4) {
        if (OUT_BF16) rmsnorm_row<true>(in + (size_t)r * D, w, (bf16_t*)out + (size_t)r * D, lane);
        else rmsnorm_row<false>(in + (size_t)r * D, w, (float*)out + (size_t)r * D, lane);
    }
}

__device__ void phase_delta_prep(const Params& P, int bid, int nb) {
    const bf16_t* proj = (const bf16_t*)(P.ws + WS_PROJ); float* qkv = (float*)(P.ws + WS_QKV); float* gb = (float*)(P.ws + WS_GB);
    const int tid = threadIdx.x, wave = tid >> 6, lane = tid & 63;
    for (int t = bid; t < T; t += nb) {
        const int s = t % SEQ;
        for (int hd = wave; hd < 24; hd += 4) {
            const int c0 = hd * 128 + lane * 2;
            float y[2] = {0.f, 0.f};
#pragma unroll
            for (int j = 0; j < 4; ++j) {
                const int ss = s - 3 + j;
                if (ss >= 0) {
                    const unsigned pr = *(const unsigned*)(proj + (size_t)(t - 3 + j) * NPROJ + c0);
                    y[0] += bf2f((bf16_t)(pr & 0xffff)) * P.conv_w[(c0) * 4 + j];
                    y[1] += bf2f((bf16_t)(pr >> 16)) * P.conv_w[(c0 + 1) * 4 + j];
                }
            }
            y[0] = silu_f(y[0]); y[1] = silu_f(y[1]);
            if (hd < 16) {
                float ss2 = wave_sum(y[0] * y[0] + y[1] * y[1]);
                float r = rsqrtf(ss2 + EPS);
                if (hd < 8) r *= 0.08838834764831845f;
                y[0] *= r; y[1] *= r;
            }
            *(float2*)(qkv + (size_t)t * 3072 + c0) = make_float2(y[0], y[1]);
        }
        if (tid < 8) {
            const float a = bf2f(proj[(size_t)t * NPROJ + C_A + tid]), b = bf2f(proj[(size_t)t * NPROJ + C_B + tid]);
            const float xs = a + P.dt_bias[tid];
            const float sp = xs > 20.f ? xs : log1pf(expf(xs));
            gb[(size_t)t * 16 + tid] = -expf(P.a_log[tid]) * sp;
            gb[(size_t)t * 16 + 8 + tid] = 1.f / (1.f + expf(-b));
        }
    }
}

__device__ void phase_recur(const Params& P, int bid, int nb, unsigned char* smem) {
    const int tid = threadIdx.x;
    float* sq = (float*)smem;
    float* sk = sq + 16 * 128;
    float* sg = sk + 16 * 128;
    for (int u = bid; u < 32; u += nb) {
        if (u < 16) {
            const int b = u >> 3, h = u & 7;
            const float* qkv = (const float*)(P.ws + WS_QKV); const float* gb = (const float*)(P.ws + WS_GB); float* odn = (float*)(P.ws + WS_ODN);
            float S[64];
            const int colj = tid >> 1, half = tid & 1;
#pragma unroll
            for (int i = 0; i < 64; ++i) S[i] = 0.f;
            for (int t0 = 0; t0 < SEQ; t0 += 16) {
                __syncthreads();
                for (int e = tid; e < 16 * 128; e += 256) { const int tt = e >> 7, i = e & 127; const size_t tok = (size_t)b * SEQ + t0 + tt;
                    sq[e] = qkv[tok * 3072 + h * 128 + i]; sk[e] = qkv[tok * 3072 + 1024 + h * 128 + i]; }
                if (tid < 16) { const size_t tok = (size_t)b * SEQ + t0 + tid; sg[tid * 2] = expf(gb[tok * 16 + h]); sg[tid * 2 + 1] = gb[tok * 16 + 8 + h]; }
                __syncthreads();
                for (int tt = 0; tt < 16; ++tt) {
                    const size_t tok = (size_t)b * SEQ + t0 + tt;
                    const float v = qkv[tok * 3072 + 2048 + h * 128 + colj];
                    const float a = sg[tt * 2], be = sg[tt * 2 + 1];
                    const float* kk = sk + tt * 128 + half * 64; const float* qq = sq + tt * 128 + half * 64;
                    float ks = 0.f;
#pragma unroll
                    for (int i = 0; i < 64; ++i) ks += kk[i] * S[i];
                    ks += __shfl_xor(ks, 1);
                    const float coef = be * (v - a * ks);
                    float o = 0.f;
#pragma unroll
                    for (int i = 0; i < 64; ++i) { S[i] = a * S[i] + kk[i] * coef; o += qq[i] * S[i]; }
                    o += __shfl_xor(o, 1);
                    if (half == 0) odn[tok * 1024 + h * 128 + colj] = o;
                }
            }
        } else {
            const int b = (u - 16) >> 3, h = (u - 16) & 7;
            const bf16_t* proj = (const bf16_t*)(P.ws + WS_PROJ); float* oret = (float*)(P.ws + WS_ORET);
            const float gamma = 1.f - exp2f(-5.f - (float)h);
            float S[64];
#pragma unroll
            for (int i = 0; i < 64; ++i) S[i] = 0.f;
            for (int t0 = 0; t0 < SEQ; t0 += 16) {
                __syncthreads();
                for (int e = tid; e < 16 * 32; e += 256) {
                    const int tt = e >> 5, i = e & 31; const size_t tok = (size_t)b * SEQ + t0 + tt;
                    const float inv = powf(10000.f, -(float)i / 32.f);
                    const float ang = (float)P.positions[tok] * inv;
                    float sn, cs; sincosf(ang, &sn, &cs);
                    const float q1 = bf2f(proj[tok * NPROJ + C_RQ + h * 64 + i]), q2 = bf2f(proj[tok * NPROJ + C_RQ + h * 64 + 32 + i]);
                    const float k1 = bf2f(proj[tok * NPROJ + C_RK + h * 64 + i]) * 0.125f, k2 = bf2f(proj[tok * NPROJ + C_RK + h * 64 + 32 + i]) * 0.125f;
                    sq[tt * 128 + i] = q1 * cs - q2 * sn; sq[tt * 128 + 32 + i] = q1 * sn + q2 * cs;
                    sk[tt * 128 + i] = k1 * cs - k2 * sn; sk[tt * 128 + 32 + i] = k1 * sn + k2 * cs;
                }
                __syncthreads();
                if (tid < 128) {
                    for (int tt = 0; tt < 16; ++tt) {
                        const size_t tok = (size_t)b * SEQ + t0 + tt;
                        const float v = bf2f(proj[tok * NPROJ + C_RV + h * 128 + tid]);
                        const float* kk = sk + tt * 128; const float* qq = sq + tt * 128;
                        float o = 0.f;
#pragma unroll
                        for (int i = 0; i < 64; ++i) { S[i] = gamma * S[i] + kk[i] * v; o += qq[i] * S[i]; }
                        oret[tok * 1024 + h * 128 + tid] = o;
                    }
                }
            }
        }
    }
}

__device__ void phase_mix(const Params& P, int bid, int nb) {
    const bf16_t* proj = (const bf16_t*)(P.ws + WS_PROJ); const float* odn = (const float*)(P.ws + WS_ODN); const float* oret = (const float*)(P.ws + WS_ORET);
    bf16_t* mixed = (bf16_t*)(P.ws + WS_MIXED);
    const int wave = threadIdx.x >> 6, lane = threadIdx.x & 63;
    for (int u = bid * 4 + wave; u < T * 16; u += nb * 4) {
        const int t = u >> 4, gph = u & 15;
        if (gph < 8) {
            const int h = gph, j = h * 128 + lane * 2;
            const float2 o = *(const float2*)(odn + (size_t)t * 1024 + j);
            const float ms = wave_sum(o.x * o.x + o.y * o.y) * (1.f / 128.f);
            const float r = rsqrtf(ms + EPS);
            const unsigned zz = *(const unsigned*)(proj + (size_t)t * NPROJ + C_Z + j);
            const float z0 = bf2f((bf16_t)(zz & 0xffff)), z1 = bf2f((bf16_t)(zz >> 16));
            const float y0 = o.x * r * P.dn_norm[lane * 2] * silu_f(z0), y1 = o.y * r * P.dn_norm[lane * 2 + 1] * silu_f(z1);
            *(unsigned*)(mixed + (size_t)t * D + j) = pack2(y0, y1);
        } else {
            const int h = gph - 8, j = h * 128 + lane * 2;
            const float2 o = *(const float2*)(oret + (size_t)t * 1024 + j);
            const float mu = wave_sum(o.x + o.y) * (1.f / 128.f);
            const float d0 = o.x - mu, d1 = o.y - mu;
            const float var = wave_sum(d0 * d0 + d1 * d1) * (1.f / 128.f);
            const float r = rsqrtf(var + EPS);
            const unsigned gg = *(const unsigned*)(proj + (size_t)t * NPROJ + C_RG + j);
            const float g0 = bf2f((bf16_t)(gg & 0xffff)), g1 = bf2f((bf16_t)(gg >> 16));
            const float y0 = (d0 * r * P.ret_gn_w[j] + P.ret_gn_b[j]) * silu_f(g0), y1 = (d1 * r * P.ret_gn_w[j + 1] + P.ret_gn_b[j + 1]) * silu_f(g1);
            *(unsigned*)(mixed + (size_t)t * D + 1024 + j) = pack2(y0, y1);
        }
    }
}

__device__ void phase_route(const Params& P, int bid, int nb) {
    const float* scores = (const float*)(P.ws + WS_SCORES); int* idx = (int*)(P.ws + WS_IDX); float* gates = (float*)(P.ws + WS_GATES);
    const int wave = threadIdx.x >> 6, lane = threadIdx.x & 63;
    const float NEG = -3.0e38f;
    for (int u = bid * 4 + wave; u < T * 8; u += nb * 4) {
        const int t = u >> 3, h = u & 7;
        float top_s[2]; int top_i[2];
#pragma unroll
        for (int p = 0; p < 2; ++p) {
            const float* sp = scores + (size_t)t * D + (h * 2 + p) * 128;
            float k0 = __uint_as_float((__float_as_uint(sp[lane]) & ~0x7Fu) | (unsigned)lane);
            float k1 = __uint_as_float((__float_as_uint(sp[lane + 64]) & ~0x7Fu) | (unsigned)(lane + 64));
            float mine = 0.f;
            for (int r = 0; r < 16; ++r) {
                const float m = wave_max(fmaxf(k0, k1));
                if (k0 == m) k0 = NEG;
                if (k1 == m) k1 = NEG;
                if (lane == r) mine = m;
            }
            top_i[p] = (int)(__float_as_uint(mine) & 0x7Fu);
            top_s[p] = mine;
        }
        float ck[4];
#pragma unroll
        for (int e = 0; e < 4; ++e) {
            const int cand = lane * 4 + e, i = cand >> 4, j = cand & 15;
            const float s = __shfl(top_s[0], i) + __shfl(top_s[1], j);
            ck[e] = __uint_as_float((__float_as_uint(s) & ~0xFFu) | (unsigned)cand);
        }
        float mine = 0.f;
        for (int r = 0; r < 16; ++r) {
            const float m = wave_max(fmaxf(fmaxf(ck[0], ck[1]), fmaxf(ck[2], ck[3])));
#pragma unroll
            for (int e = 0; e < 4; ++e) if (ck[e] == m) ck[e] = NEG;
            if (lane == r) mine = m;
        }
        const int cand = (int)(__float_as_uint(mine) & 0xFFu);
        const int i1 = __shfl(top_i[0], cand >> 4), i2 = __shfl(top_i[1], cand & 15);
        const float smax = __shfl(mine, 0);
        float e = (lane < 16) ? __expf(mine - smax) : 0.f;
        const float sum = wave_sum(e);
        if (lane < 16) { idx[(size_t)t * 128 + h * 16 + lane] = i1 * 128 + i2; gates[(size_t)t * 128 + h * 16 + lane] = e / sum; }
    }
}

__device__ void phase_peer(const Params& P, int bid, int nb) {
    const bf16_t* hn = (const bf16_t*)(P.ws + WS_HN); const int* idx = (const int*)(P.ws + WS_IDX); const float* gates = (const float*)(P.ws + WS_GATES);
    float* H = (float*)(P.ws + WS_H);
    const int wave = threadIdx.x >> 6, lane = threadIdx.x & 63;
    for (int t = bid * 4 + wave; t < T; t += nb * 4) {
        f32x4 xr[8], acc[8];
#pragma unroll
        for (int i = 0; i < 8; ++i) {
            const uint2 v = *(const uint2*)(hn + (size_t)t * D + (i * 64 + lane) * 4);
            xr[i][0] = bf2f((bf16_t)(v.x & 0xffff)); xr[i][1] = bf2f((bf16_t)(v.x >> 16)); xr[i][2] = bf2f((bf16_t)(v.y & 0xffff)); xr[i][3] = bf2f((bf16_t)(v.y >> 16));
            acc[i] = (f32x4){0.f, 0.f, 0.f, 0.f};
        }
        for (int k = 0; k < 128; ++k) {
            const int e = idx[(size_t)t * 128 + k]; const float g = gates[(size_t)t * 128 + k];
            const f32x4* up = (const f32x4*)(P.expert_u + (size_t)e * D); const f32x4* vp = (const f32x4*)(P.expert_v + (size_t)e * D);
            f32x4 uv[8], vv[8];
#pragma unroll
            for (int i = 0; i < 8; ++i) { uv[i] = up[i * 64 + lane]; vv[i] = vp[i * 64 + lane]; }
            float d = 0.f;
#pragma unroll
            for (int i = 0; i < 8; ++i) d += uv[i][0] * xr[i][0] + uv[i][1] * xr[i][1] + uv[i][2] * xr[i][2] + uv[i][3] * xr[i][3];
            d = wave_sum(d);
            const float a = 0.5f * d * (1.f + erff(d * 0.70710678118654752f)) * g;
#pragma unroll
            for (int i = 0; i < 8; ++i) acc[i] += vv[i] * a;
        }
#pragma unroll
        for (int i = 0; i < 8; ++i) { f32x4* hp = (f32x4*)(H + (size_t)t * D + (i * 64 + lane) * 4); *hp = *hp + acc[i]; }
    }
}

enum { PH_PREP = 0, PH_GEMM1, PH_DPREP, PH_RECUR, PH_MIX, PH_GEMM2, PH_NORM2, PH_GEMM3, PH_SCORES, PH_ROUTE, PH_PEER, PH_NORM3, PH_PLE, PH_GEMM4, PH_FINAL, PH_COUNT };

#define XB_TMO      128
#define XB_XCNT(j)  (256  + 64 * (j))
#define XB_XSUB(j)  (1280 + 64 * (j))
#define XB_XGEN(j)  (2304 + 64 * (j))
#define XB_TOP      3328
#define XB_TOPGEN   3392
#define XCD_BAR_WORDS 3456
#define XB_SPIN_CAP (1u << 20)
#define LAS __attribute__((address_space(3)))
__device__ __forceinline__ unsigned xb_ld(unsigned* p)              { return __hip_atomic_load(p, __ATOMIC_RELAXED, __HIP_MEMORY_SCOPE_AGENT); }
__device__ __forceinline__ unsigned xb_add(unsigned* p, unsigned v) { return __hip_atomic_fetch_add(p, v, __ATOMIC_RELAXED, __HIP_MEMORY_SCOPE_AGENT); }
__device__ __forceinline__ unsigned xb_xcc_id() { return (unsigned)__builtin_amdgcn_s_getreg((3 << 11) | 20) & 0xFu; }
#define XB_SPIN(cond, bar) do { unsigned _sp = 0; while (cond) { __builtin_amdgcn_s_sleep(1); \
    if ((++_sp & 255u) == 0u) { if (xb_ld(&(bar)[XB_TMO])) break; if (_sp > XB_SPIN_CAP) { atomicAdd(&(bar)[XB_TMO], 1u); break; } } } } while (0)
struct XcdBarrier { unsigned* bar; unsigned x; volatile LAS unsigned* st; };
__device__ __forceinline__ XcdBarrier xcd_barrier_post(unsigned* bar, volatile LAS unsigned* st) {
    XcdBarrier b; b.bar = bar; b.x = xb_xcc_id(); b.st = st;
    if (threadIdx.x == 0) (void)xb_add(&bar[XB_XCNT(b.x)], 1u);
    return b;
}
__device__ __forceinline__ void xcd_barrier_complete(unsigned* bar, unsigned x, unsigned& nloc, unsigned& nx) {
    const unsigned G = gridDim.x * gridDim.y * gridDim.z;
    unsigned sum, cnt, mine, sp = 0u;
    for (;;) {
        sum = 0u; cnt = 0u; mine = 0u;
#pragma unroll
        for (unsigned j = 0; j < 16; ++j) { const unsigned c = xb_ld(&bar[XB_XCNT(j)]); sum += c; cnt += (c > 0u) ? 1u : 0u; mine = (j == x) ? c : mine; }
        if (sum == G) break;
        __builtin_amdgcn_s_sleep(1);
        if ((++sp & 255u) == 0u) { if (xb_ld(&bar[XB_TMO])) break; if (sp > XB_SPIN_CAP) { atomicAdd(&bar[XB_TMO], 1u); break; } }
    }
    nloc = mine > 0u ? mine : 1u; nx = cnt > 0u ? cnt : 1u;
}
__device__ __forceinline__ void xcd_barrier(const XcdBarrier& b) {
    asm volatile("s_waitcnt vmcnt(0)" ::: "memory");
    __syncthreads();
    if (threadIdx.x == 0) {
        unsigned* bar = b.bar;
        __builtin_amdgcn_s_waitcnt(0);
        unsigned nloc = b.st[0], nx = b.st[1];
        if (nloc == 0u) { xcd_barrier_complete(bar, b.x, nloc, nx); b.st[0] = nloc; b.st[1] = nx; }
        const unsigned old = xb_add(&bar[XB_XSUB(b.x)], 1u);
        const unsigned gen = old / nloc;
        if (old + 1u == (gen + 1u) * nloc) {
            __builtin_amdgcn_fence(__ATOMIC_RELEASE, "agent");
            asm volatile("s_waitcnt vmcnt(0)" ::: "memory");
            const unsigned og = xb_add(&bar[XB_TOP], 1u);
            const unsigned tg = og / nx;
            if (og + 1u == (tg + 1u) * nx) xb_add(&bar[XB_TOPGEN], 1u);
            else XB_SPIN(xb_ld(&bar[XB_TOPGEN]) == tg, bar);
            __builtin_amdgcn_fence(__ATOMIC_ACQUIRE, "agent");
            xb_add(&bar[XB_XGEN(b.x)], 1u);
            asm volatile("s_waitcnt vmcnt(0)" ::: "memory");
        } else {
            XB_SPIN(xb_ld(&bar[XB_XGEN(b.x)]) == gen, bar);
            __builtin_amdgcn_fence(__ATOMIC_ACQUIRE, "agent");
            asm volatile("s_waitcnt vmcnt(0)" ::: "memory");
        }
    }
    __syncthreads();
}

__device__ __forceinline__ void run_phase(const Params& P, int ph, int bid, int nb, unsigned char* smem) {
    switch (ph) {
        case PH_PREP:   phase_prep(P, bid, nb, smem); break;
        case PH_GEMM1:  phase_gemm1(P, bid, nb, smem); break;
        case PH_DPREP:  phase_delta_prep(P, bid, nb); break;
        case PH_RECUR:  phase_recur(P, bid, nb, smem); break;
        case PH_MIX:    phase_mix(P, bid, nb); break;
        case PH_GEMM2:  phase_gemm2(P, bid, nb, smem); break;
        case PH_NORM2:  phase_rownorm<true>((const float*)(P.ws + WS_H), P.norm_ffn, P.ws + WS_HN, bid, nb); break;
        case PH_GEMM3:  phase_gemm3(P, bid, nb, smem); break;
        case PH_SCORES: phase_scores(P, bid, nb, smem); break;
        case PH_ROUTE:  phase_route(P, bid, nb); break;
        case PH_PEER:   phase_peer(P, bid, nb); break;
        case PH_NORM3:  phase_rownorm<true>((const float*)(P.ws + WS_H), P.norm_ple, P.ws + WS_HN, bid, nb); break;
        case PH_PLE:    phase_ple(P, bid, nb, smem); break;
        case PH_GEMM4:  phase_gemm4(P, bid, nb, smem); break;
        case PH_FINAL:  phase_rownorm<false>((const float*)(P.ws + WS_H), P.norm_final, P.out, bid, nb); break;
    }
}

constexpr int LDS_BYTES = 65536 + 16;

__global__ void __launch_bounds__(256, 2) fwd_kernel(Params P, int ph_lo, int ph_hi) {
    extern __shared__ __attribute__((aligned(16))) unsigned char smem[];
    const int bid = blockIdx.x, nb = gridDim.x;
    volatile LAS unsigned* st = (volatile LAS unsigned*)(smem + 65536);
    if (threadIdx.x == 0) { st[0] = 0u; st[1] = 0u; }
    __syncthreads();
    XcdBarrier xb = xcd_barrier_post((unsigned*)(P.ws + WS_BAR), st);
#define RUN(ph) if (ph_lo <= (ph) && (ph) < ph_hi) { run_phase(P, (ph), bid, nb, smem); if ((ph) + 1 < ph_hi) xcd_barrier(xb); }
    RUN(PH_PREP) RUN(PH_GEMM1) RUN(PH_DPREP) RUN(PH_RECUR) RUN(PH_MIX) RUN(PH_GEMM2) RUN(PH_NORM2) RUN(PH_GEMM3) RUN(PH_SCORES) RUN(PH_ROUTE)
    RUN(PH_PEER) RUN(PH_NORM3) RUN(PH_PLE) RUN(PH_GEMM4) RUN(PH_FINAL)
}

extern "C" void kernel_launch(void* const* d_in, const int* in_sizes, int n_in, void* d_out, int out_size, void* d_ws, size_t ws_size, hipStream_t stream) {
    static int grid = 0;
    if (grid == 0) {
        if (n_in != 21 || out_size != T * D || ws_size < WS_END) { fprintf(stderr, "kernel_launch: unexpected shapes: n_in %d out %d ws %zu (need %zu)\n", n_in, out_size, ws_size, (size_t)WS_END); grid = -1; return; }
        if (hipFuncSetAttribute((const void*)fwd_kernel, hipFuncAttributeMaxDynamicSharedMemorySize, LDS_BYTES) != hipSuccess) { fprintf(stderr, "kernel_launch: hipFuncSetAttribute failed\n"); grid = -1; return; }
        int dev = 0, cus = 0, per_cu = 0;
        hipGetDevice(&dev); hipDeviceGetAttribute(&cus, hipDeviceAttributeMultiprocessorCount, dev);
        if (hipOccupancyMaxActiveBlocksPerMultiprocessor(&per_cu, (const void*)fwd_kernel, 256, LDS_BYTES) != hipSuccess || per_cu < 1) { fprintf(stderr, "kernel_launch: occupancy query failed (%d)\n", per_cu); grid = -1; return; }
        if (per_cu > 2) per_cu = 2;
        grid = cus * per_cu;
        fprintf(stderr, "kernel_launch: grid %d (%d CUs x %d)\n", grid, cus, per_cu);
    }
    if (grid < 0) return;
    Params P{};
    P.x = (const float*)d_in[0]; P.p = (const float*)d_in[1]; P.positions = (const int*)d_in[2]; P.norm_mix = (const float*)d_in[3]; P.w_in = (const float*)d_in[4];
    P.conv_w = (const float*)d_in[5]; P.a_log = (const float*)d_in[6]; P.dt_bias = (const float*)d_in[7]; P.dn_norm = (const float*)d_in[8]; P.ret_gn_w = (const float*)d_in[9];
    P.ret_gn_b = (const float*)d_in[10]; P.w_out = (const float*)d_in[11]; P.norm_ffn = (const float*)d_in[12]; P.w_pq = (const float*)d_in[13]; P.sub_keys = (const float*)d_in[14];
    P.expert_u = (const float*)d_in[15]; P.expert_v = (const float*)d_in[16]; P.norm_ple = (const float*)d_in[17]; P.w_ple_gate = (const float*)d_in[18]; P.w_ple_proj = (const float*)d_in[19];
    P.norm_final = (const float*)d_in[20]; P.out = (float*)d_out; P.ws = (unsigned char*)d_ws;
    (void)hipMemsetAsync((unsigned char*)d_ws + WS_BAR, 0, XCD_BAR_WORDS * 4, stream);
    int lo = 0, hi = PH_COUNT;
    void* args[] = {&P, &lo, &hi};
    hipError_t e = hipLaunchCooperativeKernel((const void*)fwd_kernel, dim3(grid), dim3(256), args, LDS_BYTES, stream);
    if (e != hipSuccess) fprintf(stderr, "kernel_launch: cooperative launch failed: %s (grid %d)\n", hipGetErrorString(e), grid);
}
```

```cpp
#include <hip/hip_runtime.h>
#include <cstdio>
#include <cstdint>

typedef unsigned short bf16_t;
typedef short bf16x8 __attribute__((ext_vector_type(8)));
typedef float f32x16 __attribute__((ext_vector_type(16)));
typedef float f32x4 __attribute__((ext_vector_type(4)));

constexpr int T = 8192, D = 2048, SEQ = 4096;
constexpr int NPROJ = 7296;
constexpr int C_Z = 3072, C_RQ = 4096, C_RK = 4608, C_RV = 5120, C_RG = 6144, C_A = 7168, C_B = 7176;
constexpr int IN_COLS = 7184;
constexpr float EPS = 1e-6f;

constexpr size_t WS_HN    = 0;
constexpr size_t WS_KVT   = WS_HN;
constexpr size_t WS_WTIN  = WS_HN + (size_t)T * D * 2;
constexpr size_t WS_STR   = WS_WTIN;
constexpr size_t WS_ATTR  = WS_STR + (size_t)1024 * 128 * 64 * 2;
constexpr size_t WS_WTOUT = WS_WTIN + (size_t)NPROJ * D * 2;
constexpr size_t WS_WTPQ  = WS_WTOUT + (size_t)D * D * 2;
constexpr size_t WS_WTG   = WS_WTPQ + (size_t)D * D * 2;
constexpr size_t WS_WTPP  = WS_WTG + (size_t)D * D * 2;
constexpr size_t WS_KEYS  = WS_WTPP + (size_t)D * 256 * 2;
constexpr size_t WS_PBF   = WS_KEYS + (size_t)16 * 128 * 128 * 2;
constexpr size_t WS_PROJ  = WS_PBF + (size_t)T * 256 * 2;
constexpr size_t WS_Q     = WS_PROJ;
constexpr size_t WS_SCORES= WS_PROJ + (size_t)T * D * 2;
constexpr size_t WS_MIXED = WS_PROJ + (size_t)T * NPROJ * 2;
constexpr size_t WS_H     = WS_MIXED + (size_t)T * D * 2;
constexpr size_t WS_IDX   = WS_H + (size_t)T * D * 4;
constexpr size_t WS_GATES = WS_IDX + (size_t)T * 128 * 4;
constexpr size_t WS_U     = WS_GATES + (size_t)T * 128 * 4;
constexpr size_t WS_PLE   = WS_U;
constexpr size_t WS_W     = WS_U + (size_t)1024 * 64 * 128 * 4;
constexpr size_t WS_KDT   = WS_W + (size_t)1024 * 64 * 128 * 2;
constexpr size_t WS_QG    = WS_KDT + (size_t)1024 * 128 * 64 * 2;
constexpr size_t WS_ATT   = WS_QG + (size_t)1024 * 64 * 128 * 2;
constexpr size_t WS_VNT   = WS_ATT + (size_t)1024 * 64 * 64 * 2;
constexpr size_t WS_SC    = WS_VNT + (size_t)1024 * 128 * 64 * 2;
constexpr size_t WS_QGR   = WS_SC + (size_t)1024 * 128 * 128 * 2;
constexpr size_t WS_VNTR  = WS_QGR + (size_t)1024 * 64 * 64 * 2;
constexpr size_t WS_EG    = WS_VNTR + (size_t)1024 * 128 * 64 * 2;
constexpr size_t WS_BAR   = WS_EG + 4096;
constexpr size_t WS_END   = WS_BAR + 16384;

struct Params {
    const float *x, *p; const int* positions;
    const float *norm_mix, *w_in, *conv_w, *a_log, *dt_bias, *dn_norm, *ret_gn_w, *ret_gn_b, *w_out, *norm_ffn, *w_pq, *sub_keys,
                *expert_u, *expert_v, *norm_ple, *w_ple_gate, *w_ple_proj, *norm_final;
    float* out; unsigned char* ws;
};

__device__ __forceinline__ bf16_t f2bf(float f) { unsigned u = __float_as_uint(f); u += 0x7fffu + ((u >> 16) & 1u); return (bf16_t)(u >> 16); }
__device__ __forceinline__ float bf2f(bf16_t h) { return __uint_as_float(((unsigned)h) << 16); }
__device__ __forceinline__ unsigned pack2(float a, float b) { return (unsigned)f2bf(a) | ((unsigned)f2bf(b) << 16); }
__device__ __forceinline__ float wave_sum(float v) {
#pragma unroll
    for (int o = 32; o >= 1; o >>= 1) v += __shfl_xor(v, o);
    return v;
}
__device__ __forceinline__ float wave_max(float v) {
#pragma unroll
    for (int o = 32; o >= 1; o >>= 1) v = fmaxf(v, __shfl_xor(v, o));
    return v;
}
__device__ __forceinline__ float silu_f(float x) { return x / (1.f + __expf(-x)); }
__device__ __forceinline__ float sigmoid_f(float x) { return 1.f / (1.f + __expf(-x)); }

template <bool MAPIN>
__device__ __forceinline__ void transpose_tile(const float* __restrict__ W, int ldw, int K, bf16_t* __restrict__ Wt, int kt, int nt, float* tile  ) {
    const int tid = threadIdx.x;
    __syncthreads();
#pragma unroll
    for (int i = 0; i < 4; ++i) {
        const int idx = tid + 256 * i, kr = idx >> 4, c4 = idx & 15;
        const int n = nt * 64 + c4 * 4;
        int c = n; bool valid = true;
        if (MAPIN) { if (n < 4096) c = n; else if (n < 7168) c = n + 16; else if (n < 7184) c = n - 3072; else valid = false; }
        f32x4 v = {0.f, 0.f, 0.f, 0.f};
        if (valid) v = *(const f32x4*)(W + (size_t)(kt * 64 + kr) * ldw + c);
        float* d = tile + kr * 65 + c4 * 4;
        d[0] = v[0]; d[1] = v[1]; d[2] = v[2]; d[3] = v[3];
    }
    __syncthreads();
#pragma unroll
    for (int i = 0; i < 2; ++i) {
        const int ch = tid + 256 * i, n = ch >> 3, kc = ch & 7;
        unsigned w[4];
#pragma unroll
        for (int j = 0; j < 4; ++j) w[j] = pack2(tile[(kc * 8 + 2 * j) * 65 + n], tile[(kc * 8 + 2 * j + 1) * 65 + n]);
        uint4 o = make_uint4(w[0], w[1], w[2], w[3]);
        *(uint4*)(Wt + (size_t)(nt * 64 + n) * K + kt * 64 + kc * 8) = o;
    }
}

template <bool OUT_BF16>
__device__ __forceinline__ void rmsnorm_row(const float* __restrict__ in, const float* __restrict__ w, void* __restrict__ out, int lane) {
    f32x4 v[8]; float ss = 0.f;
#pragma unroll
    for (int i = 0; i < 8; ++i) { v[i] = *(const f32x4*)(in + (i * 64 + lane) * 4); ss += v[i][0] * v[i][0] + v[i][1] * v[i][1] + v[i][2] * v[i][2] + v[i][3] * v[i][3]; }
    ss = wave_sum(ss);
    const float r = rsqrtf(ss * (1.f / 2048.f) + EPS);
#pragma unroll
    for (int i = 0; i < 8; ++i) {
        const f32x4 g = *(const f32x4*)(w + (i * 64 + lane) * 4);
        const float a = v[i][0] * r * g[0], b = v[i][1] * r * g[1], c = v[i][2] * r * g[2], d = v[i][3] * r * g[3];
        if (OUT_BF16) { uint2 o = make_uint2(pack2(a, b), pack2(c, d)); *(uint2*)((bf16_t*)out + (i * 64 + lane) * 4) = o; }
        else { f32x4 o = {a, b, c, d}; *(f32x4*)((float*)out + (i * 64 + lane) * 4) = o; }
    }
}

__device__ __forceinline__ void phase_prep(const Params& P, int bid, int nb, unsigned char* smem) {
    float* tile = (float*)smem;
    const int tid = threadIdx.x;
    const int n_in = 32 * 114, n_sq = 32 * 32, n_pp = 4 * 32;
    const int n_tr = n_in + 3 * n_sq + n_pp;
    for (int u = bid; u < n_tr; u += nb) {
        if (u < n_in) transpose_tile<true>(P.w_in, IN_COLS, D, (bf16_t*)(P.ws + WS_WTIN), u % 32, u / 32, tile);
        else if (u < n_in + n_sq) { const int v = u - n_in; transpose_tile<false>(P.w_out, D, D, (bf16_t*)(P.ws + WS_WTOUT), v % 32, v / 32, tile); }
        else if (u < n_in + 2 * n_sq) { const int v = u - n_in - n_sq; transpose_tile<false>(P.w_pq, D, D, (bf16_t*)(P.ws + WS_WTPQ), v % 32, v / 32, tile); }
        else if (u < n_in + 3 * n_sq) { const int v = u - n_in - 2 * n_sq; transpose_tile<false>(P.w_ple_gate, D, D, (bf16_t*)(P.ws + WS_WTG), v % 32, v / 32, tile); }
        else { const int v = u - n_in - 3 * n_sq; transpose_tile<false>(P.w_ple_proj, D, 256, (bf16_t*)(P.ws + WS_WTPP), v % 4, v / 4, tile); }
    }
    {
        bf16_t* keys = (bf16_t*)(P.ws + WS_KEYS); bf16_t* pbf = (bf16_t*)(P.ws + WS_PBF);
        const int n4a = 262144 / 4, n4b = T * 256 / 4;
        for (int i = bid * 256 + tid; i < n4a + n4b; i += nb * 256) {
            const bool a = i < n4a; const int j = a ? i : i - n4a;
            const f32x4 v = *(const f32x4*)((a ? P.sub_keys : P.p) + (size_t)j * 4);
            *(uint2*)((a ? keys : pbf) + (size_t)j * 4) = make_uint2(pack2(v[0], v[1]), pack2(v[2], v[3]));
        }
    }
    {
        const int wave = tid >> 6, lane = tid & 63;
        bf16_t* hn = (bf16_t*)(P.ws + WS_HN);
        for (int r = bid * 4 + wave; r < T; r += nb * 4) rmsnorm_row<true>(P.x + (size_t)r * D, P.norm_mix, hn + (size_t)r * D, lane);
    }
}

__device__ __forceinline__ int lds_off(int row, int ch) { return row * 128 + ((ch ^ ((row >> 1) & 7)) << 4); }

__device__ __forceinline__ void gemm_mainloop(const bf16_t* __restrict__ A, int lda, const bf16_t* __restrict__ Bt, int ldb, int K,
                                              f32x16 (&acc)[2][2], unsigned char* smem) {
    const int tid = threadIdx.x, wave = tid >> 6, lane = tid & 63, wr = wave >> 1, wc = wave & 1;
    const int nk = K / 64;
    uint4 ra[4], rb[4];
    __syncthreads();
#pragma unroll
    for (int i = 0; i < 4; ++i) { const int c = tid + 256 * i, row = c >> 3, ch = c & 7;
        ra[i] = *(const uint4*)(A + (size_t)row * lda + ch * 8); rb[i] = *(const uint4*)(Bt + (size_t)row * ldb + ch * 8); }
#pragma unroll
    for (int i = 0; i < 4; ++i) { const int c = tid + 256 * i, row = c >> 3, ch = c & 7;
        *(uint4*)(smem + lds_off(row, ch)) = ra[i]; *(uint4*)(smem + 16384 + lds_off(row, ch)) = rb[i]; }
    __syncthreads();
    for (int kt = 0; kt < nk; ++kt) {
        unsigned char* cur = smem + (kt & 1) * 32768;
        unsigned char* nxt = smem + ((kt + 1) & 1) * 32768;
        const bool more = kt + 1 < nk;
        if (more) {
#pragma unroll
            for (int i = 0; i < 4; ++i) { const int c = tid + 256 * i, row = c >> 3, ch = c & 7;
                ra[i] = *(const uint4*)(A + (size_t)row * lda + (kt + 1) * 64 + ch * 8); rb[i] = *(const uint4*)(Bt + (size_t)row * ldb + (kt + 1) * 64 + ch * 8); }
        }
#pragma unroll
        for (int ks = 0; ks < 4; ++ks) {
            bf16x8 af[2], bfr[2];
#pragma unroll
            for (int i = 0; i < 2; ++i) { const int row = wr * 64 + i * 32 + (lane & 31); af[i] = *(const bf16x8*)(cur + lds_off(row, ks * 2 + (lane >> 5))); }
#pragma unroll
            for (int j = 0; j < 2; ++j) { const int row = wc * 64 + j * 32 + (lane & 31); bfr[j] = *(const bf16x8*)(cur + 16384 + lds_off(row, ks * 2 + (lane >> 5))); }
#pragma unroll
            for (int i = 0; i < 2; ++i)
#pragma unroll
                for (int j = 0; j < 2; ++j) acc[i][j] = __builtin_amdgcn_mfma_f32_32x32x16_bf16(af[i], bfr[j], acc[i][j], 0, 0, 0);
        }
        if (more) {
#pragma unroll
            for (int i = 0; i < 4; ++i) { const int c = tid + 256 * i, row = c >> 3, ch = c & 7;
                *(uint4*)(nxt + lds_off(row, ch)) = ra[i]; *(uint4*)(nxt + 16384 + lds_off(row, ch)) = rb[i]; }
        }
        __syncthreads();
    }
}
#define ACC_FOREACH(body)                                                                                   \
    { const int _tid = threadIdx.x, _wave = _tid >> 6, _lane = _tid & 63, _wr = _wave >> 1, _wc = _wave & 1; \
      _Pragma("unroll") for (int i = 0; i < 2; ++i) _Pragma("unroll") for (int j = 0; j < 2; ++j)          \
      _Pragma("unroll") for (int r = 0; r < 16; ++r) {                                                     \
          const int row = _wr * 64 + i * 32 + (r & 3) + 8 * (r >> 2) + 4 * (_lane >> 5);                   \
          const int col = _wc * 64 + j * 32 + (_lane & 31); body } }

__device__ __forceinline__ void zero_acc(f32x16 (&acc)[2][2]) {
#pragma unroll
    for (int i = 0; i < 2; ++i)
#pragma unroll
        for (int j = 0; j < 2; ++j)
#pragma unroll
            for (int r = 0; r < 16; ++r) acc[i][j][r] = 0.f;
}

__device__ __forceinline__ void phase_gemm1(const Params& P, int bid, int nb, unsigned char* smem) {
    const bf16_t* A = (const bf16_t*)(P.ws + WS_HN); const bf16_t* Bt = (const bf16_t*)(P.ws + WS_WTIN); bf16_t* C = (bf16_t*)(P.ws + WS_PROJ);
    const int nmt = T / 128, nnt = NPROJ / 128;
    for (int t = bid; t < nmt * nnt; t += nb) {
        const int mt = t % nmt, nt = t / nmt;
        f32x16 acc[2][2]; zero_acc(acc);
        gemm_mainloop(A + (size_t)mt * 128 * D, D, Bt + (size_t)nt * 128 * D, D, D, acc, smem);
        ACC_FOREACH({ C[(size_t)(mt * 128 + row) * NPROJ + nt * 128 + col] = f2bf(acc[i][j][r]); })
    }
}
__device__ __forceinline__ void phase_gemm2(const Params& P, int bid, int nb, unsigned char* smem) {
    const bf16_t* A = (const bf16_t*)(P.ws + WS_MIXED); const bf16_t* Bt = (const bf16_t*)(P.ws + WS_WTOUT); float* H = (float*)(P.ws + WS_H);
    const int nmt = T / 128, nnt = D / 128;
    for (int t = bid; t < nmt * nnt; t += nb) {
        const int mt = t % nmt, nt = t / nmt;
        f32x16 acc[2][2]; zero_acc(acc);
        gemm_mainloop(A + (size_t)mt * 128 * D, D, Bt + (size_t)nt * 128 * D, D, D, acc, smem);
        ACC_FOREACH({ const size_t o = (size_t)(mt * 128 + row) * D + nt * 128 + col; H[o] = P.x[o] + acc[i][j][r]; })
    }
}
__device__ __forceinline__ void phase_gemm3(const Params& P, int bid, int nb, unsigned char* smem) {
    const bf16_t* A = (const bf16_t*)(P.ws + WS_HN); const bf16_t* Bt = (const bf16_t*)(P.ws + WS_WTPQ); bf16_t* C = (bf16_t*)(P.ws + WS_Q);
    const int nmt = T / 128, nnt = D / 128;
    for (int t = bid; t < nmt * nnt; t += nb) {
        const int mt = t % nmt, nt = t / nmt;
        f32x16 acc[2][2]; zero_acc(acc);
        gemm_mainloop(A + (size_t)mt * 128 * D, D, Bt + (size_t)nt * 128 * D, D, D, acc, smem);
        ACC_FOREACH({ C[(size_t)(mt * 128 + row) * D + nt * 128 + col] = f2bf(acc[i][j][r]); })
    }
}
__device__ __forceinline__ void phase_scores(const Params& P, int bid, int nb, unsigned char* smem) {
    const bf16_t* A = (const bf16_t*)(P.ws + WS_Q); const bf16_t* Bt = (const bf16_t*)(P.ws + WS_KEYS); float* C = (float*)(P.ws + WS_SCORES);
    const int nmt = T / 128, nnt = 16;
    for (int t = bid; t < nmt * nnt; t += nb) {
        const int mt = t % nmt, nt = t / nmt;
        f32x16 acc[2][2]; zero_acc(acc);
        gemm_mainloop(A + (size_t)mt * 128 * D + nt * 128, D, Bt + (size_t)nt * 128 * 128, 128, 128, acc, smem);
        ACC_FOREACH({ C[(size_t)(mt * 128 + row) * D + nt * 128 + col] = acc[i][j][r]; })
    }
}
__device__ __forceinline__ void phase_ple(const Params& P, int bid, int nb, unsigned char* smem) {
    const bf16_t* A2 = (const bf16_t*)(P.ws + WS_PBF); const bf16_t* Bt2 = (const bf16_t*)(P.ws + WS_WTPP); bf16_t* C = (bf16_t*)(P.ws + WS_PLE);
    const int nmt = T / 128, nnt = D / 128;
    for (int t = bid; t < nmt * nnt; t += nb) {
        const int mt = t % nmt, nt = t / nmt;
        f32x16 acc[2][2]; zero_acc(acc);
        gemm_mainloop(A2 + (size_t)mt * 128 * 256, 256, Bt2 + (size_t)nt * 128 * 256, 256, 256, acc, smem);
        ACC_FOREACH({ C[(size_t)(mt * 128 + row) * D + nt * 128 + col] = f2bf(acc[i][j][r]); })
    }
}
__device__ __forceinline__ void phase_gemm4(const Params& P, int bid, int nb, unsigned char* smem) {
    const bf16_t* A = (const bf16_t*)(P.ws + WS_HN); const bf16_t* Bt = (const bf16_t*)(P.ws + WS_WTG);
    const bf16_t* ple = (const bf16_t*)(P.ws + WS_PLE); float* H = (float*)(P.ws + WS_H);
    const int nmt = T / 128, nnt = D / 128;
    for (int t = bid; t < nmt * nnt; t += nb) {
        const int mt = t % nmt, nt = t / nmt;
        f32x16 acc[2][2]; zero_acc(acc);
        gemm_mainloop(A + (size_t)mt * 128 * D, D, Bt + (size_t)nt * 128 * D, D, D, acc, smem);
        ACC_FOREACH({ const size_t o = (size_t)(mt * 128 + row) * D + nt * 128 + col; H[o] = H[o] + sigmoid_f(acc[i][j][r]) * bf2f(ple[o]); })
    }
}

template <bool OUT_BF16>
__device__ __forceinline__ void phase_rownorm(const float* in, const float* w, void* out, int bid, int nb) {
    const int wave = threadIdx.x >> 6, lane = threadIdx.x & 63;
    for (int r = bid * 4 + wave; r < T; r += nb * 4) {
        if (OUT_BF16) rmsnorm_row<true>(in + (size_t)r * D, w, (bf16_t*)out + (size_t)r * D, lane);
        else rmsnorm_row<false>(in + (size_t)r * D, w, (float*)out + (size_t)r * D, lane);
    }
}

__device__ __forceinline__ bf16x8 frag_ld(const unsigned char* tile, int row, int ks, int lane) { return *(const bf16x8*)(tile + lds_off(row, ks * 2 + (lane >> 5))); }
__device__ __forceinline__ void lds_st_bf16(unsigned char* tile, int row, int k, float v) { *(bf16_t*)(tile + lds_off(row, k >> 3) + (k & 7) * 2) = f2bf(v); }

__device__ __forceinline__ void d1_chunk(const Params& P, int u, unsigned char* smem) {
    const bf16_t* proj = (const bf16_t*)(P.ws + WS_PROJ);
    int tid_ = threadIdx.x; asm volatile("" : "+v"(tid_));
    const int tid = tid_, wave = tid >> 6, lane = tid & 63;
    const int b = u >> 9, h = (u >> 6) & 7, c = u & 63;
    const size_t tok0 = (size_t)b * SEQ + c * 64;
    unsigned char* Ks = smem;
    unsigned char* Qs = smem + 16384;
    unsigned char* Vraw = smem + 16384;
    float* At = (float*)(smem + 34816);
    float* Gs = (float*)(smem + 51200);
    float* Bs = Gs + 64;
    __syncthreads();
    if (wave == 0) {
        const size_t t = tok0 + lane;
        const float a = bf2f(proj[t * NPROJ + C_A + h]), bb = bf2f(proj[t * NPROJ + C_B + h]);
        const float xs = a + P.dt_bias[h];
        const float sp = xs > 20.f ? xs : log1pf(expf(xs));
        float g = -expf(P.a_log[h]) * sp;
#pragma unroll
        for (int o = 1; o < 64; o <<= 1) { const float n = __shfl_up(g, o); if (lane >= o) g += n; }
        Gs[lane] = g; Bs[lane] = 1.f / (1.f + expf(-bb));
    }
    __syncthreads();
    bf16_t* QG = (bf16_t*)(P.ws + WS_QG) + (size_t)u * 64 * 128;
    for (int task = wave; task < 128; task += 4) {
        const int tok = task >> 1, isk = task & 1;
        const int ch0 = (isk ? 1024 : 0) + h * 128 + lane * 2;
        const int sp = c * 64 + tok;
        float y0 = 0.f, y1 = 0.f;
#pragma unroll
        for (int j = 0; j < 4; ++j) {
            if (sp - 3 + j >= 0) {
                const unsigned pr = *(const unsigned*)(proj + (tok0 + tok - 3 + j) * NPROJ + ch0);
                y0 += bf2f((bf16_t)(pr & 0xffff)) * P.conv_w[ch0 * 4 + j];
                y1 += bf2f((bf16_t)(pr >> 16)) * P.conv_w[(ch0 + 1) * 4 + j];
            }
        }
        y0 = silu_f(y0); y1 = silu_f(y1);
        float r = rsqrtf(wave_sum(y0 * y0 + y1 * y1) + EPS);
        if (!isk) r *= 0.08838834764831845f;
        y0 *= r; y1 *= r;
        const int k = lane * 2, half = k >> 6, kk = k & 63;
        *(unsigned*)((isk ? Ks : Qs) + half * 8192 + lds_off(tok, kk >> 3) + (kk & 7) * 2) = pack2(y0, y1);
        if (!isk) { const float eg = expf(Gs[tok]); *(unsigned*)(QG + tok * 128 + k) = pack2(y0 * eg, y1 * eg); }
    }
    __syncthreads();
    {
        const int wr = wave >> 1, wc = wave & 1;
        f32x16 akk, aqk;
#pragma unroll
        for (int r = 0; r < 16; ++r) { akk[r] = 0.f; aqk[r] = 0.f; }
        if (!(wr == 0 && wc == 1)) {
#pragma unroll
            for (int half = 0; half < 2; ++half)
#pragma unroll
                for (int ks = 0; ks < 4; ++ks) {
                    const bf16x8 fk = frag_ld(Ks + half * 8192, wr * 32 + (lane & 31), ks, lane);
                    const bf16x8 fq = frag_ld(Qs + half * 8192, wr * 32 + (lane & 31), ks, lane);
                    const bf16x8 fb = frag_ld(Ks + half * 8192, wc * 32 + (lane & 31), ks, lane);
                    akk = __builtin_amdgcn_mfma_f32_32x32x16_bf16(fk, fb, akk, 0, 0, 0);
                    aqk = __builtin_amdgcn_mfma_f32_32x32x16_bf16(fq, fb, aqk, 0, 0, 0);
                }
        }
        const int j = wc * 32 + (lane & 31); const float Gj = Gs[j];
        bf16_t* ATT = (bf16_t*)(P.ws + WS_ATT) + (size_t)u * 64 * 64;
#pragma unroll
        for (int g4 = 0; g4 < 4; ++g4) {
            const int i0 = wr * 32 + 8 * g4 + 4 * (lane >> 5);
            f32x4 av;
#pragma unroll
            for (int e = 0; e < 4; ++e) {
                const int i = i0 + e, r = g4 * 4 + e;
                const float dec = (i >= j) ? expf(Gs[i] - Gj) : 0.f;
                av[e] = (i > j) ? Bs[i] * akk[r] * dec : 0.f;
                ATT[i * 64 + j] = f2bf(aqk[r] * dec);
            }
            *(f32x4*)(At + j * 64 + i0) = av;
        }
    }
    __syncthreads();
    {
        for (int q = tid; q < 67 * 16; q += 256) {
            const int row = q >> 4, c16 = q & 15;
            uint4 v = make_uint4(0u, 0u, 0u, 0u);
            if (c > 0 || row >= 3) v = *(const uint4*)(proj + (tok0 + row - 3) * NPROJ + 2048 + h * 128 + c16 * 8);
            *(uint4*)(Vraw + row * 256 + c16 * 16) = v;
        }
    }
    __syncthreads();
    {
        float r[64];
        if (tid < 128) {
            const int ch = 2048 + h * 128 + tid;
            const float w0 = P.conv_w[ch * 4 + 0], w1 = P.conv_w[ch * 4 + 1], w2 = P.conv_w[ch * 4 + 2], w3 = P.conv_w[ch * 4 + 3];
            const bf16_t* vcol = (const bf16_t*)Vraw + tid;
            float xm3 = bf2f(vcol[0]), xm2 = bf2f(vcol[128]), xm1 = bf2f(vcol[256]);
#pragma unroll
            for (int i = 0; i < 64; ++i) {
                const float x0 = bf2f(vcol[(i + 3) * 128]);
                const float y = w0 * xm3 + w1 * xm2 + w2 * xm1 + w3 * x0;
                r[i] = Bs[i] * silu_f(y);
                xm3 = xm2; xm2 = xm1; xm1 = x0;
            }
        } else {
            const int dk = tid - 128, half = dk >> 6, kk = dk & 63;
            const float G63 = Gs[63];
            bf16_t* KDT = (bf16_t*)(P.ws + WS_KDT) + (size_t)u * 128 * 64 + dk * 64;
#pragma unroll
            for (int i8 = 0; i8 < 8; ++i8) {
                unsigned pk[4];
#pragma unroll
                for (int e2 = 0; e2 < 4; ++e2) {
                    float kd[2];
#pragma unroll
                    for (int e = 0; e < 2; ++e) {
                        const int i = i8 * 8 + e2 * 2 + e;
                        const float kv = bf2f(*(const bf16_t*)(Ks + half * 8192 + lds_off(i, kk >> 3) + (kk & 7) * 2));
                        const float Gi = Gs[i];
                        r[i] = -Bs[i] * expf(Gi) * kv;
                        kd[e] = kv * expf(G63 - Gi);
                    }
                    pk[e2] = pack2(kd[0], kd[1]);
                }
                *(uint4*)(KDT + i8 * 8) = make_uint4(pk[0], pk[1], pk[2], pk[3]);
            }
        }
#pragma unroll
        for (int j = 0; j < 63; ++j) {
            const float xj = r[j];
#pragma unroll
            for (int i4 = ((j + 1) & ~3); i4 < 64; i4 += 4) {
                const f32x4 a = *(const f32x4*)(At + j * 64 + i4);
                r[i4] -= a[0] * xj; r[i4 + 1] -= a[1] * xj; r[i4 + 2] -= a[2] * xj; r[i4 + 3] -= a[3] * xj;
            }
        }
        if (tid < 128) {
            float* U = (float*)(P.ws + WS_U) + (size_t)u * 64 * 128 + (tid >> 5) * 2048 + (tid & 31);
#pragma unroll
            for (int i = 0; i < 64; ++i) { const int tt = i >> 5, i5 = i & 31, rr = (i5 & 3) + 4 * (i5 >> 3), hh = (i5 >> 2) & 1; U[(tt * 16 + rr) * 64 + hh * 32] = r[i]; }
        } else {
            bf16_t* W = (bf16_t*)(P.ws + WS_W) + (size_t)u * 64 * 128 + (tid - 128);
#pragma unroll
            for (int i = 0; i < 64; ++i) W[i * 128] = f2bf(r[i]);
        }
        if (tid == 0) ((float*)(P.ws + WS_EG))[u] = expf(Gs[63]);
    }
}

__device__ __forceinline__ void r1_chunk(const Params& P, int u, unsigned char* smem) {
    const bf16_t* proj = (const bf16_t*)(P.ws + WS_PROJ);
    int tid_ = threadIdx.x; asm volatile("" : "+v"(tid_));
    const int tid = tid_, wave = tid >> 6, lane = tid & 63;
    const int b = u >> 9, h = (u >> 6) & 7, c = u & 63;
    const size_t tok0 = (size_t)b * SEQ + c * 64;
    unsigned char* RQ = smem;
    unsigned char* RK = smem + 8192;
    unsigned char* VT = smem + 16384;
    unsigned char* RKT = smem + 32768;
    const float l2g = log2f(1.f - exp2f(-5.f - (float)h));
    __syncthreads();
    bf16_t* QGR = (bf16_t*)(P.ws + WS_QGR) + (size_t)u * 64 * 64;
#pragma unroll 2
    for (int it = 0; it < 8; ++it) {
        const int e = tid + 256 * it, tok = e >> 5, i = e & 31;
        const size_t t = tok0 + tok;
        const float inv = powf(10000.f, -(float)i / 32.f);
        const float ang = (float)P.positions[t] * inv;
        float sn, cs; sincosf(ang, &sn, &cs);
        const float q1 = bf2f(proj[t * NPROJ + C_RQ + h * 64 + i]), q2 = bf2f(proj[t * NPROJ + C_RQ + h * 64 + 32 + i]);
        const float k1 = bf2f(proj[t * NPROJ + C_RK + h * 64 + i]) * 0.125f, k2 = bf2f(proj[t * NPROJ + C_RK + h * 64 + 32 + i]) * 0.125f;
        const float qa = q1 * cs - q2 * sn, qb = q1 * sn + q2 * cs, ka = k1 * cs - k2 * sn, kb = k1 * sn + k2 * cs;
        const float xi = exp2f(l2g * (float)(tok + 1)), zeta = exp2f(l2g * (float)(63 - tok));
        lds_st_bf16(RQ, tok, i, qa); lds_st_bf16(RQ, tok, 32 + i, qb);
        lds_st_bf16(RK, tok, i, ka); lds_st_bf16(RK, tok, 32 + i, kb);
        lds_st_bf16(RKT, i, tok, ka * zeta); lds_st_bf16(RKT, 32 + i, tok, kb * zeta);
        QGR[tok * 64 + i] = f2bf(qa * xi); QGR[tok * 64 + 32 + i] = f2bf(qb * xi);
    }
#pragma unroll 4
    for (int it = 0; it < 16; ++it) {
        const int e = tid + 256 * it, tok = e >> 6, dp = e & 63;
        const unsigned pr = *(const unsigned*)(proj + (tok0 + tok) * NPROJ + C_RV + h * 128 + dp * 2);
        *(bf16_t*)(VT + lds_off(dp * 2, tok >> 3) + (tok & 7) * 2) = (bf16_t)(pr & 0xffff);
        *(bf16_t*)(VT + lds_off(dp * 2 + 1, tok >> 3) + (tok & 7) * 2) = (bf16_t)(pr >> 16);
    }
    __syncthreads();
    {
        bf16_t* VNTR = (bf16_t*)(P.ws + WS_VNTR) + (size_t)u * 128 * 64;
#pragma unroll
        for (int it = 0; it < 4; ++it) { const int q = tid + 256 * it, row = q >> 3, ch = q & 7; *(uint4*)(VNTR + row * 64 + ch * 8) = *(const uint4*)(VT + lds_off(row, ch)); }
    }
    {
        const int wr = wave >> 1, wc = wave & 1;
        f32x16 acc;
#pragma unroll
        for (int r = 0; r < 16; ++r) acc[r] = 0.f;
        if (!(wr == 0 && wc == 1)) {
#pragma unroll
            for (int ks = 0; ks < 4; ++ks) acc = __builtin_amdgcn_mfma_f32_32x32x16_bf16(frag_ld(RQ, wr * 32 + (lane & 31), ks, lane), frag_ld(RK, wc * 32 + (lane & 31), ks, lane), acc, 0, 0, 0);
        }
        const int j = wc * 32 + (lane & 31);
        bf16_t* ATTR = (bf16_t*)(P.ws + WS_ATTR) + (size_t)u * 64 * 64;
#pragma unroll
        for (int r = 0; r < 16; ++r) {
            const int i = wr * 32 + (r & 3) + 8 * (r >> 2) + 4 * (lane >> 5);
            const float dec = (i >= j) ? exp2f(l2g * (float)(i - j)) : 0.f;
            ATTR[i * 64 + j] = f2bf(acc[r] * dec);
        }
    }
    {
        f32x16 acc[2];
#pragma unroll
        for (int j = 0; j < 2; ++j)
#pragma unroll
            for (int r = 0; r < 16; ++r) acc[j][r] = 0.f;
#pragma unroll
        for (int ks = 0; ks < 4; ++ks) {
            const bf16x8 fa = frag_ld(VT, wave * 32 + (lane & 31), ks, lane);
#pragma unroll
            for (int j = 0; j < 2; ++j) acc[j] = __builtin_amdgcn_mfma_f32_32x32x16_bf16(fa, frag_ld(RKT, j * 32 + (lane & 31), ks, lane), acc[j], 0, 0, 0);
        }
        float* KVT = (float*)(P.ws + WS_KVT) + (size_t)u * 128 * 64;
#pragma unroll
        for (int j = 0; j < 2; ++j)
#pragma unroll
            for (int r = 0; r < 16; ++r) { const int dv = wave * 32 + (r & 3) + 8 * (r >> 2) + 4 * (lane >> 5); KVT[dv * 64 + j * 32 + (lane & 31)] = acc[j][r]; }
    }
}

__device__ __forceinline__ void phase_chunk1(const Params& P, int bid, int nb, unsigned char* smem) {
    for (int u = bid; u < 2048; u += nb) { if (u < 1024) d1_chunk(P, u, smem); else r1_chunk(P, u - 1024, smem); }
}

__device__ __forceinline__ void d2_scan(const Params& P, int bh, unsigned char* smem) {
    const int tid = threadIdx.x, wave = tid >> 6, lane = tid & 63;
    unsigned char* Wt = smem;
    unsigned char* KDt = smem + 16384;
    unsigned char* img = smem + 32768 + wave * 8192;
    const int dv0 = wave * 32;
    const size_t cb = (size_t)bh * 64;
    const bf16_t* Wg = (const bf16_t*)(P.ws + WS_W); const bf16_t* KDg = (const bf16_t*)(P.ws + WS_KDT);
    const float* Ug = (const float*)(P.ws + WS_U); const float* EGg = (const float*)(P.ws + WS_EG);
    bf16_t* SCg = (bf16_t*)(P.ws + WS_SC); bf16_t* VNg = (bf16_t*)(P.ws + WS_VNT);
    f32x16 S[4];
#pragma unroll
    for (int d = 0; d < 4; ++d)
#pragma unroll
        for (int r = 0; r < 16; ++r) S[d][r] = 0.f;
    uint4 pw0, pw1, pw2, pw3, pk0, pk1, pk2, pk3;
    __syncthreads();
#define D2_LOAD(uu) { const bf16_t* wp = Wg + (uu) * 8192 + tid * 8; const bf16_t* kp = KDg + (uu) * 8192 + tid * 8; \
        pw0 = *(const uint4*)(wp); pw1 = *(const uint4*)(wp + 2048); pw2 = *(const uint4*)(wp + 4096); pw3 = *(const uint4*)(wp + 6144); \
        pk0 = *(const uint4*)(kp); pk1 = *(const uint4*)(kp + 2048); pk2 = *(const uint4*)(kp + 4096); pk3 = *(const uint4*)(kp + 6144); }
#define D2_ST1(i, vw, vk) { const int q = tid + 256 * (i); { const int row = q >> 4, c16 = q & 15; *(uint4*)(Wt + (c16 >> 3) * 8192 + lds_off(row, c16 & 7)) = (vw); } \
        { const int row = q >> 3, ch = q & 7; *(uint4*)(KDt + lds_off(row, ch)) = (vk); } }
#define D2_STORE() { D2_ST1(0, pw0, pk0) D2_ST1(1, pw1, pk1) D2_ST1(2, pw2, pk2) D2_ST1(3, pw3, pk3) }
    D2_LOAD(cb)
    D2_STORE()
#pragma unroll
    for (int i = 0; i < 8; ++i) { *(uint4*)(img + (lane + 64 * i) * 16) = make_uint4(0u, 0u, 0u, 0u);
        const int q = lane + 64 * i; *(uint4*)(SCg + cb * 16384 + (size_t)(dv0 + (q >> 4)) * 128 + (q & 15) * 8) = make_uint4(0u, 0u, 0u, 0u); }
    __syncthreads();
    f32x16 un0, un1;
#define D2_LOADU(uu) { const float* up = Ug + (uu) * 8192 + wave * 2048 + lane; \
        _Pragma("unroll") for (int r = 0; r < 16; ++r) { un0[r] = up[r * 64]; un1[r] = up[(16 + r) * 64]; } }
    D2_LOADU(cb)
    for (int c = 0; c < 64; ++c) {
        const size_t u = cb + c;
        f32x16 vn0 = un0, vn1 = un1;
        if (c + 1 < 64) {
            D2_LOAD(u + 1)
            D2_LOADU(u + 1)
        }
        const float eg = EGg[u];
#pragma unroll
        for (int half = 0; half < 2; ++half)
#pragma unroll
            for (int ks = 0; ks < 4; ++ks) {
                const bf16x8 fb = frag_ld(img + half * 4096, lane & 31, ks, lane);
                vn0 = __builtin_amdgcn_mfma_f32_32x32x16_bf16(frag_ld(Wt + half * 8192, (lane & 31), ks, lane), fb, vn0, 0, 0, 0);
                vn1 = __builtin_amdgcn_mfma_f32_32x32x16_bf16(frag_ld(Wt + half * 8192, 32 + (lane & 31), ks, lane), fb, vn1, 0, 0, 0);
            }
#define D2_VN(tt, vv) _Pragma("unroll") for (int g4 = 0; g4 < 4; ++g4) { const int r0 = g4 * 4; \
            const uint2 pkd = make_uint2(pack2(vv[r0], vv[r0 + 1]), pack2(vv[r0 + 2], vv[r0 + 3])); \
            const int tok = (tt) * 32 + 8 * g4 + 4 * (lane >> 5); \
            *(uint2*)(img + lds_off(lane & 31, tok >> 3) + (tok & 7) * 2) = pkd; \
            *(uint2*)(VNg + u * 8192 + (size_t)(dv0 + (lane & 31)) * 64 + tok) = pkd; }
        D2_VN(0, vn0) D2_VN(1, vn1)
#pragma unroll
        for (int d = 0; d < 4; ++d)
#pragma unroll
            for (int r = 0; r < 16; ++r) S[d][r] *= eg;
#pragma unroll
        for (int ks = 0; ks < 4; ++ks) {
            const bf16x8 fb = frag_ld(img, lane & 31, ks, lane);
#pragma unroll
            for (int d = 0; d < 4; ++d) S[d] = __builtin_amdgcn_mfma_f32_32x32x16_bf16(frag_ld(KDt, d * 32 + (lane & 31), ks, lane), fb, S[d], 0, 0, 0);
        }
#pragma unroll
        for (int d = 0; d < 4; ++d)
#pragma unroll
            for (int g4 = 0; g4 < 4; ++g4) {
                const int r0 = g4 * 4;
                const uint2 pkd = make_uint2(pack2(S[d][r0], S[d][r0 + 1]), pack2(S[d][r0 + 2], S[d][r0 + 3]));
                const int kk = (d & 1) * 32 + 8 * g4 + 4 * (lane >> 5);
                *(uint2*)(img + (d >> 1) * 4096 + lds_off(lane & 31, kk >> 3) + (kk & 7) * 2) = pkd;
                if (c + 1 < 64) *(uint2*)(SCg + (u + 1) * 16384 + (size_t)(dv0 + (lane & 31)) * 128 + (d >> 1) * 64 + kk) = pkd;
            }
        __syncthreads();
        if (c + 1 < 64) D2_STORE()
        __syncthreads();
    }
}

__device__ __forceinline__ void r2_scan(const Params& P, int vb, int nvb) {
    const float* KVT = (const float*)(P.ws + WS_KVT); bf16_t* STR = (bf16_t*)(P.ws + WS_STR);
    for (int idx = vb * 256 + threadIdx.x; idx < 16 * 8192; idx += nvb * 256) {
        const int bh = idx >> 13, e = idx & 8191, h = bh & 7;
        const float cd = exp2f(64.f * log2f(1.f - exp2f(-5.f - (float)h)));
        float S = 0.f;
#pragma unroll 8
        for (int c = 0; c < 64; ++c) {
            const size_t o = ((size_t)bh * 64 + c) * 8192 + e;
            STR[o] = f2bf(S);
            S = cd * S + KVT[o];
        }
    }
}

__device__ __forceinline__ void phase_scan(const Params& P, int bid, int nb, unsigned char* smem) {
    if (bid < 16) d2_scan(P, bid, smem); else r2_scan(P, bid - 16, nb - 16);
}

template <int K1, bool RET>
__device__ __forceinline__ void chunk_out(const Params& P, int u, unsigned char* smem) {
    int tid_ = threadIdx.x; asm volatile("" : "+v"(tid_));
    const int tid = tid_, wave = tid >> 6, lane = tid & 63, wr = wave >> 1, wc = wave & 1;
    const int b = u >> 9, h = (u >> 6) & 7, c = u & 63;
    const size_t tok0 = (size_t)b * SEQ + c * 64;
    const bf16_t* A1 = RET ? (const bf16_t*)(P.ws + WS_QGR) + (size_t)u * 64 * 64 : (const bf16_t*)(P.ws + WS_QG) + (size_t)u * 64 * 128;
    const bf16_t* B1 = RET ? (const bf16_t*)(P.ws + WS_STR) + (size_t)u * 128 * 64 : (const bf16_t*)(P.ws + WS_SC) + (size_t)u * 128 * 128;
    const bf16_t* A2 = RET ? (const bf16_t*)(P.ws + WS_ATTR) + (size_t)u * 64 * 64 : (const bf16_t*)(P.ws + WS_ATT) + (size_t)u * 64 * 64;
    const bf16_t* B2 = RET ? (const bf16_t*)(P.ws + WS_VNTR) + (size_t)u * 128 * 64 : (const bf16_t*)(P.ws + WS_VNT) + (size_t)u * 128 * 64;
    unsigned char* As = smem;
    unsigned char* Bs = smem + 8192;
    float* red = (float*)(smem + 24576);
    f32x16 acc[2];
#pragma unroll
    for (int j = 0; j < 2; ++j)
#pragma unroll
        for (int r = 0; r < 16; ++r) acc[j][r] = 0.f;
    constexpr int NK1 = K1 / 64;
#pragma unroll
    for (int kt = 0; kt <= NK1; ++kt) {
        const bf16_t* Ap = (kt < NK1) ? A1 + kt * 64 : A2; const int lda = (kt < NK1) ? K1 : 64;
        const bf16_t* Bp = (kt < NK1) ? B1 + kt * 64 : B2; const int ldb = lda;
        __syncthreads();
#pragma unroll
        for (int i = 0; i < 2; ++i) { const int q = tid + 256 * i, row = q >> 3, ch = q & 7; *(uint4*)(As + lds_off(row, ch)) = *(const uint4*)(Ap + row * lda + ch * 8); }
#pragma unroll
        for (int i = 0; i < 4; ++i) { const int q = tid + 256 * i, row = q >> 3, ch = q & 7; *(uint4*)(Bs + lds_off(row, ch)) = *(const uint4*)(Bp + row * ldb + ch * 8); }
        __syncthreads();
#pragma unroll
        for (int ks = 0; ks < 4; ++ks) {
            const bf16x8 fa = frag_ld(As, wr * 32 + (lane & 31), ks, lane);
#pragma unroll
            for (int j = 0; j < 2; ++j) acc[j] = __builtin_amdgcn_mfma_f32_32x32x16_bf16(fa, frag_ld(Bs, wc * 64 + j * 32 + (lane & 31), ks, lane), acc[j], 0, 0, 0);
        }
    }
#pragma unroll
    for (int r = 0; r < 16; ++r) {
        float s1 = acc[0][r] + acc[1][r], s2 = acc[0][r] * acc[0][r] + acc[1][r] * acc[1][r];
#pragma unroll
        for (int o = 16; o >= 1; o >>= 1) { s1 += __shfl_xor(s1, o); s2 += __shfl_xor(s2, o); }
        if ((lane & 31) == 0) { const int row = wr * 32 + (r & 3) + 8 * (r >> 2) + 4 * (lane >> 5); red[(row * 2 + wc) * 2] = s1; red[(row * 2 + wc) * 2 + 1] = s2; }
    }
    __syncthreads();
    const bf16_t* proj = (const bf16_t*)(P.ws + WS_PROJ); bf16_t* mixed = (bf16_t*)(P.ws + WS_MIXED);
#pragma unroll
    for (int r = 0; r < 16; ++r) {
        const int row = wr * 32 + (r & 3) + 8 * (r >> 2) + 4 * (lane >> 5);
        const float s1 = red[row * 4] + red[row * 4 + 2], s2 = red[row * 4 + 1] + red[row * 4 + 3];
        const size_t t = tok0 + row;
#pragma unroll
        for (int j = 0; j < 2; ++j) {
            const int dv = wc * 64 + j * 32 + (lane & 31);
            float y;
            if (!RET) {
                const float rs = rsqrtf(s2 * (1.f / 128.f) + EPS);
                y = acc[j][r] * rs * P.dn_norm[dv] * silu_f(bf2f(proj[t * NPROJ + C_Z + h * 128 + dv]));
                mixed[t * D + h * 128 + dv] = f2bf(y);
            } else {
                const float mu = s1 * (1.f / 128.f);
                const float var = fmaxf(s2 * (1.f / 128.f) - mu * mu, 0.f);
                const float rs = rsqrtf(var + EPS);
                y = ((acc[j][r] - mu) * rs * P.ret_gn_w[h * 128 + dv] + P.ret_gn_b[h * 128 + dv]) * silu_f(bf2f(proj[t * NPROJ + C_RG + h * 128 + dv]));
                mixed[t * D + 1024 + h * 128 + dv] = f2bf(y);
            }
        }
    }
}

__device__ __forceinline__ void phase_chunk3(const Params& P, int bid, int nb, unsigned char* smem) {
    for (int u = bid; u < 2048; u += nb) { if (u < 1024) chunk_out<128, false>(P, u, smem); else chunk_out<64, true>(P, u - 1024, smem); }
}

__device__ __forceinline__ void phase_route(const Params& P, int bid, int nb) {
    const float* scores = (const float*)(P.ws + WS_SCORES); int* idx = (int*)(P.ws + WS_IDX); float* gates = (float*)(P.ws + WS_GATES);
    const int wave = threadIdx.x >> 6, lane = threadIdx.x & 63;
    const float NEG = -3.0e38f;
    for (int u = bid * 4 + wave; u < T * 8; u += nb * 4) {
        const int t = u >> 3, h = u & 7;
        float top_s[2]; int top_i[2];
#pragma unroll
        for (int p = 0; p < 2; ++p) {
            const float* sp = scores + (size_t)t * D + (h * 2 + p) * 128;
            float k0 = __uint_as_float((__float_as_uint(sp[lane]) & ~0x7Fu) | (unsigned)lane);
            float k1 = __uint_as_float((__float_as_uint(sp[lane + 64]) & ~0x7Fu) | (unsigned)(lane + 64));
            float mine = 0.f;
            for (int r = 0; r < 16; ++r) {
                const float m = wave_max(fmaxf(k0, k1));
                if (k0 == m) k0 = NEG;
                if (k1 == m) k1 = NEG;
                if (lane == r) mine = m;
            }
            top_i[p] = (int)(__float_as_uint(mine) & 0x7Fu);
            top_s[p] = mine;
        }
        float ck[4];
#pragma unroll
        for (int e = 0; e < 4; ++e) {
            const int cand = lane * 4 + e, i = cand >> 4, j = cand & 15;
            const float s = __shfl(top_s[0], i) + __shfl(top_s[1], j);
            ck[e] = __uint_as_float((__float_as_uint(s) & ~0xFFu) | (unsigned)cand);
        }
        float mine = 0.f;
        for (int r = 0; r < 16; ++r) {
            const float m = wave_max(fmaxf(fmaxf(ck[0], ck[1]), fmaxf(ck[2], ck[3])));
#pragma unroll
            for (int e = 0; e < 4; ++e) if (ck[e] == m) ck[e] = NEG;
            if (lane == r) mine = m;
        }
        const int cand = (int)(__float_as_uint(mine) & 0xFFu);
        const int i1 = __shfl(top_i[0], cand >> 4), i2 = __shfl(top_i[1], cand & 15);
        const float smax = __shfl(mine, 0);
        float e = (lane < 16) ? __expf(mine - smax) : 0.f;
        const float sum = wave_sum(e);
        if (lane < 16) { idx[(size_t)t * 128 + h * 16 + lane] = i1 * 128 + i2; gates[(size_t)t * 128 + h * 16 + lane] = e / sum; }
    }
}

__device__ __forceinline__ void phase_peer(const Params& P, int bid, int nb) {
    const bf16_t* hn = (const bf16_t*)(P.ws + WS_HN); const int* idx = (const int*)(P.ws + WS_IDX); const float* gates = (const float*)(P.ws + WS_GATES);
    float* H = (float*)(P.ws + WS_H);
    const int wave = threadIdx.x >> 6, lane = threadIdx.x & 63;
    for (int t = bid * 4 + wave; t < T; t += nb * 4) {
        f32x4 xr[8], acc[8];
#pragma unroll
        for (int i = 0; i < 8; ++i) {
            const uint2 v = *(const uint2*)(hn + (size_t)t * D + (i * 64 + lane) * 4);
            xr[i][0] = bf2f((bf16_t)(v.x & 0xffff)); xr[i][1] = bf2f((bf16_t)(v.x >> 16)); xr[i][2] = bf2f((bf16_t)(v.y & 0xffff)); xr[i][3] = bf2f((bf16_t)(v.y >> 16));
            acc[i] = (f32x4){0.f, 0.f, 0.f, 0.f};
        }
        for (int k = 0; k < 128; ++k) {
            const int e = idx[(size_t)t * 128 + k]; const float g = gates[(size_t)t * 128 + k];
            const f32x4* up = (const f32x4*)(P.expert_u + (size_t)e * D); const f32x4* vp = (const f32x4*)(P.expert_v + (size_t)e * D);
            f32x4 uv[8], vv[8];
#pragma unroll
            for (int i = 0; i < 8; ++i) { uv[i] = up[i * 64 + lane]; vv[i] = vp[i * 64 + lane]; }
            float d = 0.f;
#pragma unroll
            for (int i = 0; i < 8; ++i) d += uv[i][0] * xr[i][0] + uv[i][1] * xr[i][1] + uv[i][2] * xr[i][2] + uv[i][3] * xr[i][3];
            d = wave_sum(d);
            const float a = 0.5f * d * (1.f + erff(d * 0.70710678118654752f)) * g;
#pragma unroll
            for (int i = 0; i < 8; ++i) acc[i] += vv[i] * a;
        }
#pragma unroll
        for (int i = 0; i < 8; ++i) { f32x4* hp = (f32x4*)(H + (size_t)t * D + (i * 64 + lane) * 4); *hp = *hp + acc[i]; }
    }
}

enum { PH_PREP = 0, PH_GEMM1, PH_CHUNK1, PH_SCAN, PH_CHUNK3, PH_GEMM2, PH_NORM2, PH_GEMM3, PH_SCORES, PH_ROUTE, PH_PEER, PH_NORM3, PH_PLE, PH_GEMM4, PH_FINAL, PH_COUNT };

#define XB_TMO      128
#define XB_XCNT(j)  (256  + 64 * (j))
#define XB_XSUB(j)  (1280 + 64 * (j))
#define XB_XGEN(j)  (2304 + 64 * (j))
#define XB_TOP      3328
#define XB_TOPGEN   3392
#define XCD_BAR_WORDS 3456
#define XB_SPIN_CAP (1u << 20)
#define LAS __attribute__((address_space(3)))
__device__ __forceinline__ unsigned xb_ld(unsigned* p)              { return __hip_atomic_load(p, __ATOMIC_RELAXED, __HIP_MEMORY_SCOPE_AGENT); }
__device__ __forceinline__ unsigned xb_add(unsigned* p, unsigned v) { return __hip_atomic_fetch_add(p, v, __ATOMIC_RELAXED, __HIP_MEMORY_SCOPE_AGENT); }
__device__ __forceinline__ unsigned xb_xcc_id() { return (unsigned)__builtin_amdgcn_s_getreg((3 << 11) | 20) & 0xFu; }
#define XB_SPIN(cond, bar) do { unsigned _sp = 0; while (cond) { __builtin_amdgcn_s_sleep(1); \
    if ((++_sp & 255u) == 0u) { if (xb_ld(&(bar)[XB_TMO])) break; if (_sp > XB_SPIN_CAP) { atomicAdd(&(bar)[XB_TMO], 1u); break; } } } } while (0)
struct XcdBarrier { unsigned* bar; unsigned x; volatile LAS unsigned* st; };
__device__ __forceinline__ XcdBarrier xcd_barrier_post(unsigned* bar, volatile LAS unsigned* st) {
    XcdBarrier b; b.bar = bar; b.x = xb_xcc_id(); b.st = st;
    if (threadIdx.x == 0) (void)xb_add(&bar[XB_XCNT(b.x)], 1u);
    return b;
}
__device__ __forceinline__ void xcd_barrier_complete(unsigned* bar, unsigned x, unsigned& nloc, unsigned& nx) {
    const unsigned G = gridDim.x * gridDim.y * gridDim.z;
    unsigned sum, cnt, mine, sp = 0u;
    for (;;) {
        sum = 0u; cnt = 0u; mine = 0u;
#pragma unroll
        for (unsigned j = 0; j < 16; ++j) { const unsigned c = xb_ld(&bar[XB_XCNT(j)]); sum += c; cnt += (c > 0u) ? 1u : 0u; mine = (j == x) ? c : mine; }
        if (sum == G) break;
        __builtin_amdgcn_s_sleep(1);
        if ((++sp & 255u) == 0u) { if (xb_ld(&bar[XB_TMO])) break; if (sp > XB_SPIN_CAP) { atomicAdd(&bar[XB_TMO], 1u); break; } }
    }
    nloc = mine > 0u ? mine : 1u; nx = cnt > 0u ? cnt : 1u;
}
__device__ __forceinline__ void xcd_barrier(const XcdBarrier& b) {
    asm volatile("s_waitcnt vmcnt(0)" ::: "memory");
    __syncthreads();
    if (threadIdx.x == 0) {
        unsigned* bar = b.bar;
        __builtin_amdgcn_s_waitcnt(0);
        unsigned nloc = b.st[0], nx = b.st[1];
        if (nloc == 0u) { xcd_barrier_complete(bar, b.x, nloc, nx); b.st[0] = nloc; b.st[1] = nx; }
        const unsigned old = xb_add(&bar[XB_XSUB(b.x)], 1u);
        const unsigned gen = old / nloc;
        if (old + 1u == (gen + 1u) * nloc) {
            __builtin_amdgcn_fence(__ATOMIC_RELEASE, "agent");
            asm volatile("s_waitcnt vmcnt(0)" ::: "memory");
            const unsigned og = xb_add(&bar[XB_TOP], 1u);
            const unsigned tg = og / nx;
            if (og + 1u == (tg + 1u) * nx) xb_add(&bar[XB_TOPGEN], 1u);
            else XB_SPIN(xb_ld(&bar[XB_TOPGEN]) == tg, bar);
            __builtin_amdgcn_fence(__ATOMIC_ACQUIRE, "agent");
            xb_add(&bar[XB_XGEN(b.x)], 1u);
            asm volatile("s_waitcnt vmcnt(0)" ::: "memory");
        } else {
            XB_SPIN(xb_ld(&bar[XB_XGEN(b.x)]) == gen, bar);
            __builtin_amdgcn_fence(__ATOMIC_ACQUIRE, "agent");
            asm volatile("s_waitcnt vmcnt(0)" ::: "memory");
        }
    }
    __syncthreads();
}

__device__ __forceinline__ void run_phase(const Params& P, int ph, int bid, int nb, unsigned char* smem) {
    switch (ph) {
        case PH_PREP:   phase_prep(P, bid, nb, smem); break;
        case PH_GEMM1:  phase_gemm1(P, bid, nb, smem); break;
        case PH_CHUNK1: phase_chunk1(P, bid, nb, smem); break;
        case PH_SCAN:   phase_scan(P, bid, nb, smem); break;
        case PH_CHUNK3: phase_chunk3(P, bid, nb, smem); break;
        case PH_GEMM2:  phase_gemm2(P, bid, nb, smem); break;
        case PH_NORM2:  phase_rownorm<true>((const float*)(P.ws + WS_H), P.norm_ffn, P.ws + WS_HN, bid, nb); break;
        case PH_GEMM3:  phase_gemm3(P, bid, nb, smem); break;
        case PH_SCORES: phase_scores(P, bid, nb, smem); break;
        case PH_ROUTE:  phase_route(P, bid, nb); break;
        case PH_PEER:   phase_peer(P, bid, nb); break;
        case PH_NORM3:  phase_rownorm<true>((const float*)(P.ws + WS_H), P.norm_ple, P.ws + WS_HN, bid, nb); break;
        case PH_PLE:    phase_ple(P, bid, nb, smem); break;
        case PH_GEMM4:  phase_gemm4(P, bid, nb, smem); break;
        case PH_FINAL:  phase_rownorm<false>((const float*)(P.ws + WS_H), P.norm_final, P.out, bid, nb); break;
    }
}

constexpr int LDS_BYTES = 65536 + 16;

__global__ void __launch_bounds__(256, 2) fwd_kernel(Params P, int ph_lo, int ph_hi) {
    extern __shared__ __attribute__((aligned(16))) unsigned char smem[];
    const int bid = blockIdx.x, nb = gridDim.x;
    volatile LAS unsigned* st = (volatile LAS unsigned*)(smem + 65536);
    if (threadIdx.x == 0) { st[0] = 0u; st[1] = 0u; }
    __syncthreads();
    XcdBarrier xb = xcd_barrier_post((unsigned*)(P.ws + WS_BAR), st);
#define RUN(ph) if (ph_lo <= (ph) && (ph) < ph_hi) { run_phase(P, (ph), bid, nb, smem); if ((ph) + 1 < ph_hi) xcd_barrier(xb); }
    RUN(PH_PREP) RUN(PH_GEMM1) RUN(PH_CHUNK1) RUN(PH_SCAN) RUN(PH_CHUNK3) RUN(PH_GEMM2) RUN(PH_NORM2) RUN(PH_GEMM3) RUN(PH_SCORES) RUN(PH_ROUTE)
    RUN(PH_PEER) RUN(PH_NORM3) RUN(PH_PLE) RUN(PH_GEMM4) RUN(PH_FINAL)
}

extern "C" void kernel_launch(void* const* d_in, const int* in_sizes, int n_in, void* d_out, int out_size, void* d_ws, size_t ws_size, hipStream_t stream) {
    static int grid = 0;
    if (grid == 0) {
        if (n_in != 21 || out_size != T * D || ws_size < WS_END) { fprintf(stderr, "kernel_launch: unexpected shapes: n_in %d out %d ws %zu (need %zu)\n", n_in, out_size, ws_size, (size_t)WS_END); grid = -1; return; }
        if (hipFuncSetAttribute((const void*)fwd_kernel, hipFuncAttributeMaxDynamicSharedMemorySize, LDS_BYTES) != hipSuccess) { fprintf(stderr, "kernel_launch: hipFuncSetAttribute failed\n"); grid = -1; return; }
        int dev = 0, cus = 0, per_cu = 0;
        hipGetDevice(&dev); hipDeviceGetAttribute(&cus, hipDeviceAttributeMultiprocessorCount, dev);
        if (hipOccupancyMaxActiveBlocksPerMultiprocessor(&per_cu, (const void*)fwd_kernel, 256, LDS_BYTES) != hipSuccess || per_cu < 1) { fprintf(stderr, "kernel_launch: occupancy query failed (%d)\n", per_cu); grid = -1; return; }
        if (per_cu > 2) per_cu = 2;
        grid = cus * per_cu;
        fprintf(stderr, "kernel_launch: grid %d (%d CUs x %d)\n", grid, cus, per_cu);
    }
    if (grid < 0) return;
    Params P{};
    P.x = (const float*)d_in[0]; P.p = (const float*)d_in[1]; P.positions = (const int*)d_in[2]; P.norm_mix = (const float*)d_in[3]; P.w_in = (const float*)d_in[4];
    P.conv_w = (const float*)d_in[5]; P.a_log = (const float*)d_in[6]; P.dt_bias = (const float*)d_in[7]; P.dn_norm = (const float*)d_in[8]; P.ret_gn_w = (const float*)d_in[9];
    P.ret_gn_b = (const float*)d_in[10]; P.w_out = (const float*)d_in[11]; P.norm_ffn = (const float*)d_in[12]; P.w_pq = (const float*)d_in[13]; P.sub_keys = (const float*)d_in[14];
    P.expert_u = (const float*)d_in[15]; P.expert_v = (const float*)d_in[16]; P.norm_ple = (const float*)d_in[17]; P.w_ple_gate = (const float*)d_in[18]; P.w_ple_proj = (const float*)d_in[19];
    P.norm_final = (const float*)d_in[20]; P.out = (float*)d_out; P.ws = (unsigned char*)d_ws;
    (void)hipMemsetAsync((unsigned char*)d_ws + WS_BAR, 0, XCD_BAR_WORDS * 4, stream);
    int lo = 0, hi = PH_COUNT;
    void* args[] = {&P, &lo, &hi};
    hipError_t e = hipLaunchCooperativeKernel((const void*)fwd_kernel, dim3(grid), dim3(256), args, LDS_BYTES, stream);
    if (e != hipSuccess) fprintf(stderr, "kernel_launch: cooperative launch failed: %s (grid %d)\n", hipGetErrorString(e), grid);
}
```

```cpp
#include <hip/hip_runtime.h>
#include <cstdio>
#include <cstdint>

typedef unsigned short bf16_t;
typedef short bf16x8 __attribute__((ext_vector_type(8)));
typedef float f32x16 __attribute__((ext_vector_type(16)));
typedef float f32x4 __attribute__((ext_vector_type(4)));

constexpr int T = 8192, D = 2048, SEQ = 4096;
constexpr int NPROJ = 7296;
constexpr int C_Z = 3072, C_RQ = 4096, C_RK = 4608, C_RV = 5120, C_RG = 6144, C_A = 7168, C_B = 7176;
constexpr int IN_COLS = 7184;
constexpr float EPS = 1e-6f;

constexpr size_t WS_HN    = 0;
constexpr size_t WS_KVT   = WS_HN;
constexpr size_t WS_WTIN  = WS_HN + (size_t)T * D * 2;
constexpr size_t WS_STR   = WS_WTIN;
constexpr size_t WS_ATTR  = WS_STR + (size_t)1024 * 128 * 64 * 2;
constexpr size_t WS_WTOUT = WS_WTIN + (size_t)NPROJ * D * 2;
constexpr size_t WS_WTPQ  = WS_WTOUT + (size_t)D * D * 2;
constexpr size_t WS_WTG   = WS_WTPQ + (size_t)D * D * 2;
constexpr size_t WS_WTPP  = WS_WTG + (size_t)D * D * 2;
constexpr size_t WS_KEYS  = WS_WTPP + (size_t)D * 256 * 2;
constexpr size_t WS_PBF   = WS_KEYS + (size_t)16 * 128 * 128 * 2;
constexpr size_t WS_PROJ  = WS_PBF + (size_t)T * 256 * 2;
constexpr size_t WS_Q     = WS_PROJ;
constexpr size_t WS_SCORES= WS_PROJ + (size_t)T * D * 2;
constexpr size_t WS_MIXED = WS_PROJ + (size_t)T * NPROJ * 2;
constexpr size_t WS_H     = WS_MIXED + (size_t)T * D * 2;
constexpr size_t WS_IDX   = WS_H + (size_t)T * D * 4;
constexpr size_t WS_GATES = WS_IDX + (size_t)T * 128 * 4;
constexpr size_t WS_U     = WS_GATES + (size_t)T * 128 * 4;
constexpr size_t WS_W     = WS_U + (size_t)1024 * 64 * 128 * 4;
constexpr size_t WS_KDT   = WS_W + (size_t)1024 * 64 * 128 * 2;
constexpr size_t WS_QG    = WS_KDT + (size_t)1024 * 128 * 64 * 2;
constexpr size_t WS_ATT   = WS_QG + (size_t)1024 * 64 * 128 * 2;
constexpr size_t WS_VNT   = WS_ATT + (size_t)1024 * 64 * 64 * 2;
constexpr size_t WS_SC    = WS_VNT + (size_t)1024 * 128 * 64 * 2;
constexpr size_t WS_QGR   = WS_SC + (size_t)1024 * 128 * 128 * 2;
constexpr size_t WS_VNTR  = WS_QGR + (size_t)1024 * 64 * 64 * 2;
constexpr size_t WS_EG    = WS_VNTR + (size_t)1024 * 128 * 64 * 2;
constexpr size_t WS_PLE   = WS_SC;
constexpr size_t WS_EU8   = WS_U;
constexpr size_t WS_EV8   = WS_U + (size_t)16384 * 2048;
constexpr size_t WS_ESC   = WS_QG;
constexpr size_t WS_BAR   = WS_EG + 4096;
constexpr size_t WS_END   = WS_BAR + 16384;

struct Params {
    const float *x, *p; const int* positions;
    const float *norm_mix, *w_in, *conv_w, *a_log, *dt_bias, *dn_norm, *ret_gn_w, *ret_gn_b, *w_out, *norm_ffn, *w_pq, *sub_keys,
                *expert_u, *expert_v, *norm_ple, *w_ple_gate, *w_ple_proj, *norm_final;
    float* out; unsigned char* ws;
};

__device__ __forceinline__ bf16_t f2bf(float f) { unsigned u = __float_as_uint(f); u += 0x7fffu + ((u >> 16) & 1u); return (bf16_t)(u >> 16); }
__device__ __forceinline__ float bf2f(bf16_t h) { return __uint_as_float(((unsigned)h) << 16); }
__device__ __forceinline__ unsigned pack2(float a, float b) { return (unsigned)f2bf(a) | ((unsigned)f2bf(b) << 16); }
__device__ __forceinline__ float wave_sum(float v) {
#pragma unroll
    for (int o = 32; o >= 1; o >>= 1) v += __shfl_xor(v, o);
    return v;
}
__device__ __forceinline__ float wave_max(float v) {
#pragma unroll
    for (int o = 32; o >= 1; o >>= 1) v = fmaxf(v, __shfl_xor(v, o));
    return v;
}
__device__ __forceinline__ float silu_f(float x) { return x / (1.f + __expf(-x)); }
__device__ __forceinline__ float sigmoid_f(float x) { return 1.f / (1.f + __expf(-x)); }

template <bool MAPIN>
__device__ __forceinline__ void transpose_tile(const float* __restrict__ W, int ldw, int K, bf16_t* __restrict__ Wt, int kt, int nt, float* tile  ) {
    const int tid = threadIdx.x;
    __syncthreads();
#pragma unroll
    for (int i = 0; i < 4; ++i) {
        const int idx = tid + 256 * i, kr = idx >> 4, c4 = idx & 15;
        const int n = nt * 64 + c4 * 4;
        int c = n; bool valid = true;
        if (MAPIN) { if (n < 4096) c = n; else if (n < 7168) c = n + 16; else if (n < 7184) c = n - 3072; else valid = false; }
        f32x4 v = {0.f, 0.f, 0.f, 0.f};
        if (valid) v = *(const f32x4*)(W + (size_t)(kt * 64 + kr) * ldw + c);
        float* d = tile + kr * 65 + c4 * 4;
        d[0] = v[0]; d[1] = v[1]; d[2] = v[2]; d[3] = v[3];
    }
    __syncthreads();
#pragma unroll
    for (int i = 0; i < 2; ++i) {
        const int ch = tid + 256 * i, n = ch >> 3, kc = ch & 7;
        unsigned w[4];
#pragma unroll
        for (int j = 0; j < 4; ++j) w[j] = pack2(tile[(kc * 8 + 2 * j) * 65 + n], tile[(kc * 8 + 2 * j + 1) * 65 + n]);
        uint4 o = make_uint4(w[0], w[1], w[2], w[3]);
        *(uint4*)(Wt + (size_t)(nt * 64 + n) * K + kt * 64 + kc * 8) = o;
    }
}

template <bool OUT_BF16>
__device__ __forceinline__ void rmsnorm_row(const float* __restrict__ in, const float* __restrict__ w, void* __restrict__ out, int lane) {
    f32x4 v[8]; float ss = 0.f;
#pragma unroll
    for (int i = 0; i < 8; ++i) { v[i] = *(const f32x4*)(in + (i * 64 + lane) * 4); ss += v[i][0] * v[i][0] + v[i][1] * v[i][1] + v[i][2] * v[i][2] + v[i][3] * v[i][3]; }
    ss = wave_sum(ss);
    const float r = rsqrtf(ss * (1.f / 2048.f) + EPS);
#pragma unroll
    for (int i = 0; i < 8; ++i) {
        const f32x4 g = *(const f32x4*)(w + (i * 64 + lane) * 4);
        const float a = v[i][0] * r * g[0], b = v[i][1] * r * g[1], c = v[i][2] * r * g[2], d = v[i][3] * r * g[3];
        if (OUT_BF16) { uint2 o = make_uint2(pack2(a, b), pack2(c, d)); *(uint2*)((bf16_t*)out + (i * 64 + lane) * 4) = o; }
        else { f32x4 o = {a, b, c, d}; *(f32x4*)((float*)out + (i * 64 + lane) * 4) = o; }
    }
}

__device__ __forceinline__ void phase_prep(const Params& P, int bid, int nb, unsigned char* smem) {
    float* tile = (float*)smem;
    const int tid = threadIdx.x;
    const int n_in = 32 * 114, n_sq = 32 * 32, n_pp = 4 * 32;
    const int n_tr = n_in + 3 * n_sq + n_pp;
    for (int u = bid; u < n_tr; u += nb) {
        if (u < n_in) transpose_tile<true>(P.w_in, IN_COLS, D, (bf16_t*)(P.ws + WS_WTIN), u % 32, u / 32, tile);
        else if (u < n_in + n_sq) { const int v = u - n_in; transpose_tile<false>(P.w_out, D, D, (bf16_t*)(P.ws + WS_WTOUT), v % 32, v / 32, tile); }
        else if (u < n_in + 2 * n_sq) { const int v = u - n_in - n_sq; transpose_tile<false>(P.w_pq, D, D, (bf16_t*)(P.ws + WS_WTPQ), v % 32, v / 32, tile); }
        else if (u < n_in + 3 * n_sq) { const int v = u - n_in - 2 * n_sq; transpose_tile<false>(P.w_ple_gate, D, D, (bf16_t*)(P.ws + WS_WTG), v % 32, v / 32, tile); }
        else { const int v = u - n_in - 3 * n_sq; transpose_tile<false>(P.w_ple_proj, D, 256, (bf16_t*)(P.ws + WS_WTPP), v % 4, v / 4, tile); }
    }
    {
        bf16_t* keys = (bf16_t*)(P.ws + WS_KEYS); bf16_t* pbf = (bf16_t*)(P.ws + WS_PBF);
        const int n4a = 262144 / 4, n4b = T * 256 / 4;
        for (int i = bid * 256 + tid; i < n4a + n4b; i += nb * 256) {
            const bool a = i < n4a; const int j = a ? i : i - n4a;
            const f32x4 v = *(const f32x4*)((a ? P.sub_keys : P.p) + (size_t)j * 4);
            *(uint2*)((a ? keys : pbf) + (size_t)j * 4) = make_uint2(pack2(v[0], v[1]), pack2(v[2], v[3]));
        }
    }
    {
        const int wave = tid >> 6, lane = tid & 63;
        bf16_t* hn = (bf16_t*)(P.ws + WS_HN);
        for (int r = bid * 4 + wave; r < T; r += nb * 4) rmsnorm_row<true>(P.x + (size_t)r * D, P.norm_mix, hn + (size_t)r * D, lane);
    }
}

__device__ __forceinline__ int lds_off(int row, int ch) { return row * 128 + ((ch ^ ((row >> 1) & 7)) << 4); }

__device__ __forceinline__ void gemm_mainloop(const bf16_t* __restrict__ A, int lda, const bf16_t* __restrict__ Bt, int ldb, int K,
                                              f32x16 (&acc)[2][2], unsigned char* smem) {
    const int tid = threadIdx.x, wave = tid >> 6, lane = tid & 63, wr = wave >> 1, wc = wave & 1;
    const int nk = K / 64;
    uint4 ra[4], rb[4];
    __syncthreads();
#pragma unroll
    for (int i = 0; i < 4; ++i) { const int c = tid + 256 * i, row = c >> 3, ch = c & 7;
        ra[i] = *(const uint4*)(A + (size_t)row * lda + ch * 8); rb[i] = *(const uint4*)(Bt + (size_t)row * ldb + ch * 8); }
#pragma unroll
    for (int i = 0; i < 4; ++i) { const int c = tid + 256 * i, row = c >> 3, ch = c & 7;
        *(uint4*)(smem + lds_off(row, ch)) = ra[i]; *(uint4*)(smem + 16384 + lds_off(row, ch)) = rb[i]; }
    __syncthreads();
    for (int kt = 0; kt < nk; ++kt) {
        unsigned char* cur = smem + (kt & 1) * 32768;
        unsigned char* nxt = smem + ((kt + 1) & 1) * 32768;
        const bool more = kt + 1 < nk;
        if (more) {
#pragma unroll
            for (int i = 0; i < 4; ++i) { const int c = tid + 256 * i, row = c >> 3, ch = c & 7;
                ra[i] = *(const uint4*)(A + (size_t)row * lda + (kt + 1) * 64 + ch * 8); rb[i] = *(const uint4*)(Bt + (size_t)row * ldb + (kt + 1) * 64 + ch * 8); }
        }
#pragma unroll
        for (int ks = 0; ks < 4; ++ks) {
            bf16x8 af[2], bfr[2];
#pragma unroll
            for (int i = 0; i < 2; ++i) { const int row = wr * 64 + i * 32 + (lane & 31); af[i] = *(const bf16x8*)(cur + lds_off(row, ks * 2 + (lane >> 5))); }
#pragma unroll
            for (int j = 0; j < 2; ++j) { const int row = wc * 64 + j * 32 + (lane & 31); bfr[j] = *(const bf16x8*)(cur + 16384 + lds_off(row, ks * 2 + (lane >> 5))); }
#pragma unroll
            for (int i = 0; i < 2; ++i)
#pragma unroll
                for (int j = 0; j < 2; ++j) acc[i][j] = __builtin_amdgcn_mfma_f32_32x32x16_bf16(af[i], bfr[j], acc[i][j], 0, 0, 0);
        }
        if (more) {
#pragma unroll
            for (int i = 0; i < 4; ++i) { const int c = tid + 256 * i, row = c >> 3, ch = c & 7;
                *(uint4*)(nxt + lds_off(row, ch)) = ra[i]; *(uint4*)(nxt + 16384 + lds_off(row, ch)) = rb[i]; }
        }
        __syncthreads();
    }
}
#define ACC_FOREACH(body)                                                                                   \
    { const int _tid = threadIdx.x, _wave = _tid >> 6, _lane = _tid & 63, _wr = _wave >> 1, _wc = _wave & 1; \
      _Pragma("unroll") for (int i = 0; i < 2; ++i) _Pragma("unroll") for (int j = 0; j < 2; ++j)          \
      _Pragma("unroll") for (int r = 0; r < 16; ++r) {                                                     \
          const int row = _wr * 64 + i * 32 + (r & 3) + 8 * (r >> 2) + 4 * (_lane >> 5);                   \
          const int col = _wc * 64 + j * 32 + (_lane & 31); body } }

__device__ __forceinline__ void zero_acc(f32x16 (&acc)[2][2]) {
#pragma unroll
    for (int i = 0; i < 2; ++i)
#pragma unroll
        for (int j = 0; j < 2; ++j)
#pragma unroll
            for (int r = 0; r < 16; ++r) acc[i][j][r] = 0.f;
}

__device__ __forceinline__ void phase_gemm1(const Params& P, int bid, int nb, unsigned char* smem) {
    const bf16_t* A = (const bf16_t*)(P.ws + WS_HN); const bf16_t* Bt = (const bf16_t*)(P.ws + WS_WTIN); bf16_t* C = (bf16_t*)(P.ws + WS_PROJ);
    const int nmt = T / 128, nnt = NPROJ / 128;
    for (int t = bid; t < nmt * nnt; t += nb) {
        const int mt = t % nmt, nt = t / nmt;
        f32x16 acc[2][2]; zero_acc(acc);
        gemm_mainloop(A + (size_t)mt * 128 * D, D, Bt + (size_t)nt * 128 * D, D, D, acc, smem);
        ACC_FOREACH({ C[(size_t)(mt * 128 + row) * NPROJ + nt * 128 + col] = f2bf(acc[i][j][r]); })
    }
}
__device__ __forceinline__ void phase_gemm2(const Params& P, int bid, int nb, unsigned char* smem) {
    const bf16_t* A = (const bf16_t*)(P.ws + WS_MIXED); const bf16_t* Bt = (const bf16_t*)(P.ws + WS_WTOUT); float* H = (float*)(P.ws + WS_H);
    const int nmt = T / 128, nnt = D / 128;
    for (int t = bid; t < nmt * nnt; t += nb) {
        const int mt = t % nmt, nt = t / nmt;
        f32x16 acc[2][2]; zero_acc(acc);
        gemm_mainloop(A + (size_t)mt * 128 * D, D, Bt + (size_t)nt * 128 * D, D, D, acc, smem);
        ACC_FOREACH({ const size_t o = (size_t)(mt * 128 + row) * D + nt * 128 + col; H[o] = P.x[o] + acc[i][j][r]; })
    }
}
__device__ __forceinline__ void phase_gemm3(const Params& P, int bid, int nb, unsigned char* smem) {
    const bf16_t* A = (const bf16_t*)(P.ws + WS_HN); const bf16_t* Bt = (const bf16_t*)(P.ws + WS_WTPQ); bf16_t* C = (bf16_t*)(P.ws + WS_Q);
    const int nmt = T / 128, nnt = D / 128;
    for (int t = bid; t < nmt * nnt; t += nb) {
        const int mt = t % nmt, nt = t / nmt;
        f32x16 acc[2][2]; zero_acc(acc);
        gemm_mainloop(A + (size_t)mt * 128 * D, D, Bt + (size_t)nt * 128 * D, D, D, acc, smem);
        ACC_FOREACH({ C[(size_t)(mt * 128 + row) * D + nt * 128 + col] = f2bf(acc[i][j][r]); })
    }
}
__device__ __forceinline__ void phase_scores(const Params& P, int bid, int nb, unsigned char* smem) {
    const bf16_t* A = (const bf16_t*)(P.ws + WS_Q); const bf16_t* Bt = (const bf16_t*)(P.ws + WS_KEYS); float* C = (float*)(P.ws + WS_SCORES);
    const int nmt = T / 128, nnt = 16;
    for (int t = bid; t < nmt * nnt; t += nb) {
        const int mt = t % nmt, nt = t / nmt;
        f32x16 acc[2][2]; zero_acc(acc);
        gemm_mainloop(A + (size_t)mt * 128 * D + nt * 128, D, Bt + (size_t)nt * 128 * 128, 128, 128, acc, smem);
        ACC_FOREACH({ C[(size_t)(mt * 128 + row) * D + nt * 128 + col] = acc[i][j][r]; })
    }
}
__device__ __forceinline__ void phase_ple(const Params& P, int bid, int nb, unsigned char* smem) {
    const bf16_t* A2 = (const bf16_t*)(P.ws + WS_PBF); const bf16_t* Bt2 = (const bf16_t*)(P.ws + WS_WTPP); bf16_t* C = (bf16_t*)(P.ws + WS_PLE);
    const int nmt = T / 128, nnt = D / 128;
    for (int t = bid; t < nmt * nnt; t += nb) {
        const int mt = t % nmt, nt = t / nmt;
        f32x16 acc[2][2]; zero_acc(acc);
        gemm_mainloop(A2 + (size_t)mt * 128 * 256, 256, Bt2 + (size_t)nt * 128 * 256, 256, 256, acc, smem);
        ACC_FOREACH({ C[(size_t)(mt * 128 + row) * D + nt * 128 + col] = f2bf(acc[i][j][r]); })
    }
}
__device__ __forceinline__ void phase_gemm4(const Params& P, int bid, int nb, unsigned char* smem) {
    const bf16_t* A = (const bf16_t*)(P.ws + WS_HN); const bf16_t* Bt = (const bf16_t*)(P.ws + WS_WTG);
    const bf16_t* ple = (const bf16_t*)(P.ws + WS_PLE); float* H = (float*)(P.ws + WS_H);
    const int nmt = T / 128, nnt = D / 128;
    for (int t = bid; t < nmt * nnt; t += nb) {
        const int mt = t % nmt, nt = t / nmt;
        f32x16 acc[2][2]; zero_acc(acc);
        gemm_mainloop(A + (size_t)mt * 128 * D, D, Bt + (size_t)nt * 128 * D, D, D, acc, smem);
        ACC_FOREACH({ const size_t o = (size_t)(mt * 128 + row) * D + nt * 128 + col; H[o] = H[o] + sigmoid_f(acc[i][j][r]) * bf2f(ple[o]); })
    }
}

template <bool OUT_BF16>
__device__ __forceinline__ void phase_rownorm(const float* in, const float* w, void* out, int bid, int nb) {
    const int wave = threadIdx.x >> 6, lane = threadIdx.x & 63;
    for (int r = bid * 4 + wave; r < T; r += nb * 4) {
        if (OUT_BF16) rmsnorm_row<true>(in + (size_t)r * D, w, (bf16_t*)out + (size_t)r * D, lane);
        else rmsnorm_row<false>(in + (size_t)r * D, w, (float*)out + (size_t)r * D, lane);
    }
}

__device__ __forceinline__ bf16x8 frag_ld(const unsigned char* tile, int row, int ks, int lane) { return *(const bf16x8*)(tile + lds_off(row, ks * 2 + (lane >> 5))); }
__device__ __forceinline__ void lds_st_bf16(unsigned char* tile, int row, int k, float v) { *(bf16_t*)(tile + lds_off(row, k >> 3) + (k & 7) * 2) = f2bf(v); }

__device__ __forceinline__ void d1_chunk(const Params& P, int u, unsigned char* smem) {
    const bf16_t* proj = (const bf16_t*)(P.ws + WS_PROJ);
    int tid_ = threadIdx.x; asm volatile("" : "+v"(tid_));
    const int tid = tid_, wave = tid >> 6, lane = tid & 63;
    const int b = u >> 9, h = (u >> 6) & 7, c = u & 63;
    const size_t tok0 = (size_t)b * SEQ + c * 64;
    unsigned char* Ks = smem;
    unsigned char* Qs = smem + 16384;
    unsigned char* Vraw = smem + 16384;
    float* At = (float*)(smem + 34816);
    float* Gs = (float*)(smem + 51200);
    float* Bs = Gs + 64;
    __syncthreads();
    if (wave == 0) {
        const size_t t = tok0 + lane;
        const float a = bf2f(proj[t * NPROJ + C_A + h]), bb = bf2f(proj[t * NPROJ + C_B + h]);
        const float xs = a + P.dt_bias[h];
        const float sp = xs > 20.f ? xs : log1pf(expf(xs));
        float g = -expf(P.a_log[h]) * sp;
#pragma unroll
        for (int o = 1; o < 64; o <<= 1) { const float n = __shfl_up(g, o); if (lane >= o) g += n; }
        Gs[lane] = g; Bs[lane] = 1.f / (1.f + expf(-bb));
    }
    __syncthreads();
    bf16_t* QG = (bf16_t*)(P.ws + WS_QG) + (size_t)u * 64 * 128;
    for (int task = wave; task < 128; task += 4) {
        const int tok = task >> 1, isk = task & 1;
        const int ch0 = (isk ? 1024 : 0) + h * 128 + lane * 2;
        const int sp = c * 64 + tok;
        float y0 = 0.f, y1 = 0.f;
#pragma unroll
        for (int j = 0; j < 4; ++j) {
            if (sp - 3 + j >= 0) {
                const unsigned pr = *(const unsigned*)(proj + (tok0 + tok - 3 + j) * NPROJ + ch0);
                y0 += bf2f((bf16_t)(pr & 0xffff)) * P.conv_w[ch0 * 4 + j];
                y1 += bf2f((bf16_t)(pr >> 16)) * P.conv_w[(ch0 + 1) * 4 + j];
            }
        }
        y0 = silu_f(y0); y1 = silu_f(y1);
        float r = rsqrtf(wave_sum(y0 * y0 + y1 * y1) + EPS);
        if (!isk) r *= 0.08838834764831845f;
        y0 *= r; y1 *= r;
        const int k = lane * 2, half = k >> 6, kk = k & 63;
        *(unsigned*)((isk ? Ks : Qs) + half * 8192 + lds_off(tok, kk >> 3) + (kk & 7) * 2) = pack2(y0, y1);
        if (!isk) { const float eg = expf(Gs[tok]); *(unsigned*)(QG + tok * 128 + k) = pack2(y0 * eg, y1 * eg); }
    }
    __syncthreads();
    {
        const int wr = wave >> 1, wc = wave & 1;
        f32x16 akk, aqk;
#pragma unroll
        for (int r = 0; r < 16; ++r) { akk[r] = 0.f; aqk[r] = 0.f; }
        if (!(wr == 0 && wc == 1)) {
#pragma unroll
            for (int half = 0; half < 2; ++half)
#pragma unroll
                for (int ks = 0; ks < 4; ++ks) {
                    const bf16x8 fk = frag_ld(Ks + half * 8192, wr * 32 + (lane & 31), ks, lane);
                    const bf16x8 fq = frag_ld(Qs + half * 8192, wr * 32 + (lane & 31), ks, lane);
                    const bf16x8 fb = frag_ld(Ks + half * 8192, wc * 32 + (lane & 31), ks, lane);
                    akk = __builtin_amdgcn_mfma_f32_32x32x16_bf16(fk, fb, akk, 0, 0, 0);
                    aqk = __builtin_amdgcn_mfma_f32_32x32x16_bf16(fq, fb, aqk, 0, 0, 0);
                }
        }
        const int j = wc * 32 + (lane & 31); const float Gj = Gs[j];
        bf16_t* ATT = (bf16_t*)(P.ws + WS_ATT) + (size_t)u * 64 * 64;
#pragma unroll
        for (int g4 = 0; g4 < 4; ++g4) {
            const int i0 = wr * 32 + 8 * g4 + 4 * (lane >> 5);
            f32x4 av;
#pragma unroll
            for (int e = 0; e < 4; ++e) {
                const int i = i0 + e, r = g4 * 4 + e;
                const float dec = (i >= j) ? expf(Gs[i] - Gj) : 0.f;
                av[e] = (i > j) ? Bs[i] * akk[r] * dec : 0.f;
                ATT[i * 64 + j] = f2bf(aqk[r] * dec);
            }
            *(f32x4*)(At + j * 64 + i0) = av;
        }
    }
    __syncthreads();
    {
        for (int q = tid; q < 67 * 16; q += 256) {
            const int row = q >> 4, c16 = q & 15;
            uint4 v = make_uint4(0u, 0u, 0u, 0u);
            if (c > 0 || row >= 3) v = *(const uint4*)(proj + (tok0 + row - 3) * NPROJ + 2048 + h * 128 + c16 * 8);
            *(uint4*)(Vraw + row * 256 + c16 * 16) = v;
        }
    }
    __syncthreads();
    {
        float r[64];
        if (tid < 128) {
            const int ch = 2048 + h * 128 + tid;
            const float w0 = P.conv_w[ch * 4 + 0], w1 = P.conv_w[ch * 4 + 1], w2 = P.conv_w[ch * 4 + 2], w3 = P.conv_w[ch * 4 + 3];
            const bf16_t* vcol = (const bf16_t*)Vraw + tid;
            float xm3 = bf2f(vcol[0]), xm2 = bf2f(vcol[128]), xm1 = bf2f(vcol[256]);
#pragma unroll
            for (int i = 0; i < 64; ++i) {
                const float x0 = bf2f(vcol[(i + 3) * 128]);
                const float y = w0 * xm3 + w1 * xm2 + w2 * xm1 + w3 * x0;
                r[i] = Bs[i] * silu_f(y);
                xm3 = xm2; xm2 = xm1; xm1 = x0;
            }
        } else {
            const int dk = tid - 128, half = dk >> 6, kk = dk & 63;
            const float G63 = Gs[63];
            bf16_t* KDT = (bf16_t*)(P.ws + WS_KDT) + (size_t)u * 128 * 64 + dk * 64;
#pragma unroll
            for (int i8 = 0; i8 < 8; ++i8) {
                unsigned pk[4];
#pragma unroll
                for (int e2 = 0; e2 < 4; ++e2) {
                    float kd[2];
#pragma unroll
                    for (int e = 0; e < 2; ++e) {
                        const int i = i8 * 8 + e2 * 2 + e;
                        const float kv = bf2f(*(const bf16_t*)(Ks + half * 8192 + lds_off(i, kk >> 3) + (kk & 7) * 2));
                        const float Gi = Gs[i];
                        r[i] = -Bs[i] * expf(Gi) * kv;
                        kd[e] = kv * expf(G63 - Gi);
                    }
                    pk[e2] = pack2(kd[0], kd[1]);
                }
                *(uint4*)(KDT + i8 * 8) = make_uint4(pk[0], pk[1], pk[2], pk[3]);
            }
        }
#pragma unroll
        for (int j = 0; j < 63; ++j) {
            const float xj = r[j];
#pragma unroll
            for (int i4 = ((j + 1) & ~3); i4 < 64; i4 += 4) {
                const f32x4 a = *(const f32x4*)(At + j * 64 + i4);
                r[i4] -= a[0] * xj; r[i4 + 1] -= a[1] * xj; r[i4 + 2] -= a[2] * xj; r[i4 + 3] -= a[3] * xj;
            }
        }
        if (tid < 128) {
            float* U = (float*)(P.ws + WS_U) + (size_t)u * 64 * 128 + (tid >> 5) * 2048 + (tid & 31);
#pragma unroll
            for (int i = 0; i < 64; ++i) { const int tt = i >> 5, i5 = i & 31, rr = (i5 & 3) + 4 * (i5 >> 3), hh = (i5 >> 2) & 1; U[(tt * 16 + rr) * 64 + hh * 32] = r[i]; }
        } else {
            bf16_t* W = (bf16_t*)(P.ws + WS_W) + (size_t)u * 64 * 128 + (tid - 128);
#pragma unroll
            for (int i = 0; i < 64; ++i) W[i * 128] = f2bf(r[i]);
        }
        if (tid == 0) ((float*)(P.ws + WS_EG))[u] = expf(Gs[63]);
    }
}

__device__ __forceinline__ void r1_chunk(const Params& P, int u, unsigned char* smem) {
    const bf16_t* proj = (const bf16_t*)(P.ws + WS_PROJ);
    int tid_ = threadIdx.x; asm volatile("" : "+v"(tid_));
    const int tid = tid_, wave = tid >> 6, lane = tid & 63;
    const int b = u >> 9, h = (u >> 6) & 7, c = u & 63;
    const size_t tok0 = (size_t)b * SEQ + c * 64;
    unsigned char* RQ = smem;
    unsigned char* RK = smem + 8192;
    unsigned char* VT = smem + 16384;
    unsigned char* RKT = smem + 32768;
    const float l2g = log2f(1.f - exp2f(-5.f - (float)h));
    __syncthreads();
    bf16_t* QGR = (bf16_t*)(P.ws + WS_QGR) + (size_t)u * 64 * 64;
#pragma unroll 2
    for (int it = 0; it < 8; ++it) {
        const int e = tid + 256 * it, tok = e >> 5, i = e & 31;
        const size_t t = tok0 + tok;
        const float inv = powf(10000.f, -(float)i / 32.f);
        const float ang = (float)P.positions[t] * inv;
        float sn, cs; sincosf(ang, &sn, &cs);
        const float q1 = bf2f(proj[t * NPROJ + C_RQ + h * 64 + i]), q2 = bf2f(proj[t * NPROJ + C_RQ + h * 64 + 32 + i]);
        const float k1 = bf2f(proj[t * NPROJ + C_RK + h * 64 + i]) * 0.125f, k2 = bf2f(proj[t * NPROJ + C_RK + h * 64 + 32 + i]) * 0.125f;
        const float qa = q1 * cs - q2 * sn, qb = q1 * sn + q2 * cs, ka = k1 * cs - k2 * sn, kb = k1 * sn + k2 * cs;
        const float xi = exp2f(l2g * (float)(tok + 1)), zeta = exp2f(l2g * (float)(63 - tok));
        lds_st_bf16(RQ, tok, i, qa); lds_st_bf16(RQ, tok, 32 + i, qb);
        lds_st_bf16(RK, tok, i, ka); lds_st_bf16(RK, tok, 32 + i, kb);
        lds_st_bf16(RKT, i, tok, ka * zeta); lds_st_bf16(RKT, 32 + i, tok, kb * zeta);
        QGR[tok * 64 + i] = f2bf(qa * xi); QGR[tok * 64 + 32 + i] = f2bf(qb * xi);
    }
#pragma unroll 4
    for (int it = 0; it < 16; ++it) {
        const int e = tid + 256 * it, tok = e >> 6, dp = e & 63;
        const unsigned pr = *(const unsigned*)(proj + (tok0 + tok) * NPROJ + C_RV + h * 128 + dp * 2);
        *(bf16_t*)(VT + lds_off(dp * 2, tok >> 3) + (tok & 7) * 2) = (bf16_t)(pr & 0xffff);
        *(bf16_t*)(VT + lds_off(dp * 2 + 1, tok >> 3) + (tok & 7) * 2) = (bf16_t)(pr >> 16);
    }
    __syncthreads();
    {
        bf16_t* VNTR = (bf16_t*)(P.ws + WS_VNTR) + (size_t)u * 128 * 64;
#pragma unroll
        for (int it = 0; it < 4; ++it) { const int q = tid + 256 * it, row = q >> 3, ch = q & 7; *(uint4*)(VNTR + row * 64 + ch * 8) = *(const uint4*)(VT + lds_off(row, ch)); }
    }
    {
        const int wr = wave >> 1, wc = wave & 1;
        f32x16 acc;
#pragma unroll
        for (int r = 0; r < 16; ++r) acc[r] = 0.f;
        if (!(wr == 0 && wc == 1)) {
#pragma unroll
            for (int ks = 0; ks < 4; ++ks) acc = __builtin_amdgcn_mfma_f32_32x32x16_bf16(frag_ld(RQ, wr * 32 + (lane & 31), ks, lane), frag_ld(RK, wc * 32 + (lane & 31), ks, lane), acc, 0, 0, 0);
        }
        const int j = wc * 32 + (lane & 31);
        bf16_t* ATTR = (bf16_t*)(P.ws + WS_ATTR) + (size_t)u * 64 * 64;
#pragma unroll
        for (int r = 0; r < 16; ++r) {
            const int i = wr * 32 + (r & 3) + 8 * (r >> 2) + 4 * (lane >> 5);
            const float dec = (i >= j) ? exp2f(l2g * (float)(i - j)) : 0.f;
            ATTR[i * 64 + j] = f2bf(acc[r] * dec);
        }
    }
    {
        f32x16 acc[2];
#pragma unroll
        for (int j = 0; j < 2; ++j)
#pragma unroll
            for (int r = 0; r < 16; ++r) acc[j][r] = 0.f;
#pragma unroll
        for (int ks = 0; ks < 4; ++ks) {
            const bf16x8 fa = frag_ld(VT, wave * 32 + (lane & 31), ks, lane);
#pragma unroll
            for (int j = 0; j < 2; ++j) acc[j] = __builtin_amdgcn_mfma_f32_32x32x16_bf16(fa, frag_ld(RKT, j * 32 + (lane & 31), ks, lane), acc[j], 0, 0, 0);
        }
        float* KVT = (float*)(P.ws + WS_KVT) + (size_t)u * 128 * 64;
#pragma unroll
        for (int j = 0; j < 2; ++j)
#pragma unroll
            for (int r = 0; r < 16; ++r) { const int dv = wave * 32 + (r & 3) + 8 * (r >> 2) + 4 * (lane >> 5); KVT[dv * 64 + j * 32 + (lane & 31)] = acc[j][r]; }
    }
}

__device__ __forceinline__ void phase_chunk1(const Params& P, int bid, int nb, unsigned char* smem) {
    for (int u = bid; u < 2048; u += nb) { if (u < 1024) d1_chunk(P, u, smem); else r1_chunk(P, u - 1024, smem); }
}

__device__ __forceinline__ void d2_scan(const Params& P, int bh, unsigned char* smem) {
    const int tid = threadIdx.x, wave = tid >> 6, lane = tid & 63;
    unsigned char* Wt = smem;
    unsigned char* KDt = smem + 16384;
    unsigned char* img = smem + 32768 + wave * 8192;
    const int dv0 = wave * 32;
    const size_t cb = (size_t)bh * 64;
    const bf16_t* Wg = (const bf16_t*)(P.ws + WS_W); const bf16_t* KDg = (const bf16_t*)(P.ws + WS_KDT);
    const float* Ug = (const float*)(P.ws + WS_U); const float* EGg = (const float*)(P.ws + WS_EG);
    bf16_t* SCg = (bf16_t*)(P.ws + WS_SC); bf16_t* VNg = (bf16_t*)(P.ws + WS_VNT);
    f32x16 S[4];
#pragma unroll
    for (int d = 0; d < 4; ++d)
#pragma unroll
        for (int r = 0; r < 16; ++r) S[d][r] = 0.f;
    uint4 pw0, pw1, pw2, pw3, pk0, pk1, pk2, pk3;
    __syncthreads();
#define D2_LOAD(uu) { const bf16_t* wp = Wg + (uu) * 8192 + tid * 8; const bf16_t* kp = KDg + (uu) * 8192 + tid * 8; \
        pw0 = *(const uint4*)(wp); pw1 = *(const uint4*)(wp + 2048); pw2 = *(const uint4*)(wp + 4096); pw3 = *(const uint4*)(wp + 6144); \
        pk0 = *(const uint4*)(kp); pk1 = *(const uint4*)(kp + 2048); pk2 = *(const uint4*)(kp + 4096); pk3 = *(const uint4*)(kp + 6144); }
#define D2_ST1(i, vw, vk) { const int q = tid + 256 * (i); { const int row = q >> 4, c16 = q & 15; *(uint4*)(Wt + (c16 >> 3) * 8192 + lds_off(row, c16 & 7)) = (vw); } \
        { const int row = q >> 3, ch = q & 7; *(uint4*)(KDt + lds_off(row, ch)) = (vk); } }
#define D2_STORE() { D2_ST1(0, pw0, pk0) D2_ST1(1, pw1, pk1) D2_ST1(2, pw2, pk2) D2_ST1(3, pw3, pk3) }
    D2_LOAD(cb)
    D2_STORE()
#pragma unroll
    for (int i = 0; i < 8; ++i) { *(uint4*)(img + (lane + 64 * i) * 16) = make_uint4(0u, 0u, 0u, 0u);
        const int q = lane + 64 * i; *(uint4*)(SCg + cb * 16384 + (size_t)(dv0 + (q >> 4)) * 128 + (q & 15) * 8) = make_uint4(0u, 0u, 0u, 0u); }
    __syncthreads();
    f32x16 un0, un1;
#define D2_LOADU(uu) { const float* up = Ug + (uu) * 8192 + wave * 2048 + lane; \
        _Pragma("unroll") for (int r = 0; r < 16; ++r) { un0[r] = up[r * 64]; un1[r] = up[(16 + r) * 64]; } }
    D2_LOADU(cb)
    for (int c = 0; c < 64; ++c) {
        const size_t u = cb + c;
        f32x16 vn0 = un0, vn1 = un1;
        if (c + 1 < 64) {
            D2_LOAD(u + 1)
            D2_LOADU(u + 1)
        }
        const float eg = EGg[u];
#pragma unroll
        for (int half = 0; half < 2; ++half)
#pragma unroll
            for (int ks = 0; ks < 4; ++ks) {
                const bf16x8 fb = frag_ld(img + half * 4096, lane & 31, ks, lane);
                vn0 = __builtin_amdgcn_mfma_f32_32x32x16_bf16(frag_ld(Wt + half * 8192, (lane & 31), ks, lane), fb, vn0, 0, 0, 0);
                vn1 = __builtin_amdgcn_mfma_f32_32x32x16_bf16(frag_ld(Wt + half * 8192, 32 + (lane & 31), ks, lane), fb, vn1, 0, 0, 0);
            }
#define D2_VN(tt, vv) _Pragma("unroll") for (int g4 = 0; g4 < 4; ++g4) { const int r0 = g4 * 4; \
            const uint2 pkd = make_uint2(pack2(vv[r0], vv[r0 + 1]), pack2(vv[r0 + 2], vv[r0 + 3])); \
            const int tok = (tt) * 32 + 8 * g4 + 4 * (lane >> 5); \
            *(uint2*)(img + lds_off(lane & 31, tok >> 3) + (tok & 7) * 2) = pkd; \
            *(uint2*)(VNg + u * 8192 + (size_t)(dv0 + (lane & 31)) * 64 + tok) = pkd; }
        D2_VN(0, vn0) D2_VN(1, vn1)
#pragma unroll
        for (int d = 0; d < 4; ++d)
#pragma unroll
            for (int r = 0; r < 16; ++r) S[d][r] *= eg;
#pragma unroll
        for (int ks = 0; ks < 4; ++ks) {
            const bf16x8 fb = frag_ld(img, lane & 31, ks, lane);
#pragma unroll
            for (int d = 0; d < 4; ++d) S[d] = __builtin_amdgcn_mfma_f32_32x32x16_bf16(frag_ld(KDt, d * 32 + (lane & 31), ks, lane), fb, S[d], 0, 0, 0);
        }
#pragma unroll
        for (int d = 0; d < 4; ++d)
#pragma unroll
            for (int g4 = 0; g4 < 4; ++g4) {
                const int r0 = g4 * 4;
                const uint2 pkd = make_uint2(pack2(S[d][r0], S[d][r0 + 1]), pack2(S[d][r0 + 2], S[d][r0 + 3]));
                const int kk = (d & 1) * 32 + 8 * g4 + 4 * (lane >> 5);
                *(uint2*)(img + (d >> 1) * 4096 + lds_off(lane & 31, kk >> 3) + (kk & 7) * 2) = pkd;
                if (c + 1 < 64) *(uint2*)(SCg + (u + 1) * 16384 + (size_t)(dv0 + (lane & 31)) * 128 + (d >> 1) * 64 + kk) = pkd;
            }
        __syncthreads();
        if (c + 1 < 64) D2_STORE()
        __syncthreads();
    }
}

__device__ __forceinline__ void r2_scan(const Params& P, int vb, int nvb) {
    const float* KVT = (const float*)(P.ws + WS_KVT); bf16_t* STR = (bf16_t*)(P.ws + WS_STR);
    for (int idx = vb * 256 + threadIdx.x; idx < 16 * 8192; idx += nvb * 256) {
        const int bh = idx >> 13, e = idx & 8191, h = bh & 7;
        const float cd = exp2f(64.f * log2f(1.f - exp2f(-5.f - (float)h)));
        float S = 0.f;
#pragma unroll 8
        for (int c = 0; c < 64; ++c) {
            const size_t o = ((size_t)bh * 64 + c) * 8192 + e;
            STR[o] = f2bf(S);
            S = cd * S + KVT[o];
        }
    }
}

__device__ __forceinline__ void phase_scan(const Params& P, int bid, int nb, unsigned char* smem) {
    if (bid < 16) d2_scan(P, bid, smem); else r2_scan(P, bid - 16, nb - 16);
}

template <int K1, bool RET>
__device__ __forceinline__ void chunk_out(const Params& P, int u, unsigned char* smem) {
    int tid_ = threadIdx.x; asm volatile("" : "+v"(tid_));
    const int tid = tid_, wave = tid >> 6, lane = tid & 63, wr = wave >> 1, wc = wave & 1;
    const int b = u >> 9, h = (u >> 6) & 7, c = u & 63;
    const size_t tok0 = (size_t)b * SEQ + c * 64;
    const bf16_t* A1 = RET ? (const bf16_t*)(P.ws + WS_QGR) + (size_t)u * 64 * 64 : (const bf16_t*)(P.ws + WS_QG) + (size_t)u * 64 * 128;
    const bf16_t* B1 = RET ? (const bf16_t*)(P.ws + WS_STR) + (size_t)u * 128 * 64 : (const bf16_t*)(P.ws + WS_SC) + (size_t)u * 128 * 128;
    const bf16_t* A2 = RET ? (const bf16_t*)(P.ws + WS_ATTR) + (size_t)u * 64 * 64 : (const bf16_t*)(P.ws + WS_ATT) + (size_t)u * 64 * 64;
    const bf16_t* B2 = RET ? (const bf16_t*)(P.ws + WS_VNTR) + (size_t)u * 128 * 64 : (const bf16_t*)(P.ws + WS_VNT) + (size_t)u * 128 * 64;
    unsigned char* As = smem;
    unsigned char* Bs = smem + 8192;
    float* red = (float*)(smem + 24576);
    f32x16 acc[2];
#pragma unroll
    for (int j = 0; j < 2; ++j)
#pragma unroll
        for (int r = 0; r < 16; ++r) acc[j][r] = 0.f;
    constexpr int NK1 = K1 / 64;
#pragma unroll
    for (int kt = 0; kt <= NK1; ++kt) {
        const bf16_t* Ap = (kt < NK1) ? A1 + kt * 64 : A2; const int lda = (kt < NK1) ? K1 : 64;
        const bf16_t* Bp = (kt < NK1) ? B1 + kt * 64 : B2; const int ldb = lda;
        __syncthreads();
#pragma unroll
        for (int i = 0; i < 2; ++i) { const int q = tid + 256 * i, row = q >> 3, ch = q & 7; *(uint4*)(As + lds_off(row, ch)) = *(const uint4*)(Ap + row * lda + ch * 8); }
#pragma unroll
        for (int i = 0; i < 4; ++i) { const int q = tid + 256 * i, row = q >> 3, ch = q & 7; *(uint4*)(Bs + lds_off(row, ch)) = *(const uint4*)(Bp + row * ldb + ch * 8); }
        __syncthreads();
#pragma unroll
        for (int ks = 0; ks < 4; ++ks) {
            const bf16x8 fa = frag_ld(As, wr * 32 + (lane & 31), ks, lane);
#pragma unroll
            for (int j = 0; j < 2; ++j) acc[j] = __builtin_amdgcn_mfma_f32_32x32x16_bf16(fa, frag_ld(Bs, wc * 64 + j * 32 + (lane & 31), ks, lane), acc[j], 0, 0, 0);
        }
    }
#pragma unroll
    for (int r = 0; r < 16; ++r) {
        float s1 = acc[0][r] + acc[1][r], s2 = acc[0][r] * acc[0][r] + acc[1][r] * acc[1][r];
#pragma unroll
        for (int o = 16; o >= 1; o >>= 1) { s1 += __shfl_xor(s1, o); s2 += __shfl_xor(s2, o); }
        if ((lane & 31) == 0) { const int row = wr * 32 + (r & 3) + 8 * (r >> 2) + 4 * (lane >> 5); red[(row * 2 + wc) * 2] = s1; red[(row * 2 + wc) * 2 + 1] = s2; }
    }
    __syncthreads();
    const bf16_t* proj = (const bf16_t*)(P.ws + WS_PROJ); bf16_t* mixed = (bf16_t*)(P.ws + WS_MIXED);
#pragma unroll
    for (int r = 0; r < 16; ++r) {
        const int row = wr * 32 + (r & 3) + 8 * (r >> 2) + 4 * (lane >> 5);
        const float s1 = red[row * 4] + red[row * 4 + 2], s2 = red[row * 4 + 1] + red[row * 4 + 3];
        const size_t t = tok0 + row;
#pragma unroll
        for (int j = 0; j < 2; ++j) {
            const int dv = wc * 64 + j * 32 + (lane & 31);
            float y;
            if (!RET) {
                const float rs = rsqrtf(s2 * (1.f / 128.f) + EPS);
                y = acc[j][r] * rs * P.dn_norm[dv] * silu_f(bf2f(proj[t * NPROJ + C_Z + h * 128 + dv]));
                mixed[t * D + h * 128 + dv] = f2bf(y);
            } else {
                const float mu = s1 * (1.f / 128.f);
                const float var = fmaxf(s2 * (1.f / 128.f) - mu * mu, 0.f);
                const float rs = rsqrtf(var + EPS);
                y = ((acc[j][r] - mu) * rs * P.ret_gn_w[h * 128 + dv] + P.ret_gn_b[h * 128 + dv]) * silu_f(bf2f(proj[t * NPROJ + C_RG + h * 128 + dv]));
                mixed[t * D + 1024 + h * 128 + dv] = f2bf(y);
            }
        }
    }
}

__device__ __forceinline__ void phase_chunk3(const Params& P, int bid, int nb, unsigned char* smem) {
    for (int u = bid; u < 2048; u += nb) { if (u < 1024) chunk_out<128, false>(P, u, smem); else chunk_out<64, true>(P, u - 1024, smem); }
}

__device__ __forceinline__ void phase_route(const Params& P, int bid, int nb) {
    const float* scores = (const float*)(P.ws + WS_SCORES); int* idx = (int*)(P.ws + WS_IDX); float* gates = (float*)(P.ws + WS_GATES);
    const int wave = threadIdx.x >> 6, lane = threadIdx.x & 63;
    const float NEG = -3.0e38f;
    for (int u = bid * 4 + wave; u < T * 8; u += nb * 4) {
        const int t = u >> 3, h = u & 7;
        float top_s[2]; int top_i[2];
#pragma unroll
        for (int p = 0; p < 2; ++p) {
            const float* sp = scores + (size_t)t * D + (h * 2 + p) * 128;
            float k0 = __uint_as_float((__float_as_uint(sp[lane]) & ~0x7Fu) | (unsigned)lane);
            float k1 = __uint_as_float((__float_as_uint(sp[lane + 64]) & ~0x7Fu) | (unsigned)(lane + 64));
            float mine = 0.f;
            for (int r = 0; r < 16; ++r) {
                const float m = wave_max(fmaxf(k0, k1));
                if (k0 == m) k0 = NEG;
                if (k1 == m) k1 = NEG;
                if (lane == r) mine = m;
            }
            top_i[p] = (int)(__float_as_uint(mine) & 0x7Fu);
            top_s[p] = mine;
        }
        float ck[4];
#pragma unroll
        for (int e = 0; e < 4; ++e) {
            const int cand = lane * 4 + e, i = cand >> 4, j = cand & 15;
            const float s = __shfl(top_s[0], i) + __shfl(top_s[1], j);
            ck[e] = __uint_as_float((__float_as_uint(s) & ~0xFFu) | (unsigned)cand);
        }
        float mine = 0.f;
        for (int r = 0; r < 16; ++r) {
            const float m = wave_max(fmaxf(fmaxf(ck[0], ck[1]), fmaxf(ck[2], ck[3])));
#pragma unroll
            for (int e = 0; e < 4; ++e) if (ck[e] == m) ck[e] = NEG;
            if (lane == r) mine = m;
        }
        const int cand = (int)(__float_as_uint(mine) & 0xFFu);
        const int i1 = __shfl(top_i[0], cand >> 4), i2 = __shfl(top_i[1], cand & 15);
        const float smax = __shfl(mine, 0);
        float e = (lane < 16) ? __expf(mine - smax) : 0.f;
        const float sum = wave_sum(e);
        if (lane < 16) { idx[(size_t)t * 128 + h * 16 + lane] = i1 * 128 + i2; gates[(size_t)t * 128 + h * 16 + lane] = e / sum; }
    }
}

typedef float f32x2 __attribute__((ext_vector_type(2)));
__device__ __forceinline__ void phase_econv(const Params& P, int bid, int nb) {
    const int wave = threadIdx.x >> 6, lane = threadIdx.x & 63;
    float* scales = (float*)(P.ws + WS_ESC);
    for (int r = bid * 4 + wave; r < 32768; r += nb * 4) {
        const float* src = (r < 16384 ? P.expert_u : P.expert_v) + (size_t)(r & 16383) * D;
        int* dst = (int*)(P.ws + WS_EU8 + (size_t)r * 2048);
        f32x4 v[8]; float am = 0.f;
#pragma unroll
        for (int i = 0; i < 8; ++i) { v[i] = *(const f32x4*)(src + (i * 64 + lane) * 4); am = fmaxf(am, fmaxf(fmaxf(fabsf(v[i][0]), fabsf(v[i][1])), fmaxf(fabsf(v[i][2]), fabsf(v[i][3])))); }
        am = wave_max(am);
        const float sc = am > 0.f ? 224.f / am : 1.f;
#pragma unroll
        for (int i = 0; i < 8; ++i) {
            int w = 0;
            w = __builtin_amdgcn_cvt_pk_fp8_f32(v[i][0] * sc, v[i][1] * sc, w, false);
            w = __builtin_amdgcn_cvt_pk_fp8_f32(v[i][2] * sc, v[i][3] * sc, w, true);
            dst[i * 64 + lane] = w;
        }
        if (lane == 0) scales[r] = am > 0.f ? am * (1.f / 224.f) : 1.f;
    }
}

__device__ __forceinline__ float dot16(const uint4 w, const float* x) {
    float d = 0.f; const unsigned ww[4] = {w.x, w.y, w.z, w.w};
#pragma unroll
    for (int q = 0; q < 4; ++q) {
        const f32x2 lo = __builtin_amdgcn_cvt_pk_f32_fp8((int)ww[q], false), hi = __builtin_amdgcn_cvt_pk_f32_fp8((int)ww[q], true);
        d += lo[0] * x[q * 4] + lo[1] * x[q * 4 + 1] + hi[0] * x[q * 4 + 2] + hi[1] * x[q * 4 + 3];
    }
    return d;
}
__device__ __forceinline__ void axpy16(const uint4 w, const float a, float* acc) {
    const unsigned ww[4] = {w.x, w.y, w.z, w.w};
#pragma unroll
    for (int q = 0; q < 4; ++q) {
        const f32x2 lo = __builtin_amdgcn_cvt_pk_f32_fp8((int)ww[q], false), hi = __builtin_amdgcn_cvt_pk_f32_fp8((int)ww[q], true);
        acc[q * 4] += a * lo[0]; acc[q * 4 + 1] += a * lo[1]; acc[q * 4 + 2] += a * hi[0]; acc[q * 4 + 3] += a * hi[1];
    }
}
__device__ __forceinline__ float gelu_f(float d) { return 0.5f * d * (1.f + erff(d * 0.70710678118654752f)); }

__device__ __forceinline__ void phase_peer(const Params& P, int bid, int nb) {
    const bf16_t* hn = (const bf16_t*)(P.ws + WS_HN); const int* idx = (const int*)(P.ws + WS_IDX); const float* gates = (const float*)(P.ws + WS_GATES);
    float* H = (float*)(P.ws + WS_H);
    const unsigned char* EU = P.ws + WS_EU8; const unsigned char* EV = P.ws + WS_EV8; const float* SC = (const float*)(P.ws + WS_ESC);
    const int wave = threadIdx.x >> 6, lane = threadIdx.x & 63;
    for (int t = bid * 4 + wave; t < T; t += nb * 4) {
        float xr[32], acc[32];
#pragma unroll
        for (int c = 0; c < 2; ++c)
#pragma unroll
            for (int q = 0; q < 2; ++q) {
                const uint4 v = *(const uint4*)(hn + (size_t)t * D + c * 1024 + lane * 16 + q * 8);
                const unsigned ww[4] = {v.x, v.y, v.z, v.w};
#pragma unroll
                for (int j = 0; j < 4; ++j) { xr[c * 16 + q * 8 + 2 * j] = bf2f((bf16_t)(ww[j] & 0xffff)); xr[c * 16 + q * 8 + 2 * j + 1] = bf2f((bf16_t)(ww[j] >> 16)); }
            }
#pragma unroll
        for (int i = 0; i < 32; ++i) acc[i] = 0.f;
        const int   my_i0 = idx[(size_t)t * 128 + lane],   my_i1 = idx[(size_t)t * 128 + 64 + lane];
        const float my_g0 = gates[(size_t)t * 128 + lane], my_g1 = gates[(size_t)t * 128 + 64 + lane];
        uint4 a_u0, a_u1, a_v0, a_v1, a_u2, a_u3, a_v2, a_v3;
        uint4 b_u0, b_u1, b_v0, b_v1, b_u2, b_u3, b_v2, b_v3;
#define PEER_LOAD1(U0, U1, V0, V1, e) { const uint4* up = (const uint4*)(EU + (size_t)(e) * 2048) + lane; U0 = up[0]; U1 = up[64]; \
                                         const uint4* vp = (const uint4*)(EV + (size_t)(e) * 2048) + lane; V0 = vp[0]; V1 = vp[64]; }
#define PEER_COMP1(U0, U1, V0, V1, e, g) { float d = dot16(U0, xr) + dot16(U1, xr + 16); d = wave_sum(d); \
                                            const float pre = d * SC[e]; const float a = gelu_f(pre) * (g) * SC[16384 + (e)]; axpy16(V0, a, acc); axpy16(V1, a, acc + 16); }
#pragma unroll
        for (int hh = 0; hh < 2; ++hh) {
            const int mi = hh ? my_i1 : my_i0; const int mgi = __float_as_int(hh ? my_g1 : my_g0);
            { const int e0 = __builtin_amdgcn_readlane(mi, 0), e1 = __builtin_amdgcn_readlane(mi, 1); PEER_LOAD1(a_u0, a_u1, a_v0, a_v1, e0) PEER_LOAD1(a_u2, a_u3, a_v2, a_v3, e1) }
            for (int k = 0; k < 64; k += 4) {
                const int e0 = __builtin_amdgcn_readlane(mi, k), e1 = __builtin_amdgcn_readlane(mi, k + 1), e2 = __builtin_amdgcn_readlane(mi, k + 2), e3 = __builtin_amdgcn_readlane(mi, k + 3);
                const float g0 = __int_as_float(__builtin_amdgcn_readlane(mgi, k)), g1 = __int_as_float(__builtin_amdgcn_readlane(mgi, k + 1)), g2 = __int_as_float(__builtin_amdgcn_readlane(mgi, k + 2)), g3 = __int_as_float(__builtin_amdgcn_readlane(mgi, k + 3));
                PEER_LOAD1(b_u0, b_u1, b_v0, b_v1, e2) PEER_LOAD1(b_u2, b_u3, b_v2, b_v3, e3)
                PEER_COMP1(a_u0, a_u1, a_v0, a_v1, e0, g0) PEER_COMP1(a_u2, a_u3, a_v2, a_v3, e1, g1)
                if (k + 4 < 64) { const int e4 = __builtin_amdgcn_readlane(mi, k + 4), e5 = __builtin_amdgcn_readlane(mi, k + 5); PEER_LOAD1(a_u0, a_u1, a_v0, a_v1, e4) PEER_LOAD1(a_u2, a_u3, a_v2, a_v3, e5) }
                PEER_COMP1(b_u0, b_u1, b_v0, b_v1, e2, g2) PEER_COMP1(b_u2, b_u3, b_v2, b_v3, e3, g3)
            }
        }
        float ss = 0.f;
#pragma unroll
        for (int c = 0; c < 2; ++c)
#pragma unroll
            for (int q = 0; q < 4; ++q) {
                f32x4* hp = (f32x4*)(H + (size_t)t * D + c * 1024 + lane * 16 + q * 4);
                f32x4 hv = *hp;
#pragma unroll
                for (int j = 0; j < 4; ++j) { hv[j] += acc[c * 16 + q * 4 + j]; acc[c * 16 + q * 4 + j] = hv[j]; ss += hv[j] * hv[j]; }
                *hp = hv;
            }
        ss = wave_sum(ss);
        const float rs = rsqrtf(ss * (1.f / 2048.f) + EPS);
        bf16_t* hn3 = (bf16_t*)(P.ws + WS_HN) + (size_t)t * D;
#pragma unroll
        for (int c = 0; c < 2; ++c)
#pragma unroll
            for (int q = 0; q < 2; ++q) {
                unsigned w[4];
#pragma unroll
                for (int j = 0; j < 4; ++j) { const int col = c * 1024 + lane * 16 + q * 8 + 2 * j;
                    w[j] = pack2(acc[c * 16 + q * 8 + 2 * j] * rs * P.norm_ple[col], acc[c * 16 + q * 8 + 2 * j + 1] * rs * P.norm_ple[col + 1]); }
                *(uint4*)(hn3 + c * 1024 + lane * 16 + q * 8) = make_uint4(w[0], w[1], w[2], w[3]);
            }
    }
}

enum { PH_PREP = 0, PH_GEMM1, PH_CHUNK1, PH_SCAN, PH_CHUNK3, PH_ECONV, PH_GEMM2, PH_NORM2, PH_GEMM3, PH_SCORES, PH_ROUTE, PH_PEER, PH_PLE, PH_GEMM4, PH_FINAL, PH_COUNT };

#define XB_TMO      128
#define XB_XCNT(j)  (256  + 64 * (j))
#define XB_XSUB(j)  (1280 + 64 * (j))
#define XB_XGEN(j)  (2304 + 64 * (j))
#define XB_TOP      3328
#define XB_TOPGEN   3392
#define XCD_BAR_WORDS 3456
#define XB_SPIN_CAP (1u << 20)
#define LAS __attribute__((address_space(3)))
__device__ __forceinline__ unsigned xb_ld(unsigned* p)              { return __hip_atomic_load(p, __ATOMIC_RELAXED, __HIP_MEMORY_SCOPE_AGENT); }
__device__ __forceinline__ unsigned xb_add(unsigned* p, unsigned v) { return __hip_atomic_fetch_add(p, v, __ATOMIC_RELAXED, __HIP_MEMORY_SCOPE_AGENT); }
__device__ __forceinline__ unsigned xb_xcc_id() { return (unsigned)__builtin_amdgcn_s_getreg((3 << 11) | 20) & 0xFu; }
#define XB_SPIN(cond, bar) do { unsigned _sp = 0; while (cond) { __builtin_amdgcn_s_sleep(1); \
    if ((++_sp & 255u) == 0u) { if (xb_ld(&(bar)[XB_TMO])) break; if (_sp > XB_SPIN_CAP) { atomicAdd(&(bar)[XB_TMO], 1u); break; } } } } while (0)
struct XcdBarrier { unsigned* bar; unsigned x; volatile LAS unsigned* st; };
__device__ __forceinline__ XcdBarrier xcd_barrier_post(unsigned* bar, volatile LAS unsigned* st) {
    XcdBarrier b; b.bar = bar; b.x = xb_xcc_id(); b.st = st;
    if (threadIdx.x == 0) (void)xb_add(&bar[XB_XCNT(b.x)], 1u);
    return b;
}
__device__ __forceinline__ void xcd_barrier_complete(unsigned* bar, unsigned x, unsigned& nloc, unsigned& nx) {
    const unsigned G = gridDim.x * gridDim.y * gridDim.z;
    unsigned sum, cnt, mine, sp = 0u;
    for (;;) {
        sum = 0u; cnt = 0u; mine = 0u;
#pragma unroll
        for (unsigned j = 0; j < 16; ++j) { const unsigned c = xb_ld(&bar[XB_XCNT(j)]); sum += c; cnt += (c > 0u) ? 1u : 0u; mine = (j == x) ? c : mine; }
        if (sum == G) break;
        __builtin_amdgcn_s_sleep(1);
        if ((++sp & 255u) == 0u) { if (xb_ld(&bar[XB_TMO])) break; if (sp > XB_SPIN_CAP) { atomicAdd(&bar[XB_TMO], 1u); break; } }
    }
    nloc = mine > 0u ? mine : 1u; nx = cnt > 0u ? cnt : 1u;
}
__device__ __forceinline__ void xcd_barrier(const XcdBarrier& b) {
    asm volatile("s_waitcnt vmcnt(0)" ::: "memory");
    __syncthreads();
    if (threadIdx.x == 0) {
        unsigned* bar = b.bar;
        __builtin_amdgcn_s_waitcnt(0);
        unsigned nloc = b.st[0], nx = b.st[1];
        if (nloc == 0u) { xcd_barrier_complete(bar, b.x, nloc, nx); b.st[0] = nloc; b.st[1] = nx; }
        const unsigned old = xb_add(&bar[XB_XSUB(b.x)], 1u);
        const unsigned gen = old / nloc;
        if (old + 1u == (gen + 1u) * nloc) {
            __builtin_amdgcn_fence(__ATOMIC_RELEASE, "agent");
            asm volatile("s_waitcnt vmcnt(0)" ::: "memory");
            const unsigned og = xb_add(&bar[XB_TOP], 1u);
            const unsigned tg = og / nx;
            if (og + 1u == (tg + 1u) * nx) xb_add(&bar[XB_TOPGEN], 1u);
            else XB_SPIN(xb_ld(&bar[XB_TOPGEN]) == tg, bar);
            __builtin_amdgcn_fence(__ATOMIC_ACQUIRE, "agent");
            xb_add(&bar[XB_XGEN(b.x)], 1u);
            asm volatile("s_waitcnt vmcnt(0)" ::: "memory");
        } else {
            XB_SPIN(xb_ld(&bar[XB_XGEN(b.x)]) == gen, bar);
            __builtin_amdgcn_fence(__ATOMIC_ACQUIRE, "agent");
            asm volatile("s_waitcnt vmcnt(0)" ::: "memory");
        }
    }
    __syncthreads();
}

__device__ __forceinline__ void run_phase(const Params& P, int ph, int bid, int nb, unsigned char* smem) {
    switch (ph) {
        case PH_PREP:   phase_prep(P, bid, nb, smem); break;
        case PH_GEMM1:  phase_gemm1(P, bid, nb, smem); break;
        case PH_CHUNK1: phase_chunk1(P, bid, nb, smem); break;
        case PH_SCAN:   phase_scan(P, bid, nb, smem); break;
        case PH_CHUNK3: phase_chunk3(P, bid, nb, smem); break;
        case PH_ECONV:  phase_econv(P, bid, nb); break;
        case PH_GEMM2:  phase_gemm2(P, bid, nb, smem); break;
        case PH_NORM2:  phase_rownorm<true>((const float*)(P.ws + WS_H), P.norm_ffn, P.ws + WS_HN, bid, nb); break;
        case PH_GEMM3:  phase_gemm3(P, bid, nb, smem); break;
        case PH_SCORES: phase_scores(P, bid, nb, smem); break;
        case PH_ROUTE:  phase_route(P, bid, nb); break;
        case PH_PEER:   phase_peer(P, bid, nb); break;
        case PH_PLE:    phase_ple(P, bid, nb, smem); break;
        case PH_GEMM4:  phase_gemm4(P, bid, nb, smem); break;
        case PH_FINAL:  phase_rownorm<false>((const float*)(P.ws + WS_H), P.norm_final, P.out, bid, nb); break;
    }
}

constexpr int LDS_BYTES = 65536 + 16;

__global__ void __launch_bounds__(256, 2) fwd_kernel(Params P, int ph_lo, int ph_hi) {
    extern __shared__ __attribute__((aligned(16))) unsigned char smem[];
    const int bid = blockIdx.x, nb = gridDim.x;
    volatile LAS unsigned* st = (volatile LAS unsigned*)(smem + 65536);
    if (threadIdx.x == 0) { st[0] = 0u; st[1] = 0u; }
    __syncthreads();
    XcdBarrier xb = xcd_barrier_post((unsigned*)(P.ws + WS_BAR), st);
#define RUN(ph) if (ph_lo <= (ph) && (ph) < ph_hi) { run_phase(P, (ph), bid, nb, smem); if ((ph) + 1 < ph_hi) xcd_barrier(xb); }
    RUN(PH_PREP) RUN(PH_GEMM1) RUN(PH_CHUNK1) RUN(PH_SCAN) RUN(PH_CHUNK3) RUN(PH_ECONV) RUN(PH_GEMM2) RUN(PH_NORM2) RUN(PH_GEMM3) RUN(PH_SCORES) RUN(PH_ROUTE)
    RUN(PH_PEER) RUN(PH_PLE) RUN(PH_GEMM4) RUN(PH_FINAL)
}

extern "C" void kernel_launch(void* const* d_in, const int* in_sizes, int n_in, void* d_out, int out_size, void* d_ws, size_t ws_size, hipStream_t stream) {
    static int grid = 0;
    if (grid == 0) {
        if (n_in != 21 || out_size != T * D || ws_size < WS_END) { fprintf(stderr, "kernel_launch: unexpected shapes: n_in %d out %d ws %zu (need %zu)\n", n_in, out_size, ws_size, (size_t)WS_END); grid = -1; return; }
        if (hipFuncSetAttribute((const void*)fwd_kernel, hipFuncAttributeMaxDynamicSharedMemorySize, LDS_BYTES) != hipSuccess) { fprintf(stderr, "kernel_launch: hipFuncSetAttribute failed\n"); grid = -1; return; }
        int dev = 0, cus = 0, per_cu = 0;
        hipGetDevice(&dev); hipDeviceGetAttribute(&cus, hipDeviceAttributeMultiprocessorCount, dev);
        if (hipOccupancyMaxActiveBlocksPerMultiprocessor(&per_cu, (const void*)fwd_kernel, 256, LDS_BYTES) != hipSuccess || per_cu < 1) { fprintf(stderr, "kernel_launch: occupancy query failed (%d)\n", per_cu); grid = -1; return; }
        if (per_cu > 2) per_cu = 2;
        grid = cus * per_cu;
        fprintf(stderr, "kernel_launch: grid %d (%d CUs x %d)\n", grid, cus, per_cu);
    }
    if (grid < 0) return;
    Params P{};
    P.x = (const float*)d_in[0]; P.p = (const float*)d_in[1]; P.positions = (const int*)d_in[2]; P.norm_mix = (const float*)d_in[3]; P.w_in = (const float*)d_in[4];
    P.conv_w = (const float*)d_in[5]; P.a_log = (const float*)d_in[6]; P.dt_bias = (const float*)d_in[7]; P.dn_norm = (const float*)d_in[8]; P.ret_gn_w = (const float*)d_in[9];
    P.ret_gn_b = (const float*)d_in[10]; P.w_out = (const float*)d_in[11]; P.norm_ffn = (const float*)d_in[12]; P.w_pq = (const float*)d_in[13]; P.sub_keys = (const float*)d_in[14];
    P.expert_u = (const float*)d_in[15]; P.expert_v = (const float*)d_in[16]; P.norm_ple = (const float*)d_in[17]; P.w_ple_gate = (const float*)d_in[18]; P.w_ple_proj = (const float*)d_in[19];
    P.norm_final = (const float*)d_in[20]; P.out = (float*)d_out; P.ws = (unsigned char*)d_ws;
    (void)hipMemsetAsync((unsigned char*)d_ws + WS_BAR, 0, XCD_BAR_WORDS * 4, stream);
    int lo = 0, hi = PH_COUNT;
    void* args[] = {&P, &lo, &hi};
    hipError_t e = hipLaunchCooperativeKernel((const void*)fwd_kernel, dim3(grid), dim3(256), args, LDS_BYTES, stream);
    if (e != hipSuccess) fprintf(stderr, "kernel_launch: cooperative launch failed: %s (grid %d)\n", hipGetErrorString(e), grid);
}
```

```cpp
#include <hip/hip_runtime.h>
#include <cstdio>
#include <cstdint>

typedef unsigned short bf16_t;
typedef short bf16x8 __attribute__((ext_vector_type(8)));
typedef float f32x16 __attribute__((ext_vector_type(16)));
typedef float f32x4 __attribute__((ext_vector_type(4)));
#define VTID ((int)(threadIdx.x & 255u))

constexpr int T = 8192, D = 2048, SEQ = 4096;
constexpr int NPROJ = 7424;
constexpr int C_Z = 3072, C_RQ = 4096, C_RK = 4608, C_RV = 5120, C_RG = 6144, C_A = 7168, C_B = 7176;
constexpr int IN_COLS = 7184;
constexpr float EPS = 1e-6f;

constexpr size_t WS_HN    = 0;
constexpr size_t WS_KVT   = WS_HN;
constexpr size_t WS_WTIN  = WS_HN + (size_t)T * D * 2;
constexpr size_t WS_STR   = WS_WTIN;
constexpr size_t WS_ATTR  = WS_STR + (size_t)1024 * 128 * 64 * 2;
constexpr size_t WS_WTOUT = WS_WTIN + (size_t)NPROJ * D * 2;
constexpr size_t WS_WTPQ  = WS_WTOUT + (size_t)D * D * 2;
constexpr size_t WS_WTG   = WS_WTPQ + (size_t)D * D * 2;
constexpr size_t WS_WTPP  = WS_WTG + (size_t)D * D * 2;
constexpr size_t WS_KEYS  = WS_WTPP + (size_t)D * 256 * 2;
constexpr size_t WS_PBF   = WS_KEYS + (size_t)16 * 128 * 128 * 2;
constexpr size_t WS_PROJ  = WS_PBF + (size_t)T * 256 * 2;
constexpr size_t WS_Q     = WS_PROJ;
constexpr size_t WS_SCORES= WS_PROJ + (size_t)T * D * 2;
constexpr size_t WS_MIXED = WS_PROJ + (size_t)T * NPROJ * 2;
constexpr size_t WS_H     = WS_MIXED + (size_t)T * D * 2;
constexpr size_t WS_IDX   = WS_H + (size_t)T * D * 4;
constexpr size_t WS_GATES = WS_IDX + (size_t)T * 128 * 4;
constexpr size_t WS_U     = WS_GATES + (size_t)T * 128 * 4;
constexpr size_t WS_W     = WS_U + (size_t)1024 * 64 * 128 * 4;
constexpr size_t WS_KDT   = WS_W + (size_t)1024 * 64 * 128 * 2;
constexpr size_t WS_QG    = WS_KDT + (size_t)1024 * 128 * 64 * 2;
constexpr size_t WS_ATT   = WS_QG + (size_t)1024 * 64 * 128 * 2;
constexpr size_t WS_VNT   = WS_ATT + (size_t)1024 * 64 * 64 * 2;
constexpr size_t WS_SC    = WS_VNT + (size_t)1024 * 128 * 64 * 2;
constexpr size_t WS_QGR   = WS_SC + (size_t)1024 * 128 * 128 * 2;
constexpr size_t WS_VNTR  = WS_QGR + (size_t)1024 * 64 * 64 * 2;
constexpr size_t WS_EG    = WS_VNTR + (size_t)1024 * 128 * 64 * 2;
constexpr size_t WS_PLE   = WS_SC;
constexpr size_t WS_EU8   = WS_U;
constexpr size_t WS_EV8   = WS_U + (size_t)16384 * 2048;
constexpr size_t WS_ESC   = WS_QG;
constexpr size_t WS_BAR   = WS_EG + 4096;
constexpr size_t WS_END   = WS_BAR + 16384;

struct Params {
    const float *x, *p; const int* positions;
    const float *norm_mix, *w_in, *conv_w, *a_log, *dt_bias, *dn_norm, *ret_gn_w, *ret_gn_b, *w_out, *norm_ffn, *w_pq, *sub_keys,
                *expert_u, *expert_v, *norm_ple, *w_ple_gate, *w_ple_proj, *norm_final;
    float* out; unsigned char* ws;
};

__device__ __forceinline__ bf16_t f2bf(float f) { unsigned u = __float_as_uint(f); u += 0x7fffu + ((u >> 16) & 1u); return (bf16_t)(u >> 16); }
__device__ __forceinline__ float bf2f(bf16_t h) { return __uint_as_float(((unsigned)h) << 16); }
__device__ __forceinline__ unsigned pack2(float a, float b) { return (unsigned)f2bf(a) | ((unsigned)f2bf(b) << 16); }
__device__ __forceinline__ float wave_sum(float v) {
#pragma unroll
    for (int o = 32; o >= 1; o >>= 1) v += __shfl_xor(v, o);
    return v;
}
__device__ __forceinline__ float wave_max(float v) {
#pragma unroll
    for (int o = 32; o >= 1; o >>= 1) v = fmaxf(v, __shfl_xor(v, o));
    return v;
}
__device__ __forceinline__ float silu_f(float x) { return x / (1.f + __expf(-x)); }
__device__ __forceinline__ float sigmoid_f(float x) { return 1.f / (1.f + __expf(-x)); }

template <bool MAPIN>
__device__ __forceinline__ void transpose_tile(const float* __restrict__ W, int ldw, int K, bf16_t* __restrict__ Wt, int kt, int nt, float* tile  ) {
    const int tid = VTID;
    __syncthreads();
#pragma unroll
    for (int i = 0; i < 4; ++i) {
        const int idx = tid + 256 * i, kr = idx >> 4, c4 = idx & 15;
        const int n = nt * 64 + c4 * 4;
        int c = n; bool valid = true;
        if (MAPIN) { if (n < 4096) c = n; else if (n < 7168) c = n + 16; else if (n < 7184) c = n - 3072; else valid = false; }
        f32x4 v = {0.f, 0.f, 0.f, 0.f};
        if (valid) v = *(const f32x4*)(W + (size_t)(kt * 64 + kr) * ldw + c);
        float* d = tile + kr * 65 + c4 * 4;
        d[0] = v[0]; d[1] = v[1]; d[2] = v[2]; d[3] = v[3];
    }
    __syncthreads();
#pragma unroll
    for (int i = 0; i < 2; ++i) {
        const int ch = tid + 256 * i, n = ch >> 3, kc = ch & 7;
        unsigned w[4];
#pragma unroll
        for (int j = 0; j < 4; ++j) w[j] = pack2(tile[(kc * 8 + 2 * j) * 65 + n], tile[(kc * 8 + 2 * j + 1) * 65 + n]);
        uint4 o = make_uint4(w[0], w[1], w[2], w[3]);
        *(uint4*)(Wt + (size_t)(nt * 64 + n) * K + kt * 64 + kc * 8) = o;
    }
}

template <bool OUT_BF16>
__device__ __forceinline__ void rmsnorm_row(const float* __restrict__ in, const float* __restrict__ w, void* __restrict__ out, int lane) {
    f32x4 v[8]; float ss = 0.f;
#pragma unroll
    for (int i = 0; i < 8; ++i) { v[i] = *(const f32x4*)(in + (i * 64 + lane) * 4); ss += v[i][0] * v[i][0] + v[i][1] * v[i][1] + v[i][2] * v[i][2] + v[i][3] * v[i][3]; }
    ss = wave_sum(ss);
    const float r = rsqrtf(ss * (1.f / 2048.f) + EPS);
#pragma unroll
    for (int i = 0; i < 8; ++i) {
        const f32x4 g = *(const f32x4*)(w + (i * 64 + lane) * 4);
        const float a = v[i][0] * r * g[0], b = v[i][1] * r * g[1], c = v[i][2] * r * g[2], d = v[i][3] * r * g[3];
        if (OUT_BF16) { uint2 o = make_uint2(pack2(a, b), pack2(c, d)); *(uint2*)((bf16_t*)out + (i * 64 + lane) * 4) = o; }
        else { f32x4 o = {a, b, c, d}; *(f32x4*)((float*)out + (i * 64 + lane) * 4) = o; }
    }
}

__device__ __forceinline__ void phase_prep(const Params& P, int bid, int nb, unsigned char* smem) {
    float* tile = (float*)smem;
    const int tid = VTID;
    const int n_in = 32 * 116, n_sq = 32 * 32, n_pp = 4 * 32;
    const int n_tr = n_in + 3 * n_sq + n_pp;
    for (int u = bid; u < n_tr; u += nb) {
        if (u < n_in) transpose_tile<true>(P.w_in, IN_COLS, D, (bf16_t*)(P.ws + WS_WTIN), u % 32, u / 32, tile);
        else if (u < n_in + n_sq) { const int v = u - n_in; transpose_tile<false>(P.w_out, D, D, (bf16_t*)(P.ws + WS_WTOUT), v % 32, v / 32, tile); }
        else if (u < n_in + 2 * n_sq) { const int v = u - n_in - n_sq; transpose_tile<false>(P.w_pq, D, D, (bf16_t*)(P.ws + WS_WTPQ), v % 32, v / 32, tile); }
        else if (u < n_in + 3 * n_sq) { const int v = u - n_in - 2 * n_sq; transpose_tile<false>(P.w_ple_gate, D, D, (bf16_t*)(P.ws + WS_WTG), v % 32, v / 32, tile); }
        else { const int v = u - n_in - 3 * n_sq; transpose_tile<false>(P.w_ple_proj, D, 256, (bf16_t*)(P.ws + WS_WTPP), v % 4, v / 4, tile); }
    }
    {
        bf16_t* keys = (bf16_t*)(P.ws + WS_KEYS); bf16_t* pbf = (bf16_t*)(P.ws + WS_PBF);
        const int n4a = 262144 / 4, n4b = T * 256 / 4;
        for (int i = bid * 256 + tid; i < n4a + n4b; i += nb * 256) {
            const bool a = i < n4a; const int j = a ? i : i - n4a;
            const f32x4 v = *(const f32x4*)((a ? P.sub_keys : P.p) + (size_t)j * 4);
            *(uint2*)((a ? keys : pbf) + (size_t)j * 4) = make_uint2(pack2(v[0], v[1]), pack2(v[2], v[3]));
        }
    }
    {
        const int wave = tid >> 6, lane = tid & 63;
        bf16_t* hn = (bf16_t*)(P.ws + WS_HN);
        for (int r = bid * 4 + wave; r < T; r += nb * 4) rmsnorm_row<true>(P.x + (size_t)r * D, P.norm_mix, hn + (size_t)r * D, lane);
    }
}

__device__ __forceinline__ int lds_off(int row, int ch) { return row * 128 + ((ch ^ ((row >> 1) & 7)) << 4); }

__device__ __forceinline__ void gemm_mainloop(const bf16_t* __restrict__ A, int lda, const bf16_t* __restrict__ Bt, int ldb, int K,
                                              f32x16 (&acc)[2][2], unsigned char* smem) {
    const int tid = VTID, wave = tid >> 6, lane = tid & 63, wr = wave >> 1, wc = wave & 1;
    const int nk = K / 64;
    uint4 ra[4], rb[4];
    __syncthreads();
#pragma unroll
    for (int i = 0; i < 4; ++i) { const int c = tid + 256 * i, row = c >> 3, ch = c & 7;
        ra[i] = *(const uint4*)(A + (size_t)row * lda + ch * 8); rb[i] = *(const uint4*)(Bt + (size_t)row * ldb + ch * 8); }
#pragma unroll
    for (int i = 0; i < 4; ++i) { const int c = tid + 256 * i, row = c >> 3, ch = c & 7;
        *(uint4*)(smem + lds_off(row, ch)) = ra[i]; *(uint4*)(smem + 16384 + lds_off(row, ch)) = rb[i]; }
    __syncthreads();
    for (int kt = 0; kt < nk; ++kt) {
        unsigned char* cur = smem + (kt & 1) * 32768;
        unsigned char* nxt = smem + ((kt + 1) & 1) * 32768;
        const bool more = kt + 1 < nk;
        if (more) {
#pragma unroll
            for (int i = 0; i < 4; ++i) { const int c = tid + 256 * i, row = c >> 3, ch = c & 7;
                ra[i] = *(const uint4*)(A + (size_t)row * lda + (kt + 1) * 64 + ch * 8); rb[i] = *(const uint4*)(Bt + (size_t)row * ldb + (kt + 1) * 64 + ch * 8); }
        }
#pragma unroll
        for (int ks = 0; ks < 4; ++ks) {
            bf16x8 af[2], bfr[2];
#pragma unroll
            for (int i = 0; i < 2; ++i) { const int row = wr * 64 + i * 32 + (lane & 31); af[i] = *(const bf16x8*)(cur + lds_off(row, ks * 2 + (lane >> 5))); }
#pragma unroll
            for (int j = 0; j < 2; ++j) { const int row = wc * 64 + j * 32 + (lane & 31); bfr[j] = *(const bf16x8*)(cur + 16384 + lds_off(row, ks * 2 + (lane >> 5))); }
#pragma unroll
            for (int i = 0; i < 2; ++i)
#pragma unroll
                for (int j = 0; j < 2; ++j) acc[i][j] = __builtin_amdgcn_mfma_f32_32x32x16_bf16(af[i], bfr[j], acc[i][j], 0, 0, 0);
        }
        if (more) {
#pragma unroll
            for (int i = 0; i < 4; ++i) { const int c = tid + 256 * i, row = c >> 3, ch = c & 7;
                *(uint4*)(nxt + lds_off(row, ch)) = ra[i]; *(uint4*)(nxt + 16384 + lds_off(row, ch)) = rb[i]; }
        }
        __syncthreads();
    }
}
#define ACC_FOREACH(body)                                                                                   \
    { const int _tid = VTID, _wave = _tid >> 6, _lane = _tid & 63, _wr = _wave >> 1, _wc = _wave & 1; \
      _Pragma("unroll") for (int i = 0; i < 2; ++i) _Pragma("unroll") for (int j = 0; j < 2; ++j)          \
      _Pragma("unroll") for (int r = 0; r < 16; ++r) {                                                     \
          const int row = _wr * 64 + i * 32 + (r & 3) + 8 * (r >> 2) + 4 * (_lane >> 5);                   \
          const int col = _wc * 64 + j * 32 + (_lane & 31); body } }

__device__ __forceinline__ void zero_acc(f32x16 (&acc)[2][2]) {
#pragma unroll
    for (int i = 0; i < 2; ++i)
#pragma unroll
        for (int j = 0; j < 2; ++j)
#pragma unroll
            for (int r = 0; r < 16; ++r) acc[i][j][r] = 0.f;
}

__device__ __forceinline__ void phase_scores(const Params& P, int bid, int nb, unsigned char* smem) {
    const bf16_t* A = (const bf16_t*)(P.ws + WS_Q); const bf16_t* Bt = (const bf16_t*)(P.ws + WS_KEYS); float* C = (float*)(P.ws + WS_SCORES);
    const int nmt = T / 128, nnt = 16;
    for (int t = bid; t < nmt * nnt; t += nb) {
        const int mt = t % nmt, nt = t / nmt;
        f32x16 acc[2][2]; zero_acc(acc);
        gemm_mainloop(A + (size_t)mt * 128 * D + nt * 128, D, Bt + (size_t)nt * 128 * 128, 128, 128, acc, smem);
        ACC_FOREACH({ C[(size_t)(mt * 128 + row) * D + nt * 128 + col] = acc[i][j][r]; })
    }
}
__device__ __forceinline__ int g2_lds_byte(int r, int c) { const int st = (r >> 4) * 2 + (c >> 5), ob = (r & 15) * 64 + (c & 31) * 2; return st * 1024 + (ob ^ (((ob >> 9) & 1) << 5)); }
__device__ __forceinline__ void g2_stage_rc(int b, int& R, int& C) { const int st = b >> 10, sb = b & 1023, swz = sb ^ (((sb >> 9) & 1) << 5); R = (st >> 1) * 16 + (swz >> 6); C = (st & 1) * 32 + ((swz & 63) >> 1); }
__device__ __forceinline__ void g2_zero(f32x4 (&acc)[8][4]) {
#pragma unroll
    for (int m = 0; m < 8; ++m)
#pragma unroll
        for (int n = 0; n < 4; ++n) acc[m][n] = (f32x4){0.f, 0.f, 0.f, 0.f};
}
__device__ __forceinline__ void g2_mainloop(const bf16_t* __restrict__ Ab, int lda, const bf16_t* __restrict__ Bb, int ldb, int K, f32x4 (&acc)[8][4], unsigned char* shm) {
    const int tid = threadIdx.x, wid = tid >> 6, lane = tid & 63, wr = wid >> 2, wc = wid & 3, fr = lane & 15, fq = lane >> 4;
    int sR[4], sC[4];
#pragma unroll
    for (int i = 0; i < 4; ++i) g2_stage_rc(wid * 1024 + i * 8192 + lane * 16, sR[i], sC[i]);
#define G2_STAGE(buf, kt) { _Pragma("unroll") for (int i = 0; i < 4; ++i) { \
        __builtin_amdgcn_global_load_lds((const unsigned*)(Ab + (size_t)sR[i] * lda + (kt) * 64 + sC[i]), (unsigned*)(shm + (buf) * 65536 + wid * 1024 + i * 8192), 16, 0, 0); \
        __builtin_amdgcn_global_load_lds((const unsigned*)(Bb + (size_t)sR[i] * ldb + (kt) * 64 + sC[i]), (unsigned*)(shm + (buf) * 65536 + 32768 + wid * 1024 + i * 8192), 16, 0, 0); } }
    const int nt = K / 64;
    __syncthreads();
    G2_STAGE(0, 0)
    asm volatile("s_waitcnt vmcnt(0)" ::: "memory");
    __syncthreads();
    for (int t = 0; t < nt; ++t) {
        const int cur = t & 1;
        if (t + 1 < nt) G2_STAGE(cur ^ 1, t + 1)
        const unsigned char* SA = shm + cur * 65536; const unsigned char* SB = SA + 32768;
#pragma unroll
        for (int ks = 0; ks < 2; ++ks) {
            bf16x8 At[8], Bf[4];
#pragma unroll
            for (int m = 0; m < 8; ++m) At[m] = *(const bf16x8*)(SA + g2_lds_byte(wr * 128 + m * 16 + fr, ks * 32 + fq * 8));
#pragma unroll
            for (int n = 0; n < 4; ++n) Bf[n] = *(const bf16x8*)(SB + g2_lds_byte(wc * 64 + n * 16 + fr, ks * 32 + fq * 8));
#pragma unroll
            for (int m = 0; m < 8; ++m)
#pragma unroll
                for (int n = 0; n < 4; ++n) acc[m][n] = __builtin_amdgcn_mfma_f32_16x16x32_bf16(At[m], Bf[n], acc[m][n], 0, 0, 0);
            __builtin_amdgcn_sched_barrier(0);
        }
        asm volatile("s_waitcnt vmcnt(0)" ::: "memory");
        __syncthreads();
    }
}
#define G2_FOREACH(body)                                                                                       \
    { const int _tid = threadIdx.x, _wid = _tid >> 6, _lane = _tid & 63, _wr = _wid >> 2, _wc = _wid & 3, _fr = _lane & 15, _fq = _lane >> 4; \
      _Pragma("unroll") for (int m = 0; m < 8; ++m) _Pragma("unroll") for (int n = 0; n < 4; ++n)             \
      _Pragma("unroll") for (int j = 0; j < 4; ++j) {                                                         \
          const int row = _wr * 128 + m * 16 + _fq * 4 + j; const int col = _wc * 64 + n * 16 + _fr; const float val = acc[m][n][j]; body } }
__device__ __forceinline__ bool g2_tile(int bid, int nb, int it, int nM, int nN, int& pm, int& pn) {
    if (nb == 256 && nM == 32) { const int xcd = bid & 7, jj = bid >> 3; pm = 4 * xcd + (jj & 3); pn = 8 * it + (jj >> 2); return pn < nN; }
    const int t = bid + it * nb; pm = t % nM; pn = t / nM; return t < nM * nN;
}

__device__ __forceinline__ void phase_gemm1(const Params& P, int bid, int nb, unsigned char* smem) {
    const bf16_t* A = (const bf16_t*)(P.ws + WS_HN); const bf16_t* Bt = (const bf16_t*)(P.ws + WS_WTIN); bf16_t* C = (bf16_t*)(P.ws + WS_PROJ);
    int pm, pn;
    for (int it = 0; g2_tile(bid, nb, it, T / 256, NPROJ / 256, pm, pn); ++it) {
        f32x4 acc[8][4]; g2_zero(acc);
        g2_mainloop(A + (size_t)pm * 256 * D, D, Bt + (size_t)pn * 256 * D, D, D, acc, smem);
        G2_FOREACH({ C[(size_t)(pm * 256 + row) * NPROJ + pn * 256 + col] = f2bf(val); })
    }
}
__device__ __forceinline__ void phase_gemm2(const Params& P, int bid, int nb, unsigned char* smem) {
    const bf16_t* A = (const bf16_t*)(P.ws + WS_MIXED); const bf16_t* Bt = (const bf16_t*)(P.ws + WS_WTOUT); float* H = (float*)(P.ws + WS_H);
    int pm, pn;
    for (int it = 0; g2_tile(bid, nb, it, T / 256, D / 256, pm, pn); ++it) {
        f32x4 acc[8][4]; g2_zero(acc);
        g2_mainloop(A + (size_t)pm * 256 * D, D, Bt + (size_t)pn * 256 * D, D, D, acc, smem);
        G2_FOREACH({ const size_t o = (size_t)(pm * 256 + row) * D + pn * 256 + col; H[o] = P.x[o] + val; })
    }
}
__device__ __forceinline__ void phase_gemm3(const Params& P, int bid, int nb, unsigned char* smem) {
    const bf16_t* A = (const bf16_t*)(P.ws + WS_HN); const bf16_t* Bt = (const bf16_t*)(P.ws + WS_WTPQ); bf16_t* C = (bf16_t*)(P.ws + WS_Q);
    int pm, pn;
    for (int it = 0; g2_tile(bid, nb, it, T / 256, D / 256, pm, pn); ++it) {
        f32x4 acc[8][4]; g2_zero(acc);
        g2_mainloop(A + (size_t)pm * 256 * D, D, Bt + (size_t)pn * 256 * D, D, D, acc, smem);
        G2_FOREACH({ C[(size_t)(pm * 256 + row) * D + pn * 256 + col] = f2bf(val); })
    }
}
__device__ __forceinline__ void phase_ple(const Params& P, int bid, int nb, unsigned char* smem) {
    const bf16_t* A = (const bf16_t*)(P.ws + WS_PBF); const bf16_t* Bt = (const bf16_t*)(P.ws + WS_WTPP); bf16_t* C = (bf16_t*)(P.ws + WS_PLE);
    int pm, pn;
    for (int it = 0; g2_tile(bid, nb, it, T / 256, D / 256, pm, pn); ++it) {
        f32x4 acc[8][4]; g2_zero(acc);
        g2_mainloop(A + (size_t)pm * 256 * 256, 256, Bt + (size_t)pn * 256 * 256, 256, 256, acc, smem);
        G2_FOREACH({ C[(size_t)(pm * 256 + row) * D + pn * 256 + col] = f2bf(val); })
    }
}
__device__ __forceinline__ void phase_gemm4(const Params& P, int bid, int nb, unsigned char* smem) {
    const bf16_t* A = (const bf16_t*)(P.ws + WS_HN); const bf16_t* Bt = (const bf16_t*)(P.ws + WS_WTG);
    const bf16_t* ple = (const bf16_t*)(P.ws + WS_PLE); float* H = (float*)(P.ws + WS_H);
    int pm, pn;
    for (int it = 0; g2_tile(bid, nb, it, T / 256, D / 256, pm, pn); ++it) {
        f32x4 acc[8][4]; g2_zero(acc);
        g2_mainloop(A + (size_t)pm * 256 * D, D, Bt + (size_t)pn * 256 * D, D, D, acc, smem);
        G2_FOREACH({ const size_t o = (size_t)(pm * 256 + row) * D + pn * 256 + col; H[o] = H[o] + sigmoid_f(val) * bf2f(ple[o]); })
    }
}

template <bool OUT_BF16>
__device__ __forceinline__ void phase_rownorm(const float* in, const float* w, void* out, int bid, int nb) {
    const int wave = VTID >> 6, lane = VTID & 63;
    for (int r = bid * 4 + wave; r < T; r += nb * 4) {
        if (OUT_BF16) rmsnorm_row<true>(in + (size_t)r * D, w, (bf16_t*)out + (size_t)r * D, lane);
        else rmsnorm_row<false>(in + (size_t)r * D, w, (float*)out + (size_t)r * D, lane);
    }
}

__device__ __forceinline__ bf16x8 frag_ld(const unsigned char* tile, int row, int ks, int lane) { return *(const bf16x8*)(tile + lds_off(row, ks * 2 + (lane >> 5))); }
__device__ __forceinline__ void lds_st_bf16(unsigned char* tile, int row, int k, float v) { *(bf16_t*)(tile + lds_off(row, k >> 3) + (k & 7) * 2) = f2bf(v); }

__device__ __forceinline__ void d1_chunk(const Params& P, int u, unsigned char* smem) {
    const bf16_t* proj = (const bf16_t*)(P.ws + WS_PROJ);
    int tid_ = VTID; asm volatile("" : "+v"(tid_));
    const int tid = tid_, wave = tid >> 6, lane = tid & 63;
    const int b = u >> 9, h = (u >> 6) & 7, c = u & 63;
    const size_t tok0 = (size_t)b * SEQ + c * 64;
    unsigned char* Ks = smem;
    unsigned char* Qs = smem + 16384;
    unsigned char* Vraw = smem + 16384;
    float* At = (float*)(smem + 34816);
    float* Gs = (float*)(smem + 51200);
    float* Bs = Gs + 64;
    __syncthreads();
    if (wave == 0) {
        const size_t t = tok0 + lane;
        const float a = bf2f(proj[t * NPROJ + C_A + h]), bb = bf2f(proj[t * NPROJ + C_B + h]);
        const float xs = a + P.dt_bias[h];
        const float sp = xs > 20.f ? xs : log1pf(expf(xs));
        float g = -expf(P.a_log[h]) * sp;
#pragma unroll
        for (int o = 1; o < 64; o <<= 1) { const float n = __shfl_up(g, o); if (lane >= o) g += n; }
        Gs[lane] = g; Bs[lane] = 1.f / (1.f + expf(-bb));
    }
    bf16_t* QG = (bf16_t*)(P.ws + WS_QG) + (size_t)u * 64 * 128;
    unsigned char* RAW = smem + 32768;
#pragma unroll 1
    for (int isk = 0; isk < 2; ++isk) {
        const int chb = (isk ? 1024 : 0) + h * 128;
        for (int q = tid; q < 67 * 16; q += 256) {
            const int row = q >> 4, c16 = q & 15;
            uint4 v = make_uint4(0u, 0u, 0u, 0u);
            if (c > 0 || row >= 3) v = *(const uint4*)(proj + (tok0 + row - 3) * NPROJ + chb + c16 * 8);
            *(uint4*)(RAW + row * 256 + c16 * 16) = v;
        }
        const int ch0 = chb + lane * 2;
        const f32x4 cw0 = *(const f32x4*)(P.conv_w + ch0 * 4), cw1 = *(const f32x4*)(P.conv_w + ch0 * 4 + 4);
        __syncthreads();
        for (int tok = wave; tok < 64; tok += 4) {
            float y0 = 0.f, y1 = 0.f;
#pragma unroll
            for (int j = 0; j < 4; ++j) {
                const unsigned pr = *(const unsigned*)(RAW + (tok + j) * 256 + lane * 4);
                y0 += bf2f((bf16_t)(pr & 0xffff)) * cw0[j];
                y1 += bf2f((bf16_t)(pr >> 16)) * cw1[j];
            }
            y0 = silu_f(y0); y1 = silu_f(y1);
            float r = rsqrtf(wave_sum(y0 * y0 + y1 * y1) + EPS);
            if (!isk) r *= 0.08838834764831845f;
            y0 *= r; y1 *= r;
            const int k = lane * 2, half = k >> 6, kk = k & 63;
            *(unsigned*)((isk ? Ks : Qs) + half * 8192 + lds_off(tok, kk >> 3) + (kk & 7) * 2) = pack2(y0, y1);
            if (!isk) { const float eg = expf(Gs[tok]); *(unsigned*)(QG + tok * 128 + k) = pack2(y0 * eg, y1 * eg); }
        }
        __syncthreads();
    }
    {
        const int wr = wave >> 1, wc = wave & 1;
        f32x16 akk, aqk;
#pragma unroll
        for (int r = 0; r < 16; ++r) { akk[r] = 0.f; aqk[r] = 0.f; }
        if (!(wr == 0 && wc == 1)) {
#pragma unroll
            for (int half = 0; half < 2; ++half)
#pragma unroll
                for (int ks = 0; ks < 4; ++ks) {
                    const bf16x8 fk = frag_ld(Ks + half * 8192, wr * 32 + (lane & 31), ks, lane);
                    const bf16x8 fq = frag_ld(Qs + half * 8192, wr * 32 + (lane & 31), ks, lane);
                    const bf16x8 fb = frag_ld(Ks + half * 8192, wc * 32 + (lane & 31), ks, lane);
                    akk = __builtin_amdgcn_mfma_f32_32x32x16_bf16(fk, fb, akk, 0, 0, 0);
                    aqk = __builtin_amdgcn_mfma_f32_32x32x16_bf16(fq, fb, aqk, 0, 0, 0);
                }
        }
        const int j = wc * 32 + (lane & 31); const float Gj = Gs[j];
        bf16_t* ATT = (bf16_t*)(P.ws + WS_ATT) + (size_t)u * 64 * 64;
#pragma unroll
        for (int g4 = 0; g4 < 4; ++g4) {
            const int i0 = wr * 32 + 8 * g4 + 4 * (lane >> 5);
            f32x4 av;
#pragma unroll
            for (int e = 0; e < 4; ++e) {
                const int i = i0 + e, r = g4 * 4 + e;
                const float dec = (i >= j) ? expf(Gs[i] - Gj) : 0.f;
                av[e] = (i > j) ? Bs[i] * akk[r] * dec : 0.f;
                ATT[i * 64 + j] = f2bf(aqk[r] * dec);
            }
            *(f32x4*)(At + j * 64 + i0) = av;
        }
    }
    __syncthreads();
    {
        for (int q = tid; q < 67 * 16; q += 256) {
            const int row = q >> 4, c16 = q & 15;
            uint4 v = make_uint4(0u, 0u, 0u, 0u);
            if (c > 0 || row >= 3) v = *(const uint4*)(proj + (tok0 + row - 3) * NPROJ + 2048 + h * 128 + c16 * 8);
            *(uint4*)(Vraw + row * 256 + c16 * 16) = v;
        }
    }
    __syncthreads();
    {
        float r[64];
        if (tid < 128) {
            const int ch = 2048 + h * 128 + tid;
            const float w0 = P.conv_w[ch * 4 + 0], w1 = P.conv_w[ch * 4 + 1], w2 = P.conv_w[ch * 4 + 2], w3 = P.conv_w[ch * 4 + 3];
            const bf16_t* vcol = (const bf16_t*)Vraw + tid;
            float xm3 = bf2f(vcol[0]), xm2 = bf2f(vcol[128]), xm1 = bf2f(vcol[256]);
#pragma unroll
            for (int i = 0; i < 64; ++i) {
                const float x0 = bf2f(vcol[(i + 3) * 128]);
                const float y = w0 * xm3 + w1 * xm2 + w2 * xm1 + w3 * x0;
                r[i] = Bs[i] * silu_f(y);
                xm3 = xm2; xm2 = xm1; xm1 = x0;
            }
        } else {
            const int dk = tid - 128, half = dk >> 6, kk = dk & 63;
            const float G63 = Gs[63];
            bf16_t* KDT = (bf16_t*)(P.ws + WS_KDT) + (size_t)u * 128 * 64 + dk * 64;
#pragma unroll
            for (int i8 = 0; i8 < 8; ++i8) {
                unsigned pk[4];
#pragma unroll
                for (int e2 = 0; e2 < 4; ++e2) {
                    float kd[2];
#pragma unroll
                    for (int e = 0; e < 2; ++e) {
                        const int i = i8 * 8 + e2 * 2 + e;
                        const float kv = bf2f(*(const bf16_t*)(Ks + half * 8192 + lds_off(i, kk >> 3) + (kk & 7) * 2));
                        const float Gi = Gs[i];
                        r[i] = -Bs[i] * expf(Gi) * kv;
                        kd[e] = kv * expf(G63 - Gi);
                    }
                    pk[e2] = pack2(kd[0], kd[1]);
                }
                *(uint4*)(KDT + i8 * 8) = make_uint4(pk[0], pk[1], pk[2], pk[3]);
            }
        }
#pragma unroll
        for (int j = 0; j < 63; ++j) {
            const float xj = r[j];
#pragma unroll
            for (int i4 = ((j + 1) & ~3); i4 < 64; i4 += 4) {
                const f32x4 a = *(const f32x4*)(At + j * 64 + i4);
                r[i4] -= a[0] * xj; r[i4 + 1] -= a[1] * xj; r[i4 + 2] -= a[2] * xj; r[i4 + 3] -= a[3] * xj;
            }
        }
        if (tid < 128) {
            float* U = (float*)(P.ws + WS_U) + (size_t)u * 64 * 128 + (tid >> 5) * 2048 + (tid & 31);
#pragma unroll
            for (int i = 0; i < 64; ++i) { const int tt = i >> 5, i5 = i & 31, rr = (i5 & 3) + 4 * (i5 >> 3), hh = (i5 >> 2) & 1; U[(tt * 16 + rr) * 64 + hh * 32] = r[i]; }
        } else {
            bf16_t* W = (bf16_t*)(P.ws + WS_W) + (size_t)u * 64 * 128 + (tid - 128);
#pragma unroll
            for (int i = 0; i < 64; ++i) W[i * 128] = f2bf(r[i]);
        }
        if (tid == 0) ((float*)(P.ws + WS_EG))[u] = expf(Gs[63]);
    }
}

__device__ __forceinline__ void r1_chunk(const Params& P, int u, unsigned char* smem) {
    const bf16_t* proj = (const bf16_t*)(P.ws + WS_PROJ);
    int tid_ = VTID; asm volatile("" : "+v"(tid_));
    const int tid = tid_, wave = tid >> 6, lane = tid & 63;
    const int b = u >> 9, h = (u >> 6) & 7, c = u & 63;
    const size_t tok0 = (size_t)b * SEQ + c * 64;
    unsigned char* RQ = smem;
    unsigned char* RK = smem + 8192;
    unsigned char* VT = smem + 16384;
    unsigned char* RKT = smem + 32768;
    const float l2g = log2f(1.f - exp2f(-5.f - (float)h));
    unsigned char* VR = smem + 40960;
    __syncthreads();
    bf16_t* QGR = (bf16_t*)(P.ws + WS_QGR) + (size_t)u * 64 * 64;
    {
        uint4 rq[2], rk[2], rv[4];
#pragma unroll
        for (int i = 0; i < 2; ++i) { const int q = tid + 256 * i, row = q >> 3, ch = q & 7;
            rq[i] = *(const uint4*)(proj + (tok0 + row) * NPROJ + C_RQ + h * 64 + ch * 8); rk[i] = *(const uint4*)(proj + (tok0 + row) * NPROJ + C_RK + h * 64 + ch * 8); }
#pragma unroll
        for (int i = 0; i < 4; ++i) { const int q = tid + 256 * i, row = q >> 4, c16 = q & 15; rv[i] = *(const uint4*)(proj + (tok0 + row) * NPROJ + C_RV + h * 128 + c16 * 8); }
#pragma unroll
        for (int i = 0; i < 2; ++i) { const int q = tid + 256 * i, row = q >> 3, ch = q & 7; *(uint4*)(RQ + lds_off(row, ch)) = rq[i]; *(uint4*)(RK + lds_off(row, ch)) = rk[i]; }
#pragma unroll
        for (int i = 0; i < 4; ++i) { const int q = tid + 256 * i, row = q >> 4, c16 = q & 15; *(uint4*)(VR + row * 256 + c16 * 16) = rv[i]; }
    }
    __syncthreads();
#pragma unroll 1
    for (int it = 0; it < 8; ++it) {
        const int e = tid + 256 * it, tok = e >> 5, i = e & 31;
        const size_t t = tok0 + tok;
        const float inv = powf(10000.f, -(float)i / 32.f);
        const float ang = (float)P.positions[t] * inv;
        float sn, cs; sincosf(ang, &sn, &cs);
        bf16_t* q1p = (bf16_t*)(RQ + lds_off(tok, i >> 3) + (i & 7) * 2); bf16_t* q2p = (bf16_t*)(RQ + lds_off(tok, (32 + i) >> 3) + (i & 7) * 2);
        bf16_t* k1p = (bf16_t*)(RK + lds_off(tok, i >> 3) + (i & 7) * 2); bf16_t* k2p = (bf16_t*)(RK + lds_off(tok, (32 + i) >> 3) + (i & 7) * 2);
        const float q1 = bf2f(*q1p), q2 = bf2f(*q2p), k1 = bf2f(*k1p) * 0.125f, k2 = bf2f(*k2p) * 0.125f;
        const float qa = q1 * cs - q2 * sn, qb = q1 * sn + q2 * cs, ka = k1 * cs - k2 * sn, kb = k1 * sn + k2 * cs;
        const float xi = exp2f(l2g * (float)(tok + 1)), zeta = exp2f(l2g * (float)(63 - tok));
        *q1p = f2bf(qa); *q2p = f2bf(qb); *k1p = f2bf(ka); *k2p = f2bf(kb);
        lds_st_bf16(RKT, i, tok, ka * zeta); lds_st_bf16(RKT, 32 + i, tok, kb * zeta);
        QGR[tok * 64 + i] = f2bf(qa * xi); QGR[tok * 64 + 32 + i] = f2bf(qb * xi);
    }
#pragma unroll 4
    for (int it = 0; it < 16; ++it) {
        const int e = tid + 256 * it, tok = e >> 6, dp = e & 63;
        const unsigned pr = *(const unsigned*)(VR + tok * 256 + dp * 4);
        *(bf16_t*)(VT + lds_off(dp * 2, tok >> 3) + (tok & 7) * 2) = (bf16_t)(pr & 0xffff);
        *(bf16_t*)(VT + lds_off(dp * 2 + 1, tok >> 3) + (tok & 7) * 2) = (bf16_t)(pr >> 16);
    }
    __syncthreads();
    {
        bf16_t* VNTR = (bf16_t*)(P.ws + WS_VNTR) + (size_t)u * 128 * 64;
#pragma unroll
        for (int it = 0; it < 4; ++it) { const int q = tid + 256 * it, row = q >> 3, ch = q & 7; *(uint4*)(VNTR + row * 64 + ch * 8) = *(const uint4*)(VT + lds_off(row, ch)); }
    }
    {
        const int wr = wave >> 1, wc = wave & 1;
        f32x16 acc;
#pragma unroll
        for (int r = 0; r < 16; ++r) acc[r] = 0.f;
        if (!(wr == 0 && wc == 1)) {
#pragma unroll
            for (int ks = 0; ks < 4; ++ks) acc = __builtin_amdgcn_mfma_f32_32x32x16_bf16(frag_ld(RQ, wr * 32 + (lane & 31), ks, lane), frag_ld(RK, wc * 32 + (lane & 31), ks, lane), acc, 0, 0, 0);
        }
        const int j = wc * 32 + (lane & 31);
        bf16_t* ATTR = (bf16_t*)(P.ws + WS_ATTR) + (size_t)u * 64 * 64;
#pragma unroll
        for (int r = 0; r < 16; ++r) {
            const int i = wr * 32 + (r & 3) + 8 * (r >> 2) + 4 * (lane >> 5);
            const float dec = (i >= j) ? exp2f(l2g * (float)(i - j)) : 0.f;
            ATTR[i * 64 + j] = f2bf(acc[r] * dec);
        }
    }
    {
        f32x16 acc[2];
#pragma unroll
        for (int j = 0; j < 2; ++j)
#pragma unroll
            for (int r = 0; r < 16; ++r) acc[j][r] = 0.f;
#pragma unroll
        for (int ks = 0; ks < 4; ++ks) {
            const bf16x8 fa = frag_ld(VT, wave * 32 + (lane & 31), ks, lane);
#pragma unroll
            for (int j = 0; j < 2; ++j) acc[j] = __builtin_amdgcn_mfma_f32_32x32x16_bf16(fa, frag_ld(RKT, j * 32 + (lane & 31), ks, lane), acc[j], 0, 0, 0);
        }
        float* KVT = (float*)(P.ws + WS_KVT) + (size_t)u * 128 * 64;
#pragma unroll
        for (int j = 0; j < 2; ++j)
#pragma unroll
            for (int r = 0; r < 16; ++r) { const int dv = wave * 32 + (r & 3) + 8 * (r >> 2) + 4 * (lane >> 5); KVT[dv * 64 + j * 32 + (lane & 31)] = acc[j][r]; }
    }
}

__device__ __forceinline__ void phase_chunk1(const Params& P, int bid, int nb, unsigned char* smem) {
    for (int u = bid; u < 2048; u += nb) { if (u < 1024) d1_chunk(P, u, smem); else r1_chunk(P, u - 1024, smem); }
}

__device__ __forceinline__ void d2_scan(const Params& P, int bh, unsigned char* smem) {
    const int tid = VTID, wave = tid >> 6, lane = tid & 63;
    unsigned char* Wt = smem;
    unsigned char* KDt = smem + 16384;
    unsigned char* img = smem + 32768 + wave * 8192;
    const int dv0 = wave * 32;
    const size_t cb = (size_t)bh * 64;
    const bf16_t* Wg = (const bf16_t*)(P.ws + WS_W); const bf16_t* KDg = (const bf16_t*)(P.ws + WS_KDT);
    const float* Ug = (const float*)(P.ws + WS_U); const float* EGg = (const float*)(P.ws + WS_EG);
    bf16_t* SCg = (bf16_t*)(P.ws + WS_SC); bf16_t* VNg = (bf16_t*)(P.ws + WS_VNT);
    f32x16 S[4];
#pragma unroll
    for (int d = 0; d < 4; ++d)
#pragma unroll
        for (int r = 0; r < 16; ++r) S[d][r] = 0.f;
    uint4 pw0, pw1, pw2, pw3, pk0, pk1, pk2, pk3;
    __syncthreads();
#define D2_LOAD(uu) { const bf16_t* wp = Wg + (uu) * 8192 + tid * 8; const bf16_t* kp = KDg + (uu) * 8192 + tid * 8; \
        pw0 = *(const uint4*)(wp); pw1 = *(const uint4*)(wp + 2048); pw2 = *(const uint4*)(wp + 4096); pw3 = *(const uint4*)(wp + 6144); \
        pk0 = *(const uint4*)(kp); pk1 = *(const uint4*)(kp + 2048); pk2 = *(const uint4*)(kp + 4096); pk3 = *(const uint4*)(kp + 6144); }
#define D2_ST1(i, vw, vk) { const int q = tid + 256 * (i); { const int row = q >> 4, c16 = q & 15; *(uint4*)(Wt + (c16 >> 3) * 8192 + lds_off(row, c16 & 7)) = (vw); } \
        { const int row = q >> 3, ch = q & 7; *(uint4*)(KDt + lds_off(row, ch)) = (vk); } }
#define D2_STORE() { D2_ST1(0, pw0, pk0) D2_ST1(1, pw1, pk1) D2_ST1(2, pw2, pk2) D2_ST1(3, pw3, pk3) }
    D2_LOAD(cb)
    D2_STORE()
#pragma unroll
    for (int i = 0; i < 8; ++i) { *(uint4*)(img + (lane + 64 * i) * 16) = make_uint4(0u, 0u, 0u, 0u);
        *(uint4*)(SCg + cb * 16384 + wave * 4096 + (lane + 64 * i) * 8) = make_uint4(0u, 0u, 0u, 0u); }
    __syncthreads();
    const int egl = __float_as_int(EGg[cb + lane]);
    f32x16 un0, un1;
#define D2_LOADU(uu) { const float* up = Ug + (uu) * 8192 + wave * 2048 + lane; \
        _Pragma("unroll") for (int r = 0; r < 16; ++r) { un0[r] = up[r * 64]; un1[r] = up[(16 + r) * 64]; } }
    D2_LOADU(cb)
    for (int c = 0; c < 64; ++c) {
        const size_t u = cb + c;
        f32x16 vn0 = un0, vn1 = un1;
        if (c + 1 < 64) {
            D2_LOAD(u + 1)
            D2_LOADU(u + 1)
        }
        const float eg = __int_as_float(__builtin_amdgcn_readlane(egl, c));
#pragma unroll
        for (int half = 0; half < 2; ++half)
#pragma unroll
            for (int ks = 0; ks < 4; ++ks) {
                const bf16x8 fb = frag_ld(img + half * 4096, lane & 31, ks, lane);
                vn0 = __builtin_amdgcn_mfma_f32_32x32x16_bf16(frag_ld(Wt + half * 8192, (lane & 31), ks, lane), fb, vn0, 0, 0, 0);
                vn1 = __builtin_amdgcn_mfma_f32_32x32x16_bf16(frag_ld(Wt + half * 8192, 32 + (lane & 31), ks, lane), fb, vn1, 0, 0, 0);
            }
#define D2_VN(tt, vv) _Pragma("unroll") for (int g4 = 0; g4 < 4; ++g4) { const int r0 = g4 * 4; \
            const uint2 pkd = make_uint2(pack2(vv[r0], vv[r0 + 1]), pack2(vv[r0 + 2], vv[r0 + 3])); \
            const int tok = (tt) * 32 + 8 * g4 + 4 * (lane >> 5); \
            *(uint2*)(img + lds_off(lane & 31, tok >> 3) + (tok & 7) * 2) = pkd; \
            *(uint2*)(VNg + u * 8192 + ((((wave * 2 + (tt)) * 4 + g4) * 64 + lane) * 4)) = pkd; }
        D2_VN(0, vn0) D2_VN(1, vn1)
#pragma unroll
        for (int d = 0; d < 4; ++d)
#pragma unroll
            for (int r = 0; r < 16; ++r) S[d][r] *= eg;
#pragma unroll
        for (int ks = 0; ks < 4; ++ks) {
            const bf16x8 fb = frag_ld(img, lane & 31, ks, lane);
#pragma unroll
            for (int d = 0; d < 4; ++d) S[d] = __builtin_amdgcn_mfma_f32_32x32x16_bf16(frag_ld(KDt, d * 32 + (lane & 31), ks, lane), fb, S[d], 0, 0, 0);
        }
#pragma unroll
        for (int d = 0; d < 4; ++d)
#pragma unroll
            for (int g4 = 0; g4 < 4; ++g4) {
                const int r0 = g4 * 4;
                const uint2 pkd = make_uint2(pack2(S[d][r0], S[d][r0 + 1]), pack2(S[d][r0 + 2], S[d][r0 + 3]));
                const int kk = (d & 1) * 32 + 8 * g4 + 4 * (lane >> 5);
                *(uint2*)(img + (d >> 1) * 4096 + lds_off(lane & 31, kk >> 3) + (kk & 7) * 2) = pkd;
                if (c + 1 < 64) *(uint2*)(SCg + (u + 1) * 16384 + ((((wave * 4 + d) * 4 + g4) * 64 + lane) * 4)) = pkd;
            }
        __syncthreads();
        if (c + 1 < 64) D2_STORE()
        __syncthreads();
    }
}

__device__ __forceinline__ void r2_scan(const Params& P, int vb, int nvb) {
    const float* KVT = (const float*)(P.ws + WS_KVT); bf16_t* STR = (bf16_t*)(P.ws + WS_STR);
    for (int idx = vb * 256 + VTID; idx < 16 * 8192; idx += nvb * 256) {
        const int bh = idx >> 13, e = idx & 8191, h = bh & 7;
        const float cd = exp2f(64.f * log2f(1.f - exp2f(-5.f - (float)h)));
        float S = 0.f;
#pragma unroll 8
        for (int c = 0; c < 64; ++c) {
            const size_t o = ((size_t)bh * 64 + c) * 8192 + e;
            STR[o] = f2bf(S);
            S = cd * S + KVT[o];
        }
    }
}

__device__ __forceinline__ void d2_idle() {
    __syncthreads(); __syncthreads();
    for (int c = 0; c < 64; ++c) { __syncthreads(); __syncthreads(); }
}
__device__ __forceinline__ void phase_scan(const Params& P, int bid, int nb, unsigned char* smem) {
    const int rb = bid >> 1, half = bid & 1;
    if (rb < 16) { if (half == 0) d2_scan(P, rb, smem); else d2_idle(); }
    else r2_scan(P, bid - 32, nb - 32);
}

template <int K1, bool RET>
__device__ __forceinline__ void chunk_out(const Params& P, int u, unsigned char* smem) {
    int tid_ = VTID; asm volatile("" : "+v"(tid_));
    const int tid = tid_, wave = tid >> 6, lane = tid & 63, wr = wave >> 1, wc = wave & 1;
    const int b = u >> 9, h = (u >> 6) & 7, c = u & 63;
    const size_t tok0 = (size_t)b * SEQ + c * 64;
    const bf16_t* A1 = RET ? (const bf16_t*)(P.ws + WS_QGR) + (size_t)u * 64 * 64 : (const bf16_t*)(P.ws + WS_QG) + (size_t)u * 64 * 128;
    const bf16_t* B1 = RET ? (const bf16_t*)(P.ws + WS_STR) + (size_t)u * 128 * 64 : (const bf16_t*)(P.ws + WS_SC) + (size_t)u * 128 * 128;
    const bf16_t* A2 = RET ? (const bf16_t*)(P.ws + WS_ATTR) + (size_t)u * 64 * 64 : (const bf16_t*)(P.ws + WS_ATT) + (size_t)u * 64 * 64;
    const bf16_t* B2 = RET ? (const bf16_t*)(P.ws + WS_VNTR) + (size_t)u * 128 * 64 : (const bf16_t*)(P.ws + WS_VNT) + (size_t)u * 128 * 64;
    unsigned char* As = smem;
    unsigned char* Bs = smem + 8192;
    float* red = (float*)(smem + 24576);
    f32x16 acc[2];
#pragma unroll
    for (int j = 0; j < 2; ++j)
#pragma unroll
        for (int r = 0; r < 16; ++r) acc[j][r] = 0.f;
    constexpr int NK1 = K1 / 64;
#pragma unroll
    for (int kt = 0; kt <= NK1; ++kt) {
        const bf16_t* Ap = (kt < NK1) ? A1 + kt * 64 : A2; const int lda = (kt < NK1) ? K1 : 64;
        const bf16_t* Bp = (kt < NK1) ? B1 + kt * 64 : B2; const int ldb = lda;
        __syncthreads();
#pragma unroll
        for (int i = 0; i < 2; ++i) { const int q = tid + 256 * i, row = q >> 3, ch = q & 7; *(uint4*)(As + lds_off(row, ch)) = *(const uint4*)(Ap + row * lda + ch * 8); }
        if (RET) {
#pragma unroll
            for (int i = 0; i < 4; ++i) { const int q = tid + 256 * i, row = q >> 3, ch = q & 7; *(uint4*)(Bs + lds_off(row, ch)) = *(const uint4*)(Bp + row * ldb + ch * 8); }
        } else {
#pragma unroll
            for (int i = 0; i < 8; ++i) {
                const int q = tid + 256 * i, ln = q & 63, g4 = (q >> 6) & 3, dd = (q >> 8) & 1, w = q >> 9;
                const size_t piece = (kt < NK1) ? (size_t)(((w * 4 + 2 * kt + dd) * 4 + g4) * 64 + ln) : (size_t)(((w * 2 + dd) * 4 + g4) * 64 + ln);
                const bf16_t* src = (kt < NK1) ? B1 : B2;
                const int kk = dd * 32 + 8 * g4 + 4 * (ln >> 5);
                *(uint2*)(Bs + lds_off(w * 32 + (ln & 31), kk >> 3) + (kk & 7) * 2) = *(const uint2*)(src + piece * 4);
            }
        }
        __syncthreads();
#pragma unroll
        for (int ks = 0; ks < 4; ++ks) {
            const bf16x8 fa = frag_ld(As, wr * 32 + (lane & 31), ks, lane);
#pragma unroll
            for (int j = 0; j < 2; ++j) acc[j] = __builtin_amdgcn_mfma_f32_32x32x16_bf16(fa, frag_ld(Bs, wc * 64 + j * 32 + (lane & 31), ks, lane), acc[j], 0, 0, 0);
        }
    }
#pragma unroll
    for (int r = 0; r < 16; ++r) {
        float s1 = acc[0][r] + acc[1][r], s2 = acc[0][r] * acc[0][r] + acc[1][r] * acc[1][r];
#pragma unroll
        for (int o = 16; o >= 1; o >>= 1) { s1 += __shfl_xor(s1, o); s2 += __shfl_xor(s2, o); }
        if ((lane & 31) == 0) { const int row = wr * 32 + (r & 3) + 8 * (r >> 2) + 4 * (lane >> 5); red[(row * 2 + wc) * 2] = s1; red[(row * 2 + wc) * 2 + 1] = s2; }
    }
    __syncthreads();
    const bf16_t* proj = (const bf16_t*)(P.ws + WS_PROJ); bf16_t* mixed = (bf16_t*)(P.ws + WS_MIXED);
#pragma unroll
    for (int r = 0; r < 16; ++r) {
        const int row = wr * 32 + (r & 3) + 8 * (r >> 2) + 4 * (lane >> 5);
        const float s1 = red[row * 4] + red[row * 4 + 2], s2 = red[row * 4 + 1] + red[row * 4 + 3];
        const size_t t = tok0 + row;
#pragma unroll
        for (int j = 0; j < 2; ++j) {
            const int dv = wc * 64 + j * 32 + (lane & 31);
            float y;
            if (!RET) {
                const float rs = rsqrtf(s2 * (1.f / 128.f) + EPS);
                y = acc[j][r] * rs * P.dn_norm[dv] * silu_f(bf2f(proj[t * NPROJ + C_Z + h * 128 + dv]));
                mixed[t * D + h * 128 + dv] = f2bf(y);
            } else {
                const float mu = s1 * (1.f / 128.f);
                const float var = fmaxf(s2 * (1.f / 128.f) - mu * mu, 0.f);
                const float rs = rsqrtf(var + EPS);
                y = ((acc[j][r] - mu) * rs * P.ret_gn_w[h * 128 + dv] + P.ret_gn_b[h * 128 + dv]) * silu_f(bf2f(proj[t * NPROJ + C_RG + h * 128 + dv]));
                mixed[t * D + 1024 + h * 128 + dv] = f2bf(y);
            }
        }
    }
}

__device__ __forceinline__ void phase_chunk3(const Params& P, int bid, int nb, unsigned char* smem) {
    for (int u = bid; u < 2048; u += nb) { if (u < 1024) chunk_out<128, false>(P, u, smem); else chunk_out<64, true>(P, u - 1024, smem); }
}

__device__ __forceinline__ void ins16(float (&l)[16], float x) {
#pragma unroll
    for (int i = 0; i < 16; ++i) { const float hi = fmaxf(l[i], x); x = fminf(l[i], x); l[i] = hi; }
}
__device__ __forceinline__ void phase_route(const Params& P, int bid, int nb, unsigned char* smem) {
    const float* scores = (const float*)(P.ws + WS_SCORES); int* idx = (int*)(P.ws + WS_IDX); float* gates = (float*)(P.ws + WS_GATES);
    int tid_ = VTID; asm volatile("" : "+v"(tid_));
    const int tid = tid_;
    float* tile = (float*)smem;
    unsigned* L = (unsigned*)(smem + 256 * 33 * 4);
    const float NEG = -3.0e38f;
    for (int u = bid; u < 512; u += nb) {
        const size_t R0 = (size_t)u * 256;
        float l[16];
#pragma unroll
        for (int i = 0; i < 16; ++i) l[i] = NEG;
        for (int ch = 0; ch < 4; ++ch) {
            __syncthreads();
#pragma unroll
            for (int i = 0; i < 8; ++i) {
                const int q = tid + 256 * i, row = q >> 3, c4 = q & 7;
                const f32x4 v = *(const f32x4*)(scores + (R0 + row) * 128 + ch * 32 + c4 * 4);
                float* d = tile + row * 33 + c4 * 4; d[0] = v[0]; d[1] = v[1]; d[2] = v[2]; d[3] = v[3];
            }
            __syncthreads();
#pragma unroll
            for (int j = 0; j < 32; ++j) {
                const float x = __uint_as_float((__float_as_uint(tile[tid * 33 + j]) & ~0x7Fu) | (unsigned)(ch * 32 + j));
                ins16(l, x);
            }
        }
#pragma unroll
        for (int i = 0; i < 16; ++i) L[tid * 16 + i] = __float_as_uint(l[i]);
        __syncthreads();
        const int pe = tid & ~1, po = tid | 1;
        float s1[16], s2[16];
#pragma unroll
        for (int i = 0; i < 16; ++i) { s1[i] = __uint_as_float(L[pe * 16 + i]); s2[i] = __uint_as_float(L[po * 16 + i]); }
        float m[16];
#pragma unroll
        for (int i = 0; i < 16; ++i) m[i] = NEG;
#pragma unroll
        for (int i = 0; i < 16; ++i)
#pragma unroll
            for (int j = 0; j < 16; ++j)
                if ((i + 1) * (j + 1) <= 16) ins16(m, __uint_as_float((__float_as_uint(s1[i] + s2[j]) & ~0xFFu) | (unsigned)(i * 16 + j)));
        float e[16], sum = 0.f;
#pragma unroll
        for (int r = 0; r < 16; ++r) { e[r] = __expf(m[r] - m[0]); sum += e[r]; }
        const float inv = 1.f / sum;
        const int par = tid & 1;
        const size_t ob = ((R0 + tid) >> 1) * 16 + par * 8;
#pragma unroll
        for (int r = 0; r < 8; ++r) {
            float k_lo = m[r], k_hi = m[r + 8], e_lo = e[r], e_hi = e[r + 8];
            asm volatile("" : "+v"(k_lo), "+v"(k_hi), "+v"(e_lo), "+v"(e_hi));
            const float key = par ? k_hi : k_lo;
            const float ev = par ? e_hi : e_lo;
            const unsigned cand = __float_as_uint(key) & 0xFFu;
            const unsigned i1 = L[pe * 16 + (cand >> 4)] & 0x7Fu, i2 = L[po * 16 + (cand & 15)] & 0x7Fu;
            idx[ob + r] = (int)(i1 * 128 + i2);
            gates[ob + r] = ev * inv;
        }
    }
}

typedef float f32x2 __attribute__((ext_vector_type(2)));
__device__ __forceinline__ void phase_econv(const Params& P, int bid, int nb) {
    const int wave = VTID >> 6, lane = VTID & 63;
    float* scales = (float*)(P.ws + WS_ESC);
    for (int r = bid * 4 + wave; r < 32768; r += nb * 4) {
        const float* src = (r < 16384 ? P.expert_u : P.expert_v) + (size_t)(r & 16383) * D;
        int* dst = (int*)(P.ws + WS_EU8 + (size_t)r * 2048);
        f32x4 v[8]; float am = 0.f;
#pragma unroll
        for (int i = 0; i < 8; ++i) { v[i] = *(const f32x4*)(src + (i * 64 + lane) * 4); am = fmaxf(am, fmaxf(fmaxf(fabsf(v[i][0]), fabsf(v[i][1])), fmaxf(fabsf(v[i][2]), fabsf(v[i][3])))); }
        am = wave_max(am);
        const float sc = am > 0.f ? 224.f / am : 1.f;
#pragma unroll
        for (int i = 0; i < 8; ++i) {
            int w = 0;
            w = __builtin_amdgcn_cvt_pk_fp8_f32(v[i][0] * sc, v[i][1] * sc, w, false);
            w = __builtin_amdgcn_cvt_pk_fp8_f32(v[i][2] * sc, v[i][3] * sc, w, true);
            dst[i * 64 + lane] = w;
        }
        if (lane == 0) scales[r] = am > 0.f ? am * (1.f / 224.f) : 1.f;
    }
}

__device__ __forceinline__ float dot16(const uint4 w, const float* x) {
    float d = 0.f; const unsigned ww[4] = {w.x, w.y, w.z, w.w};
#pragma unroll
    for (int q = 0; q < 4; ++q) {
        const f32x2 lo = __builtin_amdgcn_cvt_pk_f32_fp8((int)ww[q], false), hi = __builtin_amdgcn_cvt_pk_f32_fp8((int)ww[q], true);
        d += lo[0] * x[q * 4] + lo[1] * x[q * 4 + 1] + hi[0] * x[q * 4 + 2] + hi[1] * x[q * 4 + 3];
    }
    return d;
}
__device__ __forceinline__ void axpy16(const uint4 w, const float a, float* acc) {
    const unsigned ww[4] = {w.x, w.y, w.z, w.w};
#pragma unroll
    for (int q = 0; q < 4; ++q) {
        const f32x2 lo = __builtin_amdgcn_cvt_pk_f32_fp8((int)ww[q], false), hi = __builtin_amdgcn_cvt_pk_f32_fp8((int)ww[q], true);
        acc[q * 4] += a * lo[0]; acc[q * 4 + 1] += a * lo[1]; acc[q * 4 + 2] += a * hi[0]; acc[q * 4 + 3] += a * hi[1];
    }
}
__device__ __forceinline__ float gelu_f(float d) { return 0.5f * d * (1.f + erff(d * 0.70710678118654752f)); }

__device__ __forceinline__ void phase_peer(const Params& P, int bid, int nb) {
    const bf16_t* hn = (const bf16_t*)(P.ws + WS_HN); const int* idx = (const int*)(P.ws + WS_IDX); const float* gates = (const float*)(P.ws + WS_GATES);
    float* H = (float*)(P.ws + WS_H);
    const unsigned char* EU = P.ws + WS_EU8; const unsigned char* EV = P.ws + WS_EV8; const float* SC = (const float*)(P.ws + WS_ESC);
    const int wave = VTID >> 6, lane = VTID & 63;
    for (int t = bid * 4 + wave; t < T; t += nb * 4) {
        float xr[32], acc[32];
#pragma unroll
        for (int c = 0; c < 2; ++c)
#pragma unroll
            for (int q = 0; q < 2; ++q) {
                const uint4 v = *(const uint4*)(hn + (size_t)t * D + c * 1024 + lane * 16 + q * 8);
                const unsigned ww[4] = {v.x, v.y, v.z, v.w};
#pragma unroll
                for (int j = 0; j < 4; ++j) { xr[c * 16 + q * 8 + 2 * j] = bf2f((bf16_t)(ww[j] & 0xffff)); xr[c * 16 + q * 8 + 2 * j + 1] = bf2f((bf16_t)(ww[j] >> 16)); }
            }
#pragma unroll
        for (int i = 0; i < 32; ++i) acc[i] = 0.f;
        const int   my_i0 = idx[(size_t)t * 128 + lane],   my_i1 = idx[(size_t)t * 128 + 64 + lane];
        const float my_g0 = gates[(size_t)t * 128 + lane], my_g1 = gates[(size_t)t * 128 + 64 + lane];
        uint4 a_u0, a_u1, a_v0, a_v1, a_u2, a_u3, a_v2, a_v3;
        uint4 b_u0, b_u1, b_v0, b_v1, b_u2, b_u3, b_v2, b_v3;
#define PEER_LOAD1(U0, U1, V0, V1, e) { const uint4* up = (const uint4*)(EU + (size_t)(e) * 2048) + lane; U0 = up[0]; U1 = up[64]; \
                                         const uint4* vp = (const uint4*)(EV + (size_t)(e) * 2048) + lane; V0 = vp[0]; V1 = vp[64]; }
#define PEER_COMP1(U0, U1, V0, V1, e, g) { float d = dot16(U0, xr) + dot16(U1, xr + 16); d = wave_sum(d); \
                                            const float pre = d * SC[e]; const float a = gelu_f(pre) * (g) * SC[16384 + (e)]; axpy16(V0, a, acc); axpy16(V1, a, acc + 16); }
#pragma unroll
        for (int hh = 0; hh < 2; ++hh) {
            const int mi = hh ? my_i1 : my_i0; const int mgi = __float_as_int(hh ? my_g1 : my_g0);
            { const int e0 = __builtin_amdgcn_readlane(mi, 0), e1 = __builtin_amdgcn_readlane(mi, 1); PEER_LOAD1(a_u0, a_u1, a_v0, a_v1, e0) PEER_LOAD1(a_u2, a_u3, a_v2, a_v3, e1) }
            for (int k = 0; k < 64; k += 4) {
                const int e0 = __builtin_amdgcn_readlane(mi, k), e1 = __builtin_amdgcn_readlane(mi, k + 1), e2 = __builtin_amdgcn_readlane(mi, k + 2), e3 = __builtin_amdgcn_readlane(mi, k + 3);
                const float g0 = __int_as_float(__builtin_amdgcn_readlane(mgi, k)), g1 = __int_as_float(__builtin_amdgcn_readlane(mgi, k + 1)), g2 = __int_as_float(__builtin_amdgcn_readlane(mgi, k + 2)), g3 = __int_as_float(__builtin_amdgcn_readlane(mgi, k + 3));
                PEER_LOAD1(b_u0, b_u1, b_v0, b_v1, e2) PEER_LOAD1(b_u2, b_u3, b_v2, b_v3, e3)
                PEER_COMP1(a_u0, a_u1, a_v0, a_v1, e0, g0) PEER_COMP1(a_u2, a_u3, a_v2, a_v3, e1, g1)
                if (k + 4 < 64) { const int e4 = __builtin_amdgcn_readlane(mi, k + 4), e5 = __builtin_amdgcn_readlane(mi, k + 5); PEER_LOAD1(a_u0, a_u1, a_v0, a_v1, e4) PEER_LOAD1(a_u2, a_u3, a_v2, a_v3, e5) }
                PEER_COMP1(b_u0, b_u1, b_v0, b_v1, e2, g2) PEER_COMP1(b_u2, b_u3, b_v2, b_v3, e3, g3)
            }
        }
        float ss = 0.f;
#pragma unroll
        for (int c = 0; c < 2; ++c)
#pragma unroll
            for (int q = 0; q < 4; ++q) {
                f32x4* hp = (f32x4*)(H + (size_t)t * D + c * 1024 + lane * 16 + q * 4);
                f32x4 hv = *hp;
#pragma unroll
                for (int j = 0; j < 4; ++j) { hv[j] += acc[c * 16 + q * 4 + j]; acc[c * 16 + q * 4 + j] = hv[j]; ss += hv[j] * hv[j]; }
                *hp = hv;
            }
        ss = wave_sum(ss);
        const float rs = rsqrtf(ss * (1.f / 2048.f) + EPS);
        bf16_t* hn3 = (bf16_t*)(P.ws + WS_HN) + (size_t)t * D;
#pragma unroll
        for (int c = 0; c < 2; ++c)
#pragma unroll
            for (int q = 0; q < 2; ++q) {
                unsigned w[4];
#pragma unroll
                for (int j = 0; j < 4; ++j) { const int col = c * 1024 + lane * 16 + q * 8 + 2 * j;
                    w[j] = pack2(acc[c * 16 + q * 8 + 2 * j] * rs * P.norm_ple[col], acc[c * 16 + q * 8 + 2 * j + 1] * rs * P.norm_ple[col + 1]); }
                *(uint4*)(hn3 + c * 1024 + lane * 16 + q * 8) = make_uint4(w[0], w[1], w[2], w[3]);
            }
    }
}

enum { PH_PREP = 0, PH_GEMM1, PH_CHUNK1, PH_SCAN, PH_CHUNK3, PH_ECONV, PH_GEMM2, PH_NORM2, PH_GEMM3, PH_SCORES, PH_ROUTE, PH_PEER, PH_PLE, PH_GEMM4, PH_FINAL, PH_COUNT };

#define XB_TMO      128
#define XB_XCNT(j)  (256  + 64 * (j))
#define XB_XSUB(j)  (1280 + 64 * (j))
#define XB_XGEN(j)  (2304 + 64 * (j))
#define XB_TOP      3328
#define XB_TOPGEN   3392
#define XCD_BAR_WORDS 3456
#define XB_SPIN_CAP (1u << 20)
#define LAS __attribute__((address_space(3)))
__device__ __forceinline__ unsigned xb_ld(unsigned* p)              { return __hip_atomic_load(p, __ATOMIC_RELAXED, __HIP_MEMORY_SCOPE_AGENT); }
__device__ __forceinline__ unsigned xb_add(unsigned* p, unsigned v) { return __hip_atomic_fetch_add(p, v, __ATOMIC_RELAXED, __HIP_MEMORY_SCOPE_AGENT); }
__device__ __forceinline__ unsigned xb_xcc_id() { return (unsigned)__builtin_amdgcn_s_getreg((3 << 11) | 20) & 0xFu; }
#define XB_SPIN(cond, bar) do { unsigned _sp = 0; while (cond) { __builtin_amdgcn_s_sleep(1); \
    if ((++_sp & 255u) == 0u) { if (xb_ld(&(bar)[XB_TMO])) break; if (_sp > XB_SPIN_CAP) { atomicAdd(&(bar)[XB_TMO], 1u); break; } } } } while (0)
struct XcdBarrier { unsigned* bar; unsigned x; volatile LAS unsigned* st; };
__device__ __forceinline__ XcdBarrier xcd_barrier_post(unsigned* bar, volatile LAS unsigned* st) {
    XcdBarrier b; b.bar = bar; b.x = xb_xcc_id(); b.st = st;
    if (threadIdx.x == 0) (void)xb_add(&bar[XB_XCNT(b.x)], 1u);
    return b;
}
__device__ __forceinline__ void xcd_barrier_complete(unsigned* bar, unsigned x, unsigned& nloc, unsigned& nx) {
    const unsigned G = gridDim.x * gridDim.y * gridDim.z;
    unsigned sum, cnt, mine, sp = 0u;
    for (;;) {
        sum = 0u; cnt = 0u; mine = 0u;
#pragma unroll
        for (unsigned j = 0; j < 16; ++j) { const unsigned c = xb_ld(&bar[XB_XCNT(j)]); sum += c; cnt += (c > 0u) ? 1u : 0u; mine = (j == x) ? c : mine; }
        if (sum == G) break;
        __builtin_amdgcn_s_sleep(1);
        if ((++sp & 255u) == 0u) { if (xb_ld(&bar[XB_TMO])) break; if (sp > XB_SPIN_CAP) { atomicAdd(&bar[XB_TMO], 1u); break; } }
    }
    nloc = mine > 0u ? mine : 1u; nx = cnt > 0u ? cnt : 1u;
}
__device__ __forceinline__ void xcd_barrier(const XcdBarrier& b) {
    asm volatile("s_waitcnt vmcnt(0)" ::: "memory");
    __syncthreads();
    if (threadIdx.x == 0) {
        unsigned* bar = b.bar;
        __builtin_amdgcn_s_waitcnt(0);
        unsigned nloc = b.st[0], nx = b.st[1];
        if (nloc == 0u) { xcd_barrier_complete(bar, b.x, nloc, nx); b.st[0] = nloc; b.st[1] = nx; }
        const unsigned old = xb_add(&bar[XB_XSUB(b.x)], 1u);
        const unsigned gen = old / nloc;
        if (old + 1u == (gen + 1u) * nloc) {
            __builtin_amdgcn_fence(__ATOMIC_RELEASE, "agent");
            asm volatile("s_waitcnt vmcnt(0)" ::: "memory");
            const unsigned og = xb_add(&bar[XB_TOP], 1u);
            const unsigned tg = og / nx;
            if (og + 1u == (tg + 1u) * nx) xb_add(&bar[XB_TOPGEN], 1u);
            else XB_SPIN(xb_ld(&bar[XB_TOPGEN]) == tg, bar);
            __builtin_amdgcn_fence(__ATOMIC_ACQUIRE, "agent");
            xb_add(&bar[XB_XGEN(b.x)], 1u);
            asm volatile("s_waitcnt vmcnt(0)" ::: "memory");
        } else {
            XB_SPIN(xb_ld(&bar[XB_XGEN(b.x)]) == gen, bar);
            __builtin_amdgcn_fence(__ATOMIC_ACQUIRE, "agent");
            asm volatile("s_waitcnt vmcnt(0)" ::: "memory");
        }
    }
    __syncthreads();
}

__device__ __forceinline__ void run_phase(const Params& P, int ph, int bid, int nb, unsigned char* smem, int rbid, int rnb, unsigned char* rsmem) {
    switch (ph) {
        case PH_PREP:   phase_prep(P, bid, nb, smem); break;
        case PH_GEMM1:  phase_gemm1(P, rbid, rnb, rsmem); break;
        case PH_CHUNK1: phase_chunk1(P, bid, nb, smem); break;
        case PH_SCAN:   phase_scan(P, bid, nb, smem); break;
        case PH_CHUNK3: phase_chunk3(P, bid, nb, smem); break;
        case PH_ECONV:  phase_econv(P, bid, nb); break;
        case PH_GEMM2:  phase_gemm2(P, rbid, rnb, rsmem); break;
        case PH_NORM2:  phase_rownorm<true>((const float*)(P.ws + WS_H), P.norm_ffn, P.ws + WS_HN, bid, nb); break;
        case PH_GEMM3:  phase_gemm3(P, rbid, rnb, rsmem); break;
        case PH_SCORES: phase_scores(P, bid, nb, smem); break;
        case PH_ROUTE:  phase_route(P, bid, nb, smem); break;
        case PH_PEER:   phase_peer(P, bid, nb); break;
        case PH_PLE:    phase_ple(P, rbid, rnb, rsmem); break;
        case PH_GEMM4:  phase_gemm4(P, rbid, rnb, rsmem); break;
        case PH_FINAL:  phase_rownorm<false>((const float*)(P.ws + WS_H), P.norm_final, P.out, bid, nb); break;
    }
}

#ifndef PROBE_A
#define PROBE_A -1
#endif
#ifndef PROBE_B
#define PROBE_B -1
#endif
constexpr int LDS_BYTES = 131072 + 16 + 256;

__global__ void __launch_bounds__(512, 2) fwd_kernel(Params P, int ph_lo, int ph_hi) {
    extern __shared__ __attribute__((aligned(16))) unsigned char rsmem[];
    const int rbid = blockIdx.x, rnb = gridDim.x;
    const int half = threadIdx.x >> 8;
    const int bid = rbid * 2 + half, nb = rnb * 2;
    unsigned char* smem = rsmem + half * 65536;
    volatile LAS unsigned* st = (volatile LAS unsigned*)(rsmem + 131072);
    if (threadIdx.x == 0) { st[0] = 0u; st[1] = 0u; }
    __syncthreads();
    XcdBarrier xb = xcd_barrier_post((unsigned*)(P.ws + WS_BAR), st);
#if PROBE_A >= 0
    unsigned long long* tstamp = (unsigned long long*)(rsmem + 131072 + 16);
    xcd_barrier(xb);
    if (threadIdx.x == 0) tstamp[0] = __builtin_amdgcn_s_memrealtime();
#define RUN(ph) if (ph_lo <= (ph) && (ph) < ph_hi) { run_phase(P, (ph), bid, nb, smem, rbid, rnb, rsmem); xcd_barrier(xb); if (threadIdx.x == 0) tstamp[(ph) + 1] = __builtin_amdgcn_s_memrealtime(); }
#else
#ifndef REPEAT_PH
#define REPEAT_PH -1
#endif
#define RUN(ph) if (ph_lo <= (ph) && (ph) < ph_hi) { run_phase(P, (ph), bid, nb, smem, rbid, rnb, rsmem); if ((ph) == REPEAT_PH) { xcd_barrier(xb); run_phase(P, (ph), bid, nb, smem, rbid, rnb, rsmem); } if ((ph) + 1 < ph_hi) xcd_barrier(xb); }
#endif
    RUN(PH_PREP) RUN(PH_GEMM1) RUN(PH_CHUNK1) RUN(PH_SCAN) RUN(PH_CHUNK3) RUN(PH_ECONV) RUN(PH_GEMM2) RUN(PH_NORM2) RUN(PH_GEMM3) RUN(PH_SCORES) RUN(PH_ROUTE)
    RUN(PH_PEER) RUN(PH_PLE) RUN(PH_GEMM4) RUN(PH_FINAL)
#if PROBE_A >= 0
    __syncthreads();
    if (rbid == 0) {
        const float da = (float)(tstamp[PROBE_A + 1] - tstamp[PROBE_A]) * 0.01f;
        if (threadIdx.x == 0) P.out[0] = da;
#if PROBE_B >= 0
        const float db = (float)(tstamp[PROBE_B + 1] - tstamp[PROBE_B]) * 0.01f * (1.f / 16.f);
        for (int i = threadIdx.x; i < 65536; i += 512) P.out[65536 + i] = db;
#endif
    }
#endif
}

extern "C" void kernel_launch(void* const* d_in, const int* in_sizes, int n_in, void* d_out, int out_size, void* d_ws, size_t ws_size, hipStream_t stream) {
    static int grid = 0;
    if (grid == 0) {
        if (n_in != 21 || out_size != T * D || ws_size < WS_END) { fprintf(stderr, "kernel_launch: unexpected shapes: n_in %d out %d ws %zu (need %zu)\n", n_in, out_size, ws_size, (size_t)WS_END); grid = -1; return; }
        if (hipFuncSetAttribute((const void*)fwd_kernel, hipFuncAttributeMaxDynamicSharedMemorySize, LDS_BYTES) != hipSuccess) { fprintf(stderr, "kernel_launch: hipFuncSetAttribute failed\n"); grid = -1; return; }
        int dev = 0, cus = 0, per_cu = 0;
        hipGetDevice(&dev); hipDeviceGetAttribute(&cus, hipDeviceAttributeMultiprocessorCount, dev);
        if (hipOccupancyMaxActiveBlocksPerMultiprocessor(&per_cu, (const void*)fwd_kernel, 512, LDS_BYTES) != hipSuccess || per_cu < 1) { fprintf(stderr, "kernel_launch: occupancy query failed (%d)\n", per_cu); grid = -1; return; }
        if (per_cu > 1) per_cu = 1;
        grid = cus * per_cu;
        fprintf(stderr, "kernel_launch: grid %d (%d CUs x %d)\n", grid, cus, per_cu);
    }
    if (grid < 0) return;
    Params P{};
    P.x = (const float*)d_in[0]; P.p = (const float*)d_in[1]; P.positions = (const int*)d_in[2]; P.norm_mix = (const float*)d_in[3]; P.w_in = (const float*)d_in[4];
    P.conv_w = (const float*)d_in[5]; P.a_log = (const float*)d_in[6]; P.dt_bias = (const float*)d_in[7]; P.dn_norm = (const float*)d_in[8]; P.ret_gn_w = (const float*)d_in[9];
    P.ret_gn_b = (const float*)d_in[10]; P.w_out = (const float*)d_in[11]; P.norm_ffn = (const float*)d_in[12]; P.w_pq = (const float*)d_in[13]; P.sub_keys = (const float*)d_in[14];
    P.expert_u = (const float*)d_in[15]; P.expert_v = (const float*)d_in[16]; P.norm_ple = (const float*)d_in[17]; P.w_ple_gate = (const float*)d_in[18]; P.w_ple_proj = (const float*)d_in[19];
    P.norm_final = (const float*)d_in[20]; P.out = (float*)d_out; P.ws = (unsigned char*)d_ws;
    (void)hipMemsetAsync((unsigned char*)d_ws + WS_BAR, 0, XCD_BAR_WORDS * 4, stream);
    int lo = 0, hi = PH_COUNT;
    void* args[] = {&P, &lo, &hi};
    hipError_t e = hipLaunchCooperativeKernel((const void*)fwd_kernel, dim3(grid), dim3(512), args, LDS_BYTES, stream);
    if (e != hipSuccess) fprintf(stderr, "kernel_launch: cooperative launch failed: %s (grid %d)\n", hipGetErrorString(e), grid);
}
```

```cpp
#include <hip/hip_runtime.h>
#include <cstdio>
#include <cstdint>

typedef unsigned short bf16_t;
typedef short bf16x8 __attribute__((ext_vector_type(8)));
typedef float f32x16 __attribute__((ext_vector_type(16)));
typedef float f32x4 __attribute__((ext_vector_type(4)));
__device__ __forceinline__ int fresh_tid() { int t = (int)threadIdx.x; asm volatile("" : "+v"(t)); return t; }
#define VTID (fresh_tid() & 255)

constexpr int T = 8192, D = 2048, SEQ = 4096;
constexpr int NPROJ = 7424;
constexpr int C_Z = 3072, C_RQ = 4096, C_RK = 4608, C_RV = 5120, C_RG = 6144, C_A = 7168, C_B = 7176;
constexpr int IN_COLS = 7184;
constexpr float EPS = 1e-6f;

constexpr size_t WS_HN    = 0;
constexpr size_t WS_KVT   = WS_HN;
constexpr size_t WS_WTIN  = WS_HN + (size_t)T * D * 2;
constexpr size_t WS_STR   = WS_WTIN;
constexpr size_t WS_ATTR  = WS_STR + (size_t)1024 * 128 * 64 * 2;
constexpr size_t WS_WTOUT = WS_WTIN + (size_t)NPROJ * D * 2;
constexpr size_t WS_WTPQ  = WS_WTOUT + (size_t)D * D * 2;
constexpr size_t WS_WTG   = WS_WTPQ + (size_t)D * D * 2;
constexpr size_t WS_WTPP  = WS_WTG + (size_t)D * D * 2;
constexpr size_t WS_KEYS  = WS_WTPP + (size_t)D * 256 * 2;
constexpr size_t WS_PBF   = WS_KEYS + (size_t)16 * 128 * 128 * 2;
constexpr size_t WS_PROJ  = WS_PBF + (size_t)T * 256 * 2;
constexpr size_t WS_Q     = WS_PROJ;
constexpr size_t WS_SCORES= WS_PROJ + (size_t)T * D * 2;
constexpr size_t WS_MIXED = WS_PROJ + (size_t)T * NPROJ * 2;
constexpr size_t WS_H     = WS_MIXED + (size_t)T * D * 2;
constexpr size_t WS_IDX   = WS_H + (size_t)T * D * 4;
constexpr size_t WS_GATES = WS_IDX + (size_t)T * 128 * 4;
constexpr size_t WS_U     = WS_GATES + (size_t)T * 128 * 4;
constexpr size_t WS_W     = WS_U + (size_t)1024 * 64 * 128 * 4;
constexpr size_t WS_KDT   = WS_W + (size_t)1024 * 64 * 128 * 2;
constexpr size_t WS_QG    = WS_KDT + (size_t)1024 * 128 * 64 * 2;
constexpr size_t WS_ATT   = WS_QG + (size_t)1024 * 64 * 128 * 2;
constexpr size_t WS_QGR   = WS_ATT + (size_t)1024 * 64 * 64 * 2;
constexpr size_t WS_EU8   = WS_QGR + (size_t)1024 * 64 * 64 * 2;
constexpr size_t WS_EV8   = WS_EU8 + (size_t)16384 * 2048;
constexpr size_t WS_ESC   = WS_EV8 + (size_t)16384 * 2048;
constexpr size_t WS_EG    = WS_ESC + (size_t)2 * 16384 * 4;
constexpr size_t WS_RSS   = WS_EG + 4096;
constexpr size_t WS_BAR   = WS_RSS + (size_t)T * 4;
constexpr size_t WS_END   = WS_BAR + 16384;
constexpr size_t WS_VNT   = WS_H;
constexpr size_t WS_SC    = WS_VNT + (size_t)1024 * 128 * 64 * 2;
constexpr size_t WS_VNTR  = WS_SC + (size_t)1024 * 128 * 128 * 2;
static_assert(WS_VNTR + (size_t)1024 * 128 * 64 * 2 == WS_H + (size_t)T * D * 4, "chunk buffers must fit the H region");

struct Params {
    const float *x, *p; const int* positions;
    const float *norm_mix, *w_in, *conv_w, *a_log, *dt_bias, *dn_norm, *ret_gn_w, *ret_gn_b, *w_out, *norm_ffn, *w_pq, *sub_keys,
                *expert_u, *expert_v, *norm_ple, *w_ple_gate, *w_ple_proj, *norm_final;
    float* out; unsigned char* ws;
};

__device__ __forceinline__ bf16_t f2bf(float f) { unsigned u = __float_as_uint(f); u += 0x7fffu + ((u >> 16) & 1u); return (bf16_t)(u >> 16); }
__device__ __forceinline__ float bf2f(bf16_t h) { return __uint_as_float(((unsigned)h) << 16); }
__device__ __forceinline__ unsigned pack2(float a, float b) { return (unsigned)f2bf(a) | ((unsigned)f2bf(b) << 16); }
__device__ __forceinline__ float wave_sum(float v) {
#pragma unroll
    for (int o = 32; o >= 1; o >>= 1) v += __shfl_xor(v, o);
    return v;
}
__device__ __forceinline__ float wave_max(float v) {
#pragma unroll
    for (int o = 32; o >= 1; o >>= 1) v = fmaxf(v, __shfl_xor(v, o));
    return v;
}
__device__ __forceinline__ float silu_f(float x) { return x / (1.f + __expf(-x)); }
__device__ __forceinline__ float sigmoid_f(float x) { return 1.f / (1.f + __expf(-x)); }

template <bool MAPIN>
__device__ __forceinline__ void transpose_tile(const float* __restrict__ W, int ldw, int K, bf16_t* __restrict__ Wt, int kt, int nt, float* tile  ) {
    const int tid = VTID;
    __syncthreads();
#pragma unroll
    for (int i = 0; i < 4; ++i) {
        const int idx = tid + 256 * i, kr = idx >> 4, c4 = idx & 15;
        const int n = nt * 64 + c4 * 4;
        int c = n; bool valid = true;
        if (MAPIN) { if (n < 4096) c = n; else if (n < 7168) c = n + 16; else if (n < 7184) c = n - 3072; else valid = false; }
        f32x4 v = {0.f, 0.f, 0.f, 0.f};
        if (valid) v = *(const f32x4*)(W + (size_t)(kt * 64 + kr) * ldw + c);
        float* d = tile + kr * 65 + c4 * 4;
        d[0] = v[0]; d[1] = v[1]; d[2] = v[2]; d[3] = v[3];
    }
    __syncthreads();
#pragma unroll
    for (int i = 0; i < 2; ++i) {
        const int ch = tid + 256 * i, n = ch >> 3, kc = ch & 7;
        unsigned w[4];
#pragma unroll
        for (int j = 0; j < 4; ++j) w[j] = pack2(tile[(kc * 8 + 2 * j) * 65 + n], tile[(kc * 8 + 2 * j + 1) * 65 + n]);
        uint4 o = make_uint4(w[0], w[1], w[2], w[3]);
        *(uint4*)(Wt + (size_t)(nt * 64 + n) * K + kt * 64 + kc * 8) = o;
    }
}

template <bool OUT_BF16>
__device__ __forceinline__ void rmsnorm_row(const float* __restrict__ in, const float* __restrict__ w, void* __restrict__ out, int lane) {
    f32x4 v[8]; float ss = 0.f;
#pragma unroll
    for (int i = 0; i < 8; ++i) { v[i] = *(const f32x4*)(in + (i * 64 + lane) * 4); ss += v[i][0] * v[i][0] + v[i][1] * v[i][1] + v[i][2] * v[i][2] + v[i][3] * v[i][3]; }
    ss = wave_sum(ss);
    const float r = rsqrtf(ss * (1.f / 2048.f) + EPS);
#pragma unroll
    for (int i = 0; i < 8; ++i) {
        const f32x4 g = *(const f32x4*)(w + (i * 64 + lane) * 4);
        const float a = v[i][0] * r * g[0], b = v[i][1] * r * g[1], c = v[i][2] * r * g[2], d = v[i][3] * r * g[3];
        if (OUT_BF16) { uint2 o = make_uint2(pack2(a, b), pack2(c, d)); *(uint2*)((bf16_t*)out + (i * 64 + lane) * 4) = o; }
        else { f32x4 o = {a, b, c, d}; *(f32x4*)((float*)out + (i * 64 + lane) * 4) = o; }
    }
}

__device__ __forceinline__ void phase_prep(const Params& P, int bid, int nb, unsigned char* smem) {
    float* tile = (float*)smem;
    const int tid = VTID;
    const int n_in = 32 * 116, n_sq = 32 * 32, n_pp = 4 * 32;
    const int n_tr = n_in + 3 * n_sq + n_pp;
    for (int u = bid; u < n_tr; u += nb) {
        if (u < n_in) transpose_tile<true>(P.w_in, IN_COLS, D, (bf16_t*)(P.ws + WS_WTIN), u % 32, u / 32, tile);
        else if (u < n_in + n_sq) { const int v = u - n_in; transpose_tile<false>(P.w_out, D, D, (bf16_t*)(P.ws + WS_WTOUT), v % 32, v / 32, tile); }
        else if (u < n_in + 2 * n_sq) { const int v = u - n_in - n_sq; transpose_tile<false>(P.w_pq, D, D, (bf16_t*)(P.ws + WS_WTPQ), v % 32, v / 32, tile); }
        else if (u < n_in + 3 * n_sq) { const int v = u - n_in - 2 * n_sq; transpose_tile<false>(P.w_ple_gate, D, D, (bf16_t*)(P.ws + WS_WTG), v % 32, v / 32, tile); }
        else { const int v = u - n_in - 3 * n_sq; transpose_tile<false>(P.w_ple_proj, D, 256, (bf16_t*)(P.ws + WS_WTPP), v % 4, v / 4, tile); }
    }
    {
        bf16_t* keys = (bf16_t*)(P.ws + WS_KEYS); bf16_t* pbf = (bf16_t*)(P.ws + WS_PBF);
        const int n4a = 262144 / 4, n4b = T * 256 / 4;
        for (int i = bid * 256 + tid; i < n4a + n4b; i += nb * 256) {
            const bool a = i < n4a; const int j = a ? i : i - n4a;
            const f32x4 v = *(const f32x4*)((a ? P.sub_keys : P.p) + (size_t)j * 4);
            *(uint2*)((a ? keys : pbf) + (size_t)j * 4) = make_uint2(pack2(v[0], v[1]), pack2(v[2], v[3]));
        }
    }
    { float* rss = (float*)(P.ws + WS_RSS); for (int i = bid * 256 + tid; i < T; i += nb * 256) rss[i] = 0.f; }
    {
        const int wave = tid >> 6, lane = tid & 63;
        bf16_t* hn = (bf16_t*)(P.ws + WS_HN);
        for (int r = bid * 4 + wave; r < T; r += nb * 4) rmsnorm_row<true>(P.x + (size_t)r * D, P.norm_mix, hn + (size_t)r * D, lane);
    }
}

__device__ __forceinline__ int lds_off(int row, int ch) { return row * 128 + ((ch ^ ((row >> 1) & 7)) << 4); }

__device__ __forceinline__ void gemm_mainloop(const bf16_t* __restrict__ A, int lda, const bf16_t* __restrict__ Bt, int ldb, int K,
                                              f32x16 (&acc)[2][2], unsigned char* smem) {
    const int tid = VTID, wave = tid >> 6, lane = tid & 63, wr = wave >> 1, wc = wave & 1;
    const int nk = K / 64;
    uint4 ra[4], rb[4];
    __syncthreads();
#pragma unroll
    for (int i = 0; i < 4; ++i) { const int c = tid + 256 * i, row = c >> 3, ch = c & 7;
        ra[i] = *(const uint4*)(A + (size_t)row * lda + ch * 8); rb[i] = *(const uint4*)(Bt + (size_t)row * ldb + ch * 8); }
#pragma unroll
    for (int i = 0; i < 4; ++i) { const int c = tid + 256 * i, row = c >> 3, ch = c & 7;
        *(uint4*)(smem + lds_off(row, ch)) = ra[i]; *(uint4*)(smem + 16384 + lds_off(row, ch)) = rb[i]; }
    __syncthreads();
    for (int kt = 0; kt < nk; ++kt) {
        unsigned char* cur = smem + (kt & 1) * 32768;
        unsigned char* nxt = smem + ((kt + 1) & 1) * 32768;
        const bool more = kt + 1 < nk;
        if (more) {
#pragma unroll
            for (int i = 0; i < 4; ++i) { const int c = tid + 256 * i, row = c >> 3, ch = c & 7;
                ra[i] = *(const uint4*)(A + (size_t)row * lda + (kt + 1) * 64 + ch * 8); rb[i] = *(const uint4*)(Bt + (size_t)row * ldb + (kt + 1) * 64 + ch * 8); }
        }
#pragma unroll
        for (int ks = 0; ks < 4; ++ks) {
            bf16x8 af[2], bfr[2];
#pragma unroll
            for (int i = 0; i < 2; ++i) { const int row = wr * 64 + i * 32 + (lane & 31); af[i] = *(const bf16x8*)(cur + lds_off(row, ks * 2 + (lane >> 5))); }
#pragma unroll
            for (int j = 0; j < 2; ++j) { const int row = wc * 64 + j * 32 + (lane & 31); bfr[j] = *(const bf16x8*)(cur + 16384 + lds_off(row, ks * 2 + (lane >> 5))); }
#pragma unroll
            for (int i = 0; i < 2; ++i)
#pragma unroll
                for (int j = 0; j < 2; ++j) acc[i][j] = __builtin_amdgcn_mfma_f32_32x32x16_bf16(af[i], bfr[j], acc[i][j], 0, 0, 0);
        }
        if (more) {
#pragma unroll
            for (int i = 0; i < 4; ++i) { const int c = tid + 256 * i, row = c >> 3, ch = c & 7;
                *(uint4*)(nxt + lds_off(row, ch)) = ra[i]; *(uint4*)(nxt + 16384 + lds_off(row, ch)) = rb[i]; }
        }
        __syncthreads();
    }
}
#define ACC_FOREACH(body)                                                                                   \
    { const int _tid = VTID, _wave = _tid >> 6, _lane = _tid & 63, _wr = _wave >> 1, _wc = _wave & 1; \
      _Pragma("unroll") for (int i = 0; i < 2; ++i) _Pragma("unroll") for (int j = 0; j < 2; ++j)          \
      _Pragma("unroll") for (int r = 0; r < 16; ++r) {                                                     \
          const int row = _wr * 64 + i * 32 + (r & 3) + 8 * (r >> 2) + 4 * (_lane >> 5);                   \
          const int col = _wc * 64 + j * 32 + (_lane & 31); body } }

__device__ __forceinline__ void zero_acc(f32x16 (&acc)[2][2]) {
#pragma unroll
    for (int i = 0; i < 2; ++i)
#pragma unroll
        for (int j = 0; j < 2; ++j)
#pragma unroll
            for (int r = 0; r < 16; ++r) acc[i][j][r] = 0.f;
}

__device__ __forceinline__ void phase_scores(const Params& P, int bid, int nb, unsigned char* smem) {
    const bf16_t* A = (const bf16_t*)(P.ws + WS_Q); const bf16_t* Bt = (const bf16_t*)(P.ws + WS_KEYS); float* C = (float*)(P.ws + WS_SCORES);
    const int nmt = T / 128, nnt = 16;
    for (int t = bid; t < nmt * nnt; t += nb) {
        const int mt = t % nmt, nt = t / nmt;
        f32x16 acc[2][2]; zero_acc(acc);
        gemm_mainloop(A + (size_t)mt * 128 * D + nt * 128, D, Bt + (size_t)nt * 128 * 128, 128, 128, acc, smem);
        ACC_FOREACH({ C[(size_t)(mt * 128 + row) * D + nt * 128 + col] = acc[i][j][r]; })
    }
}
__device__ __forceinline__ int g2_lds_byte(int r, int c) { const int st = (r >> 4) * 2 + (c >> 5), ob = (r & 15) * 64 + (c & 31) * 2; return st * 1024 + (ob ^ (((ob >> 9) & 1) << 5)); }
__device__ __forceinline__ void g2_stage_rc(int b, int& R, int& C) { const int st = b >> 10, sb = b & 1023, swz = sb ^ (((sb >> 9) & 1) << 5); R = (st >> 1) * 16 + (swz >> 6); C = (st & 1) * 32 + ((swz & 63) >> 1); }
__device__ __forceinline__ void g2_zero(f32x4 (&acc)[8][4]) {
#pragma unroll
    for (int m = 0; m < 8; ++m)
#pragma unroll
        for (int n = 0; n < 4; ++n) acc[m][n] = (f32x4){0.f, 0.f, 0.f, 0.f};
}
__device__ __forceinline__ void g2_mainloop(const bf16_t* __restrict__ Ab, int lda, const bf16_t* __restrict__ Bb, int ldb, int K, f32x4 (&acc)[8][4], unsigned char* shm) {
    const int tid = fresh_tid(), wid = tid >> 6, lane = tid & 63, wr = wid >> 2, wc = wid & 3, fr = lane & 15, fq = lane >> 4;
    int sR[4], sC[4];
#pragma unroll
    for (int i = 0; i < 4; ++i) g2_stage_rc(wid * 1024 + i * 8192 + lane * 16, sR[i], sC[i]);
#define G2_STAGE(buf, kt) { _Pragma("unroll") for (int i = 0; i < 4; ++i) { \
        __builtin_amdgcn_global_load_lds((const unsigned*)(Ab + (size_t)sR[i] * lda + (kt) * 64 + sC[i]), (unsigned*)(shm + (buf) * 65536 + wid * 1024 + i * 8192), 16, 0, 0); \
        __builtin_amdgcn_global_load_lds((const unsigned*)(Bb + (size_t)sR[i] * ldb + (kt) * 64 + sC[i]), (unsigned*)(shm + (buf) * 65536 + 32768 + wid * 1024 + i * 8192), 16, 0, 0); } }
    const int nt = K / 64;
    __syncthreads();
    G2_STAGE(0, 0)
    asm volatile("s_waitcnt vmcnt(0)" ::: "memory");
    __syncthreads();
    for (int t = 0; t < nt; ++t) {
        const int cur = t & 1;
        if (t + 1 < nt) G2_STAGE(cur ^ 1, t + 1)
        const unsigned char* SA = shm + cur * 65536; const unsigned char* SB = SA + 32768;
#pragma unroll
        for (int ks = 0; ks < 2; ++ks) {
            bf16x8 At[8], Bf[4];
#pragma unroll
            for (int m = 0; m < 8; ++m) At[m] = *(const bf16x8*)(SA + g2_lds_byte(wr * 128 + m * 16 + fr, ks * 32 + fq * 8));
#pragma unroll
            for (int n = 0; n < 4; ++n) Bf[n] = *(const bf16x8*)(SB + g2_lds_byte(wc * 64 + n * 16 + fr, ks * 32 + fq * 8));
#pragma unroll
            for (int m = 0; m < 8; ++m)
#pragma unroll
                for (int n = 0; n < 4; ++n) acc[m][n] = __builtin_amdgcn_mfma_f32_16x16x32_bf16(At[m], Bf[n], acc[m][n], 0, 0, 0);
            __builtin_amdgcn_sched_barrier(0);
        }
        asm volatile("s_waitcnt vmcnt(0)" ::: "memory");
        __syncthreads();
    }
}
#define G2_FOREACH(body)                                                                                       \
    { const int _tid = fresh_tid(), _wid = _tid >> 6, _lane = _tid & 63, _wr = _wid >> 2, _wc = _wid & 3, _fr = _lane & 15, _fq = _lane >> 4; \
      _Pragma("unroll") for (int m = 0; m < 8; ++m) _Pragma("unroll") for (int n = 0; n < 4; ++n)             \
      _Pragma("unroll") for (int j = 0; j < 4; ++j) {                                                         \
          const int row = _wr * 128 + m * 16 + _fq * 4 + j; const int col = _wc * 64 + n * 16 + _fr; const float val = acc[m][n][j]; body } }
#define G8_HT (128 * 64)
__device__ __forceinline__ void g8_mainloop(const bf16_t* __restrict__ A, const bf16_t* __restrict__ Bt, int K, int brow, int bcol, f32x4 (&acc)[2][2][4][2], unsigned char* shmb) {
    bf16_t* shm = (bf16_t*)shmb;
    const int tid = fresh_tid();
    const int wid = tid >> 6, lane = tid & 63, wr = wid >> 2, wc = wid & 3, fr = lane & 15, fq = lane >> 4;
#define G8_SA(b, h) (shm + ((b) * 2 + (h)) * G8_HT)
#define G8_SB(b, h) (shm + (4 + (b) * 2 + (h)) * G8_HT)
#define G8_STAGE(Pp, BASE, br, kt) do { const long _g = (long)(br) * K + (long)(kt) * 64; \
    _Pragma("unroll") for (int _i = 0; _i < 2; ++_i) { const int _b = tid * 16 + _i * 8192; int _r, _c; g2_stage_rc(_b, _r, _c); \
      __builtin_amdgcn_global_load_lds((const unsigned*)(BASE + _g + (long)_r * K + _c), (unsigned*)((char*)(Pp) + _b), 16, 0, 0); } } while (0)
#define G8_LDA(dst, b, h) _Pragma("unroll") for (int m = 0; m < 4; ++m) _Pragma("unroll") for (int k = 0; k < 2; ++k) \
    dst[m][k] = *reinterpret_cast<const bf16x8*>((const char*)G8_SA(b, h) + g2_lds_byte(wr * 64 + m * 16 + fr, k * 32 + fq * 8))
#define G8_LDB(dst, b, h) _Pragma("unroll") for (int n = 0; n < 2; ++n) _Pragma("unroll") for (int k = 0; k < 2; ++k) \
    dst[n][k] = *reinterpret_cast<const bf16x8*>((const char*)G8_SB(b, h) + g2_lds_byte(wc * 32 + n * 16 + fr, k * 32 + fq * 8))
#define G8_MMA(ai, bj, At_, Bt_) do { __builtin_amdgcn_s_setprio(1); \
    _Pragma("unroll") for (int m = 0; m < 4; ++m) _Pragma("unroll") for (int n = 0; n < 2; ++n) _Pragma("unroll") for (int k = 0; k < 2; ++k) \
      acc[ai][bj][m][n] = __builtin_amdgcn_mfma_f32_16x16x32_bf16(At_[m][k], Bt_[n][k], acc[ai][bj][m][n], 0, 0, 0); \
    __builtin_amdgcn_s_setprio(0); } while (0)
#define G8_WAIT_V(n) asm volatile("s_waitcnt vmcnt(" #n ")" ::: "memory")
#define G8_WAIT_L(n) asm volatile("s_waitcnt lgkmcnt(" #n ")" ::: "memory")
#define G8_BAR __builtin_amdgcn_s_barrier()
#define G8_SCHED __builtin_amdgcn_sched_barrier(0)
    bf16x8 At[4][2], B0[2][2], B1[2][2];
    const int nt = K / 64;
    __syncthreads();
    G8_STAGE(G8_SB(0, 0), Bt, bcol, 0); G8_STAGE(G8_SA(0, 0), A, brow, 0);
    G8_STAGE(G8_SB(0, 1), Bt, bcol + 128, 0); G8_STAGE(G8_SA(0, 1), A, brow + 128, 0);
    if (wr == 1) G8_BAR;
    G8_WAIT_V(4); G8_BAR;
    G8_STAGE(G8_SB(1, 0), Bt, bcol, 1); G8_STAGE(G8_SA(1, 0), A, brow, 1); G8_STAGE(G8_SB(1, 1), Bt, bcol + 128, 1);
    G8_WAIT_V(6); G8_BAR;
    for (int t = 0; t < nt - 2; t += 2) {
        G8_LDB(B0, 0, 0); G8_SCHED; G8_LDA(At, 0, 0); G8_STAGE(G8_SA(1, 1), A, brow + 128, t + 1);
        G8_WAIT_L(8); G8_BAR; G8_WAIT_L(0); G8_MMA(0, 0, At, B0); G8_BAR; G8_SCHED;
        G8_LDB(B1, 0, 1); G8_STAGE(G8_SB(0, 0), Bt, bcol, t + 2);
        G8_BAR; G8_WAIT_L(0); G8_MMA(0, 1, At, B1); G8_BAR;
        G8_LDA(At, 0, 1); G8_STAGE(G8_SA(0, 0), A, brow, t + 2);
        G8_BAR; G8_WAIT_L(0); G8_MMA(1, 0, At, B0); G8_BAR; G8_SCHED;
        G8_STAGE(G8_SB(0, 1), Bt, bcol + 128, t + 2);
        G8_WAIT_V(6); G8_BAR; G8_MMA(1, 1, At, B1); G8_BAR;
        G8_LDB(B0, 1, 0); G8_SCHED; G8_LDA(At, 1, 0); G8_STAGE(G8_SA(0, 1), A, brow + 128, t + 2);
        G8_WAIT_L(8); G8_BAR; G8_WAIT_L(0); G8_MMA(0, 0, At, B0); G8_BAR; G8_SCHED;
        G8_LDB(B1, 1, 1); G8_STAGE(G8_SB(1, 0), Bt, bcol, t + 3);
        G8_BAR; G8_WAIT_L(0); G8_MMA(0, 1, At, B1); G8_BAR;
        G8_LDA(At, 1, 1); G8_STAGE(G8_SA(1, 0), A, brow, t + 3);
        G8_BAR; G8_WAIT_L(0); G8_MMA(1, 0, At, B0); G8_BAR; G8_SCHED;
        G8_STAGE(G8_SB(1, 1), Bt, bcol + 128, t + 3);
        G8_WAIT_V(6); G8_BAR; G8_MMA(1, 1, At, B1); G8_BAR;
    }
    { G8_LDB(B0, 0, 0); G8_LDA(At, 0, 0); G8_STAGE(G8_SA(1, 1), A, brow + 128, nt - 1);
      G8_BAR; G8_WAIT_L(0); G8_MMA(0, 0, At, B0); G8_BAR;
      G8_LDB(B1, 0, 1); G8_BAR; G8_WAIT_L(0); G8_MMA(0, 1, At, B1); G8_BAR;
      G8_LDA(At, 0, 1); G8_WAIT_V(4); G8_BAR; G8_WAIT_L(0); G8_MMA(1, 0, At, B0); G8_MMA(1, 1, At, B1); G8_BAR; }
    { G8_LDB(B0, 1, 0); G8_LDA(At, 1, 0); G8_WAIT_V(2); G8_BAR; G8_WAIT_L(0); G8_MMA(0, 0, At, B0); G8_BAR;
      G8_LDB(B1, 1, 1); G8_WAIT_V(0); G8_BAR; G8_WAIT_L(0); G8_MMA(0, 1, At, B1); G8_BAR;
      G8_LDA(At, 1, 1); G8_BAR; G8_WAIT_L(0); G8_MMA(1, 0, At, B0); G8_MMA(1, 1, At, B1); G8_BAR; }
    if (wr == 0) G8_BAR;
}
__device__ __forceinline__ void g8_zero(f32x4 (&acc)[2][2][4][2]) {
#pragma unroll
    for (int a = 0; a < 2; ++a)
#pragma unroll
        for (int b = 0; b < 2; ++b)
#pragma unroll
            for (int m = 0; m < 4; ++m)
#pragma unroll
                for (int n = 0; n < 2; ++n) acc[a][b][m][n] = (f32x4){0.f, 0.f, 0.f, 0.f};
}
#define G8_FOREACH(body)                                                                                       \
    { const int _tid = fresh_tid(), _wid = _tid >> 6, _lane = _tid & 63, _wr = _wid >> 2, _wc = _wid & 3, _fr = _lane & 15, _fq = _lane >> 4; \
      _Pragma("unroll") for (int ai = 0; ai < 2; ++ai) _Pragma("unroll") for (int bj = 0; bj < 2; ++bj)       \
      _Pragma("unroll") for (int m = 0; m < 4; ++m) _Pragma("unroll") for (int n = 0; n < 2; ++n)             \
      _Pragma("unroll") for (int j = 0; j < 4; ++j) {                                                         \
          const int row = ai * 128 + _wr * 64 + m * 16 + _fq * 4 + j; const int col = bj * 128 + _wc * 32 + n * 16 + _fr; const float val = acc[ai][bj][m][n][j]; body } }

__device__ __forceinline__ bool g2_tile(int bid, int nb, int it, int nM, int nN, int& pm, int& pn) {
    if (nb == 256 && nM == 32) { const int xcd = bid & 7, jj = bid >> 3; pm = 4 * xcd + (jj & 3); pn = 8 * it + (jj >> 2); return pn < nN; }
    const int t = bid + it * nb; pm = t % nM; pn = t / nM; return t < nM * nN;
}

__device__ __forceinline__ void phase_gemm1(const Params& P, int bid, int nb, unsigned char* smem) {
    const bf16_t* A = (const bf16_t*)(P.ws + WS_HN); const bf16_t* Bt = (const bf16_t*)(P.ws + WS_WTIN); bf16_t* C = (bf16_t*)(P.ws + WS_PROJ);
    int pm, pn;
    for (int it = 0; g2_tile(bid, nb, it, T / 256, NPROJ / 256, pm, pn); ++it) {
        f32x4 acc[2][2][4][2]; g8_zero(acc);
        g8_mainloop(A, Bt, D, pm * 256, pn * 256, acc, smem);
        G8_FOREACH({ C[(size_t)(pm * 256 + row) * NPROJ + pn * 256 + col] = f2bf(val); })
    }
}
__device__ __forceinline__ void phase_gemm2(const Params& P, int bid, int nb, unsigned char* smem) {
    const bf16_t* A = (const bf16_t*)(P.ws + WS_MIXED); const bf16_t* Bt = (const bf16_t*)(P.ws + WS_WTOUT); float* H = (float*)(P.ws + WS_H);
    bf16_t* HW = (bf16_t*)(P.ws + WS_HN); float* rss = (float*)(P.ws + WS_RSS);
    int pm, pn;
    for (int it = 0; g2_tile(bid, nb, it, T / 256, D / 256, pm, pn); ++it) {
        f32x4 acc[2][2][4][2]; g8_zero(acc);
        g8_mainloop(A, Bt, D, pm * 256, pn * 256, acc, smem);
        const int tid = fresh_tid(), wid = tid >> 6, lane = tid & 63, wr = wid >> 2, wc = wid & 3, fr = lane & 15, fq = lane >> 4;
#pragma unroll
        for (int ai = 0; ai < 2; ++ai)
#pragma unroll
            for (int m = 0; m < 4; ++m)
#pragma unroll
                for (int j = 0; j < 4; ++j) {
                    const int row = pm * 256 + ai * 128 + wr * 64 + m * 16 + fq * 4 + j;
                    float ss = 0.f;
#pragma unroll
                    for (int bj = 0; bj < 2; ++bj)
#pragma unroll
                        for (int n = 0; n < 2; ++n) {
                            const int col = pn * 256 + bj * 128 + wc * 32 + n * 16 + fr;
                            const size_t o = (size_t)row * D + col;
                            const float v = P.x[o] + acc[ai][bj][m][n][j];
                            H[o] = v; HW[o] = f2bf(v * P.norm_ffn[col]); ss += v * v;
                        }
                    ss += __shfl_xor(ss, 1); ss += __shfl_xor(ss, 2); ss += __shfl_xor(ss, 4); ss += __shfl_xor(ss, 8);
                    if (fr == 0) atomicAdd(rss + row, ss);
                }
    }
}
__device__ __forceinline__ void phase_gemm3(const Params& P, int bid, int nb, unsigned char* smem) {
    const bf16_t* A = (const bf16_t*)(P.ws + WS_HN); const bf16_t* Bt = (const bf16_t*)(P.ws + WS_WTPQ); bf16_t* C = (bf16_t*)(P.ws + WS_Q);
    int pm, pn;
    for (int it = 0; g2_tile(bid, nb, it, T / 256, D / 256, pm, pn); ++it) {
        f32x4 acc[2][2][4][2]; g8_zero(acc);
        g8_mainloop(A, Bt, D, pm * 256, pn * 256, acc, smem);
        const float* rss = (const float*)(P.ws + WS_RSS);
        G8_FOREACH({ const float rs = rsqrtf(rss[pm * 256 + row] * (1.f / 2048.f) + EPS); C[(size_t)(pm * 256 + row) * D + pn * 256 + col] = f2bf(val * rs); })
    }
}
__device__ __forceinline__ void phase_ple(const Params& P, int bid, int nb, unsigned char* smem) {
    const bf16_t* A = (const bf16_t*)(P.ws + WS_PBF); const bf16_t* Bt = (const bf16_t*)(P.ws + WS_WTPP); bf16_t* C = (bf16_t*)P.out;
    for (int t = bid; t < 256; t += nb) {
        const int pm = t & 31, pn = t >> 5;
        f32x4 acc[8][4]; g2_zero(acc);
        g2_mainloop(A + (size_t)pm * 256 * 256, 256, Bt + (size_t)pn * 256 * 256, 256, 256, acc, smem);
        G2_FOREACH({ C[(size_t)(pm * 256 + row) * D + pn * 256 + col] = f2bf(val); })
    }
}
__device__ __forceinline__ void phase_gemm4(const Params& P, int bid, int nb, unsigned char* smem) {
    const bf16_t* A = (const bf16_t*)(P.ws + WS_HN); const bf16_t* Bt = (const bf16_t*)(P.ws + WS_WTG);
    const bf16_t* ple = (const bf16_t*)P.out; float* H = (float*)(P.ws + WS_H);
    int pm, pn;
    for (int it = 0; g2_tile(bid, nb, it, T / 256, D / 256, pm, pn); ++it) {
        f32x4 acc[2][2][4][2]; g8_zero(acc);
        g8_mainloop(A, Bt, D, pm * 256, pn * 256, acc, smem);
        G8_FOREACH({ const size_t o = (size_t)(pm * 256 + row) * D + pn * 256 + col; H[o] = H[o] + sigmoid_f(val) * bf2f(ple[o]); })
    }
}

template <bool OUT_BF16>
__device__ __forceinline__ void phase_rownorm(const float* in, const float* w, void* out, int bid, int nb) {
    const int wave = VTID >> 6, lane = VTID & 63;
    for (int r = bid * 4 + wave; r < T; r += nb * 4) {
        if (OUT_BF16) rmsnorm_row<true>(in + (size_t)r * D, w, (bf16_t*)out + (size_t)r * D, lane);
        else rmsnorm_row<false>(in + (size_t)r * D, w, (float*)out + (size_t)r * D, lane);
    }
}

__device__ __forceinline__ bf16x8 frag_ld(const unsigned char* tile, int row, int ks, int lane) { return *(const bf16x8*)(tile + lds_off(row, ks * 2 + (lane >> 5))); }
__device__ __forceinline__ void lds_st_bf16(unsigned char* tile, int row, int k, float v) { *(bf16_t*)(tile + lds_off(row, k >> 3) + (k & 7) * 2) = f2bf(v); }

__device__ __forceinline__ void d1_chunk(const Params& P, int u, unsigned char* smem) {
    const bf16_t* proj = (const bf16_t*)(P.ws + WS_PROJ);
    int tid_ = VTID; asm volatile("" : "+v"(tid_));
    const int tid = tid_, wave = tid >> 6, lane = tid & 63;
    const int b = u >> 9, h = (u >> 6) & 7, c = u & 63;
    const size_t tok0 = (size_t)b * SEQ + c * 64;
    unsigned char* Ks = smem;
    unsigned char* Qs = smem + 16384;
    unsigned char* Vraw = smem + 16384;
    float* At = (float*)(smem + 34816);
    float* Gs = (float*)(smem + 51200);
    float* Bs = Gs + 64;
    __syncthreads();
    if (wave == 0) {
        const size_t t = tok0 + lane;
        const float a = bf2f(proj[t * NPROJ + C_A + h]), bb = bf2f(proj[t * NPROJ + C_B + h]);
        const float xs = a + P.dt_bias[h];
        const float sp = xs > 20.f ? xs : log1pf(expf(xs));
        float g = -expf(P.a_log[h]) * sp;
#pragma unroll
        for (int o = 1; o < 64; o <<= 1) { const float n = __shfl_up(g, o); if (lane >= o) g += n; }
        Gs[lane] = g; Bs[lane] = 1.f / (1.f + expf(-bb));
    }
    bf16_t* QG = (bf16_t*)(P.ws + WS_QG) + (size_t)u * 64 * 128;
    unsigned char* RAW = smem + 32768;
#pragma unroll 1
    for (int isk = 0; isk < 2; ++isk) {
        const int chb = (isk ? 1024 : 0) + h * 128;
        for (int q = tid; q < 67 * 16; q += 256) {
            const int row = q >> 4, c16 = q & 15;
            uint4 v = make_uint4(0u, 0u, 0u, 0u);
            if (c > 0 || row >= 3) v = *(const uint4*)(proj + (tok0 + row - 3) * NPROJ + chb + c16 * 8);
            *(uint4*)(RAW + row * 256 + c16 * 16) = v;
        }
        const int ch0 = chb + lane * 2;
        const f32x4 cw0 = *(const f32x4*)(P.conv_w + ch0 * 4), cw1 = *(const f32x4*)(P.conv_w + ch0 * 4 + 4);
        __syncthreads();
        for (int tok = wave; tok < 64; tok += 4) {
            float y0 = 0.f, y1 = 0.f;
#pragma unroll
            for (int j = 0; j < 4; ++j) {
                const unsigned pr = *(const unsigned*)(RAW + (tok + j) * 256 + lane * 4);
                y0 += bf2f((bf16_t)(pr & 0xffff)) * cw0[j];
                y1 += bf2f((bf16_t)(pr >> 16)) * cw1[j];
            }
            y0 = silu_f(y0); y1 = silu_f(y1);
            float r = rsqrtf(wave_sum(y0 * y0 + y1 * y1) + EPS);
            if (!isk) r *= 0.08838834764831845f;
            y0 *= r; y1 *= r;
            const int k = lane * 2, half = k >> 6, kk = k & 63;
            *(unsigned*)((isk ? Ks : Qs) + half * 8192 + lds_off(tok, kk >> 3) + (kk & 7) * 2) = pack2(y0, y1);
            if (!isk) { const float eg = expf(Gs[tok]); *(unsigned*)(QG + tok * 128 + k) = pack2(y0 * eg, y1 * eg); }
        }
        __syncthreads();
    }
    {
        const int wr = wave >> 1, wc = wave & 1;
        f32x16 akk, aqk;
#pragma unroll
        for (int r = 0; r < 16; ++r) { akk[r] = 0.f; aqk[r] = 0.f; }
        if (!(wr == 0 && wc == 1)) {
#pragma unroll
            for (int half = 0; half < 2; ++half)
#pragma unroll
                for (int ks = 0; ks < 4; ++ks) {
                    const bf16x8 fk = frag_ld(Ks + half * 8192, wr * 32 + (lane & 31), ks, lane);
                    const bf16x8 fq = frag_ld(Qs + half * 8192, wr * 32 + (lane & 31), ks, lane);
                    const bf16x8 fb = frag_ld(Ks + half * 8192, wc * 32 + (lane & 31), ks, lane);
                    akk = __builtin_amdgcn_mfma_f32_32x32x16_bf16(fk, fb, akk, 0, 0, 0);
                    aqk = __builtin_amdgcn_mfma_f32_32x32x16_bf16(fq, fb, aqk, 0, 0, 0);
                }
        }
        const int j = wc * 32 + (lane & 31); const float Gj = Gs[j];
        bf16_t* ATT = (bf16_t*)(P.ws + WS_ATT) + (size_t)u * 64 * 64;
#pragma unroll
        for (int g4 = 0; g4 < 4; ++g4) {
            const int i0 = wr * 32 + 8 * g4 + 4 * (lane >> 5);
            f32x4 av;
#pragma unroll
            for (int e = 0; e < 4; ++e) {
                const int i = i0 + e, r = g4 * 4 + e;
                const float dec = (i >= j) ? expf(Gs[i] - Gj) : 0.f;
                av[e] = (i > j) ? Bs[i] * akk[r] * dec : 0.f;
                ATT[i * 64 + j] = f2bf(aqk[r] * dec);
            }
            *(f32x4*)(At + j * 64 + i0) = av;
        }
    }
    __syncthreads();
    {
        for (int q = tid; q < 67 * 16; q += 256) {
            const int row = q >> 4, c16 = q & 15;
            uint4 v = make_uint4(0u, 0u, 0u, 0u);
            if (c > 0 || row >= 3) v = *(const uint4*)(proj + (tok0 + row - 3) * NPROJ + 2048 + h * 128 + c16 * 8);
            *(uint4*)(Vraw + row * 256 + c16 * 16) = v;
        }
    }
    __syncthreads();
    {
        float r[64];
        if (tid < 128) {
            const int ch = 2048 + h * 128 + tid;
            const float w0 = P.conv_w[ch * 4 + 0], w1 = P.conv_w[ch * 4 + 1], w2 = P.conv_w[ch * 4 + 2], w3 = P.conv_w[ch * 4 + 3];
            const bf16_t* vcol = (const bf16_t*)Vraw + tid;
            float xm3 = bf2f(vcol[0]), xm2 = bf2f(vcol[128]), xm1 = bf2f(vcol[256]);
#pragma unroll
            for (int i = 0; i < 64; ++i) {
                const float x0 = bf2f(vcol[(i + 3) * 128]);
                const float y = w0 * xm3 + w1 * xm2 + w2 * xm1 + w3 * x0;
                r[i] = Bs[i] * silu_f(y);
                xm3 = xm2; xm2 = xm1; xm1 = x0;
            }
        } else {
            const int dk = tid - 128, half = dk >> 6, kk = dk & 63;
            const float G63 = Gs[63];
            bf16_t* KDT = (bf16_t*)(P.ws + WS_KDT) + (size_t)u * 128 * 64 + dk * 64;
#pragma unroll
            for (int i8 = 0; i8 < 8; ++i8) {
                unsigned pk[4];
#pragma unroll
                for (int e2 = 0; e2 < 4; ++e2) {
                    float kd[2];
#pragma unroll
                    for (int e = 0; e < 2; ++e) {
                        const int i = i8 * 8 + e2 * 2 + e;
                        const float kv = bf2f(*(const bf16_t*)(Ks + half * 8192 + lds_off(i, kk >> 3) + (kk & 7) * 2));
                        const float Gi = Gs[i];
                        r[i] = -Bs[i] * expf(Gi) * kv;
                        kd[e] = kv * expf(G63 - Gi);
                    }
                    pk[e2] = pack2(kd[0], kd[1]);
                }
                *(uint4*)(KDT + i8 * 8) = make_uint4(pk[0], pk[1], pk[2], pk[3]);
            }
        }
#pragma unroll
        for (int j = 0; j < 63; ++j) {
            const float xj = r[j];
#pragma unroll
            for (int i4 = ((j + 1) & ~3); i4 < 64; i4 += 4) {
                const f32x4 a = *(const f32x4*)(At + j * 64 + i4);
                r[i4] -= a[0] * xj; r[i4 + 1] -= a[1] * xj; r[i4 + 2] -= a[2] * xj; r[i4 + 3] -= a[3] * xj;
            }
        }
        if (tid < 128) {
            float* U = (float*)(P.ws + WS_U) + (size_t)u * 64 * 128 + (tid >> 5) * 2048 + (tid & 31);
#pragma unroll
            for (int i = 0; i < 64; ++i) { const int tt = i >> 5, i5 = i & 31, rr = (i5 & 3) + 4 * (i5 >> 3), hh = (i5 >> 2) & 1; U[(tt * 16 + rr) * 64 + hh * 32] = r[i]; }
        } else {
            bf16_t* W = (bf16_t*)(P.ws + WS_W) + (size_t)u * 64 * 128 + (tid - 128);
#pragma unroll
            for (int i = 0; i < 64; ++i) W[i * 128] = f2bf(r[i]);
        }
        if (tid == 0) ((float*)(P.ws + WS_EG))[u] = expf(Gs[63]);
    }
}

__device__ __forceinline__ void r1_chunk(const Params& P, int u, unsigned char* smem) {
    const bf16_t* proj = (const bf16_t*)(P.ws + WS_PROJ);
    int tid_ = VTID; asm volatile("" : "+v"(tid_));
    const int tid = tid_, wave = tid >> 6, lane = tid & 63;
    const int b = u >> 9, h = (u >> 6) & 7, c = u & 63;
    const size_t tok0 = (size_t)b * SEQ + c * 64;
    unsigned char* RQ = smem;
    unsigned char* RK = smem + 8192;
    unsigned char* VT = smem + 16384;
    unsigned char* RKT = smem + 32768;
    const float l2g = log2f(1.f - exp2f(-5.f - (float)h));
    unsigned char* VR = smem + 40960;
    __syncthreads();
    bf16_t* QGR = (bf16_t*)(P.ws + WS_QGR) + (size_t)u * 64 * 64;
    {
        uint4 rq[2], rk[2], rv[4];
#pragma unroll
        for (int i = 0; i < 2; ++i) { const int q = tid + 256 * i, row = q >> 3, ch = q & 7;
            rq[i] = *(const uint4*)(proj + (tok0 + row) * NPROJ + C_RQ + h * 64 + ch * 8); rk[i] = *(const uint4*)(proj + (tok0 + row) * NPROJ + C_RK + h * 64 + ch * 8); }
#pragma unroll
        for (int i = 0; i < 4; ++i) { const int q = tid + 256 * i, row = q >> 4, c16 = q & 15; rv[i] = *(const uint4*)(proj + (tok0 + row) * NPROJ + C_RV + h * 128 + c16 * 8); }
#pragma unroll
        for (int i = 0; i < 2; ++i) { const int q = tid + 256 * i, row = q >> 3, ch = q & 7; *(uint4*)(RQ + lds_off(row, ch)) = rq[i]; *(uint4*)(RK + lds_off(row, ch)) = rk[i]; }
#pragma unroll
        for (int i = 0; i < 4; ++i) { const int q = tid + 256 * i, row = q >> 4, c16 = q & 15; *(uint4*)(VR + row * 256 + c16 * 16) = rv[i]; }
    }
    __syncthreads();
#pragma unroll 1
    for (int it = 0; it < 8; ++it) {
        const int e = tid + 256 * it, tok = e >> 5, i = e & 31;
        const size_t t = tok0 + tok;
        const float inv = powf(10000.f, -(float)i / 32.f);
        const float ang = (float)P.positions[t] * inv;
        float sn, cs; sincosf(ang, &sn, &cs);
        bf16_t* q1p = (bf16_t*)(RQ + lds_off(tok, i >> 3) + (i & 7) * 2); bf16_t* q2p = (bf16_t*)(RQ + lds_off(tok, (32 + i) >> 3) + (i & 7) * 2);
        bf16_t* k1p = (bf16_t*)(RK + lds_off(tok, i >> 3) + (i & 7) * 2); bf16_t* k2p = (bf16_t*)(RK + lds_off(tok, (32 + i) >> 3) + (i & 7) * 2);
        const float q1 = bf2f(*q1p), q2 = bf2f(*q2p), k1 = bf2f(*k1p) * 0.125f, k2 = bf2f(*k2p) * 0.125f;
        const float qa = q1 * cs - q2 * sn, qb = q1 * sn + q2 * cs, ka = k1 * cs - k2 * sn, kb = k1 * sn + k2 * cs;
        const float xi = exp2f(l2g * (float)(tok + 1)), zeta = exp2f(l2g * (float)(63 - tok));
        *q1p = f2bf(qa); *q2p = f2bf(qb); *k1p = f2bf(ka); *k2p = f2bf(kb);
        lds_st_bf16(RKT, i, tok, ka * zeta); lds_st_bf16(RKT, 32 + i, tok, kb * zeta);
        QGR[tok * 64 + i] = f2bf(qa * xi); QGR[tok * 64 + 32 + i] = f2bf(qb * xi);
    }
#pragma unroll 4
    for (int it = 0; it < 16; ++it) {
        const int e = tid + 256 * it, tok = e >> 6, dp = e & 63;
        const unsigned pr = *(const unsigned*)(VR + tok * 256 + dp * 4);
        *(bf16_t*)(VT + lds_off(dp * 2, tok >> 3) + (tok & 7) * 2) = (bf16_t)(pr & 0xffff);
        *(bf16_t*)(VT + lds_off(dp * 2 + 1, tok >> 3) + (tok & 7) * 2) = (bf16_t)(pr >> 16);
    }
    __syncthreads();
    {
        bf16_t* VNTR = (bf16_t*)(P.ws + WS_VNTR) + (size_t)u * 128 * 64;
#pragma unroll
        for (int it = 0; it < 4; ++it) { const int q = tid + 256 * it, row = q >> 3, ch = q & 7; *(uint4*)(VNTR + row * 64 + ch * 8) = *(const uint4*)(VT + lds_off(row, ch)); }
    }
    {
        const int wr = wave >> 1, wc = wave & 1;
        f32x16 acc;
#pragma unroll
        for (int r = 0; r < 16; ++r) acc[r] = 0.f;
        if (!(wr == 0 && wc == 1)) {
#pragma unroll
            for (int ks = 0; ks < 4; ++ks) acc = __builtin_amdgcn_mfma_f32_32x32x16_bf16(frag_ld(RQ, wr * 32 + (lane & 31), ks, lane), frag_ld(RK, wc * 32 + (lane & 31), ks, lane), acc, 0, 0, 0);
        }
        const int j = wc * 32 + (lane & 31);
        bf16_t* ATTR = (bf16_t*)(P.ws + WS_ATTR) + (size_t)u * 64 * 64;
#pragma unroll
        for (int r = 0; r < 16; ++r) {
            const int i = wr * 32 + (r & 3) + 8 * (r >> 2) + 4 * (lane >> 5);
            const float dec = (i >= j) ? exp2f(l2g * (float)(i - j)) : 0.f;
            ATTR[i * 64 + j] = f2bf(acc[r] * dec);
        }
    }
    {
        f32x16 acc[2];
#pragma unroll
        for (int j = 0; j < 2; ++j)
#pragma unroll
            for (int r = 0; r < 16; ++r) acc[j][r] = 0.f;
#pragma unroll
        for (int ks = 0; ks < 4; ++ks) {
            const bf16x8 fa = frag_ld(VT, wave * 32 + (lane & 31), ks, lane);
#pragma unroll
            for (int j = 0; j < 2; ++j) acc[j] = __builtin_amdgcn_mfma_f32_32x32x16_bf16(fa, frag_ld(RKT, j * 32 + (lane & 31), ks, lane), acc[j], 0, 0, 0);
        }
        float* KVT = (float*)(P.ws + WS_KVT) + (size_t)u * 128 * 64;
#pragma unroll
        for (int j = 0; j < 2; ++j)
#pragma unroll
            for (int r = 0; r < 16; ++r) { const int dv = wave * 32 + (r & 3) + 8 * (r >> 2) + 4 * (lane >> 5); KVT[dv * 64 + j * 32 + (lane & 31)] = acc[j][r]; }
    }
}

__device__ __forceinline__ void phase_chunk1(const Params& P, int bid, int nb, unsigned char* smem) {
    for (int u = bid; u < 2048; u += nb) { if (u < 1024) d1_chunk(P, u, smem); else r1_chunk(P, u - 1024, smem); }
}

__device__ __forceinline__ void d2_scan(const Params& P, int bh, unsigned char* smem) {
    const int tid = VTID, wave = tid >> 6, lane = tid & 63;
    unsigned char* Wt = smem;
    unsigned char* KDt = smem + 16384;
    unsigned char* img = smem + 32768 + wave * 8192;
    const int dv0 = wave * 32;
    const size_t cb = (size_t)bh * 64;
    const bf16_t* Wg = (const bf16_t*)(P.ws + WS_W); const bf16_t* KDg = (const bf16_t*)(P.ws + WS_KDT);
    const float* Ug = (const float*)(P.ws + WS_U); const float* EGg = (const float*)(P.ws + WS_EG);
    bf16_t* SCg = (bf16_t*)(P.ws + WS_SC); bf16_t* VNg = (bf16_t*)(P.ws + WS_VNT);
    f32x16 S[4];
#pragma unroll
    for (int d = 0; d < 4; ++d)
#pragma unroll
        for (int r = 0; r < 16; ++r) S[d][r] = 0.f;
    uint4 pw0, pw1, pw2, pw3, pk0, pk1, pk2, pk3;
    __syncthreads();
#define D2_LOAD(uu) { const bf16_t* wp = Wg + (uu) * 8192 + tid * 8; const bf16_t* kp = KDg + (uu) * 8192 + tid * 8; \
        pw0 = *(const uint4*)(wp); pw1 = *(const uint4*)(wp + 2048); pw2 = *(const uint4*)(wp + 4096); pw3 = *(const uint4*)(wp + 6144); \
        pk0 = *(const uint4*)(kp); pk1 = *(const uint4*)(kp + 2048); pk2 = *(const uint4*)(kp + 4096); pk3 = *(const uint4*)(kp + 6144); }
#define D2_ST1(i, vw, vk) { const int q = tid + 256 * (i); { const int row = q >> 4, c16 = q & 15; *(uint4*)(Wt + (c16 >> 3) * 8192 + lds_off(row, c16 & 7)) = (vw); } \
        { const int row = q >> 3, ch = q & 7; *(uint4*)(KDt + lds_off(row, ch)) = (vk); } }
#define D2_STORE() { D2_ST1(0, pw0, pk0) D2_ST1(1, pw1, pk1) D2_ST1(2, pw2, pk2) D2_ST1(3, pw3, pk3) }
    D2_LOAD(cb)
    D2_STORE()
#pragma unroll
    for (int i = 0; i < 8; ++i) { *(uint4*)(img + (lane + 64 * i) * 16) = make_uint4(0u, 0u, 0u, 0u);
        *(uint4*)(SCg + cb * 16384 + wave * 4096 + (lane + 64 * i) * 8) = make_uint4(0u, 0u, 0u, 0u); }
    __syncthreads();
    const int egl = __float_as_int(EGg[cb + lane]);
    f32x16 un0, un1;
#define D2_LOADU(uu) { const float* up = Ug + (uu) * 8192 + wave * 2048 + lane; \
        _Pragma("unroll") for (int r = 0; r < 16; ++r) { un0[r] = up[r * 64]; un1[r] = up[(16 + r) * 64]; } }
    D2_LOADU(cb)
    for (int c = 0; c < 64; ++c) {
        const size_t u = cb + c;
        f32x16 vn0 = un0, vn1 = un1;
        if (c + 1 < 64) {
            D2_LOAD(u + 1)
            D2_LOADU(u + 1)
        }
        const float eg = __int_as_float(__builtin_amdgcn_readlane(egl, c));
#pragma unroll
        for (int half = 0; half < 2; ++half)
#pragma unroll
            for (int ks = 0; ks < 4; ++ks) {
                const bf16x8 fb = frag_ld(img + half * 4096, lane & 31, ks, lane);
                vn0 = __builtin_amdgcn_mfma_f32_32x32x16_bf16(frag_ld(Wt + half * 8192, (lane & 31), ks, lane), fb, vn0, 0, 0, 0);
                vn1 = __builtin_amdgcn_mfma_f32_32x32x16_bf16(frag_ld(Wt + half * 8192, 32 + (lane & 31), ks, lane), fb, vn1, 0, 0, 0);
            }
#define D2_VN(tt, vv) _Pragma("unroll") for (int g4 = 0; g4 < 4; ++g4) { const int r0 = g4 * 4; \
            const uint2 pkd = make_uint2(pack2(vv[r0], vv[r0 + 1]), pack2(vv[r0 + 2], vv[r0 + 3])); \
            const int tok = (tt) * 32 + 8 * g4 + 4 * (lane >> 5); \
            *(uint2*)(img + lds_off(lane & 31, tok >> 3) + (tok & 7) * 2) = pkd; \
            *(uint2*)(VNg + u * 8192 + ((((wave * 2 + (tt)) * 4 + g4) * 64 + lane) * 4)) = pkd; }
        D2_VN(0, vn0) D2_VN(1, vn1)
#pragma unroll
        for (int d = 0; d < 4; ++d)
#pragma unroll
            for (int r = 0; r < 16; ++r) S[d][r] *= eg;
#pragma unroll
        for (int ks = 0; ks < 4; ++ks) {
            const bf16x8 fb = frag_ld(img, lane & 31, ks, lane);
#pragma unroll
            for (int d = 0; d < 4; ++d) S[d] = __builtin_amdgcn_mfma_f32_32x32x16_bf16(frag_ld(KDt, d * 32 + (lane & 31), ks, lane), fb, S[d], 0, 0, 0);
        }
#pragma unroll
        for (int d = 0; d < 4; ++d)
#pragma unroll
            for (int g4 = 0; g4 < 4; ++g4) {
                const int r0 = g4 * 4;
                const uint2 pkd = make_uint2(pack2(S[d][r0], S[d][r0 + 1]), pack2(S[d][r0 + 2], S[d][r0 + 3]));
                const int kk = (d & 1) * 32 + 8 * g4 + 4 * (lane >> 5);
                *(uint2*)(img + (d >> 1) * 4096 + lds_off(lane & 31, kk >> 3) + (kk & 7) * 2) = pkd;
                if (c + 1 < 64) *(uint2*)(SCg + (u + 1) * 16384 + ((((wave * 4 + d) * 4 + g4) * 64 + lane) * 4)) = pkd;
            }
        __syncthreads();
        if (c + 1 < 64) D2_STORE()
        __syncthreads();
    }
}

__device__ __forceinline__ void r2_scan(const Params& P, int vb, int nvb) {
    const float* KVT = (const float*)(P.ws + WS_KVT); bf16_t* STR = (bf16_t*)(P.ws + WS_STR);
    int tid_ = VTID; asm volatile("" : "+v"(tid_));
    for (int idx = vb * 256 + tid_; idx < 16 * 8192; idx += nvb * 256) {
        const int bh = idx >> 13, e = idx & 8191, h = bh & 7;
        const float cd = exp2f(64.f * log2f(1.f - exp2f(-5.f - (float)h)));
        float S = 0.f;
#pragma unroll 8
        for (int c = 0; c < 64; ++c) {
            const size_t o = ((size_t)bh * 64 + c) * 8192 + e;
            STR[o] = f2bf(S);
            S = cd * S + KVT[o];
        }
    }
}

__device__ __forceinline__ void d2_idle() {
    __syncthreads(); __syncthreads();
    for (int c = 0; c < 64; ++c) { __syncthreads(); __syncthreads(); }
}
__device__ __forceinline__ void phase_econv(const Params& P, int bid, int nb);
__device__ __forceinline__ void phase_scan(const Params& P, int bid, int nb, unsigned char* smem, int rbid, int rnb, unsigned char* rsmem) {
    if (rbid < 16) { if ((bid & 1) == 0) d2_scan(P, rbid, smem); else d2_idle(); }
    else {
        phase_ple(P, rbid - 16, rnb - 16, rsmem);
        r2_scan(P, bid - 32, nb - 32);
        phase_econv(P, bid - 32, nb - 32);
    }
}

template <int K1, bool RET>
__device__ __forceinline__ void chunk_out(const Params& P, int u, unsigned char* smem) {
    int tid_ = VTID; asm volatile("" : "+v"(tid_));
    const int tid = tid_, wave = tid >> 6, lane = tid & 63, wr = wave >> 1, wc = wave & 1;
    const int b = u >> 9, h = (u >> 6) & 7, c = u & 63;
    const size_t tok0 = (size_t)b * SEQ + c * 64;
    const bf16_t* A1 = RET ? (const bf16_t*)(P.ws + WS_QGR) + (size_t)u * 64 * 64 : (const bf16_t*)(P.ws + WS_QG) + (size_t)u * 64 * 128;
    const bf16_t* B1 = RET ? (const bf16_t*)(P.ws + WS_STR) + (size_t)u * 128 * 64 : (const bf16_t*)(P.ws + WS_SC) + (size_t)u * 128 * 128;
    const bf16_t* A2 = RET ? (const bf16_t*)(P.ws + WS_ATTR) + (size_t)u * 64 * 64 : (const bf16_t*)(P.ws + WS_ATT) + (size_t)u * 64 * 64;
    const bf16_t* B2 = RET ? (const bf16_t*)(P.ws + WS_VNTR) + (size_t)u * 128 * 64 : (const bf16_t*)(P.ws + WS_VNT) + (size_t)u * 128 * 64;
    unsigned char* As = smem;
    unsigned char* Bs = smem + 8192;
    float* red = (float*)(smem + 24576);
    f32x16 acc[2];
#pragma unroll
    for (int j = 0; j < 2; ++j)
#pragma unroll
        for (int r = 0; r < 16; ++r) acc[j][r] = 0.f;
    constexpr int NK1 = K1 / 64;
#pragma unroll
    for (int kt = 0; kt <= NK1; ++kt) {
        const bf16_t* Ap = (kt < NK1) ? A1 + kt * 64 : A2; const int lda = (kt < NK1) ? K1 : 64;
        const bf16_t* Bp = (kt < NK1) ? B1 + kt * 64 : B2; const int ldb = lda;
        __syncthreads();
#pragma unroll
        for (int i = 0; i < 2; ++i) { const int q = tid + 256 * i, row = q >> 3, ch = q & 7; *(uint4*)(As + lds_off(row, ch)) = *(const uint4*)(Ap + row * lda + ch * 8); }
        if (RET) {
#pragma unroll
            for (int i = 0; i < 4; ++i) { const int q = tid + 256 * i, row = q >> 3, ch = q & 7; *(uint4*)(Bs + lds_off(row, ch)) = *(const uint4*)(Bp + row * ldb + ch * 8); }
        } else {
#pragma unroll
            for (int i = 0; i < 8; ++i) {
                const int q = tid + 256 * i, ln = q & 63, g4 = (q >> 6) & 3, dd = (q >> 8) & 1, w = q >> 9;
                const size_t piece = (kt < NK1) ? (size_t)(((w * 4 + 2 * kt + dd) * 4 + g4) * 64 + ln) : (size_t)(((w * 2 + dd) * 4 + g4) * 64 + ln);
                const bf16_t* src = (kt < NK1) ? B1 : B2;
                const int kk = dd * 32 + 8 * g4 + 4 * (ln >> 5);
                *(uint2*)(Bs + lds_off(w * 32 + (ln & 31), kk >> 3) + (kk & 7) * 2) = *(const uint2*)(src + piece * 4);
            }
        }
        __syncthreads();
#pragma unroll
        for (int ks = 0; ks < 4; ++ks) {
            const bf16x8 fa = frag_ld(As, wr * 32 + (lane & 31), ks, lane);
#pragma unroll
            for (int j = 0; j < 2; ++j) acc[j] = __builtin_amdgcn_mfma_f32_32x32x16_bf16(fa, frag_ld(Bs, wc * 64 + j * 32 + (lane & 31), ks, lane), acc[j], 0, 0, 0);
        }
    }
#pragma unroll
    for (int r = 0; r < 16; ++r) {
        float s1 = acc[0][r] + acc[1][r], s2 = acc[0][r] * acc[0][r] + acc[1][r] * acc[1][r];
#pragma unroll
        for (int o = 16; o >= 1; o >>= 1) { s1 += __shfl_xor(s1, o); s2 += __shfl_xor(s2, o); }
        if ((lane & 31) == 0) { const int row = wr * 32 + (r & 3) + 8 * (r >> 2) + 4 * (lane >> 5); red[(row * 2 + wc) * 2] = s1; red[(row * 2 + wc) * 2 + 1] = s2; }
    }
    __syncthreads();
    const bf16_t* proj = (const bf16_t*)(P.ws + WS_PROJ); bf16_t* mixed = (bf16_t*)(P.ws + WS_MIXED);
#pragma unroll
    for (int r = 0; r < 16; ++r) {
        const int row = wr * 32 + (r & 3) + 8 * (r >> 2) + 4 * (lane >> 5);
        const float s1 = red[row * 4] + red[row * 4 + 2], s2 = red[row * 4 + 1] + red[row * 4 + 3];
        const size_t t = tok0 + row;
#pragma unroll
        for (int j = 0; j < 2; ++j) {
            const int dv = wc * 64 + j * 32 + (lane & 31);
            float y;
            if (!RET) {
                const float rs = rsqrtf(s2 * (1.f / 128.f) + EPS);
                y = acc[j][r] * rs * P.dn_norm[dv] * silu_f(bf2f(proj[t * NPROJ + C_Z + h * 128 + dv]));
                mixed[t * D + h * 128 + dv] = f2bf(y);
            } else {
                const float mu = s1 * (1.f / 128.f);
                const float var = fmaxf(s2 * (1.f / 128.f) - mu * mu, 0.f);
                const float rs = rsqrtf(var + EPS);
                y = ((acc[j][r] - mu) * rs * P.ret_gn_w[h * 128 + dv] + P.ret_gn_b[h * 128 + dv]) * silu_f(bf2f(proj[t * NPROJ + C_RG + h * 128 + dv]));
                mixed[t * D + 1024 + h * 128 + dv] = f2bf(y);
            }
        }
    }
}

__device__ __forceinline__ void phase_chunk3(const Params& P, int bid, int nb, unsigned char* smem) {
    for (int u = bid; u < 2048; u += nb) { if (u < 1024) chunk_out<128, false>(P, u, smem); else chunk_out<64, true>(P, u - 1024, smem); }
}

__device__ __forceinline__ void ins16(float (&l)[16], float x) {
#pragma unroll
    for (int i = 0; i < 16; ++i) { const float hi = fmaxf(l[i], x); x = fminf(l[i], x); l[i] = hi; }
}
__device__ __forceinline__ void phase_route(const Params& P, int bid, int nb, unsigned char* smem) {
    const float* scores = (const float*)(P.ws + WS_SCORES); int* idx = (int*)(P.ws + WS_IDX); float* gates = (float*)(P.ws + WS_GATES);
    int tid_ = VTID; asm volatile("" : "+v"(tid_));
    const int tid = tid_;
    float* tile = (float*)smem;
    unsigned* L = (unsigned*)(smem + 256 * 33 * 4);
    const float NEG = -3.0e38f;
    for (int u = bid; u < 512; u += nb) {
        const size_t R0 = (size_t)u * 256;
        float l[16];
#pragma unroll
        for (int i = 0; i < 16; ++i) l[i] = NEG;
        for (int ch = 0; ch < 4; ++ch) {
            __syncthreads();
#pragma unroll
            for (int i = 0; i < 8; ++i) {
                const int q = tid + 256 * i, row = q >> 3, c4 = q & 7;
                const f32x4 v = *(const f32x4*)(scores + (R0 + row) * 128 + ch * 32 + c4 * 4);
                float* d = tile + row * 33 + c4 * 4; d[0] = v[0]; d[1] = v[1]; d[2] = v[2]; d[3] = v[3];
            }
            __syncthreads();
#pragma unroll
            for (int j = 0; j < 32; ++j) {
                const float x = __uint_as_float((__float_as_uint(tile[tid * 33 + j]) & ~0x7Fu) | (unsigned)(ch * 32 + j));
                ins16(l, x);
            }
        }
#pragma unroll
        for (int i = 0; i < 16; ++i) L[tid * 16 + i] = __float_as_uint(l[i]);
        __syncthreads();
        const int pe = tid & ~1, po = tid | 1;
        float s1[16], s2[16];
#pragma unroll
        for (int i = 0; i < 16; ++i) { s1[i] = __uint_as_float(L[pe * 16 + i]); s2[i] = __uint_as_float(L[po * 16 + i]); }
        float m[16];
#pragma unroll
        for (int i = 0; i < 16; ++i) m[i] = NEG;
#pragma unroll
        for (int i = 0; i < 16; ++i)
#pragma unroll
            for (int j = 0; j < 16; ++j)
                if ((i + 1) * (j + 1) <= 16) ins16(m, __uint_as_float((__float_as_uint(s1[i] + s2[j]) & ~0xFFu) | (unsigned)(i * 16 + j)));
        float e[16], sum = 0.f;
#pragma unroll
        for (int r = 0; r < 16; ++r) { e[r] = __expf(m[r] - m[0]); sum += e[r]; }
        const float inv = 1.f / sum;
        const int par = tid & 1;
        const size_t ob = ((R0 + tid) >> 1) * 16 + par * 8;
#pragma unroll
        for (int r = 0; r < 8; ++r) {
            float k_lo = m[r], k_hi = m[r + 8], e_lo = e[r], e_hi = e[r + 8];
            asm volatile("" : "+v"(k_lo), "+v"(k_hi), "+v"(e_lo), "+v"(e_hi));
            const float key = par ? k_hi : k_lo;
            const float ev = par ? e_hi : e_lo;
            const unsigned cand = __float_as_uint(key) & 0xFFu;
            const unsigned i1 = L[pe * 16 + (cand >> 4)] & 0x7Fu, i2 = L[po * 16 + (cand & 15)] & 0x7Fu;
            idx[ob + r] = (int)(i1 * 128 + i2);
            gates[ob + r] = ev * inv;
        }
    }
}

typedef float f32x2 __attribute__((ext_vector_type(2)));
__device__ __forceinline__ void phase_econv(const Params& P, int bid, int nb) {
    int tid_ = VTID; asm volatile("" : "+v"(tid_));
    const int wave = tid_ >> 6, lane = tid_ & 63;
    float* scales = (float*)(P.ws + WS_ESC);
    for (int r = bid * 4 + wave; r < 32768; r += nb * 4) {
        const float* src = (r < 16384 ? P.expert_u : P.expert_v) + (size_t)(r & 16383) * D;
        int* dst = (int*)(P.ws + WS_EU8 + (size_t)r * 2048);
        f32x4 v[8]; float am = 0.f;
#pragma unroll
        for (int i = 0; i < 8; ++i) { v[i] = *(const f32x4*)(src + (i * 64 + lane) * 4); am = fmaxf(am, fmaxf(fmaxf(fabsf(v[i][0]), fabsf(v[i][1])), fmaxf(fabsf(v[i][2]), fabsf(v[i][3])))); }
        am = wave_max(am);
        const float sc = am > 0.f ? 224.f / am : 1.f;
#pragma unroll
        for (int i = 0; i < 8; ++i) {
            int w = 0;
            w = __builtin_amdgcn_cvt_pk_fp8_f32(v[i][0] * sc, v[i][1] * sc, w, false);
            w = __builtin_amdgcn_cvt_pk_fp8_f32(v[i][2] * sc, v[i][3] * sc, w, true);
            dst[i * 64 + lane] = w;
        }
        if (lane == 0) scales[r] = am > 0.f ? am * (1.f / 224.f) : 1.f;
    }
}

__device__ __forceinline__ float dot16(const uint4 w, const float* x) {
    float d = 0.f; const unsigned ww[4] = {w.x, w.y, w.z, w.w};
#pragma unroll
    for (int q = 0; q < 4; ++q) {
        const f32x2 lo = __builtin_amdgcn_cvt_pk_f32_fp8((int)ww[q], false), hi = __builtin_amdgcn_cvt_pk_f32_fp8((int)ww[q], true);
        d += lo[0] * x[q * 4] + lo[1] * x[q * 4 + 1] + hi[0] * x[q * 4 + 2] + hi[1] * x[q * 4 + 3];
    }
    return d;
}
__device__ __forceinline__ void axpy16(const uint4 w, const float a, float* acc) {
    const unsigned ww[4] = {w.x, w.y, w.z, w.w};
#pragma unroll
    for (int q = 0; q < 4; ++q) {
        const f32x2 lo = __builtin_amdgcn_cvt_pk_f32_fp8((int)ww[q], false), hi = __builtin_amdgcn_cvt_pk_f32_fp8((int)ww[q], true);
        acc[q * 4] += a * lo[0]; acc[q * 4 + 1] += a * lo[1]; acc[q * 4 + 2] += a * hi[0]; acc[q * 4 + 3] += a * hi[1];
    }
}
__device__ __forceinline__ float gelu_f(float d) { return 0.5f * d * (1.f + erff(d * 0.70710678118654752f)); }

template <bool DRY>
__device__ __forceinline__ void phase_peer(const Params& P, int bid, int nb) {
    const bf16_t* hn = (const bf16_t*)(P.ws + WS_HN); const int* idx = (const int*)(P.ws + WS_IDX); const float* gates = (const float*)(P.ws + WS_GATES);
    float* H = (float*)(P.ws + WS_H);
    const unsigned char* EU = P.ws + WS_EU8; const unsigned char* EV = P.ws + WS_EV8; const float* SC = (const float*)(P.ws + WS_ESC);
    const int wave = VTID >> 6, lane = VTID & 63;
    for (int t = bid * 4 + wave; t < T; t += nb * 4) {
        float xr[32], acc[32];
#pragma unroll
        for (int c = 0; c < 2; ++c)
#pragma unroll
            for (int q = 0; q < 2; ++q) {
                const uint4 v = *(const uint4*)(hn + (size_t)t * D + c * 1024 + lane * 16 + q * 8);
                const unsigned ww[4] = {v.x, v.y, v.z, v.w};
#pragma unroll
                for (int j = 0; j < 4; ++j) { xr[c * 16 + q * 8 + 2 * j] = bf2f((bf16_t)(ww[j] & 0xffff)); xr[c * 16 + q * 8 + 2 * j + 1] = bf2f((bf16_t)(ww[j] >> 16)); }
            }
#pragma unroll
        for (int i = 0; i < 32; ++i) acc[i] = 0.f;
        const float rs_t = rsqrtf(((const float*)(P.ws + WS_RSS))[t] * (1.f / 2048.f) + EPS);
        const int   my_i0 = idx[(size_t)t * 128 + lane],   my_i1 = idx[(size_t)t * 128 + 64 + lane];
        const float my_g0 = gates[(size_t)t * 128 + lane], my_g1 = gates[(size_t)t * 128 + 64 + lane];
        uint4 a_u0, a_u1, a_v0, a_v1, a_u2, a_u3, a_v2, a_v3;
        uint4 b_u0, b_u1, b_v0, b_v1, b_u2, b_u3, b_v2, b_v3;
#define PEER_LOAD1(U0, U1, V0, V1, e) { const uint4* up = (const uint4*)(EU + (size_t)(e) * 2048) + lane; U0 = up[0]; U1 = up[64]; \
                                         const uint4* vp = (const uint4*)(EV + (size_t)(e) * 2048) + lane; V0 = vp[0]; V1 = vp[64]; }
#define PEER_COMP1(U0, U1, V0, V1, e, g) { float d = dot16(U0, xr) + dot16(U1, xr + 16); d = wave_sum(d); \
                                            const float pre = d * SC[e] * rs_t; const float a = gelu_f(pre) * (g) * SC[16384 + (e)]; axpy16(V0, a, acc); axpy16(V1, a, acc + 16); }
#pragma unroll
        for (int hh = 0; hh < 2; ++hh) {
            const int mi = hh ? my_i1 : my_i0; const int mgi = __float_as_int(hh ? my_g1 : my_g0);
            { const int e0 = __builtin_amdgcn_readlane(mi, 0), e1 = __builtin_amdgcn_readlane(mi, 1); PEER_LOAD1(a_u0, a_u1, a_v0, a_v1, e0) PEER_LOAD1(a_u2, a_u3, a_v2, a_v3, e1) }
            for (int k = 0; k < 64; k += 4) {
                const int e0 = __builtin_amdgcn_readlane(mi, k), e1 = __builtin_amdgcn_readlane(mi, k + 1), e2 = __builtin_amdgcn_readlane(mi, k + 2), e3 = __builtin_amdgcn_readlane(mi, k + 3);
                const float g0 = __int_as_float(__builtin_amdgcn_readlane(mgi, k)), g1 = __int_as_float(__builtin_amdgcn_readlane(mgi, k + 1)), g2 = __int_as_float(__builtin_amdgcn_readlane(mgi, k + 2)), g3 = __int_as_float(__builtin_amdgcn_readlane(mgi, k + 3));
                PEER_LOAD1(b_u0, b_u1, b_v0, b_v1, e2) PEER_LOAD1(b_u2, b_u3, b_v2, b_v3, e3)
                PEER_COMP1(a_u0, a_u1, a_v0, a_v1, e0, g0) PEER_COMP1(a_u2, a_u3, a_v2, a_v3, e1, g1)
                if (k + 4 < 64) { const int e4 = __builtin_amdgcn_readlane(mi, k + 4), e5 = __builtin_amdgcn_readlane(mi, k + 5); PEER_LOAD1(a_u0, a_u1, a_v0, a_v1, e4) PEER_LOAD1(a_u2, a_u3, a_v2, a_v3, e5) }
                PEER_COMP1(b_u0, b_u1, b_v0, b_v1, e2, g2) PEER_COMP1(b_u2, b_u3, b_v2, b_v3, e3, g3)
            }
        }
        if (DRY) {
#pragma unroll
            for (int i = 0; i < 32; ++i) asm volatile("" :: "v"(acc[i]));
            continue;
        }
        float ss = 0.f;
#pragma unroll
        for (int c = 0; c < 2; ++c)
#pragma unroll
            for (int q = 0; q < 4; ++q) {
                f32x4* hp = (f32x4*)(H + (size_t)t * D + c * 1024 + lane * 16 + q * 4);
                f32x4 hv = *hp;
#pragma unroll
                for (int j = 0; j < 4; ++j) { hv[j] += acc[c * 16 + q * 4 + j]; acc[c * 16 + q * 4 + j] = hv[j]; ss += hv[j] * hv[j]; }
                *hp = hv;
            }
        ss = wave_sum(ss);
        const float rs = rsqrtf(ss * (1.f / 2048.f) + EPS);
        bf16_t* hn3 = (bf16_t*)(P.ws + WS_HN) + (size_t)t * D;
#pragma unroll
        for (int c = 0; c < 2; ++c)
#pragma unroll
            for (int q = 0; q < 2; ++q) {
                unsigned w[4];
#pragma unroll
                for (int j = 0; j < 4; ++j) { const int col = c * 1024 + lane * 16 + q * 8 + 2 * j;
                    w[j] = pack2(acc[c * 16 + q * 8 + 2 * j] * rs * P.norm_ple[col], acc[c * 16 + q * 8 + 2 * j + 1] * rs * P.norm_ple[col + 1]); }
                *(uint4*)(hn3 + c * 1024 + lane * 16 + q * 8) = make_uint4(w[0], w[1], w[2], w[3]);
            }
    }
}

enum { PH_PREP = 0, PH_GEMM1, PH_CHUNK1, PH_SCAN, PH_CHUNK3, PH_GEMM2, PH_GEMM3, PH_SCORES, PH_ROUTE, PH_PEER, PH_GEMM4, PH_FINAL, PH_COUNT };

#define XB_TMO      128
#define XB_XCNT(j)  (256  + 64 * (j))
#define XB_XSUB(j)  (1280 + 64 * (j))
#define XB_XGEN(j)  (2304 + 64 * (j))
#define XB_TOP      3328
#define XB_TOPGEN   3392
#define XCD_BAR_WORDS 3456
#define XB_SPIN_CAP (1u << 20)
#define LAS __attribute__((address_space(3)))
__device__ __forceinline__ unsigned xb_ld(unsigned* p)              { return __hip_atomic_load(p, __ATOMIC_RELAXED, __HIP_MEMORY_SCOPE_AGENT); }
__device__ __forceinline__ unsigned xb_add(unsigned* p, unsigned v) { return __hip_atomic_fetch_add(p, v, __ATOMIC_RELAXED, __HIP_MEMORY_SCOPE_AGENT); }
__device__ __forceinline__ unsigned xb_xcc_id() { return (unsigned)__builtin_amdgcn_s_getreg((3 << 11) | 20) & 0xFu; }
#define XB_SPIN(cond, bar) do { unsigned _sp = 0; while (cond) { __builtin_amdgcn_s_sleep(1); \
    if ((++_sp & 255u) == 0u) { if (xb_ld(&(bar)[XB_TMO])) break; if (_sp > XB_SPIN_CAP) { atomicAdd(&(bar)[XB_TMO], 1u); break; } } } } while (0)
struct XcdBarrier { unsigned* bar; unsigned x; volatile LAS unsigned* st; };
__device__ __forceinline__ XcdBarrier xcd_barrier_post(unsigned* bar, volatile LAS unsigned* st) {
    XcdBarrier b; b.bar = bar; b.x = xb_xcc_id(); b.st = st;
    if (threadIdx.x == 0) (void)xb_add(&bar[XB_XCNT(b.x)], 1u);
    return b;
}
__device__ __forceinline__ void xcd_barrier_complete(unsigned* bar, unsigned x, unsigned& nloc, unsigned& nx) {
    const unsigned G = gridDim.x * gridDim.y * gridDim.z;
    unsigned sum, cnt, mine, sp = 0u;
    for (;;) {
        sum = 0u; cnt = 0u; mine = 0u;
#pragma unroll
        for (unsigned j = 0; j < 16; ++j) { const unsigned c = xb_ld(&bar[XB_XCNT(j)]); sum += c; cnt += (c > 0u) ? 1u : 0u; mine = (j == x) ? c : mine; }
        if (sum == G) break;
        __builtin_amdgcn_s_sleep(1);
        if ((++sp & 255u) == 0u) { if (xb_ld(&bar[XB_TMO])) break; if (sp > XB_SPIN_CAP) { atomicAdd(&bar[XB_TMO], 1u); break; } }
    }
    nloc = mine > 0u ? mine : 1u; nx = cnt > 0u ? cnt : 1u;
}
__device__ __forceinline__ void xcd_barrier(const XcdBarrier& b) {
    asm volatile("s_waitcnt vmcnt(0)" ::: "memory");
    __syncthreads();
    if (threadIdx.x == 0) {
        unsigned* bar = b.bar;
        __builtin_amdgcn_s_waitcnt(0);
        unsigned nloc = b.st[0], nx = b.st[1];
        if (nloc == 0u) { xcd_barrier_complete(bar, b.x, nloc, nx); b.st[0] = nloc; b.st[1] = nx; }
        const unsigned old = xb_add(&bar[XB_XSUB(b.x)], 1u);
        const unsigned gen = old / nloc;
        if (old + 1u == (gen + 1u) * nloc) {
            __builtin_amdgcn_fence(__ATOMIC_RELEASE, "agent");
            asm volatile("s_waitcnt vmcnt(0)" ::: "memory");
            const unsigned og = xb_add(&bar[XB_TOP], 1u);
            const unsigned tg = og / nx;
            if (og + 1u == (tg + 1u) * nx) xb_add(&bar[XB_TOPGEN], 1u);
            else XB_SPIN(xb_ld(&bar[XB_TOPGEN]) == tg, bar);
            __builtin_amdgcn_fence(__ATOMIC_ACQUIRE, "agent");
            xb_add(&bar[XB_XGEN(b.x)], 1u);
            asm volatile("s_waitcnt vmcnt(0)" ::: "memory");
        } else {
            XB_SPIN(xb_ld(&bar[XB_XGEN(b.x)]) == gen, bar);
            __builtin_amdgcn_fence(__ATOMIC_ACQUIRE, "agent");
            asm volatile("s_waitcnt vmcnt(0)" ::: "memory");
        }
    }
    __syncthreads();
}

__device__ __forceinline__ void run_phase(const Params& P, int ph, int bid, int nb, unsigned char* smem, int rbid, int rnb, unsigned char* rsmem) {
    switch (ph) {
        case PH_PREP:   phase_prep(P, bid, nb, smem); break;
        case PH_GEMM1:  phase_gemm1(P, rbid, rnb, rsmem); break;
        case PH_CHUNK1: phase_chunk1(P, bid, nb, smem); break;
        case PH_SCAN:   phase_scan(P, bid, nb, smem, rbid, rnb, rsmem); break;
        case PH_CHUNK3: phase_chunk3(P, bid, nb, smem); break;
        case PH_GEMM2:  phase_gemm2(P, rbid, rnb, rsmem); break;
        case PH_GEMM3:  phase_gemm3(P, rbid, rnb, rsmem); break;
        case PH_SCORES: phase_scores(P, bid, nb, smem); break;
        case PH_ROUTE:  phase_route(P, bid, nb, smem); break;
        case PH_PEER:   phase_peer<false>(P, bid, nb); break;
        case PH_PEER + 100: phase_peer<true>(P, bid, nb); break;
        case PH_GEMM4:  phase_gemm4(P, rbid, rnb, rsmem); break;
        case PH_FINAL:  phase_rownorm<false>((const float*)(P.ws + WS_H), P.norm_final, P.out, bid, nb); break;
    }
}

#ifndef PROBE_A
#define PROBE_A -1
#endif
#ifndef PROBE_B
#define PROBE_B -1
#endif
constexpr int LDS_BYTES = 131072 + 16 + 256;

__global__ void __launch_bounds__(512, 2) fwd_kernel(Params P, int ph_lo, int ph_hi) {
    extern __shared__ __attribute__((aligned(16))) unsigned char rsmem[];
    const int rbid = blockIdx.x, rnb = gridDim.x;
    const int half = __builtin_amdgcn_readfirstlane((int)(threadIdx.x >> 8));
    const int bid = rbid * 2 + half, nb = rnb * 2;
    unsigned char* smem = rsmem + half * 65536;
    volatile LAS unsigned* st = (volatile LAS unsigned*)(rsmem + 131072);
    if (threadIdx.x == 0) { st[0] = 0u; st[1] = 0u; }
    __syncthreads();
    XcdBarrier xb = xcd_barrier_post((unsigned*)(P.ws + WS_BAR), st);
#if PROBE_A >= 0
    unsigned long long* tstamp = (unsigned long long*)(rsmem + 131072 + 16);
    xcd_barrier(xb);
    if (threadIdx.x == 0) tstamp[0] = __builtin_amdgcn_s_memrealtime();
#define RUN(ph) if (ph_lo <= (ph) && (ph) < ph_hi) { run_phase(P, (ph), bid, nb, smem, rbid, rnb, rsmem); xcd_barrier(xb); if (threadIdx.x == 0) tstamp[(ph) + 1] = __builtin_amdgcn_s_memrealtime(); }
#else
#ifndef REPEAT_PH
#define REPEAT_PH -1
#endif
#define RUN(ph) if (ph_lo <= (ph) && (ph) < ph_hi) { if ((ph) == REPEAT_PH && (ph) == PH_PEER) { run_phase(P, PH_PEER + 100, bid, nb, smem, rbid, rnb, rsmem); xcd_barrier(xb); } run_phase(P, (ph), bid, nb, smem, rbid, rnb, rsmem); if ((ph) == REPEAT_PH && (ph) != PH_PEER) { xcd_barrier(xb); run_phase(P, (ph) == PH_PEER ? PH_PEER + 100 : (ph), bid, nb, smem, rbid, rnb, rsmem); } if ((ph) + 1 < ph_hi) xcd_barrier(xb); }
#endif
    RUN(PH_PREP) RUN(PH_GEMM1) RUN(PH_CHUNK1) RUN(PH_SCAN) RUN(PH_CHUNK3) RUN(PH_GEMM2) RUN(PH_GEMM3) RUN(PH_SCORES) RUN(PH_ROUTE)
    RUN(PH_PEER) RUN(PH_GEMM4) RUN(PH_FINAL)
#if PROBE_A >= 0
    __syncthreads();
    if (rbid == 0) {
        const float da = (float)(tstamp[PROBE_A + 1] - tstamp[PROBE_A]) * 0.01f;
        if (threadIdx.x == 0) P.out[0] = da;
#if PROBE_B >= 0
        const float db = (float)(tstamp[PROBE_B + 1] - tstamp[PROBE_B]) * 0.01f * (1.f / 16.f);
        for (int i = threadIdx.x; i < 65536; i += 512) P.out[65536 + i] = db;
#endif
    }
#endif
}

extern "C" void kernel_launch(void* const* d_in, const int* in_sizes, int n_in, void* d_out, int out_size, void* d_ws, size_t ws_size, hipStream_t stream) {
    static int grid = 0;
    if (grid == 0) {
        if (n_in != 21 || out_size != T * D || ws_size < WS_END) { fprintf(stderr, "kernel_launch: unexpected shapes: n_in %d out %d ws %zu (need %zu)\n", n_in, out_size, ws_size, (size_t)WS_END); grid = -1; return; }
        if (hipFuncSetAttribute((const void*)fwd_kernel, hipFuncAttributeMaxDynamicSharedMemorySize, LDS_BYTES) != hipSuccess) { fprintf(stderr, "kernel_launch: hipFuncSetAttribute failed\n"); grid = -1; return; }
        int dev = 0, cus = 0, per_cu = 0;
        hipGetDevice(&dev); hipDeviceGetAttribute(&cus, hipDeviceAttributeMultiprocessorCount, dev);
        if (hipOccupancyMaxActiveBlocksPerMultiprocessor(&per_cu, (const void*)fwd_kernel, 512, LDS_BYTES) != hipSuccess || per_cu < 1) { fprintf(stderr, "kernel_launch: occupancy query failed (%d)\n", per_cu); grid = -1; return; }
        if (per_cu > 1) per_cu = 1;
        grid = cus * per_cu;
        fprintf(stderr, "kernel_launch: grid %d (%d CUs x %d)\n", grid, cus, per_cu);
    }
    if (grid < 0) return;
    Params P{};
    P.x = (const float*)d_in[0]; P.p = (const float*)d_in[1]; P.positions = (const int*)d_in[2]; P.norm_mix = (const float*)d_in[3]; P.w_in = (const float*)d_in[4];
    P.conv_w = (const float*)d_in[5]; P.a_log = (const float*)d_in[6]; P.dt_bias = (const float*)d_in[7]; P.dn_norm = (const float*)d_in[8]; P.ret_gn_w = (const float*)d_in[9];
    P.ret_gn_b = (const float*)d_in[10]; P.w_out = (const float*)d_in[11]; P.norm_ffn = (const float*)d_in[12]; P.w_pq = (const float*)d_in[13]; P.sub_keys = (const float*)d_in[14];
    P.expert_u = (const float*)d_in[15]; P.expert_v = (const float*)d_in[16]; P.norm_ple = (const float*)d_in[17]; P.w_ple_gate = (const float*)d_in[18]; P.w_ple_proj = (const float*)d_in[19];
    P.norm_final = (const float*)d_in[20]; P.out = (float*)d_out; P.ws = (unsigned char*)d_ws;
    (void)hipMemsetAsync((unsigned char*)d_ws + WS_BAR, 0, XCD_BAR_WORDS * 4, stream);
    int lo = 0, hi = PH_COUNT;
    void* args[] = {&P, &lo, &hi};
    hipError_t e = hipLaunchCooperativeKernel((const void*)fwd_kernel, dim3(grid), dim3(512), args, LDS_BYTES, stream);
    if (e != hipSuccess) fprintf(stderr, "kernel_launch: cooperative launch failed: %s (grid %d)\n", hipGetErrorString(e), grid);
}
```

```cpp
#include <hip/hip_runtime.h>
#include <cstdio>
#include <cstdint>

typedef unsigned short bf16_t;
typedef short bf16x8 __attribute__((ext_vector_type(8)));
typedef float f32x16 __attribute__((ext_vector_type(16)));
typedef float f32x4 __attribute__((ext_vector_type(4)));
__device__ __forceinline__ int fresh_tid() { int t = (int)threadIdx.x; asm volatile("" : "+v"(t)); return t; }
#define VTID (fresh_tid() & 255)

constexpr int T = 8192, D = 2048, SEQ = 4096;
constexpr int NPROJ = 7424;
constexpr int C_Z = 3072, C_RQ = 4096, C_RK = 4608, C_RV = 5120, C_RG = 6144, C_A = 7168, C_B = 7176;
constexpr int IN_COLS = 7184;
constexpr float EPS = 1e-6f;

constexpr size_t WS_HN    = 0;
constexpr size_t WS_KVT   = WS_HN;
constexpr size_t WS_WTIN  = WS_HN + (size_t)T * D * 2;
constexpr size_t WS_STR   = WS_WTIN;
constexpr size_t WS_ATTR  = WS_STR + (size_t)1024 * 128 * 64 * 2;
constexpr size_t WS_WTOUT = WS_WTIN + (size_t)NPROJ * D * 2;
constexpr size_t WS_WTPQ  = WS_WTOUT + (size_t)D * D * 2;
constexpr size_t WS_WTG   = WS_WTPQ + (size_t)D * D * 2;
constexpr size_t WS_WTPP  = WS_WTG + (size_t)D * D * 2;
constexpr size_t WS_KEYS  = WS_WTPP + (size_t)D * 256 * 2;
constexpr size_t WS_PBF   = WS_KEYS + (size_t)16 * 128 * 128 * 2;
constexpr size_t WS_PROJ  = WS_PBF + (size_t)T * 256 * 2;
constexpr size_t WS_Q     = WS_PROJ;
constexpr size_t WS_SCORES= WS_PROJ + (size_t)T * D * 2;
constexpr size_t WS_MIXED = WS_PROJ + (size_t)T * NPROJ * 2;
constexpr size_t WS_H     = WS_MIXED + (size_t)T * D * 2;
constexpr size_t WS_IDX   = WS_H + (size_t)T * D * 4;
constexpr size_t WS_GATES = WS_IDX + (size_t)T * 128 * 4;
constexpr size_t WS_U     = WS_GATES + (size_t)T * 128 * 4;
constexpr size_t WS_W     = WS_U + (size_t)1024 * 64 * 128 * 4;
constexpr size_t WS_KDT   = WS_W + (size_t)1024 * 64 * 128 * 2;
constexpr size_t WS_QG    = WS_KDT + (size_t)1024 * 128 * 64 * 2;
constexpr size_t WS_ATT   = WS_QG + (size_t)1024 * 64 * 128 * 2;
constexpr size_t WS_QGR   = WS_ATT + (size_t)1024 * 64 * 64 * 2;
constexpr size_t WS_EU8   = WS_QGR + (size_t)1024 * 64 * 64 * 2;
constexpr size_t WS_EV8   = WS_EU8 + (size_t)16384 * 2048;
constexpr size_t WS_ESC   = WS_EV8 + (size_t)16384 * 2048;
constexpr size_t WS_EG    = WS_ESC + (size_t)2 * 16384 * 4;
constexpr size_t WS_RSS   = WS_EG + 4096;
constexpr size_t WS_BAR   = WS_RSS + (size_t)T * 4;
constexpr size_t WS_END   = WS_BAR + 16384;
constexpr size_t WS_VNT   = WS_H;
constexpr size_t WS_SC    = WS_VNT + (size_t)1024 * 128 * 64 * 2;
constexpr size_t WS_VNTR  = WS_SC + (size_t)1024 * 128 * 128 * 2;
static_assert(WS_VNTR + (size_t)1024 * 128 * 64 * 2 == WS_H + (size_t)T * D * 4, "chunk buffers must fit the H region");

struct Params {
    const float *x, *p; const int* positions;
    const float *norm_mix, *w_in, *conv_w, *a_log, *dt_bias, *dn_norm, *ret_gn_w, *ret_gn_b, *w_out, *norm_ffn, *w_pq, *sub_keys,
                *expert_u, *expert_v, *norm_ple, *w_ple_gate, *w_ple_proj, *norm_final;
    float* out; unsigned char* ws;
};

__device__ __forceinline__ bf16_t f2bf(float f) { unsigned u = __float_as_uint(f); u += 0x7fffu + ((u >> 16) & 1u); return (bf16_t)(u >> 16); }
__device__ __forceinline__ float bf2f(bf16_t h) { return __uint_as_float(((unsigned)h) << 16); }
__device__ __forceinline__ unsigned pack2(float a, float b) { return (unsigned)f2bf(a) | ((unsigned)f2bf(b) << 16); }
__device__ __forceinline__ float wave_sum(float v) {
#pragma unroll
    for (int o = 32; o >= 1; o >>= 1) v += __shfl_xor(v, o);
    return v;
}
__device__ __forceinline__ float wave_max(float v) {
#pragma unroll
    for (int o = 32; o >= 1; o >>= 1) v = fmaxf(v, __shfl_xor(v, o));
    return v;
}
__device__ __forceinline__ float silu_f(float x) { return x / (1.f + __expf(-x)); }
__device__ __forceinline__ float sigmoid_f(float x) { return 1.f / (1.f + __expf(-x)); }

template <bool MAPIN>
__device__ __forceinline__ void transpose_tile(const float* __restrict__ W, int ldw, int K, bf16_t* __restrict__ Wt, int kt, int nt, float* tile  ) {
    const int tid = VTID;
    __syncthreads();
#pragma unroll
    for (int i = 0; i < 4; ++i) {
        const int idx = tid + 256 * i, kr = idx >> 4, c4 = idx & 15;
        const int n = nt * 64 + c4 * 4;
        int c = n; bool valid = true;
        if (MAPIN) { if (n < 4096) c = n; else if (n < 7168) c = n + 16; else if (n < 7184) c = n - 3072; else valid = false; }
        f32x4 v = {0.f, 0.f, 0.f, 0.f};
        if (valid) v = *(const f32x4*)(W + (size_t)(kt * 64 + kr) * ldw + c);
        float* d = tile + kr * 65 + c4 * 4;
        d[0] = v[0]; d[1] = v[1]; d[2] = v[2]; d[3] = v[3];
    }
    __syncthreads();
#pragma unroll
    for (int i = 0; i < 2; ++i) {
        const int ch = tid + 256 * i, n = ch >> 3, kc = ch & 7;
        unsigned w[4];
#pragma unroll
        for (int j = 0; j < 4; ++j) w[j] = pack2(tile[(kc * 8 + 2 * j) * 65 + n], tile[(kc * 8 + 2 * j + 1) * 65 + n]);
        uint4 o = make_uint4(w[0], w[1], w[2], w[3]);
        *(uint4*)(Wt + (size_t)(nt * 64 + n) * K + kt * 64 + kc * 8) = o;
    }
}

template <bool OUT_BF16>
__device__ __forceinline__ void rmsnorm_row(const float* __restrict__ in, const float* __restrict__ w, void* __restrict__ out, int lane) {
    f32x4 v[8]; float ss = 0.f;
#pragma unroll
    for (int i = 0; i < 8; ++i) { v[i] = *(const f32x4*)(in + (i * 64 + lane) * 4); ss += v[i][0] * v[i][0] + v[i][1] * v[i][1] + v[i][2] * v[i][2] + v[i][3] * v[i][3]; }
    ss = wave_sum(ss);
    const float r = rsqrtf(ss * (1.f / 2048.f) + EPS);
#pragma unroll
    for (int i = 0; i < 8; ++i) {
        const f32x4 g = *(const f32x4*)(w + (i * 64 + lane) * 4);
        const float a = v[i][0] * r * g[0], b = v[i][1] * r * g[1], c = v[i][2] * r * g[2], d = v[i][3] * r * g[3];
        if (OUT_BF16) { uint2 o = make_uint2(pack2(a, b), pack2(c, d)); *(uint2*)((bf16_t*)out + (i * 64 + lane) * 4) = o; }
        else { f32x4 o = {a, b, c, d}; *(f32x4*)((float*)out + (i * 64 + lane) * 4) = o; }
    }
}

__device__ __forceinline__ void phase_prep(const Params& P, int bid, int nb, unsigned char* smem) {
    float* tile = (float*)smem;
    const int tid = VTID;
    const int n_in = 32 * 116, n_sq = 32 * 32, n_pp = 4 * 32;
    const int n_tr = n_in + 3 * n_sq + n_pp;
    for (int u = bid; u < n_tr; u += nb) {
        if (u < n_in) transpose_tile<true>(P.w_in, IN_COLS, D, (bf16_t*)(P.ws + WS_WTIN), u % 32, u / 32, tile);
        else if (u < n_in + n_sq) { const int v = u - n_in; transpose_tile<false>(P.w_out, D, D, (bf16_t*)(P.ws + WS_WTOUT), v % 32, v / 32, tile); }
        else if (u < n_in + 2 * n_sq) { const int v = u - n_in - n_sq; transpose_tile<false>(P.w_pq, D, D, (bf16_t*)(P.ws + WS_WTPQ), v % 32, v / 32, tile); }
        else if (u < n_in + 3 * n_sq) { const int v = u - n_in - 2 * n_sq; transpose_tile<false>(P.w_ple_gate, D, D, (bf16_t*)(P.ws + WS_WTG), v % 32, v / 32, tile); }
        else { const int v = u - n_in - 3 * n_sq; transpose_tile<false>(P.w_ple_proj, D, 256, (bf16_t*)(P.ws + WS_WTPP), v % 4, v / 4, tile); }
    }
    {
        bf16_t* keys = (bf16_t*)(P.ws + WS_KEYS); bf16_t* pbf = (bf16_t*)(P.ws + WS_PBF);
        const int n4a = 262144 / 4, n4b = T * 256 / 4;
        for (int i = bid * 256 + tid; i < n4a + n4b; i += nb * 256) {
            const bool a = i < n4a; const int j = a ? i : i - n4a;
            const f32x4 v = *(const f32x4*)((a ? P.sub_keys : P.p) + (size_t)j * 4);
            *(uint2*)((a ? keys : pbf) + (size_t)j * 4) = make_uint2(pack2(v[0], v[1]), pack2(v[2], v[3]));
        }
    }
    { float* rss = (float*)(P.ws + WS_RSS); for (int i = bid * 256 + tid; i < T; i += nb * 256) rss[i] = 0.f; }
    {
        const int wave = tid >> 6, lane = tid & 63;
        bf16_t* hn = (bf16_t*)(P.ws + WS_HN);
        for (int r = bid * 4 + wave; r < T; r += nb * 4) rmsnorm_row<true>(P.x + (size_t)r * D, P.norm_mix, hn + (size_t)r * D, lane);
    }
}

__device__ __forceinline__ int lds_off(int row, int ch) { return row * 128 + ((ch ^ ((row >> 1) & 7)) << 4); }

__device__ __forceinline__ void gemm_mainloop(const bf16_t* __restrict__ A, int lda, const bf16_t* __restrict__ Bt, int ldb, int K,
                                              f32x16 (&acc)[2][2], unsigned char* smem) {
    const int tid = VTID, wave = tid >> 6, lane = tid & 63, wr = wave >> 1, wc = wave & 1;
    const int nk = K / 64;
    uint4 ra[4], rb[4];
    __syncthreads();
#pragma unroll
    for (int i = 0; i < 4; ++i) { const int c = tid + 256 * i, row = c >> 3, ch = c & 7;
        ra[i] = *(const uint4*)(A + (size_t)row * lda + ch * 8); rb[i] = *(const uint4*)(Bt + (size_t)row * ldb + ch * 8); }
#pragma unroll
    for (int i = 0; i < 4; ++i) { const int c = tid + 256 * i, row = c >> 3, ch = c & 7;
        *(uint4*)(smem + lds_off(row, ch)) = ra[i]; *(uint4*)(smem + 16384 + lds_off(row, ch)) = rb[i]; }
    __syncthreads();
    for (int kt = 0; kt < nk; ++kt) {
        unsigned char* cur = smem + (kt & 1) * 32768;
        unsigned char* nxt = smem + ((kt + 1) & 1) * 32768;
        const bool more = kt + 1 < nk;
        if (more) {
#pragma unroll
            for (int i = 0; i < 4; ++i) { const int c = tid + 256 * i, row = c >> 3, ch = c & 7;
                ra[i] = *(const uint4*)(A + (size_t)row * lda + (kt + 1) * 64 + ch * 8); rb[i] = *(const uint4*)(Bt + (size_t)row * ldb + (kt + 1) * 64 + ch * 8); }
        }
#pragma unroll
        for (int ks = 0; ks < 4; ++ks) {
            bf16x8 af[2], bfr[2];
#pragma unroll
            for (int i = 0; i < 2; ++i) { const int row = wr * 64 + i * 32 + (lane & 31); af[i] = *(const bf16x8*)(cur + lds_off(row, ks * 2 + (lane >> 5))); }
#pragma unroll
            for (int j = 0; j < 2; ++j) { const int row = wc * 64 + j * 32 + (lane & 31); bfr[j] = *(const bf16x8*)(cur + 16384 + lds_off(row, ks * 2 + (lane >> 5))); }
#pragma unroll
            for (int i = 0; i < 2; ++i)
#pragma unroll
                for (int j = 0; j < 2; ++j) acc[i][j] = __builtin_amdgcn_mfma_f32_32x32x16_bf16(af[i], bfr[j], acc[i][j], 0, 0, 0);
        }
        if (more) {
#pragma unroll
            for (int i = 0; i < 4; ++i) { const int c = tid + 256 * i, row = c >> 3, ch = c & 7;
                *(uint4*)(nxt + lds_off(row, ch)) = ra[i]; *(uint4*)(nxt + 16384 + lds_off(row, ch)) = rb[i]; }
        }
        __syncthreads();
    }
}
#define ACC_FOREACH(body)                                                                                   \
    { const int _tid = VTID, _wave = _tid >> 6, _lane = _tid & 63, _wr = _wave >> 1, _wc = _wave & 1; \
      _Pragma("unroll") for (int i = 0; i < 2; ++i) _Pragma("unroll") for (int j = 0; j < 2; ++j)          \
      _Pragma("unroll") for (int r = 0; r < 16; ++r) {                                                     \
          const int row = _wr * 64 + i * 32 + (r & 3) + 8 * (r >> 2) + 4 * (_lane >> 5);                   \
          const int col = _wc * 64 + j * 32 + (_lane & 31); body } }

__device__ __forceinline__ void zero_acc(f32x16 (&acc)[2][2]) {
#pragma unroll
    for (int i = 0; i < 2; ++i)
#pragma unroll
        for (int j = 0; j < 2; ++j)
#pragma unroll
            for (int r = 0; r < 16; ++r) acc[i][j][r] = 0.f;
}

__device__ __forceinline__ void phase_scores(const Params& P, int bid, int nb, unsigned char* smem) {
    const bf16_t* A = (const bf16_t*)(P.ws + WS_Q); const bf16_t* Bt = (const bf16_t*)(P.ws + WS_KEYS); float* C = (float*)(P.ws + WS_SCORES);
    const int nmt = T / 128, nnt = 16;
    for (int t = bid; t < nmt * nnt; t += nb) {
        const int mt = t % nmt, nt = t / nmt;
        f32x16 acc[2][2]; zero_acc(acc);
        gemm_mainloop(A + (size_t)mt * 128 * D + nt * 128, D, Bt + (size_t)nt * 128 * 128, 128, 128, acc, smem);
        ACC_FOREACH({ C[(size_t)(mt * 128 + row) * D + nt * 128 + col] = acc[i][j][r]; })
    }
}
__device__ __forceinline__ int g2_lds_byte(int r, int c) { const int st = (r >> 4) * 2 + (c >> 5), ob = (r & 15) * 64 + (c & 31) * 2; return st * 1024 + (ob ^ (((ob >> 9) & 1) << 5)); }
__device__ __forceinline__ void g2_stage_rc(int b, int& R, int& C) { const int st = b >> 10, sb = b & 1023, swz = sb ^ (((sb >> 9) & 1) << 5); R = (st >> 1) * 16 + (swz >> 6); C = (st & 1) * 32 + ((swz & 63) >> 1); }
__device__ __forceinline__ void g2_zero(f32x4 (&acc)[8][4]) {
#pragma unroll
    for (int m = 0; m < 8; ++m)
#pragma unroll
        for (int n = 0; n < 4; ++n) acc[m][n] = (f32x4){0.f, 0.f, 0.f, 0.f};
}
__device__ __forceinline__ void g2_mainloop(const bf16_t* __restrict__ Ab, int lda, const bf16_t* __restrict__ Bb, int ldb, int K, f32x4 (&acc)[8][4], unsigned char* shm) {
    const int tid = fresh_tid(), wid = tid >> 6, lane = tid & 63, wr = wid >> 2, wc = wid & 3, fr = lane & 15, fq = lane >> 4;
    int sR[4], sC[4];
#pragma unroll
    for (int i = 0; i < 4; ++i) g2_stage_rc(wid * 1024 + i * 8192 + lane * 16, sR[i], sC[i]);
#define G2_STAGE(buf, kt) { _Pragma("unroll") for (int i = 0; i < 4; ++i) { \
        __builtin_amdgcn_global_load_lds((const unsigned*)(Ab + (size_t)sR[i] * lda + (kt) * 64 + sC[i]), (unsigned*)(shm + (buf) * 65536 + wid * 1024 + i * 8192), 16, 0, 0); \
        __builtin_amdgcn_global_load_lds((const unsigned*)(Bb + (size_t)sR[i] * ldb + (kt) * 64 + sC[i]), (unsigned*)(shm + (buf) * 65536 + 32768 + wid * 1024 + i * 8192), 16, 0, 0); } }
    const int nt = K / 64;
    __syncthreads();
    G2_STAGE(0, 0)
    asm volatile("s_waitcnt vmcnt(0)" ::: "memory");
    __syncthreads();
    for (int t = 0; t < nt; ++t) {
        const int cur = t & 1;
        if (t + 1 < nt) G2_STAGE(cur ^ 1, t + 1)
        const unsigned char* SA = shm + cur * 65536; const unsigned char* SB = SA + 32768;
#pragma unroll
        for (int ks = 0; ks < 2; ++ks) {
            bf16x8 At[8], Bf[4];
#pragma unroll
            for (int m = 0; m < 8; ++m) At[m] = *(const bf16x8*)(SA + g2_lds_byte(wr * 128 + m * 16 + fr, ks * 32 + fq * 8));
#pragma unroll
            for (int n = 0; n < 4; ++n) Bf[n] = *(const bf16x8*)(SB + g2_lds_byte(wc * 64 + n * 16 + fr, ks * 32 + fq * 8));
#pragma unroll
            for (int m = 0; m < 8; ++m)
#pragma unroll
                for (int n = 0; n < 4; ++n) acc[m][n] = __builtin_amdgcn_mfma_f32_16x16x32_bf16(At[m], Bf[n], acc[m][n], 0, 0, 0);
            __builtin_amdgcn_sched_barrier(0);
        }
        asm volatile("s_waitcnt vmcnt(0)" ::: "memory");
        __syncthreads();
    }
}
#define G2_FOREACH(body)                                                                                       \
    { const int _tid = fresh_tid(), _wid = _tid >> 6, _lane = _tid & 63, _wr = _wid >> 2, _wc = _wid & 3, _fr = _lane & 15, _fq = _lane >> 4; \
      _Pragma("unroll") for (int m = 0; m < 8; ++m) _Pragma("unroll") for (int n = 0; n < 4; ++n)             \
      _Pragma("unroll") for (int j = 0; j < 4; ++j) {                                                         \
          const int row = _wr * 128 + m * 16 + _fq * 4 + j; const int col = _wc * 64 + n * 16 + _fr; const float val = acc[m][n][j]; body } }
#define G8_HT (128 * 64)
__device__ __forceinline__ void g8_mainloop(const bf16_t* __restrict__ A, const bf16_t* __restrict__ Bt, int K, int brow, int bcol, f32x4 (&acc)[2][2][4][2], unsigned char* shmb) {
    bf16_t* shm = (bf16_t*)shmb;
    const int tid = fresh_tid();
    const int wid = tid >> 6, lane = tid & 63, wr = wid >> 2, wc = wid & 3, fr = lane & 15, fq = lane >> 4;
#define G8_SA(b, h) (shm + ((b) * 2 + (h)) * G8_HT)
#define G8_SB(b, h) (shm + (4 + (b) * 2 + (h)) * G8_HT)
#define G8_STAGE(Pp, BASE, br, kt) do { const long _g = (long)(br) * K + (long)(kt) * 64; \
    _Pragma("unroll") for (int _i = 0; _i < 2; ++_i) { const int _b = tid * 16 + _i * 8192; int _r, _c; g2_stage_rc(_b, _r, _c); \
      __builtin_amdgcn_global_load_lds((const unsigned*)(BASE + _g + (long)_r * K + _c), (unsigned*)((char*)(Pp) + _b), 16, 0, 0); } } while (0)
#define G8_LDA(dst, b, h) _Pragma("unroll") for (int m = 0; m < 4; ++m) _Pragma("unroll") for (int k = 0; k < 2; ++k) \
    dst[m][k] = *reinterpret_cast<const bf16x8*>((const char*)G8_SA(b, h) + g2_lds_byte(wr * 64 + m * 16 + fr, k * 32 + fq * 8))
#define G8_LDB(dst, b, h) _Pragma("unroll") for (int n = 0; n < 2; ++n) _Pragma("unroll") for (int k = 0; k < 2; ++k) \
    dst[n][k] = *reinterpret_cast<const bf16x8*>((const char*)G8_SB(b, h) + g2_lds_byte(wc * 32 + n * 16 + fr, k * 32 + fq * 8))
#define G8_MMA(ai, bj, At_, Bt_) do { __builtin_amdgcn_s_setprio(1); \
    _Pragma("unroll") for (int m = 0; m < 4; ++m) _Pragma("unroll") for (int n = 0; n < 2; ++n) _Pragma("unroll") for (int k = 0; k < 2; ++k) \
      acc[ai][bj][m][n] = __builtin_amdgcn_mfma_f32_16x16x32_bf16(At_[m][k], Bt_[n][k], acc[ai][bj][m][n], 0, 0, 0); \
    __builtin_amdgcn_s_setprio(0); } while (0)
#define G8_WAIT_V(n) asm volatile("s_waitcnt vmcnt(" #n ")" ::: "memory")
#define G8_WAIT_L(n) asm volatile("s_waitcnt lgkmcnt(" #n ")" ::: "memory")
#define G8_BAR __builtin_amdgcn_s_barrier()
#define G8_SCHED __builtin_amdgcn_sched_barrier(0)
    bf16x8 At[4][2], B0[2][2], B1[2][2];
    const int nt = K / 64;
    __syncthreads();
    G8_STAGE(G8_SB(0, 0), Bt, bcol, 0); G8_STAGE(G8_SA(0, 0), A, brow, 0);
    G8_STAGE(G8_SB(0, 1), Bt, bcol + 128, 0); G8_STAGE(G8_SA(0, 1), A, brow + 128, 0);
    if (wr == 1) G8_BAR;
    G8_WAIT_V(4); G8_BAR;
    G8_STAGE(G8_SB(1, 0), Bt, bcol, 1); G8_STAGE(G8_SA(1, 0), A, brow, 1); G8_STAGE(G8_SB(1, 1), Bt, bcol + 128, 1);
    G8_WAIT_V(6); G8_BAR;
    for (int t = 0; t < nt - 2; t += 2) {
        G8_LDB(B0, 0, 0); G8_SCHED; G8_LDA(At, 0, 0); G8_STAGE(G8_SA(1, 1), A, brow + 128, t + 1);
        G8_WAIT_L(8); G8_BAR; G8_WAIT_L(0); G8_MMA(0, 0, At, B0); G8_BAR; G8_SCHED;
        G8_LDB(B1, 0, 1); G8_STAGE(G8_SB(0, 0), Bt, bcol, t + 2);
        G8_BAR; G8_WAIT_L(0); G8_MMA(0, 1, At, B1); G8_BAR;
        G8_LDA(At, 0, 1); G8_STAGE(G8_SA(0, 0), A, brow, t + 2);
        G8_BAR; G8_WAIT_L(0); G8_MMA(1, 0, At, B0); G8_BAR; G8_SCHED;
        G8_STAGE(G8_SB(0, 1), Bt, bcol + 128, t + 2);
        G8_WAIT_V(6); G8_BAR; G8_MMA(1, 1, At, B1); G8_BAR;
        G8_LDB(B0, 1, 0); G8_SCHED; G8_LDA(At, 1, 0); G8_STAGE(G8_SA(0, 1), A, brow + 128, t + 2);
        G8_WAIT_L(8); G8_BAR; G8_WAIT_L(0); G8_MMA(0, 0, At, B0); G8_BAR; G8_SCHED;
        G8_LDB(B1, 1, 1); G8_STAGE(G8_SB(1, 0), Bt, bcol, t + 3);
        G8_BAR; G8_WAIT_L(0); G8_MMA(0, 1, At, B1); G8_BAR;
        G8_LDA(At, 1, 1); G8_STAGE(G8_SA(1, 0), A, brow, t + 3);
        G8_BAR; G8_WAIT_L(0); G8_MMA(1, 0, At, B0); G8_BAR; G8_SCHED;
        G8_STAGE(G8_SB(1, 1), Bt, bcol + 128, t + 3);
        G8_WAIT_V(6); G8_BAR; G8_MMA(1, 1, At, B1); G8_BAR;
    }
    { G8_LDB(B0, 0, 0); G8_LDA(At, 0, 0); G8_STAGE(G8_SA(1, 1), A, brow + 128, nt - 1);
      G8_BAR; G8_WAIT_L(0); G8_MMA(0, 0, At, B0); G8_BAR;
      G8_LDB(B1, 0, 1); G8_BAR; G8_WAIT_L(0); G8_MMA(0, 1, At, B1); G8_BAR;
      G8_LDA(At, 0, 1); G8_WAIT_V(4); G8_BAR; G8_WAIT_L(0); G8_MMA(1, 0, At, B0); G8_MMA(1, 1, At, B1); G8_BAR; }
    { G8_LDB(B0, 1, 0); G8_LDA(At, 1, 0); G8_WAIT_V(2); G8_BAR; G8_WAIT_L(0); G8_MMA(0, 0, At, B0); G8_BAR;
      G8_LDB(B1, 1, 1); G8_WAIT_V(0); G8_BAR; G8_WAIT_L(0); G8_MMA(0, 1, At, B1); G8_BAR;
      G8_LDA(At, 1, 1); G8_BAR; G8_WAIT_L(0); G8_MMA(1, 0, At, B0); G8_MMA(1, 1, At, B1); G8_BAR; }
    if (wr == 0) G8_BAR;
}
__device__ __forceinline__ void g8_zero(f32x4 (&acc)[2][2][4][2]) {
#pragma unroll
    for (int a = 0; a < 2; ++a)
#pragma unroll
        for (int b = 0; b < 2; ++b)
#pragma unroll
            for (int m = 0; m < 4; ++m)
#pragma unroll
                for (int n = 0; n < 2; ++n) acc[a][b][m][n] = (f32x4){0.f, 0.f, 0.f, 0.f};
}
#define G8_FOREACH(body)                                                                                       \
    { const int _tid = fresh_tid(), _wid = _tid >> 6, _lane = _tid & 63, _wr = _wid >> 2, _wc = _wid & 3, _fr = _lane & 15, _fq = _lane >> 4; \
      _Pragma("unroll") for (int ai = 0; ai < 2; ++ai) _Pragma("unroll") for (int bj = 0; bj < 2; ++bj)       \
      _Pragma("unroll") for (int m = 0; m < 4; ++m) _Pragma("unroll") for (int n = 0; n < 2; ++n)             \
      _Pragma("unroll") for (int j = 0; j < 4; ++j) {                                                         \
          const int row = ai * 128 + _wr * 64 + m * 16 + _fq * 4 + j; const int col = bj * 128 + _wc * 32 + n * 16 + _fr; const float val = acc[ai][bj][m][n][j]; body } }

__device__ __forceinline__ bool g2_tile(int bid, int nb, int it, int nM, int nN, int& pm, int& pn) {
    if (nb == 256 && nM == 32) { const int xcd = bid & 7, jj = bid >> 3; pm = 4 * xcd + (jj & 3); pn = 8 * it + (jj >> 2); return pn < nN; }
    const int t = bid + it * nb; pm = t % nM; pn = t / nM; return t < nM * nN;
}

__device__ __forceinline__ void phase_gemm1(const Params& P, int bid, int nb, unsigned char* smem) {
    const bf16_t* A = (const bf16_t*)(P.ws + WS_HN); const bf16_t* Bt = (const bf16_t*)(P.ws + WS_WTIN); bf16_t* C = (bf16_t*)(P.ws + WS_PROJ);
    int pm, pn;
    for (int it = 0; g2_tile(bid, nb, it, T / 256, NPROJ / 256, pm, pn); ++it) {
        f32x4 acc[2][2][4][2]; g8_zero(acc);
        g8_mainloop(A, Bt, D, pm * 256, pn * 256, acc, smem);
        G8_FOREACH({ C[(size_t)(pm * 256 + row) * NPROJ + pn * 256 + col] = f2bf(val); })
    }
}
__device__ __forceinline__ void phase_gemm2(const Params& P, int bid, int nb, unsigned char* smem) {
    const bf16_t* A = (const bf16_t*)(P.ws + WS_MIXED); const bf16_t* Bt = (const bf16_t*)(P.ws + WS_WTOUT); float* H = (float*)(P.ws + WS_H);
    bf16_t* HW = (bf16_t*)(P.ws + WS_HN); float* rss = (float*)(P.ws + WS_RSS);
    int pm, pn;
    for (int it = 0; g2_tile(bid, nb, it, T / 256, D / 256, pm, pn); ++it) {
        f32x4 acc[2][2][4][2]; g8_zero(acc);
        g8_mainloop(A, Bt, D, pm * 256, pn * 256, acc, smem);
        const int tid = fresh_tid(), wid = tid >> 6, lane = tid & 63, wr = wid >> 2, wc = wid & 3, fr = lane & 15, fq = lane >> 4;
#pragma unroll
        for (int ai = 0; ai < 2; ++ai)
#pragma unroll
            for (int m = 0; m < 4; ++m)
#pragma unroll
                for (int j = 0; j < 4; ++j) {
                    const int row = pm * 256 + ai * 128 + wr * 64 + m * 16 + fq * 4 + j;
                    float ss = 0.f;
#pragma unroll
                    for (int bj = 0; bj < 2; ++bj)
#pragma unroll
                        for (int n = 0; n < 2; ++n) {
                            const int col = pn * 256 + bj * 128 + wc * 32 + n * 16 + fr;
                            const size_t o = (size_t)row * D + col;
                            const float v = P.x[o] + acc[ai][bj][m][n][j];
                            H[o] = v; HW[o] = f2bf(v * P.norm_ffn[col]); ss += v * v;
                        }
                    ss += __shfl_xor(ss, 1); ss += __shfl_xor(ss, 2); ss += __shfl_xor(ss, 4); ss += __shfl_xor(ss, 8);
                    if (fr == 0) atomicAdd(rss + row, ss);
                }
    }
}
__device__ __forceinline__ void phase_gemm3(const Params& P, int bid, int nb, unsigned char* smem) {
    const bf16_t* A = (const bf16_t*)(P.ws + WS_HN); const bf16_t* Bt = (const bf16_t*)(P.ws + WS_WTPQ); bf16_t* C = (bf16_t*)(P.ws + WS_Q);
    int pm, pn;
    for (int it = 0; g2_tile(bid, nb, it, T / 256, D / 256, pm, pn); ++it) {
        f32x4 acc[2][2][4][2]; g8_zero(acc);
        g8_mainloop(A, Bt, D, pm * 256, pn * 256, acc, smem);
        const float* rss = (const float*)(P.ws + WS_RSS);
        G8_FOREACH({ const float rs = rsqrtf(rss[pm * 256 + row] * (1.f / 2048.f) + EPS); C[(size_t)(pm * 256 + row) * D + pn * 256 + col] = f2bf(val * rs); })
    }
}
__device__ __forceinline__ void phase_ple(const Params& P, int bid, int nb, unsigned char* smem) {
    const bf16_t* A = (const bf16_t*)(P.ws + WS_PBF); const bf16_t* Bt = (const bf16_t*)(P.ws + WS_WTPP); bf16_t* C = (bf16_t*)P.out;
    for (int t = bid; t < 256; t += nb) {
        const int pm = t & 31, pn = t >> 5;
        f32x4 acc[8][4]; g2_zero(acc);
        g2_mainloop(A + (size_t)pm * 256 * 256, 256, Bt + (size_t)pn * 256 * 256, 256, 256, acc, smem);
        G2_FOREACH({ C[(size_t)(pm * 256 + row) * D + pn * 256 + col] = f2bf(val); })
    }
}
__device__ __forceinline__ void phase_gemm4(const Params& P, int bid, int nb, unsigned char* smem) {
    const bf16_t* A = (const bf16_t*)(P.ws + WS_HN); const bf16_t* Bt = (const bf16_t*)(P.ws + WS_WTG);
    const bf16_t* ple = (const bf16_t*)P.out; float* H = (float*)(P.ws + WS_H);
    int pm, pn;
    for (int it = 0; g2_tile(bid, nb, it, T / 256, D / 256, pm, pn); ++it) {
        f32x4 acc[2][2][4][2]; g8_zero(acc);
        g8_mainloop(A, Bt, D, pm * 256, pn * 256, acc, smem);
        G8_FOREACH({ const size_t o = (size_t)(pm * 256 + row) * D + pn * 256 + col; H[o] = H[o] + sigmoid_f(val) * bf2f(ple[o]); })
    }
}

template <bool OUT_BF16>
__device__ __forceinline__ void phase_rownorm(const float* in, const float* w, void* out, int bid, int nb) {
    const int wave = VTID >> 6, lane = VTID & 63;
    for (int r = bid * 4 + wave; r < T; r += nb * 4) {
        if (OUT_BF16) rmsnorm_row<true>(in + (size_t)r * D, w, (bf16_t*)out + (size_t)r * D, lane);
        else rmsnorm_row<false>(in + (size_t)r * D, w, (float*)out + (size_t)r * D, lane);
    }
}

__device__ __forceinline__ bf16x8 frag_ld(const unsigned char* tile, int row, int ks, int lane) { return *(const bf16x8*)(tile + lds_off(row, ks * 2 + (lane >> 5))); }
__device__ __forceinline__ void lds_st_bf16(unsigned char* tile, int row, int k, float v) { *(bf16_t*)(tile + lds_off(row, k >> 3) + (k & 7) * 2) = f2bf(v); }

__device__ __forceinline__ void d1_chunk(const Params& P, int u, unsigned char* smem) {
    const bf16_t* proj = (const bf16_t*)(P.ws + WS_PROJ);
    int tid_ = VTID; asm volatile("" : "+v"(tid_));
    const int tid = tid_, wave = tid >> 6, lane = tid & 63;
    const int b = u >> 9, h = (u >> 6) & 7, c = u & 63;
    const size_t tok0 = (size_t)b * SEQ + c * 64;
    unsigned char* Ks = smem;
    unsigned char* Qs = smem + 16384;
    unsigned char* Vraw = smem + 16384;
    float* At = (float*)(smem + 34816);
    float* Gs = (float*)(smem + 51200);
    float* Bs = Gs + 64;
    __syncthreads();
    if (wave == 0) {
        const size_t t = tok0 + lane;
        const float a = bf2f(proj[t * NPROJ + C_A + h]), bb = bf2f(proj[t * NPROJ + C_B + h]);
        const float xs = a + P.dt_bias[h];
        const float sp = xs > 20.f ? xs : log1pf(expf(xs));
        float g = -expf(P.a_log[h]) * sp;
#pragma unroll
        for (int o = 1; o < 64; o <<= 1) { const float n = __shfl_up(g, o); if (lane >= o) g += n; }
        Gs[lane] = g; Bs[lane] = 1.f / (1.f + expf(-bb));
    }
    bf16_t* QG = (bf16_t*)(P.ws + WS_QG) + (size_t)u * 64 * 128;
    unsigned char* RAW = smem + 32768;
#pragma unroll 1
    for (int isk = 0; isk < 2; ++isk) {
        const int chb = (isk ? 1024 : 0) + h * 128;
        for (int q = tid; q < 67 * 16; q += 256) {
            const int row = q >> 4, c16 = q & 15;
            uint4 v = make_uint4(0u, 0u, 0u, 0u);
            if (c > 0 || row >= 3) v = *(const uint4*)(proj + (tok0 + row - 3) * NPROJ + chb + c16 * 8);
            *(uint4*)(RAW + row * 256 + c16 * 16) = v;
        }
        const int ch0 = chb + lane * 2;
        const f32x4 cw0 = *(const f32x4*)(P.conv_w + ch0 * 4), cw1 = *(const f32x4*)(P.conv_w + ch0 * 4 + 4);
        __syncthreads();
        for (int tok = wave; tok < 64; tok += 4) {
            float y0 = 0.f, y1 = 0.f;
#pragma unroll
            for (int j = 0; j < 4; ++j) {
                const unsigned pr = *(const unsigned*)(RAW + (tok + j) * 256 + lane * 4);
                y0 += bf2f((bf16_t)(pr & 0xffff)) * cw0[j];
                y1 += bf2f((bf16_t)(pr >> 16)) * cw1[j];
            }
            y0 = silu_f(y0); y1 = silu_f(y1);
            float r = rsqrtf(wave_sum(y0 * y0 + y1 * y1) + EPS);
            if (!isk) r *= 0.08838834764831845f;
            y0 *= r; y1 *= r;
            const int k = lane * 2, half = k >> 6, kk = k & 63;
            *(unsigned*)((isk ? Ks : Qs) + half * 8192 + lds_off(tok, kk >> 3) + (kk & 7) * 2) = pack2(y0, y1);
            if (!isk) { const float eg = expf(Gs[tok]); *(unsigned*)(QG + tok * 128 + k) = pack2(y0 * eg, y1 * eg); }
        }
        __syncthreads();
    }
    {
        const int wr = wave >> 1, wc = wave & 1;
        f32x16 akk, aqk;
#pragma unroll
        for (int r = 0; r < 16; ++r) { akk[r] = 0.f; aqk[r] = 0.f; }
        if (!(wr == 0 && wc == 1)) {
#pragma unroll
            for (int half = 0; half < 2; ++half)
#pragma unroll
                for (int ks = 0; ks < 4; ++ks) {
                    const bf16x8 fk = frag_ld(Ks + half * 8192, wr * 32 + (lane & 31), ks, lane);
                    const bf16x8 fq = frag_ld(Qs + half * 8192, wr * 32 + (lane & 31), ks, lane);
                    const bf16x8 fb = frag_ld(Ks + half * 8192, wc * 32 + (lane & 31), ks, lane);
                    akk = __builtin_amdgcn_mfma_f32_32x32x16_bf16(fk, fb, akk, 0, 0, 0);
                    aqk = __builtin_amdgcn_mfma_f32_32x32x16_bf16(fq, fb, aqk, 0, 0, 0);
                }
        }
        const int j = wc * 32 + (lane & 31); const float Gj = Gs[j];
        bf16_t* ATT = (bf16_t*)(P.ws + WS_ATT) + (size_t)u * 64 * 64;
#pragma unroll
        for (int g4 = 0; g4 < 4; ++g4) {
            const int i0 = wr * 32 + 8 * g4 + 4 * (lane >> 5);
            f32x4 av;
#pragma unroll
            for (int e = 0; e < 4; ++e) {
                const int i = i0 + e, r = g4 * 4 + e;
                const float dec = (i >= j) ? expf(Gs[i] - Gj) : 0.f;
                av[e] = (i > j) ? Bs[i] * akk[r] * dec : 0.f;
                ATT[i * 64 + j] = f2bf(aqk[r] * dec);
            }
            *(f32x4*)(At + j * 64 + i0) = av;
        }
    }
    __syncthreads();
    {
        for (int q = tid; q < 67 * 16; q += 256) {
            const int row = q >> 4, c16 = q & 15;
            uint4 v = make_uint4(0u, 0u, 0u, 0u);
            if (c > 0 || row >= 3) v = *(const uint4*)(proj + (tok0 + row - 3) * NPROJ + 2048 + h * 128 + c16 * 8);
            *(uint4*)(Vraw + row * 256 + c16 * 16) = v;
        }
    }
    __syncthreads();
    {
        float r[64];
        if (tid < 128) {
            const int ch = 2048 + h * 128 + tid;
            const float w0 = P.conv_w[ch * 4 + 0], w1 = P.conv_w[ch * 4 + 1], w2 = P.conv_w[ch * 4 + 2], w3 = P.conv_w[ch * 4 + 3];
            const bf16_t* vcol = (const bf16_t*)Vraw + tid;
            float xm3 = bf2f(vcol[0]), xm2 = bf2f(vcol[128]), xm1 = bf2f(vcol[256]);
#pragma unroll
            for (int i = 0; i < 64; ++i) {
                const float x0 = bf2f(vcol[(i + 3) * 128]);
                const float y = w0 * xm3 + w1 * xm2 + w2 * xm1 + w3 * x0;
                r[i] = Bs[i] * silu_f(y);
                xm3 = xm2; xm2 = xm1; xm1 = x0;
            }
        } else {
            const int dk = tid - 128, half = dk >> 6, kk = dk & 63;
            const float G63 = Gs[63];
            bf16_t* KDT = (bf16_t*)(P.ws + WS_KDT) + (size_t)u * 128 * 64 + dk * 64;
#pragma unroll
            for (int i8 = 0; i8 < 8; ++i8) {
                unsigned pk[4];
#pragma unroll
                for (int e2 = 0; e2 < 4; ++e2) {
                    float kd[2];
#pragma unroll
                    for (int e = 0; e < 2; ++e) {
                        const int i = i8 * 8 + e2 * 2 + e;
                        const float kv = bf2f(*(const bf16_t*)(Ks + half * 8192 + lds_off(i, kk >> 3) + (kk & 7) * 2));
                        const float Gi = Gs[i];
                        r[i] = -Bs[i] * expf(Gi) * kv;
                        kd[e] = kv * expf(G63 - Gi);
                    }
                    pk[e2] = pack2(kd[0], kd[1]);
                }
                *(uint4*)(KDT + i8 * 8) = make_uint4(pk[0], pk[1], pk[2], pk[3]);
            }
        }
#pragma unroll
        for (int j = 0; j < 63; ++j) {
            const float xj = r[j];
#pragma unroll
            for (int i4 = ((j + 1) & ~3); i4 < 64; i4 += 4) {
                const f32x4 a = *(const f32x4*)(At + j * 64 + i4);
                r[i4] -= a[0] * xj; r[i4 + 1] -= a[1] * xj; r[i4 + 2] -= a[2] * xj; r[i4 + 3] -= a[3] * xj;
            }
        }
        if (tid < 128) {
            float* U = (float*)(P.ws + WS_U) + (size_t)u * 64 * 128 + (tid >> 5) * 2048 + (tid & 31);
#pragma unroll
            for (int i = 0; i < 64; ++i) { const int tt = i >> 5, i5 = i & 31, rr = (i5 & 3) + 4 * (i5 >> 3), hh = (i5 >> 2) & 1; U[(tt * 16 + rr) * 64 + hh * 32] = r[i]; }
        } else {
            bf16_t* W = (bf16_t*)(P.ws + WS_W) + (size_t)u * 64 * 128 + (tid - 128);
#pragma unroll
            for (int i = 0; i < 64; ++i) W[i * 128] = f2bf(r[i]);
        }
        if (tid == 0) ((float*)(P.ws + WS_EG))[u] = expf(Gs[63]);
    }
}

__device__ __forceinline__ void r1_chunk(const Params& P, int u, unsigned char* smem) {
    const bf16_t* proj = (const bf16_t*)(P.ws + WS_PROJ);
    int tid_ = VTID; asm volatile("" : "+v"(tid_));
    const int tid = tid_, wave = tid >> 6, lane = tid & 63;
    const int b = u >> 9, h = (u >> 6) & 7, c = u & 63;
    const size_t tok0 = (size_t)b * SEQ + c * 64;
    unsigned char* RQ = smem;
    unsigned char* RK = smem + 8192;
    unsigned char* VT = smem + 16384;
    unsigned char* RKT = smem + 32768;
    const float l2g = log2f(1.f - exp2f(-5.f - (float)h));
    unsigned char* VR = smem + 40960;
    __syncthreads();
    bf16_t* QGR = (bf16_t*)(P.ws + WS_QGR) + (size_t)u * 64 * 64;
    {
        uint4 rq[2], rk[2], rv[4];
#pragma unroll
        for (int i = 0; i < 2; ++i) { const int q = tid + 256 * i, row = q >> 3, ch = q & 7;
            rq[i] = *(const uint4*)(proj + (tok0 + row) * NPROJ + C_RQ + h * 64 + ch * 8); rk[i] = *(const uint4*)(proj + (tok0 + row) * NPROJ + C_RK + h * 64 + ch * 8); }
#pragma unroll
        for (int i = 0; i < 4; ++i) { const int q = tid + 256 * i, row = q >> 4, c16 = q & 15; rv[i] = *(const uint4*)(proj + (tok0 + row) * NPROJ + C_RV + h * 128 + c16 * 8); }
#pragma unroll
        for (int i = 0; i < 2; ++i) { const int q = tid + 256 * i, row = q >> 3, ch = q & 7; *(uint4*)(RQ + lds_off(row, ch)) = rq[i]; *(uint4*)(RK + lds_off(row, ch)) = rk[i]; }
#pragma unroll
        for (int i = 0; i < 4; ++i) { const int q = tid + 256 * i, row = q >> 4, c16 = q & 15; *(uint4*)(VR + row * 256 + c16 * 16) = rv[i]; }
    }
    __syncthreads();
#pragma unroll 1
    for (int it = 0; it < 8; ++it) {
        const int e = tid + 256 * it, tok = e >> 5, i = e & 31;
        const size_t t = tok0 + tok;
        const float inv = powf(10000.f, -(float)i / 32.f);
        const float ang = (float)P.positions[t] * inv;
        float sn, cs; sincosf(ang, &sn, &cs);
        bf16_t* q1p = (bf16_t*)(RQ + lds_off(tok, i >> 3) + (i & 7) * 2); bf16_t* q2p = (bf16_t*)(RQ + lds_off(tok, (32 + i) >> 3) + (i & 7) * 2);
        bf16_t* k1p = (bf16_t*)(RK + lds_off(tok, i >> 3) + (i & 7) * 2); bf16_t* k2p = (bf16_t*)(RK + lds_off(tok, (32 + i) >> 3) + (i & 7) * 2);
        const float q1 = bf2f(*q1p), q2 = bf2f(*q2p), k1 = bf2f(*k1p) * 0.125f, k2 = bf2f(*k2p) * 0.125f;
        const float qa = q1 * cs - q2 * sn, qb = q1 * sn + q2 * cs, ka = k1 * cs - k2 * sn, kb = k1 * sn + k2 * cs;
        const float xi = exp2f(l2g * (float)(tok + 1)), zeta = exp2f(l2g * (float)(63 - tok));
        *q1p = f2bf(qa); *q2p = f2bf(qb); *k1p = f2bf(ka); *k2p = f2bf(kb);
        lds_st_bf16(RKT, i, tok, ka * zeta); lds_st_bf16(RKT, 32 + i, tok, kb * zeta);
        QGR[tok * 64 + i] = f2bf(qa * xi); QGR[tok * 64 + 32 + i] = f2bf(qb * xi);
    }
#pragma unroll 4
    for (int it = 0; it < 16; ++it) {
        const int e = tid + 256 * it, tok = e >> 6, dp = e & 63;
        const unsigned pr = *(const unsigned*)(VR + tok * 256 + dp * 4);
        *(bf16_t*)(VT + lds_off(dp * 2, tok >> 3) + (tok & 7) * 2) = (bf16_t)(pr & 0xffff);
        *(bf16_t*)(VT + lds_off(dp * 2 + 1, tok >> 3) + (tok & 7) * 2) = (bf16_t)(pr >> 16);
    }
    __syncthreads();
    {
        bf16_t* VNTR = (bf16_t*)(P.ws + WS_VNTR) + (size_t)u * 128 * 64;
#pragma unroll
        for (int it = 0; it < 4; ++it) { const int q = tid + 256 * it, row = q >> 3, ch = q & 7; *(uint4*)(VNTR + row * 64 + ch * 8) = *(const uint4*)(VT + lds_off(row, ch)); }
    }
    {
        const int wr = wave >> 1, wc = wave & 1;
        f32x16 acc;
#pragma unroll
        for (int r = 0; r < 16; ++r) acc[r] = 0.f;
        if (!(wr == 0 && wc == 1)) {
#pragma unroll
            for (int ks = 0; ks < 4; ++ks) acc = __builtin_amdgcn_mfma_f32_32x32x16_bf16(frag_ld(RQ, wr * 32 + (lane & 31), ks, lane), frag_ld(RK, wc * 32 + (lane & 31), ks, lane), acc, 0, 0, 0);
        }
        const int j = wc * 32 + (lane & 31);
        bf16_t* ATTR = (bf16_t*)(P.ws + WS_ATTR) + (size_t)u * 64 * 64;
#pragma unroll
        for (int r = 0; r < 16; ++r) {
            const int i = wr * 32 + (r & 3) + 8 * (r >> 2) + 4 * (lane >> 5);
            const float dec = (i >= j) ? exp2f(l2g * (float)(i - j)) : 0.f;
            ATTR[i * 64 + j] = f2bf(acc[r] * dec);
        }
    }
    {
        f32x16 acc[2];
#pragma unroll
        for (int j = 0; j < 2; ++j)
#pragma unroll
            for (int r = 0; r < 16; ++r) acc[j][r] = 0.f;
#pragma unroll
        for (int ks = 0; ks < 4; ++ks) {
            const bf16x8 fa = frag_ld(VT, wave * 32 + (lane & 31), ks, lane);
#pragma unroll
            for (int j = 0; j < 2; ++j) acc[j] = __builtin_amdgcn_mfma_f32_32x32x16_bf16(fa, frag_ld(RKT, j * 32 + (lane & 31), ks, lane), acc[j], 0, 0, 0);
        }
        float* KVT = (float*)(P.ws + WS_KVT) + (size_t)u * 128 * 64;
#pragma unroll
        for (int j = 0; j < 2; ++j)
#pragma unroll
            for (int r = 0; r < 16; ++r) { const int dv = wave * 32 + (r & 3) + 8 * (r >> 2) + 4 * (lane >> 5); KVT[dv * 64 + j * 32 + (lane & 31)] = acc[j][r]; }
    }
}

__device__ __forceinline__ void phase_chunk1(const Params& P, int bid, int nb, unsigned char* smem) {
    for (int u = bid; u < 2048; u += nb) { if (u < 1024) d1_chunk(P, u, smem); else r1_chunk(P, u - 1024, smem); }
}

__device__ __forceinline__ void d2_scan(const Params& P, int bh, unsigned char* smem) {
    const int tid = VTID, wave = tid >> 6, lane = tid & 63;
    unsigned char* Wt = smem;
    unsigned char* KDt = smem + 16384;
    unsigned char* img = smem + 32768 + wave * 8192;
    const int dv0 = wave * 32;
    const size_t cb = (size_t)bh * 64;
    const bf16_t* Wg = (const bf16_t*)(P.ws + WS_W); const bf16_t* KDg = (const bf16_t*)(P.ws + WS_KDT);
    const float* Ug = (const float*)(P.ws + WS_U); const float* EGg = (const float*)(P.ws + WS_EG);
    bf16_t* SCg = (bf16_t*)(P.ws + WS_SC); bf16_t* VNg = (bf16_t*)(P.ws + WS_VNT);
    f32x16 S[4];
#pragma unroll
    for (int d = 0; d < 4; ++d)
#pragma unroll
        for (int r = 0; r < 16; ++r) S[d][r] = 0.f;
    uint4 pw0, pw1, pw2, pw3, pk0, pk1, pk2, pk3;
    __syncthreads();
#define D2_LOAD(uu) { const bf16_t* wp = Wg + (uu) * 8192 + tid * 8; const bf16_t* kp = KDg + (uu) * 8192 + tid * 8; \
        pw0 = *(const uint4*)(wp); pw1 = *(const uint4*)(wp + 2048); pw2 = *(const uint4*)(wp + 4096); pw3 = *(const uint4*)(wp + 6144); \
        pk0 = *(const uint4*)(kp); pk1 = *(const uint4*)(kp + 2048); pk2 = *(const uint4*)(kp + 4096); pk3 = *(const uint4*)(kp + 6144); }
#define D2_ST1(i, vw, vk) { const int q = tid + 256 * (i); { const int row = q >> 4, c16 = q & 15; *(uint4*)(Wt + (c16 >> 3) * 8192 + lds_off(row, c16 & 7)) = (vw); } \
        { const int row = q >> 3, ch = q & 7; *(uint4*)(KDt + lds_off(row, ch)) = (vk); } }
#define D2_STORE() { D2_ST1(0, pw0, pk0) D2_ST1(1, pw1, pk1) D2_ST1(2, pw2, pk2) D2_ST1(3, pw3, pk3) }
    D2_LOAD(cb)
    D2_STORE()
#pragma unroll
    for (int i = 0; i < 8; ++i) { *(uint4*)(img + (lane + 64 * i) * 16) = make_uint4(0u, 0u, 0u, 0u);
        *(uint4*)(SCg + cb * 16384 + wave * 4096 + (lane + 64 * i) * 8) = make_uint4(0u, 0u, 0u, 0u); }
    __syncthreads();
    const int egl = __float_as_int(EGg[cb + lane]);
    f32x16 un0, un1;
#define D2_LOADU(uu) { const float* up = Ug + (uu) * 8192 + wave * 2048 + lane; \
        _Pragma("unroll") for (int r = 0; r < 16; ++r) { un0[r] = up[r * 64]; un1[r] = up[(16 + r) * 64]; } }
    D2_LOADU(cb)
    for (int c = 0; c < 64; ++c) {
        const size_t u = cb + c;
        f32x16 vn0 = un0, vn1 = un1;
        if (c + 1 < 64) {
            D2_LOAD(u + 1)
            D2_LOADU(u + 1)
        }
        const float eg = __int_as_float(__builtin_amdgcn_readlane(egl, c));
#pragma unroll
        for (int half = 0; half < 2; ++half)
#pragma unroll
            for (int ks = 0; ks < 4; ++ks) {
                const bf16x8 fb = frag_ld(img + half * 4096, lane & 31, ks, lane);
                vn0 = __builtin_amdgcn_mfma_f32_32x32x16_bf16(frag_ld(Wt + half * 8192, (lane & 31), ks, lane), fb, vn0, 0, 0, 0);
                vn1 = __builtin_amdgcn_mfma_f32_32x32x16_bf16(frag_ld(Wt + half * 8192, 32 + (lane & 31), ks, lane), fb, vn1, 0, 0, 0);
            }
#define D2_VN(tt, vv) _Pragma("unroll") for (int g4 = 0; g4 < 4; ++g4) { const int r0 = g4 * 4; \
            const uint2 pkd = make_uint2(pack2(vv[r0], vv[r0 + 1]), pack2(vv[r0 + 2], vv[r0 + 3])); \
            const int tok = (tt) * 32 + 8 * g4 + 4 * (lane >> 5); \
            *(uint2*)(img + lds_off(lane & 31, tok >> 3) + (tok & 7) * 2) = pkd; \
            *(uint2*)(VNg + u * 8192 + ((((wave * 2 + (tt)) * 4 + g4) * 64 + lane) * 4)) = pkd; }
        D2_VN(0, vn0) D2_VN(1, vn1)
#pragma unroll
        for (int d = 0; d < 4; ++d)
#pragma unroll
            for (int r = 0; r < 16; ++r) S[d][r] *= eg;
#pragma unroll
        for (int ks = 0; ks < 4; ++ks) {
            const bf16x8 fb = frag_ld(img, lane & 31, ks, lane);
#pragma unroll
            for (int d = 0; d < 4; ++d) S[d] = __builtin_amdgcn_mfma_f32_32x32x16_bf16(frag_ld(KDt, d * 32 + (lane & 31), ks, lane), fb, S[d], 0, 0, 0);
        }
#pragma unroll
        for (int d = 0; d < 4; ++d)
#pragma unroll
            for (int g4 = 0; g4 < 4; ++g4) {
                const int r0 = g4 * 4;
                const uint2 pkd = make_uint2(pack2(S[d][r0], S[d][r0 + 1]), pack2(S[d][r0 + 2], S[d][r0 + 3]));
                const int kk = (d & 1) * 32 + 8 * g4 + 4 * (lane >> 5);
                *(uint2*)(img + (d >> 1) * 4096 + lds_off(lane & 31, kk >> 3) + (kk & 7) * 2) = pkd;
                if (c + 1 < 64) *(uint2*)(SCg + (u + 1) * 16384 + ((((wave * 4 + d) * 4 + g4) * 64 + lane) * 4)) = pkd;
            }
        __syncthreads();
        if (c + 1 < 64) D2_STORE()
        __syncthreads();
    }
}

__device__ __forceinline__ void r2_scan(const Params& P, int vb, int nvb) {
    const float* KVT = (const float*)(P.ws + WS_KVT); bf16_t* STR = (bf16_t*)(P.ws + WS_STR);
    int tid_ = VTID; asm volatile("" : "+v"(tid_));
    for (int idx = vb * 256 + tid_; idx < 16 * 8192; idx += nvb * 256) {
        const int bh = idx >> 13, e = idx & 8191, h = bh & 7;
        const float cd = exp2f(64.f * log2f(1.f - exp2f(-5.f - (float)h)));
        float S = 0.f;
#pragma unroll 8
        for (int c = 0; c < 64; ++c) {
            const size_t o = ((size_t)bh * 64 + c) * 8192 + e;
            STR[o] = f2bf(S);
            S = cd * S + KVT[o];
        }
    }
}

__device__ __forceinline__ void d2_idle() {
    __syncthreads(); __syncthreads();
    for (int c = 0; c < 64; ++c) { __syncthreads(); __syncthreads(); }
}
__device__ __forceinline__ void phase_econv(const Params& P, int bid, int nb, unsigned char* smem);
__device__ __forceinline__ void phase_scan(const Params& P, int bid, int nb, unsigned char* smem, int rbid, int rnb, unsigned char* rsmem) {
    if (rbid < 16) { if ((bid & 1) == 0) d2_scan(P, rbid, smem); else d2_idle(); }
    else {
        phase_ple(P, rbid - 16, rnb - 16, rsmem);
        r2_scan(P, bid - 32, nb - 32);
        phase_econv(P, bid - 32, nb - 32, smem);
    }
}

template <int K1, bool RET>
__device__ __forceinline__ void chunk_out(const Params& P, int u, unsigned char* smem) {
    int tid_ = VTID; asm volatile("" : "+v"(tid_));
    const int tid = tid_, wave = tid >> 6, lane = tid & 63, wr = wave >> 1, wc = wave & 1;
    const int b = u >> 9, h = (u >> 6) & 7, c = u & 63;
    const size_t tok0 = (size_t)b * SEQ + c * 64;
    const bf16_t* A1 = RET ? (const bf16_t*)(P.ws + WS_QGR) + (size_t)u * 64 * 64 : (const bf16_t*)(P.ws + WS_QG) + (size_t)u * 64 * 128;
    const bf16_t* B1 = RET ? (const bf16_t*)(P.ws + WS_STR) + (size_t)u * 128 * 64 : (const bf16_t*)(P.ws + WS_SC) + (size_t)u * 128 * 128;
    const bf16_t* A2 = RET ? (const bf16_t*)(P.ws + WS_ATTR) + (size_t)u * 64 * 64 : (const bf16_t*)(P.ws + WS_ATT) + (size_t)u * 64 * 64;
    const bf16_t* B2 = RET ? (const bf16_t*)(P.ws + WS_VNTR) + (size_t)u * 128 * 64 : (const bf16_t*)(P.ws + WS_VNT) + (size_t)u * 128 * 64;
    unsigned char* As = smem;
    unsigned char* Bs = smem + 8192;
    float* red = (float*)(smem + 24576);
    f32x16 acc[2];
#pragma unroll
    for (int j = 0; j < 2; ++j)
#pragma unroll
        for (int r = 0; r < 16; ++r) acc[j][r] = 0.f;
    constexpr int NK1 = K1 / 64;
#pragma unroll
    for (int kt = 0; kt <= NK1; ++kt) {
        const bf16_t* Ap = (kt < NK1) ? A1 + kt * 64 : A2; const int lda = (kt < NK1) ? K1 : 64;
        const bf16_t* Bp = (kt < NK1) ? B1 + kt * 64 : B2; const int ldb = lda;
        __syncthreads();
#pragma unroll
        for (int i = 0; i < 2; ++i) { const int q = tid + 256 * i, row = q >> 3, ch = q & 7; *(uint4*)(As + lds_off(row, ch)) = *(const uint4*)(Ap + row * lda + ch * 8); }
        if (RET) {
#pragma unroll
            for (int i = 0; i < 4; ++i) { const int q = tid + 256 * i, row = q >> 3, ch = q & 7; *(uint4*)(Bs + lds_off(row, ch)) = *(const uint4*)(Bp + row * ldb + ch * 8); }
        } else {
#pragma unroll
            for (int i = 0; i < 8; ++i) {
                const int q = tid + 256 * i, ln = q & 63, g4 = (q >> 6) & 3, dd = (q >> 8) & 1, w = q >> 9;
                const size_t piece = (kt < NK1) ? (size_t)(((w * 4 + 2 * kt + dd) * 4 + g4) * 64 + ln) : (size_t)(((w * 2 + dd) * 4 + g4) * 64 + ln);
                const bf16_t* src = (kt < NK1) ? B1 : B2;
                const int kk = dd * 32 + 8 * g4 + 4 * (ln >> 5);
                *(uint2*)(Bs + lds_off(w * 32 + (ln & 31), kk >> 3) + (kk & 7) * 2) = *(const uint2*)(src + piece * 4);
            }
        }
        __syncthreads();
#pragma unroll
        for (int ks = 0; ks < 4; ++ks) {
            const bf16x8 fa = frag_ld(As, wr * 32 + (lane & 31), ks, lane);
#pragma unroll
            for (int j = 0; j < 2; ++j) acc[j] = __builtin_amdgcn_mfma_f32_32x32x16_bf16(fa, frag_ld(Bs, wc * 64 + j * 32 + (lane & 31), ks, lane), acc[j], 0, 0, 0);
        }
    }
#pragma unroll
    for (int r = 0; r < 16; ++r) {
        float s1 = acc[0][r] + acc[1][r], s2 = acc[0][r] * acc[0][r] + acc[1][r] * acc[1][r];
#pragma unroll
        for (int o = 16; o >= 1; o >>= 1) { s1 += __shfl_xor(s1, o); s2 += __shfl_xor(s2, o); }
        if ((lane & 31) == 0) { const int row = wr * 32 + (r & 3) + 8 * (r >> 2) + 4 * (lane >> 5); red[(row * 2 + wc) * 2] = s1; red[(row * 2 + wc) * 2 + 1] = s2; }
    }
    __syncthreads();
    const bf16_t* proj = (const bf16_t*)(P.ws + WS_PROJ); bf16_t* mixed = (bf16_t*)(P.ws + WS_MIXED);
#pragma unroll
    for (int r = 0; r < 16; ++r) {
        const int row = wr * 32 + (r & 3) + 8 * (r >> 2) + 4 * (lane >> 5);
        const float s1 = red[row * 4] + red[row * 4 + 2], s2 = red[row * 4 + 1] + red[row * 4 + 3];
        const size_t t = tok0 + row;
#pragma unroll
        for (int j = 0; j < 2; ++j) {
            const int dv = wc * 64 + j * 32 + (lane & 31);
            float y;
            if (!RET) {
                const float rs = rsqrtf(s2 * (1.f / 128.f) + EPS);
                y = acc[j][r] * rs * P.dn_norm[dv] * silu_f(bf2f(proj[t * NPROJ + C_Z + h * 128 + dv]));
                mixed[t * D + h * 128 + dv] = f2bf(y);
            } else {
                const float mu = s1 * (1.f / 128.f);
                const float var = fmaxf(s2 * (1.f / 128.f) - mu * mu, 0.f);
                const float rs = rsqrtf(var + EPS);
                y = ((acc[j][r] - mu) * rs * P.ret_gn_w[h * 128 + dv] + P.ret_gn_b[h * 128 + dv]) * silu_f(bf2f(proj[t * NPROJ + C_RG + h * 128 + dv]));
                mixed[t * D + 1024 + h * 128 + dv] = f2bf(y);
            }
        }
    }
}

__device__ __forceinline__ void phase_chunk3(const Params& P, int bid, int nb, unsigned char* smem) {
    for (int u = bid; u < 2048; u += nb) { if (u < 1024) chunk_out<128, false>(P, u, smem); else chunk_out<64, true>(P, u - 1024, smem); }
}

__device__ __forceinline__ void ins16(float (&l)[16], float x) {
#pragma unroll
    for (int i = 0; i < 16; ++i) { const float hi = fmaxf(l[i], x); x = fminf(l[i], x); l[i] = hi; }
}
__device__ __forceinline__ void phase_route(const Params& P, int bid, int nb, unsigned char* smem) {
    const float* scores = (const float*)(P.ws + WS_SCORES); int* idx = (int*)(P.ws + WS_IDX); float* gates = (float*)(P.ws + WS_GATES);
    int tid_ = VTID; asm volatile("" : "+v"(tid_));
    const int tid = tid_;
    float* tile = (float*)smem;
    unsigned* L = (unsigned*)(smem + 256 * 33 * 4);
    const float NEG = -3.0e38f;
    for (int u = bid; u < 512; u += nb) {
        const size_t R0 = (size_t)u * 256;
        float l[16];
#pragma unroll
        for (int i = 0; i < 16; ++i) l[i] = NEG;
        for (int ch = 0; ch < 4; ++ch) {
            __syncthreads();
#pragma unroll
            for (int i = 0; i < 8; ++i) {
                const int q = tid + 256 * i, row = q >> 3, c4 = q & 7;
                const f32x4 v = *(const f32x4*)(scores + (R0 + row) * 128 + ch * 32 + c4 * 4);
                float* d = tile + row * 33 + c4 * 4; d[0] = v[0]; d[1] = v[1]; d[2] = v[2]; d[3] = v[3];
            }
            __syncthreads();
#pragma unroll
            for (int j = 0; j < 32; ++j) {
                const float x = __uint_as_float((__float_as_uint(tile[tid * 33 + j]) & ~0x7Fu) | (unsigned)(ch * 32 + j));
                ins16(l, x);
            }
        }
#pragma unroll
        for (int i = 0; i < 16; ++i) L[tid * 16 + i] = __float_as_uint(l[i]);
        __syncthreads();
        const int pe = tid & ~1, po = tid | 1;
        float s1[16], s2[16];
#pragma unroll
        for (int i = 0; i < 16; ++i) { s1[i] = __uint_as_float(L[pe * 16 + i]); s2[i] = __uint_as_float(L[po * 16 + i]); }
        float m[16];
#pragma unroll
        for (int i = 0; i < 16; ++i) m[i] = NEG;
#pragma unroll
        for (int i = 0; i < 16; ++i)
#pragma unroll
            for (int j = 0; j < 16; ++j)
                if ((i + 1) * (j + 1) <= 16) ins16(m, __uint_as_float((__float_as_uint(s1[i] + s2[j]) & ~0xFFu) | (unsigned)(i * 16 + j)));
        float e[16], sum = 0.f;
#pragma unroll
        for (int r = 0; r < 16; ++r) { e[r] = __expf(m[r] - m[0]); sum += e[r]; }
        const float inv = 1.f / sum;
        const int par = tid & 1;
        const size_t ob = ((R0 + tid) >> 1) * 16 + par * 8;
#pragma unroll
        for (int r = 0; r < 8; ++r) {
            float k_lo = m[r], k_hi = m[r + 8], e_lo = e[r], e_hi = e[r + 8];
            asm volatile("" : "+v"(k_lo), "+v"(k_hi), "+v"(e_lo), "+v"(e_hi));
            const float key = par ? k_hi : k_lo;
            const float ev = par ? e_hi : e_lo;
            const unsigned cand = __float_as_uint(key) & 0xFFu;
            const unsigned i1 = L[pe * 16 + (cand >> 4)] & 0x7Fu, i2 = L[po * 16 + (cand & 15)] & 0x7Fu;
            idx[ob + r] = (int)(i1 * 128 + i2);
            gates[ob + r] = ev * inv;
        }
    }
}

typedef float f32x2 __attribute__((ext_vector_type(2)));
typedef float v32f __attribute__((ext_vector_type(32)));
typedef float v16f __attribute__((ext_vector_type(16)));
typedef unsigned v6u __attribute__((ext_vector_type(6)));
constexpr int EROW = 1536;
__device__ __forceinline__ void fp6_calibrate(int (&sig)[32]) {
    v16f tlo, thi;
#pragma unroll
    for (int i = 0; i < 16; ++i) { tlo[i] = (i < 8) ? 0.125f * i : 1.f + 0.125f * (i - 8); thi[i] = (i < 8) ? 2.f + 0.25f * i : 4.f + 0.5f * (i - 8); }
    asm volatile("" : "+v"(tlo), "+v"(thi));
    const v6u tw = __builtin_amdgcn_cvt_scalef32_2xpk16_fp6_f32(tlo, thi, 1.0f);
    const v32f tr = __builtin_amdgcn_cvt_scalef32_pk32_f32_fp6(tw, 1.0f);
#pragma unroll
    for (int j = 0; j < 32; ++j) {
        const float v = tr[j];
        const int k = v < 2.f ? (int)(v * 8.f + 0.5f) : (v < 4.f ? 16 + (int)((v - 2.f) * 4.f + 0.5f) : 24 + (int)((v - 4.f) * 2.f + 0.5f));
        sig[j] = __builtin_amdgcn_readfirstlane(k) & 31;
    }
}
__device__ __forceinline__ void phase_econv(const Params& P, int bid, int nb, unsigned char* smem) {
    int tid_ = VTID; asm volatile("" : "+v"(tid_));
    const int wave = tid_ >> 6, lane = tid_ & 63;
    float* scales = (float*)(P.ws + WS_ESC);
    float* pad = (float*)smem + wave * (64 * 33 + 64);
    int* tab = (int*)(pad + 64 * 33);
    int inv[32];
    {
        int sig[32]; fp6_calibrate(sig);
#pragma unroll
        for (int j = 0; j < 32; ++j) if (lane == 0) tab[sig[j]] = j;
#pragma unroll
        for (int k = 0; k < 32; ++k) inv[k] = __builtin_amdgcn_readfirstlane(tab[k]) & 31;
    }
    for (int r = bid * 4 + wave; r < 32768; r += nb * 4) {
        const float* src = (r < 16384 ? P.expert_u : P.expert_v) + (size_t)(r & 16383) * D + lane * 32;
        unsigned char* dst = P.ws + WS_EU8 + (size_t)r * EROW + lane * 24;
        f32x4 v[8]; float am = 0.f;
#pragma unroll
        for (int i = 0; i < 8; ++i) { v[i] = *(const f32x4*)(src + i * 4); am = fmaxf(am, fmaxf(fmaxf(fabsf(v[i][0]), fabsf(v[i][1])), fmaxf(fabsf(v[i][2]), fabsf(v[i][3])))); }
        am = wave_max(am);
        const float sc = am > 0.f ? 7.5f / am : 1.f;
#pragma unroll
        for (int j = 0; j < 32; ++j) pad[lane * 33 + j] = v[j >> 2][j & 3] * sc;
        v16f lo, hi;
#pragma unroll
        for (int k = 0; k < 16; ++k) { lo[k] = pad[lane * 33 + inv[k]]; hi[k] = pad[lane * 33 + inv[16 + k]]; }
        const v6u w = __builtin_amdgcn_cvt_scalef32_2xpk16_fp6_f32(lo, hi, 1.0f);
        *(uint2*)(dst) = make_uint2(w[0], w[1]); *(uint2*)(dst + 8) = make_uint2(w[2], w[3]); *(uint2*)(dst + 16) = make_uint2(w[4], w[5]);
        if (lane == 0) scales[r] = am > 0.f ? am * (1.f / 7.5f) : 1.f;
    }
}

__device__ __forceinline__ float gelu_f(float d) { return 0.5f * d * (1.f + erff(d * 0.70710678118654752f)); }

template <bool DRY>
__device__ __forceinline__ void phase_peer(const Params& P, int bid, int nb) {
    const bf16_t* hn = (const bf16_t*)(P.ws + WS_HN); const int* idx = (const int*)(P.ws + WS_IDX); const float* gates = (const float*)(P.ws + WS_GATES);
    float* H = (float*)(P.ws + WS_H);
    const unsigned char* EU = P.ws + WS_EU8; const unsigned char* EV = P.ws + WS_EU8 + (size_t)16384 * EROW; const float* SC = (const float*)(P.ws + WS_ESC);
    const int wave = VTID >> 6, lane = VTID & 63;
    for (int t = bid * 4 + wave; t < T; t += nb * 4) {
        v32f xr, acc;
#pragma unroll
        for (int q = 0; q < 4; ++q) {
            const uint4 v = *(const uint4*)(hn + (size_t)t * D + lane * 32 + q * 8);
            const unsigned ww[4] = {v.x, v.y, v.z, v.w};
#pragma unroll
            for (int j = 0; j < 4; ++j) { xr[q * 8 + 2 * j] = bf2f((bf16_t)(ww[j] & 0xffff)); xr[q * 8 + 2 * j + 1] = bf2f((bf16_t)(ww[j] >> 16)); }
        }
#pragma unroll
        for (int i = 0; i < 32; ++i) acc[i] = 0.f;
        const float rs_t = rsqrtf(((const float*)(P.ws + WS_RSS))[t] * (1.f / 2048.f) + EPS);
        const int   my_i0 = idx[(size_t)t * 128 + lane],   my_i1 = idx[(size_t)t * 128 + 64 + lane];
        const float my_g0 = gates[(size_t)t * 128 + lane], my_g1 = gates[(size_t)t * 128 + 64 + lane];
        uint2 a_u0, a_u1, a_u2, a_v0, a_v1, a_v2, b_u0, b_u1, b_u2, b_v0, b_v1, b_v2, c_u0, c_u1, c_u2, c_v0, c_v1, c_v2;
#define PEER_LOAD1(U0, U1, U2, V0, V1, V2, e) { const uint2* up = (const uint2*)(EU + (size_t)(e) * EROW + lane * 24); U0 = up[0]; U1 = up[1]; U2 = up[2]; \
                                                 const uint2* vp = (const uint2*)(EV + (size_t)(e) * EROW + lane * 24); V0 = vp[0]; V1 = vp[1]; V2 = vp[2]; }
#define PEER_COMP1(U0, U1, U2, V0, V1, V2, e, g) { const v6u uw = {U0.x, U0.y, U1.x, U1.y, U2.x, U2.y}; const v32f uf = __builtin_amdgcn_cvt_scalef32_pk32_f32_fp6(uw, 1.0f); \
        float d = 0.f; _Pragma("unroll") for (int i = 0; i < 32; ++i) d += uf[i] * xr[i]; d = wave_sum(d); \
        const float pre = d * SC[e] * rs_t; const float a = gelu_f(pre) * (g) * SC[16384 + (e)]; \
        const v6u vw = {V0.x, V0.y, V1.x, V1.y, V2.x, V2.y}; const v32f vf = __builtin_amdgcn_cvt_scalef32_pk32_f32_fp6(vw, 1.0f); \
        _Pragma("unroll") for (int i = 0; i < 32; ++i) acc[i] += a * vf[i]; __builtin_amdgcn_sched_barrier(0); }
#define PEER_E(k) ((k) < 64 ? __builtin_amdgcn_readlane(my_i0, (k)) : __builtin_amdgcn_readlane(my_i1, (k) - 64))
#define PEER_G(k) __int_as_float((k) < 64 ? __builtin_amdgcn_readlane(__float_as_int(my_g0), (k)) : __builtin_amdgcn_readlane(__float_as_int(my_g1), (k) - 64))
        { const int e0 = PEER_E(0), e1 = PEER_E(1); PEER_LOAD1(a_u0, a_u1, a_u2, a_v0, a_v1, a_v2, e0) PEER_LOAD1(b_u0, b_u1, b_u2, b_v0, b_v1, b_v2, e1) }
        for (int k = 0; k < 126; k += 3) {
            { const int e2 = PEER_E(k + 2); PEER_LOAD1(c_u0, c_u1, c_u2, c_v0, c_v1, c_v2, e2) }
            { const int e0 = PEER_E(k); const float g0 = PEER_G(k); PEER_COMP1(a_u0, a_u1, a_u2, a_v0, a_v1, a_v2, e0, g0) }
            { const int e3 = PEER_E(k + 3); PEER_LOAD1(a_u0, a_u1, a_u2, a_v0, a_v1, a_v2, e3) }
            { const int e1 = PEER_E(k + 1); const float g1 = PEER_G(k + 1); PEER_COMP1(b_u0, b_u1, b_u2, b_v0, b_v1, b_v2, e1, g1) }
            { const int e4 = PEER_E(k + 4); PEER_LOAD1(b_u0, b_u1, b_u2, b_v0, b_v1, b_v2, e4) }
            { const int e2 = PEER_E(k + 2); const float g2 = PEER_G(k + 2); PEER_COMP1(c_u0, c_u1, c_u2, c_v0, c_v1, c_v2, e2, g2) }
        }
        { const int e0 = PEER_E(126); const float g0 = PEER_G(126); PEER_COMP1(a_u0, a_u1, a_u2, a_v0, a_v1, a_v2, e0, g0) }
        { const int e1 = PEER_E(127); const float g1 = PEER_G(127); PEER_COMP1(b_u0, b_u1, b_u2, b_v0, b_v1, b_v2, e1, g1) }
        if (DRY) {
#pragma unroll
            for (int i = 0; i < 32; ++i) asm volatile("" :: "v"(acc[i]));
            continue;
        }
        float ss = 0.f;
#pragma unroll
        for (int q = 0; q < 8; ++q) {
            f32x4* hp = (f32x4*)(H + (size_t)t * D + lane * 32 + q * 4);
            f32x4 hv = *hp;
#pragma unroll
            for (int j = 0; j < 4; ++j) { hv[j] += acc[q * 4 + j]; acc[q * 4 + j] = hv[j]; ss += hv[j] * hv[j]; }
            *hp = hv;
        }
        ss = wave_sum(ss);
        const float rs = rsqrtf(ss * (1.f / 2048.f) + EPS);
        bf16_t* hn3 = (bf16_t*)(P.ws + WS_HN) + (size_t)t * D + lane * 32;
#pragma unroll
        for (int q = 0; q < 4; ++q) {
            unsigned w[4];
#pragma unroll
            for (int j = 0; j < 4; ++j) { const int col = lane * 32 + q * 8 + 2 * j;
                w[j] = pack2(acc[q * 8 + 2 * j] * rs * P.norm_ple[col], acc[q * 8 + 2 * j + 1] * rs * P.norm_ple[col + 1]); }
            *(uint4*)(hn3 + q * 8) = make_uint4(w[0], w[1], w[2], w[3]);
        }
    }
}

enum { PH_PREP = 0, PH_GEMM1, PH_CHUNK1, PH_SCAN, PH_CHUNK3, PH_GEMM2, PH_GEMM3, PH_SCORES, PH_ROUTE, PH_PEER, PH_GEMM4, PH_FINAL, PH_COUNT };

#define XB_TMO      128
#define XB_XCNT(j)  (256  + 64 * (j))
#define XB_XSUB(j)  (1280 + 64 * (j))
#define XB_XGEN(j)  (2304 + 64 * (j))
#define XB_TOP      3328
#define XB_TOPGEN   3392
#define XCD_BAR_WORDS 3456
#define XB_SPIN_CAP (1u << 20)
#define LAS __attribute__((address_space(3)))
__device__ __forceinline__ unsigned xb_ld(unsigned* p)              { return __hip_atomic_load(p, __ATOMIC_RELAXED, __HIP_MEMORY_SCOPE_AGENT); }
__device__ __forceinline__ unsigned xb_add(unsigned* p, unsigned v) { return __hip_atomic_fetch_add(p, v, __ATOMIC_RELAXED, __HIP_MEMORY_SCOPE_AGENT); }
__device__ __forceinline__ unsigned xb_xcc_id() { return (unsigned)__builtin_amdgcn_s_getreg((3 << 11) | 20) & 0xFu; }
#define XB_SPIN(cond, bar) do { unsigned _sp = 0; while (cond) { __builtin_amdgcn_s_sleep(1); \
    if ((++_sp & 255u) == 0u) { if (xb_ld(&(bar)[XB_TMO])) break; if (_sp > XB_SPIN_CAP) { atomicAdd(&(bar)[XB_TMO], 1u); break; } } } } while (0)
struct XcdBarrier { unsigned* bar; unsigned x; volatile LAS unsigned* st; };
__device__ __forceinline__ XcdBarrier xcd_barrier_post(unsigned* bar, volatile LAS unsigned* st) {
    XcdBarrier b; b.bar = bar; b.x = xb_xcc_id(); b.st = st;
    if (threadIdx.x == 0) (void)xb_add(&bar[XB_XCNT(b.x)], 1u);
    return b;
}
__device__ __forceinline__ void xcd_barrier_complete(unsigned* bar, unsigned x, unsigned& nloc, unsigned& nx) {
    const unsigned G = gridDim.x * gridDim.y * gridDim.z;
    unsigned sum, cnt, mine, sp = 0u;
    for (;;) {
        sum = 0u; cnt = 0u; mine = 0u;
#pragma unroll
        for (unsigned j = 0; j < 16; ++j) { const unsigned c = xb_ld(&bar[XB_XCNT(j)]); sum += c; cnt += (c > 0u) ? 1u : 0u; mine = (j == x) ? c : mine; }
        if (sum == G) break;
        __builtin_amdgcn_s_sleep(1);
        if ((++sp & 255u) == 0u) { if (xb_ld(&bar[XB_TMO])) break; if (sp > XB_SPIN_CAP) { atomicAdd(&bar[XB_TMO], 1u); break; } }
    }
    nloc = mine > 0u ? mine : 1u; nx = cnt > 0u ? cnt : 1u;
}
__device__ __forceinline__ void xcd_barrier(const XcdBarrier& b) {
    asm volatile("s_waitcnt vmcnt(0)" ::: "memory");
    __syncthreads();
    if (threadIdx.x == 0) {
        unsigned* bar = b.bar;
        __builtin_amdgcn_s_waitcnt(0);
        unsigned nloc = b.st[0], nx = b.st[1];
        if (nloc == 0u) { xcd_barrier_complete(bar, b.x, nloc, nx); b.st[0] = nloc; b.st[1] = nx; }
        const unsigned old = xb_add(&bar[XB_XSUB(b.x)], 1u);
        const unsigned gen = old / nloc;
        if (old + 1u == (gen + 1u) * nloc) {
            __builtin_amdgcn_fence(__ATOMIC_RELEASE, "agent");
            asm volatile("s_waitcnt vmcnt(0)" ::: "memory");
            const unsigned og = xb_add(&bar[XB_TOP], 1u);
            const unsigned tg = og / nx;
            if (og + 1u == (tg + 1u) * nx) xb_add(&bar[XB_TOPGEN], 1u);
            else XB_SPIN(xb_ld(&bar[XB_TOPGEN]) == tg, bar);
            __builtin_amdgcn_fence(__ATOMIC_ACQUIRE, "agent");
            xb_add(&bar[XB_XGEN(b.x)], 1u);
            asm volatile("s_waitcnt vmcnt(0)" ::: "memory");
        } else {
            XB_SPIN(xb_ld(&bar[XB_XGEN(b.x)]) == gen, bar);
            __builtin_amdgcn_fence(__ATOMIC_ACQUIRE, "agent");
            asm volatile("s_waitcnt vmcnt(0)" ::: "memory");
        }
    }
    __syncthreads();
}

__device__ __forceinline__ void run_phase(const Params& P, int ph, int bid, int nb, unsigned char* smem, int rbid, int rnb, unsigned char* rsmem) {
    switch (ph) {
        case PH_PREP:   phase_prep(P, bid, nb, smem); break;
        case PH_GEMM1:  phase_gemm1(P, rbid, rnb, rsmem); break;
        case PH_CHUNK1: phase_chunk1(P, bid, nb, smem); break;
        case PH_SCAN:   phase_scan(P, bid, nb, smem, rbid, rnb, rsmem); break;
        case PH_CHUNK3: phase_chunk3(P, bid, nb, smem); break;
        case PH_GEMM2:  phase_gemm2(P, rbid, rnb, rsmem); break;
        case PH_GEMM3:  phase_gemm3(P, rbid, rnb, rsmem); break;
        case PH_SCORES: phase_scores(P, bid, nb, smem); break;
        case PH_ROUTE:  phase_route(P, bid, nb, smem); break;
        case PH_PEER:   phase_peer<false>(P, bid, nb); break;
        case PH_PEER + 100: phase_peer<true>(P, bid, nb); break;
        case PH_GEMM4:  phase_gemm4(P, rbid, rnb, rsmem); break;
        case PH_FINAL:  phase_rownorm<false>((const float*)(P.ws + WS_H), P.norm_final, P.out, bid, nb); break;
    }
}

#ifndef PROBE_A
#define PROBE_A -1
#endif
#ifndef PROBE_B
#define PROBE_B -1
#endif
constexpr int LDS_BYTES = 131072 + 16 + 256;

__global__ void __launch_bounds__(512, 2) fwd_kernel(Params P, int ph_lo, int ph_hi) {
    extern __shared__ __attribute__((aligned(16))) unsigned char rsmem[];
    const int rbid = blockIdx.x, rnb = gridDim.x;
    const int half = __builtin_amdgcn_readfirstlane((int)(threadIdx.x >> 8));
    const int bid = rbid * 2 + half, nb = rnb * 2;
    unsigned char* smem = rsmem + half * 65536;
    volatile LAS unsigned* st = (volatile LAS unsigned*)(rsmem + 131072);
    if (threadIdx.x == 0) { st[0] = 0u; st[1] = 0u; }
    __syncthreads();
    XcdBarrier xb = xcd_barrier_post((unsigned*)(P.ws + WS_BAR), st);
#if PROBE_A >= 0
    unsigned long long* tstamp = (unsigned long long*)(rsmem + 131072 + 16);
    xcd_barrier(xb);
    if (threadIdx.x == 0) tstamp[0] = __builtin_amdgcn_s_memrealtime();
#define RUN(ph) if (ph_lo <= (ph) && (ph) < ph_hi) { run_phase(P, (ph), bid, nb, smem, rbid, rnb, rsmem); xcd_barrier(xb); if (threadIdx.x == 0) tstamp[(ph) + 1] = __builtin_amdgcn_s_memrealtime(); }
#else
#ifndef REPEAT_PH
#define REPEAT_PH -1
#endif
#define RUN(ph) if (ph_lo <= (ph) && (ph) < ph_hi) { if ((ph) == REPEAT_PH && (ph) == PH_PEER) { run_phase(P, PH_PEER + 100, bid, nb, smem, rbid, rnb, rsmem); xcd_barrier(xb); } run_phase(P, (ph), bid, nb, smem, rbid, rnb, rsmem); if ((ph) == REPEAT_PH && (ph) != PH_PEER) { xcd_barrier(xb); run_phase(P, (ph) == PH_PEER ? PH_PEER + 100 : (ph), bid, nb, smem, rbid, rnb, rsmem); } if ((ph) + 1 < ph_hi) xcd_barrier(xb); }
#endif
    RUN(PH_PREP) RUN(PH_GEMM1) RUN(PH_CHUNK1) RUN(PH_SCAN) RUN(PH_CHUNK3) RUN(PH_GEMM2) RUN(PH_GEMM3) RUN(PH_SCORES) RUN(PH_ROUTE)
    RUN(PH_PEER) RUN(PH_GEMM4) RUN(PH_FINAL)
#if PROBE_A >= 0
    __syncthreads();
    if (rbid == 0) {
        const float da = (float)(tstamp[PROBE_A + 1] - tstamp[PROBE_A]) * 0.01f;
        if (threadIdx.x == 0) P.out[0] = da;
#if PROBE_B >= 0
        const float db = (float)(tstamp[PROBE_B + 1] - tstamp[PROBE_B]) * 0.01f * (1.f / 16.f);
        for (int i = threadIdx.x; i < 65536; i += 512) P.out[65536 + i] = db;
#endif
    }
#endif
}

extern "C" void kernel_launch(void* const* d_in, const int* in_sizes, int n_in, void* d_out, int out_size, void* d_ws, size_t ws_size, hipStream_t stream) {
    static int grid = 0;
    if (grid == 0) {
        if (n_in != 21 || out_size != T * D || ws_size < WS_END) { fprintf(stderr, "kernel_launch: unexpected shapes: n_in %d out %d ws %zu (need %zu)\n", n_in, out_size, ws_size, (size_t)WS_END); grid = -1; return; }
        if (hipFuncSetAttribute((const void*)fwd_kernel, hipFuncAttributeMaxDynamicSharedMemorySize, LDS_BYTES) != hipSuccess) { fprintf(stderr, "kernel_launch: hipFuncSetAttribute failed\n"); grid = -1; return; }
        int dev = 0, cus = 0, per_cu = 0;
        hipGetDevice(&dev); hipDeviceGetAttribute(&cus, hipDeviceAttributeMultiprocessorCount, dev);
        if (hipOccupancyMaxActiveBlocksPerMultiprocessor(&per_cu, (const void*)fwd_kernel, 512, LDS_BYTES) != hipSuccess || per_cu < 1) { fprintf(stderr, "kernel_launch: occupancy query failed (%d)\n", per_cu); grid = -1; return; }
        if (per_cu > 1) per_cu = 1;
        grid = cus * per_cu;
        fprintf(stderr, "kernel_launch: grid %d (%d CUs x %d)\n", grid, cus, per_cu);
    }
    if (grid < 0) return;
    Params P{};
    P.x = (const float*)d_in[0]; P.p = (const float*)d_in[1]; P.positions = (const int*)d_in[2]; P.norm_mix = (const float*)d_in[3]; P.w_in = (const float*)d_in[4];
    P.conv_w = (const float*)d_in[5]; P.a_log = (const float*)d_in[6]; P.dt_bias = (const float*)d_in[7]; P.dn_norm = (const float*)d_in[8]; P.ret_gn_w = (const float*)d_in[9];
    P.ret_gn_b = (const float*)d_in[10]; P.w_out = (const float*)d_in[11]; P.norm_ffn = (const float*)d_in[12]; P.w_pq = (const float*)d_in[13]; P.sub_keys = (const float*)d_in[14];
    P.expert_u = (const float*)d_in[15]; P.expert_v = (const float*)d_in[16]; P.norm_ple = (const float*)d_in[17]; P.w_ple_gate = (const float*)d_in[18]; P.w_ple_proj = (const float*)d_in[19];
    P.norm_final = (const float*)d_in[20]; P.out = (float*)d_out; P.ws = (unsigned char*)d_ws;
    (void)hipMemsetAsync((unsigned char*)d_ws + WS_BAR, 0, XCD_BAR_WORDS * 4, stream);
    int lo = 0, hi = PH_COUNT;
    void* args[] = {&P, &lo, &hi};
    hipError_t e = hipLaunchCooperativeKernel((const void*)fwd_kernel, dim3(grid), dim3(512), args, LDS_BYTES, stream);
    if (e != hipSuccess) fprintf(stderr, "kernel_launch: cooperative launch failed: %s (grid %d)\n", hipGetErrorString(e), grid);
}
```

```cpp
#include <hip/hip_runtime.h>
#include <cstdio>
#include <cstdint>

typedef unsigned short bf16_t;
typedef short bf16x8 __attribute__((ext_vector_type(8)));
typedef float f32x16 __attribute__((ext_vector_type(16)));
typedef float f32x4 __attribute__((ext_vector_type(4)));
__device__ __forceinline__ int fresh_tid() { int t = (int)threadIdx.x; asm volatile("" : "+v"(t)); return t; }
#define VTID (fresh_tid() & 255)

constexpr int T = 8192, D = 2048, SEQ = 4096;
constexpr int NPROJ = 7424;
constexpr int C_Z = 3072, C_RQ = 4096, C_RK = 4608, C_RV = 5120, C_RG = 6144, C_A = 7168, C_B = 7176;
constexpr int IN_COLS = 7184;
constexpr float EPS = 1e-6f;

constexpr size_t WS_HN    = 0;
constexpr size_t WS_KVT   = WS_HN;
constexpr size_t WS_WTIN  = WS_HN + (size_t)T * D * 2;
constexpr size_t WS_STR   = WS_WTIN;
constexpr size_t WS_ATTR  = WS_STR + (size_t)1024 * 128 * 64 * 2;
constexpr size_t WS_WTOUT = WS_WTIN + (size_t)NPROJ * D * 2;
constexpr size_t WS_WTPQ  = WS_WTOUT + (size_t)D * D * 2;
constexpr size_t WS_WTG   = WS_WTPQ + (size_t)D * D * 2;
constexpr size_t WS_WTPP  = WS_WTG + (size_t)D * D * 2;
constexpr size_t WS_KEYS  = WS_WTPP + (size_t)D * 256 * 2;
constexpr size_t WS_PBF   = WS_KEYS + (size_t)16 * 128 * 128 * 2;
constexpr size_t WS_PROJ  = WS_PBF + (size_t)T * 256 * 2;
constexpr size_t WS_Q     = WS_PROJ;
constexpr size_t WS_SCORES= WS_PROJ + (size_t)T * D * 2;
constexpr size_t WS_MIXED = WS_PROJ + (size_t)T * NPROJ * 2;
constexpr size_t WS_H     = WS_MIXED + (size_t)T * D * 2;
constexpr size_t WS_IDX   = WS_H + (size_t)T * D * 4;
constexpr size_t WS_GATES = WS_IDX + (size_t)T * 128 * 4;
constexpr size_t WS_U     = WS_GATES + (size_t)T * 128 * 4;
constexpr size_t WS_W     = WS_U + (size_t)1024 * 64 * 128 * 4;
constexpr size_t WS_KDT   = WS_W + (size_t)1024 * 64 * 128 * 2;
constexpr size_t WS_QG    = WS_KDT + (size_t)1024 * 128 * 64 * 2;
constexpr size_t WS_ATT   = WS_QG + (size_t)1024 * 64 * 128 * 2;
constexpr size_t WS_QGR   = WS_ATT + (size_t)1024 * 64 * 64 * 2;
constexpr size_t WS_EU8   = WS_QGR + (size_t)1024 * 64 * 64 * 2;
constexpr size_t WS_EV8   = WS_EU8 + (size_t)16384 * 2048;
constexpr size_t WS_ESC   = WS_EV8 + (size_t)16384 * 2048;
constexpr size_t WS_EG    = WS_ESC + (size_t)2 * 16384 * 4;
constexpr size_t WS_RSS   = WS_EG + 4096;
constexpr size_t WS_BAR   = WS_RSS + (size_t)T * 4;
constexpr size_t WS_END   = WS_BAR + 16384;
constexpr size_t WS_VNT   = WS_H;
constexpr size_t WS_SC    = WS_VNT + (size_t)1024 * 128 * 64 * 2;
constexpr size_t WS_VNTR  = WS_SC + (size_t)1024 * 128 * 128 * 2;
static_assert(WS_VNTR + (size_t)1024 * 128 * 64 * 2 == WS_H + (size_t)T * D * 4, "chunk buffers must fit the H region");

struct Params {
    const float *x, *p; const int* positions;
    const float *norm_mix, *w_in, *conv_w, *a_log, *dt_bias, *dn_norm, *ret_gn_w, *ret_gn_b, *w_out, *norm_ffn, *w_pq, *sub_keys,
                *expert_u, *expert_v, *norm_ple, *w_ple_gate, *w_ple_proj, *norm_final;
    float* out; unsigned char* ws;
};

typedef __bf16 bf16v2_t __attribute__((ext_vector_type(2)));
typedef float f32v2_t __attribute__((ext_vector_type(2)));
__device__ __forceinline__ bf16_t f2bf(float f) { return __builtin_bit_cast(bf16_t, (__bf16)f); }
__device__ __forceinline__ float bf2f(bf16_t h) { return __uint_as_float(((unsigned)h) << 16); }
__device__ __forceinline__ unsigned pack2(float a, float b) { const f32v2_t v = {a, b}; return __builtin_bit_cast(unsigned, __builtin_convertvector(v, bf16v2_t)); }
__device__ __forceinline__ float wave_sum(float v) {
#pragma unroll
    for (int o = 32; o >= 1; o >>= 1) v += __shfl_xor(v, o);
    return v;
}
__device__ __forceinline__ float wave_max(float v) {
#pragma unroll
    for (int o = 32; o >= 1; o >>= 1) v = fmaxf(v, __shfl_xor(v, o));
    return v;
}
__device__ __forceinline__ float silu_f(float x) { return x / (1.f + __expf(-x)); }
__device__ __forceinline__ float sigmoid_f(float x) { return 1.f / (1.f + __expf(-x)); }

template <bool MAPIN>
__device__ __forceinline__ void transpose_tile(const float* __restrict__ W, int ldw, int K, bf16_t* __restrict__ Wt, int kt, int nt, float* tile  ) {
    const int tid = VTID;
    __syncthreads();
#pragma unroll
    for (int i = 0; i < 4; ++i) {
        const int idx = tid + 256 * i, kr = idx >> 4, c4 = idx & 15;
        const int n = nt * 64 + c4 * 4;
        int c = n; bool valid = true;
        if (MAPIN) { if (n < 4096) c = n; else if (n < 7168) c = n + 16; else if (n < 7184) c = n - 3072; else valid = false; }
        f32x4 v = {0.f, 0.f, 0.f, 0.f};
        if (valid) v = *(const f32x4*)(W + (size_t)(kt * 64 + kr) * ldw + c);
        float* d = tile + kr * 65 + c4 * 4;
        d[0] = v[0]; d[1] = v[1]; d[2] = v[2]; d[3] = v[3];
    }
    __syncthreads();
#pragma unroll
    for (int i = 0; i < 2; ++i) {
        const int ch = tid + 256 * i, n = ch >> 3, kc = ch & 7;
        unsigned w[4];
#pragma unroll
        for (int j = 0; j < 4; ++j) w[j] = pack2(tile[(kc * 8 + 2 * j) * 65 + n], tile[(kc * 8 + 2 * j + 1) * 65 + n]);
        uint4 o = make_uint4(w[0], w[1], w[2], w[3]);
        *(uint4*)(Wt + (size_t)(nt * 64 + n) * K + kt * 64 + kc * 8) = o;
    }
}

template <bool OUT_BF16>
__device__ __forceinline__ void rmsnorm_row(const float* __restrict__ in, const float* __restrict__ w, void* __restrict__ out, int lane) {
    f32x4 v[8]; float ss = 0.f;
#pragma unroll
    for (int i = 0; i < 8; ++i) { v[i] = *(const f32x4*)(in + (i * 64 + lane) * 4); ss += v[i][0] * v[i][0] + v[i][1] * v[i][1] + v[i][2] * v[i][2] + v[i][3] * v[i][3]; }
    ss = wave_sum(ss);
    const float r = rsqrtf(ss * (1.f / 2048.f) + EPS);
#pragma unroll
    for (int i = 0; i < 8; ++i) {
        const f32x4 g = *(const f32x4*)(w + (i * 64 + lane) * 4);
        const float a = v[i][0] * r * g[0], b = v[i][1] * r * g[1], c = v[i][2] * r * g[2], d = v[i][3] * r * g[3];
        if (OUT_BF16) { uint2 o = make_uint2(pack2(a, b), pack2(c, d)); *(uint2*)((bf16_t*)out + (i * 64 + lane) * 4) = o; }
        else { f32x4 o = {a, b, c, d}; *(f32x4*)((float*)out + (i * 64 + lane) * 4) = o; }
    }
}

__device__ __forceinline__ void phase_prep(const Params& P, int bid, int nb, unsigned char* smem) {
    float* tile = (float*)smem;
    const int tid = VTID;
    const int n_in = 32 * 116, n_sq = 32 * 32, n_pp = 4 * 32;
    const int n_tr = n_in + 3 * n_sq + n_pp;
    for (int u = bid; u < n_tr; u += nb) {
        if (u < n_in) transpose_tile<true>(P.w_in, IN_COLS, D, (bf16_t*)(P.ws + WS_WTIN), u % 32, u / 32, tile);
        else if (u < n_in + n_sq) { const int v = u - n_in; transpose_tile<false>(P.w_out, D, D, (bf16_t*)(P.ws + WS_WTOUT), v % 32, v / 32, tile); }
        else if (u < n_in + 2 * n_sq) { const int v = u - n_in - n_sq; transpose_tile<false>(P.w_pq, D, D, (bf16_t*)(P.ws + WS_WTPQ), v % 32, v / 32, tile); }
        else if (u < n_in + 3 * n_sq) { const int v = u - n_in - 2 * n_sq; transpose_tile<false>(P.w_ple_gate, D, D, (bf16_t*)(P.ws + WS_WTG), v % 32, v / 32, tile); }
        else { const int v = u - n_in - 3 * n_sq; transpose_tile<false>(P.w_ple_proj, D, 256, (bf16_t*)(P.ws + WS_WTPP), v % 4, v / 4, tile); }
    }
    {
        bf16_t* keys = (bf16_t*)(P.ws + WS_KEYS); bf16_t* pbf = (bf16_t*)(P.ws + WS_PBF);
        const int n4a = 262144 / 4, n4b = T * 256 / 4;
        for (int i = bid * 256 + tid; i < n4a + n4b; i += nb * 256) {
            const bool a = i < n4a; const int j = a ? i : i - n4a;
            const f32x4 v = *(const f32x4*)((a ? P.sub_keys : P.p) + (size_t)j * 4);
            *(uint2*)((a ? keys : pbf) + (size_t)j * 4) = make_uint2(pack2(v[0], v[1]), pack2(v[2], v[3]));
        }
    }
    { float* rss = (float*)(P.ws + WS_RSS); for (int i = bid * 256 + tid; i < T; i += nb * 256) rss[i] = 0.f; }
    {
        const int wave = tid >> 6, lane = tid & 63;
        bf16_t* hn = (bf16_t*)(P.ws + WS_HN);
        for (int r = bid * 4 + wave; r < T; r += nb * 4) rmsnorm_row<true>(P.x + (size_t)r * D, P.norm_mix, hn + (size_t)r * D, lane);
    }
}

__device__ __forceinline__ int lds_off(int row, int ch) { return row * 128 + ((ch ^ ((row >> 1) & 7)) << 4); }

__device__ __forceinline__ void gemm_mainloop(const bf16_t* __restrict__ A, int lda, const bf16_t* __restrict__ Bt, int ldb, int K,
                                              f32x16 (&acc)[2][2], unsigned char* smem) {
    const int tid = VTID, wave = tid >> 6, lane = tid & 63, wr = wave >> 1, wc = wave & 1;
    const int nk = K / 64;
    uint4 ra[4], rb[4];
    __syncthreads();
#pragma unroll
    for (int i = 0; i < 4; ++i) { const int c = tid + 256 * i, row = c >> 3, ch = c & 7;
        ra[i] = *(const uint4*)(A + (size_t)row * lda + ch * 8); rb[i] = *(const uint4*)(Bt + (size_t)row * ldb + ch * 8); }
#pragma unroll
    for (int i = 0; i < 4; ++i) { const int c = tid + 256 * i, row = c >> 3, ch = c & 7;
        *(uint4*)(smem + lds_off(row, ch)) = ra[i]; *(uint4*)(smem + 16384 + lds_off(row, ch)) = rb[i]; }
    __syncthreads();
    for (int kt = 0; kt < nk; ++kt) {
        unsigned char* cur = smem + (kt & 1) * 32768;
        unsigned char* nxt = smem + ((kt + 1) & 1) * 32768;
        const bool more = kt + 1 < nk;
        if (more) {
#pragma unroll
            for (int i = 0; i < 4; ++i) { const int c = tid + 256 * i, row = c >> 3, ch = c & 7;
                ra[i] = *(const uint4*)(A + (size_t)row * lda + (kt + 1) * 64 + ch * 8); rb[i] = *(const uint4*)(Bt + (size_t)row * ldb + (kt + 1) * 64 + ch * 8); }
        }
#pragma unroll
        for (int ks = 0; ks < 4; ++ks) {
            bf16x8 af[2], bfr[2];
#pragma unroll
            for (int i = 0; i < 2; ++i) { const int row = wr * 64 + i * 32 + (lane & 31); af[i] = *(const bf16x8*)(cur + lds_off(row, ks * 2 + (lane >> 5))); }
#pragma unroll
            for (int j = 0; j < 2; ++j) { const int row = wc * 64 + j * 32 + (lane & 31); bfr[j] = *(const bf16x8*)(cur + 16384 + lds_off(row, ks * 2 + (lane >> 5))); }
#pragma unroll
            for (int i = 0; i < 2; ++i)
#pragma unroll
                for (int j = 0; j < 2; ++j) acc[i][j] = __builtin_amdgcn_mfma_f32_32x32x16_bf16(af[i], bfr[j], acc[i][j], 0, 0, 0);
        }
        if (more) {
#pragma unroll
            for (int i = 0; i < 4; ++i) { const int c = tid + 256 * i, row = c >> 3, ch = c & 7;
                *(uint4*)(nxt + lds_off(row, ch)) = ra[i]; *(uint4*)(nxt + 16384 + lds_off(row, ch)) = rb[i]; }
        }
        __syncthreads();
    }
}
#define ACC_FOREACH(body)                                                                                   \
    { const int _tid = VTID, _wave = _tid >> 6, _lane = _tid & 63, _wr = _wave >> 1, _wc = _wave & 1; \
      _Pragma("unroll") for (int i = 0; i < 2; ++i) _Pragma("unroll") for (int j = 0; j < 2; ++j)          \
      _Pragma("unroll") for (int r = 0; r < 16; ++r) {                                                     \
          const int row = _wr * 64 + i * 32 + (r & 3) + 8 * (r >> 2) + 4 * (_lane >> 5);                   \
          const int col = _wc * 64 + j * 32 + (_lane & 31); body } }

__device__ __forceinline__ void zero_acc(f32x16 (&acc)[2][2]) {
#pragma unroll
    for (int i = 0; i < 2; ++i)
#pragma unroll
        for (int j = 0; j < 2; ++j)
#pragma unroll
            for (int r = 0; r < 16; ++r) acc[i][j][r] = 0.f;
}

__device__ __forceinline__ void phase_scores(const Params& P, int bid, int nb, unsigned char* smem) {
    const bf16_t* A = (const bf16_t*)(P.ws + WS_Q); const bf16_t* Bt = (const bf16_t*)(P.ws + WS_KEYS); float* C = (float*)(P.ws + WS_SCORES);
    const int nmt = T / 128, nnt = 16;
    for (int t = bid; t < nmt * nnt; t += nb) {
        const int mt = t % nmt, nt = t / nmt;
        f32x16 acc[2][2]; zero_acc(acc);
        gemm_mainloop(A + (size_t)mt * 128 * D + nt * 128, D, Bt + (size_t)nt * 128 * 128, 128, 128, acc, smem);
        ACC_FOREACH({ C[(size_t)(mt * 128 + row) * D + nt * 128 + col] = acc[i][j][r]; })
    }
}
__device__ __forceinline__ int g2_lds_byte(int r, int c) { const int st = (r >> 4) * 2 + (c >> 5), ob = (r & 15) * 64 + (c & 31) * 2; return st * 1024 + (ob ^ (((ob >> 9) & 1) << 5)); }
__device__ __forceinline__ void g2_stage_rc(int b, int& R, int& C) { const int st = b >> 10, sb = b & 1023, swz = sb ^ (((sb >> 9) & 1) << 5); R = (st >> 1) * 16 + (swz >> 6); C = (st & 1) * 32 + ((swz & 63) >> 1); }
__device__ __forceinline__ void g2_zero(f32x4 (&acc)[8][4]) {
#pragma unroll
    for (int m = 0; m < 8; ++m)
#pragma unroll
        for (int n = 0; n < 4; ++n) acc[m][n] = (f32x4){0.f, 0.f, 0.f, 0.f};
}
__device__ __forceinline__ void g2_mainloop(const bf16_t* __restrict__ Ab, int lda, const bf16_t* __restrict__ Bb, int ldb, int K, f32x4 (&acc)[8][4], unsigned char* shm) {
    const int tid = fresh_tid(), wid = tid >> 6, lane = tid & 63, wr = wid >> 2, wc = wid & 3, fr = lane & 15, fq = lane >> 4;
    int sR[4], sC[4];
#pragma unroll
    for (int i = 0; i < 4; ++i) g2_stage_rc(wid * 1024 + i * 8192 + lane * 16, sR[i], sC[i]);
#define G2_STAGE(buf, kt) { _Pragma("unroll") for (int i = 0; i < 4; ++i) { \
        __builtin_amdgcn_global_load_lds((const unsigned*)(Ab + (size_t)sR[i] * lda + (kt) * 64 + sC[i]), (unsigned*)(shm + (buf) * 65536 + wid * 1024 + i * 8192), 16, 0, 0); \
        __builtin_amdgcn_global_load_lds((const unsigned*)(Bb + (size_t)sR[i] * ldb + (kt) * 64 + sC[i]), (unsigned*)(shm + (buf) * 65536 + 32768 + wid * 1024 + i * 8192), 16, 0, 0); } }
    const int nt = K / 64;
    __syncthreads();
    G2_STAGE(0, 0)
    asm volatile("s_waitcnt vmcnt(0)" ::: "memory");
    __syncthreads();
    for (int t = 0; t < nt; ++t) {
        const int cur = t & 1;
        if (t + 1 < nt) G2_STAGE(cur ^ 1, t + 1)
        const unsigned char* SA = shm + cur * 65536; const unsigned char* SB = SA + 32768;
#pragma unroll
        for (int ks = 0; ks < 2; ++ks) {
            bf16x8 At[8], Bf[4];
#pragma unroll
            for (int m = 0; m < 8; ++m) At[m] = *(const bf16x8*)(SA + g2_lds_byte(wr * 128 + m * 16 + fr, ks * 32 + fq * 8));
#pragma unroll
            for (int n = 0; n < 4; ++n) Bf[n] = *(const bf16x8*)(SB + g2_lds_byte(wc * 64 + n * 16 + fr, ks * 32 + fq * 8));
#pragma unroll
            for (int m = 0; m < 8; ++m)
#pragma unroll
                for (int n = 0; n < 4; ++n) acc[m][n] = __builtin_amdgcn_mfma_f32_16x16x32_bf16(At[m], Bf[n], acc[m][n], 0, 0, 0);
            __builtin_amdgcn_sched_barrier(0);
        }
        asm volatile("s_waitcnt vmcnt(0)" ::: "memory");
        __syncthreads();
    }
}
#define G2_FOREACH(body)                                                                                       \
    { const int _tid = fresh_tid(), _wid = _tid >> 6, _lane = _tid & 63, _wr = _wid >> 2, _wc = _wid & 3, _fr = _lane & 15, _fq = _lane >> 4; \
      _Pragma("unroll") for (int m = 0; m < 8; ++m) _Pragma("unroll") for (int n = 0; n < 4; ++n)             \
      _Pragma("unroll") for (int j = 0; j < 4; ++j) {                                                         \
          const int row = _wr * 128 + m * 16 + _fq * 4 + j; const int col = _wc * 64 + n * 16 + _fr; const float val = acc[m][n][j]; body } }
#define G8_HT (128 * 64)
__device__ __forceinline__ void g8_mainloop(const bf16_t* __restrict__ A, const bf16_t* __restrict__ Bt, int K, int brow, int bcol, f32x4 (&acc)[2][2][4][2], unsigned char* shmb) {
    bf16_t* shm = (bf16_t*)shmb;
    const int tid = fresh_tid();
    const int wid = tid >> 6, lane = tid & 63, wr = wid >> 2, wc = wid & 3, fr = lane & 15, fq = lane >> 4;
#define G8_SA(b, h) (shm + ((b) * 2 + (h)) * G8_HT)
#define G8_SB(b, h) (shm + (4 + (b) * 2 + (h)) * G8_HT)
#define G8_STAGE(Pp, BASE, br, kt) do { const long _g = (long)(br) * K + (long)(kt) * 64; \
    _Pragma("unroll") for (int _i = 0; _i < 2; ++_i) { const int _b = tid * 16 + _i * 8192; int _r, _c; g2_stage_rc(_b, _r, _c); \
      __builtin_amdgcn_global_load_lds((const unsigned*)(BASE + _g + (long)_r * K + _c), (unsigned*)((char*)(Pp) + _b), 16, 0, 0); } } while (0)
#define G8_LDA(dst, b, h) _Pragma("unroll") for (int m = 0; m < 4; ++m) _Pragma("unroll") for (int k = 0; k < 2; ++k) \
    dst[m][k] = *reinterpret_cast<const bf16x8*>((const char*)G8_SA(b, h) + g2_lds_byte(wr * 64 + m * 16 + fr, k * 32 + fq * 8))
#define G8_LDB(dst, b, h) _Pragma("unroll") for (int n = 0; n < 2; ++n) _Pragma("unroll") for (int k = 0; k < 2; ++k) \
    dst[n][k] = *reinterpret_cast<const bf16x8*>((const char*)G8_SB(b, h) + g2_lds_byte(wc * 32 + n * 16 + fr, k * 32 + fq * 8))
#define G8_MMA(ai, bj, At_, Bt_) do { __builtin_amdgcn_s_setprio(1); \
    _Pragma("unroll") for (int m = 0; m < 4; ++m) _Pragma("unroll") for (int n = 0; n < 2; ++n) _Pragma("unroll") for (int k = 0; k < 2; ++k) \
      acc[ai][bj][m][n] = __builtin_amdgcn_mfma_f32_16x16x32_bf16(At_[m][k], Bt_[n][k], acc[ai][bj][m][n], 0, 0, 0); \
    __builtin_amdgcn_s_setprio(0); } while (0)
#define G8_WAIT_V(n) asm volatile("s_waitcnt vmcnt(" #n ")" ::: "memory")
#define G8_WAIT_L(n) asm volatile("s_waitcnt lgkmcnt(" #n ")" ::: "memory")
#define G8_BAR __builtin_amdgcn_s_barrier()
#define G8_SCHED __builtin_amdgcn_sched_barrier(0)
    bf16x8 At[4][2], B0[2][2], B1[2][2];
    const int nt = K / 64;
    __syncthreads();
    G8_STAGE(G8_SB(0, 0), Bt, bcol, 0); G8_STAGE(G8_SA(0, 0), A, brow, 0);
    G8_STAGE(G8_SB(0, 1), Bt, bcol + 128, 0); G8_STAGE(G8_SA(0, 1), A, brow + 128, 0);
    if (wr == 1) G8_BAR;
    G8_WAIT_V(4); G8_BAR;
    G8_STAGE(G8_SB(1, 0), Bt, bcol, 1); G8_STAGE(G8_SA(1, 0), A, brow, 1); G8_STAGE(G8_SB(1, 1), Bt, bcol + 128, 1);
    G8_WAIT_V(6); G8_BAR;
    for (int t = 0; t < nt - 2; t += 2) {
        G8_LDB(B0, 0, 0); G8_SCHED; G8_LDA(At, 0, 0); G8_STAGE(G8_SA(1, 1), A, brow + 128, t + 1);
        G8_WAIT_L(8); G8_BAR; G8_WAIT_L(0); G8_MMA(0, 0, At, B0); G8_BAR; G8_SCHED;
        G8_LDB(B1, 0, 1); G8_STAGE(G8_SB(0, 0), Bt, bcol, t + 2);
        G8_BAR; G8_WAIT_L(0); G8_MMA(0, 1, At, B1); G8_BAR;
        G8_LDA(At, 0, 1); G8_STAGE(G8_SA(0, 0), A, brow, t + 2);
        G8_BAR; G8_WAIT_L(0); G8_MMA(1, 0, At, B0); G8_BAR; G8_SCHED;
        G8_STAGE(G8_SB(0, 1), Bt, bcol + 128, t + 2);
        G8_WAIT_V(6); G8_BAR; G8_MMA(1, 1, At, B1); G8_BAR;
        G8_LDB(B0, 1, 0); G8_SCHED; G8_LDA(At, 1, 0); G8_STAGE(G8_SA(0, 1), A, brow + 128, t + 2);
        G8_WAIT_L(8); G8_BAR; G8_WAIT_L(0); G8_MMA(0, 0, At, B0); G8_BAR; G8_SCHED;
        G8_LDB(B1, 1, 1); G8_STAGE(G8_SB(1, 0), Bt, bcol, t + 3);
        G8_BAR; G8_WAIT_L(0); G8_MMA(0, 1, At, B1); G8_BAR;
        G8_LDA(At, 1, 1); G8_STAGE(G8_SA(1, 0), A, brow, t + 3);
        G8_BAR; G8_WAIT_L(0); G8_MMA(1, 0, At, B0); G8_BAR; G8_SCHED;
        G8_STAGE(G8_SB(1, 1), Bt, bcol + 128, t + 3);
        G8_WAIT_V(6); G8_BAR; G8_MMA(1, 1, At, B1); G8_BAR;
    }
    { G8_LDB(B0, 0, 0); G8_LDA(At, 0, 0); G8_STAGE(G8_SA(1, 1), A, brow + 128, nt - 1);
      G8_BAR; G8_WAIT_L(0); G8_MMA(0, 0, At, B0); G8_BAR;
      G8_LDB(B1, 0, 1); G8_BAR; G8_WAIT_L(0); G8_MMA(0, 1, At, B1); G8_BAR;
      G8_LDA(At, 0, 1); G8_WAIT_V(4); G8_BAR; G8_WAIT_L(0); G8_MMA(1, 0, At, B0); G8_MMA(1, 1, At, B1); G8_BAR; }
    { G8_LDB(B0, 1, 0); G8_LDA(At, 1, 0); G8_WAIT_V(2); G8_BAR; G8_WAIT_L(0); G8_MMA(0, 0, At, B0); G8_BAR;
      G8_LDB(B1, 1, 1); G8_WAIT_V(0); G8_BAR; G8_WAIT_L(0); G8_MMA(0, 1, At, B1); G8_BAR;
      G8_LDA(At, 1, 1); G8_BAR; G8_WAIT_L(0); G8_MMA(1, 0, At, B0); G8_MMA(1, 1, At, B1); G8_BAR; }
    if (wr == 0) G8_BAR;
}
__device__ __forceinline__ void g8_zero(f32x4 (&acc)[2][2][4][2]) {
#pragma unroll
    for (int a = 0; a < 2; ++a)
#pragma unroll
        for (int b = 0; b < 2; ++b)
#pragma unroll
            for (int m = 0; m < 4; ++m)
#pragma unroll
                for (int n = 0; n < 2; ++n) acc[a][b][m][n] = (f32x4){0.f, 0.f, 0.f, 0.f};
}
#define G8_FOREACH(body)                                                                                       \
    { const int _tid = fresh_tid(), _wid = _tid >> 6, _lane = _tid & 63, _wr = _wid >> 2, _wc = _wid & 3, _fr = _lane & 15, _fq = _lane >> 4; \
      _Pragma("unroll") for (int ai = 0; ai < 2; ++ai) _Pragma("unroll") for (int bj = 0; bj < 2; ++bj)       \
      _Pragma("unroll") for (int m = 0; m < 4; ++m) _Pragma("unroll") for (int n = 0; n < 2; ++n)             \
      _Pragma("unroll") for (int j = 0; j < 4; ++j) {                                                         \
          const int row = ai * 128 + _wr * 64 + m * 16 + _fq * 4 + j; const int col = bj * 128 + _wc * 32 + n * 16 + _fr; const float val = acc[ai][bj][m][n][j]; body } }

__device__ __forceinline__ bool g2_tile(int bid, int nb, int it, int nM, int nN, int& pm, int& pn) {
    if (nb == 256 && nM == 32) { const int xcd = bid & 7, jj = bid >> 3; pm = 4 * xcd + (jj & 3); pn = 8 * it + (jj >> 2); return pn < nN; }
    const int t = bid + it * nb; pm = t % nM; pn = t / nM; return t < nM * nN;
}

__device__ __forceinline__ void phase_ple(const Params& P, int bid, int nb, unsigned char* smem) {
    const bf16_t* A = (const bf16_t*)(P.ws + WS_PBF); const bf16_t* Bt = (const bf16_t*)(P.ws + WS_WTPP); bf16_t* C = (bf16_t*)P.out;
    for (int t = bid; t < 256; t += nb) {
        const int pm = t & 31, pn = t >> 5;
        f32x4 acc[8][4]; g2_zero(acc);
        g2_mainloop(A + (size_t)pm * 256 * 256, 256, Bt + (size_t)pn * 256 * 256, 256, 256, acc, smem);
        G2_FOREACH({ C[(size_t)(pm * 256 + row) * D + pn * 256 + col] = f2bf(val); })
    }
}
__device__ __forceinline__ void phase_gemm1(const Params& P, int bid, int nb, unsigned char* smem) {
    const bf16_t* A = (const bf16_t*)(P.ws + WS_HN); const bf16_t* Bt = (const bf16_t*)(P.ws + WS_WTIN); bf16_t* C = (bf16_t*)(P.ws + WS_PROJ);
    int pm, pn;
    for (int it = 0; g2_tile(bid, nb, it, T / 256, NPROJ / 256, pm, pn); ++it) {
        f32x4 acc[2][2][4][2]; g8_zero(acc);
        g8_mainloop(A, Bt, D, pm * 256, pn * 256, acc, smem);
        G8_FOREACH({ C[(size_t)(pm * 256 + row) * NPROJ + pn * 256 + col] = f2bf(val); })
    }
    if (nb == 256 && bid >= 160) phase_ple(P, bid - 160, 96, smem);
}
__device__ __forceinline__ void phase_gemm2(const Params& P, int bid, int nb, unsigned char* smem) {
    const bf16_t* A = (const bf16_t*)(P.ws + WS_MIXED); const bf16_t* Bt = (const bf16_t*)(P.ws + WS_WTOUT); float* H = (float*)(P.ws + WS_H);
    bf16_t* HW = (bf16_t*)(P.ws + WS_HN); float* rss = (float*)(P.ws + WS_RSS);
    int pm, pn;
    for (int it = 0; g2_tile(bid, nb, it, T / 256, D / 256, pm, pn); ++it) {
        f32x4 acc[2][2][4][2]; g8_zero(acc);
        g8_mainloop(A, Bt, D, pm * 256, pn * 256, acc, smem);
        const int tid = fresh_tid(), wid = tid >> 6, lane = tid & 63, wr = wid >> 2, wc = wid & 3, fr = lane & 15, fq = lane >> 4;
#pragma unroll
        for (int ai = 0; ai < 2; ++ai)
#pragma unroll
            for (int m = 0; m < 4; ++m)
#pragma unroll
                for (int j = 0; j < 4; ++j) {
                    const int row = pm * 256 + ai * 128 + wr * 64 + m * 16 + fq * 4 + j;
                    float ss = 0.f;
#pragma unroll
                    for (int bj = 0; bj < 2; ++bj)
#pragma unroll
                        for (int n = 0; n < 2; ++n) {
                            const int col = pn * 256 + bj * 128 + wc * 32 + n * 16 + fr;
                            const size_t o = (size_t)row * D + col;
                            const float v = P.x[o] + acc[ai][bj][m][n][j];
                            H[o] = v; HW[o] = f2bf(v * P.norm_ffn[col]); ss += v * v;
                        }
                    ss += __shfl_xor(ss, 1); ss += __shfl_xor(ss, 2); ss += __shfl_xor(ss, 4); ss += __shfl_xor(ss, 8);
                    if (fr == 0) atomicAdd(rss + row, ss);
                }
    }
}
__device__ __forceinline__ void phase_gemm3(const Params& P, int bid, int nb, unsigned char* smem) {
    const bf16_t* A = (const bf16_t*)(P.ws + WS_HN); const bf16_t* Bt = (const bf16_t*)(P.ws + WS_WTPQ); bf16_t* C = (bf16_t*)(P.ws + WS_Q);
    int pm, pn;
    for (int it = 0; g2_tile(bid, nb, it, T / 256, D / 256, pm, pn); ++it) {
        f32x4 acc[2][2][4][2]; g8_zero(acc);
        g8_mainloop(A, Bt, D, pm * 256, pn * 256, acc, smem);
        const float* rss = (const float*)(P.ws + WS_RSS);
        G8_FOREACH({ const float rs = rsqrtf(rss[pm * 256 + row] * (1.f / 2048.f) + EPS); C[(size_t)(pm * 256 + row) * D + pn * 256 + col] = f2bf(val * rs); })
    }
}
__device__ __forceinline__ void phase_gemm4(const Params& P, int bid, int nb, unsigned char* smem) {
    const bf16_t* A = (const bf16_t*)(P.ws + WS_HN); const bf16_t* Bt = (const bf16_t*)(P.ws + WS_WTG);
    const bf16_t* ple = (const bf16_t*)P.out; float* H = (float*)(P.ws + WS_H);
    int pm, pn;
    for (int it = 0; g2_tile(bid, nb, it, T / 256, D / 256, pm, pn); ++it) {
        f32x4 acc[2][2][4][2]; g8_zero(acc);
        g8_mainloop(A, Bt, D, pm * 256, pn * 256, acc, smem);
        G8_FOREACH({ const size_t o = (size_t)(pm * 256 + row) * D + pn * 256 + col; H[o] = H[o] + sigmoid_f(val) * bf2f(ple[o]); })
    }
}

template <bool OUT_BF16>
__device__ __forceinline__ void phase_rownorm(const float* in, const float* w, void* out, int bid, int nb) {
    const int wave = VTID >> 6, lane = VTID & 63;
    for (int r = bid * 4 + wave; r < T; r += nb * 4) {
        if (OUT_BF16) rmsnorm_row<true>(in + (size_t)r * D, w, (bf16_t*)out + (size_t)r * D, lane);
        else rmsnorm_row<false>(in + (size_t)r * D, w, (float*)out + (size_t)r * D, lane);
    }
}

__device__ __forceinline__ bf16x8 frag_ld(const unsigned char* tile, int row, int ks, int lane) { return *(const bf16x8*)(tile + lds_off(row, ks * 2 + (lane >> 5))); }
__device__ __forceinline__ void lds_st_bf16(unsigned char* tile, int row, int k, float v) { *(bf16_t*)(tile + lds_off(row, k >> 3) + (k & 7) * 2) = f2bf(v); }

__device__ __forceinline__ void d1_chunk(const Params& P, int u, unsigned char* smem) {
    const bf16_t* proj = (const bf16_t*)(P.ws + WS_PROJ);
    int tid_ = VTID; asm volatile("" : "+v"(tid_));
    const int tid = tid_, wave = tid >> 6, lane = tid & 63;
    const int b = u >> 9, h = (u >> 6) & 7, c = u & 63;
    const size_t tok0 = (size_t)b * SEQ + c * 64;
    unsigned char* Ks = smem;
    unsigned char* Qs = smem + 16384;
    unsigned char* Vraw = smem + 16384;
    float* At = (float*)(smem + 34816);
    float* Gs = (float*)(smem + 51200);
    float* Bs = Gs + 64;
    __syncthreads();
    if (wave == 0) {
        const size_t t = tok0 + lane;
        const float a = bf2f(proj[t * NPROJ + C_A + h]), bb = bf2f(proj[t * NPROJ + C_B + h]);
        const float xs = a + P.dt_bias[h];
        const float sp = xs > 20.f ? xs : log1pf(expf(xs));
        float g = -expf(P.a_log[h]) * sp;
#pragma unroll
        for (int o = 1; o < 64; o <<= 1) { const float n = __shfl_up(g, o); if (lane >= o) g += n; }
        Gs[lane] = g; Bs[lane] = 1.f / (1.f + expf(-bb));
    }
    bf16_t* QG = (bf16_t*)(P.ws + WS_QG) + (size_t)u * 64 * 128;
    unsigned char* RAW = smem + 32768;
#pragma unroll 1
    for (int isk = 0; isk < 2; ++isk) {
        const int chb = (isk ? 1024 : 0) + h * 128;
        for (int q = tid; q < 67 * 16; q += 256) {
            const int row = q >> 4, c16 = q & 15;
            uint4 v = make_uint4(0u, 0u, 0u, 0u);
            if (c > 0 || row >= 3) v = *(const uint4*)(proj + (tok0 + row - 3) * NPROJ + chb + c16 * 8);
            *(uint4*)(RAW + row * 256 + c16 * 16) = v;
        }
        const int ch0 = chb + lane * 2;
        const f32x4 cw0 = *(const f32x4*)(P.conv_w + ch0 * 4), cw1 = *(const f32x4*)(P.conv_w + ch0 * 4 + 4);
        __syncthreads();
        for (int tok = wave; tok < 64; tok += 4) {
            float y0 = 0.f, y1 = 0.f;
#pragma unroll
            for (int j = 0; j < 4; ++j) {
                const unsigned pr = *(const unsigned*)(RAW + (tok + j) * 256 + lane * 4);
                y0 += bf2f((bf16_t)(pr & 0xffff)) * cw0[j];
                y1 += bf2f((bf16_t)(pr >> 16)) * cw1[j];
            }
            y0 = silu_f(y0); y1 = silu_f(y1);
            float r = rsqrtf(wave_sum(y0 * y0 + y1 * y1) + EPS);
            if (!isk) r *= 0.08838834764831845f;
            y0 *= r; y1 *= r;
            const int k = lane * 2, half = k >> 6, kk = k & 63;
            *(unsigned*)((isk ? Ks : Qs) + half * 8192 + lds_off(tok, kk >> 3) + (kk & 7) * 2) = pack2(y0, y1);
            if (!isk) { const float eg = expf(Gs[tok]); *(unsigned*)(QG + tok * 128 + k) = pack2(y0 * eg, y1 * eg); }
        }
        __syncthreads();
    }
    {
        const int wr = wave >> 1, wc = wave & 1;
        f32x16 akk, aqk;
#pragma unroll
        for (int r = 0; r < 16; ++r) { akk[r] = 0.f; aqk[r] = 0.f; }
        if (!(wr == 0 && wc == 1)) {
#pragma unroll
            for (int half = 0; half < 2; ++half)
#pragma unroll
                for (int ks = 0; ks < 4; ++ks) {
                    const bf16x8 fk = frag_ld(Ks + half * 8192, wr * 32 + (lane & 31), ks, lane);
                    const bf16x8 fq = frag_ld(Qs + half * 8192, wr * 32 + (lane & 31), ks, lane);
                    const bf16x8 fb = frag_ld(Ks + half * 8192, wc * 32 + (lane & 31), ks, lane);
                    akk = __builtin_amdgcn_mfma_f32_32x32x16_bf16(fk, fb, akk, 0, 0, 0);
                    aqk = __builtin_amdgcn_mfma_f32_32x32x16_bf16(fq, fb, aqk, 0, 0, 0);
                }
        }
        const int j = wc * 32 + (lane & 31); const float Gj = Gs[j];
        bf16_t* ATT = (bf16_t*)(P.ws + WS_ATT) + (size_t)u * 64 * 64;
#pragma unroll
        for (int g4 = 0; g4 < 4; ++g4) {
            const int i0 = wr * 32 + 8 * g4 + 4 * (lane >> 5);
            f32x4 av;
#pragma unroll
            for (int e = 0; e < 4; ++e) {
                const int i = i0 + e, r = g4 * 4 + e;
                const float dec = (i >= j) ? expf(Gs[i] - Gj) : 0.f;
                av[e] = (i > j) ? Bs[i] * akk[r] * dec : 0.f;
                ATT[i * 64 + j] = f2bf(aqk[r] * dec);
            }
            *(f32x4*)(At + j * 64 + i0) = av;
        }
    }
    __syncthreads();
    {
        for (int q = tid; q < 67 * 16; q += 256) {
            const int row = q >> 4, c16 = q & 15;
            uint4 v = make_uint4(0u, 0u, 0u, 0u);
            if (c > 0 || row >= 3) v = *(const uint4*)(proj + (tok0 + row - 3) * NPROJ + 2048 + h * 128 + c16 * 8);
            *(uint4*)(Vraw + row * 256 + c16 * 16) = v;
        }
    }
    __syncthreads();
    {
        float r[64];
        if (tid < 128) {
            const int ch = 2048 + h * 128 + tid;
            const float w0 = P.conv_w[ch * 4 + 0], w1 = P.conv_w[ch * 4 + 1], w2 = P.conv_w[ch * 4 + 2], w3 = P.conv_w[ch * 4 + 3];
            const bf16_t* vcol = (const bf16_t*)Vraw + tid;
            float xm3 = bf2f(vcol[0]), xm2 = bf2f(vcol[128]), xm1 = bf2f(vcol[256]);
#pragma unroll
            for (int i = 0; i < 64; ++i) {
                const float x0 = bf2f(vcol[(i + 3) * 128]);
                const float y = w0 * xm3 + w1 * xm2 + w2 * xm1 + w3 * x0;
                r[i] = Bs[i] * silu_f(y);
                xm3 = xm2; xm2 = xm1; xm1 = x0;
            }
        } else {
            const int dk = tid - 128, half = dk >> 6, kk = dk & 63;
            const float G63 = Gs[63];
            bf16_t* KDT = (bf16_t*)(P.ws + WS_KDT) + (size_t)u * 128 * 64 + dk * 64;
#pragma unroll
            for (int i8 = 0; i8 < 8; ++i8) {
                unsigned pk[4];
#pragma unroll
                for (int e2 = 0; e2 < 4; ++e2) {
                    float kd[2];
#pragma unroll
                    for (int e = 0; e < 2; ++e) {
                        const int i = i8 * 8 + e2 * 2 + e;
                        const float kv = bf2f(*(const bf16_t*)(Ks + half * 8192 + lds_off(i, kk >> 3) + (kk & 7) * 2));
                        const float Gi = Gs[i];
                        r[i] = -Bs[i] * expf(Gi) * kv;
                        kd[e] = kv * expf(G63 - Gi);
                    }
                    pk[e2] = pack2(kd[0], kd[1]);
                }
                *(uint4*)(KDT + i8 * 8) = make_uint4(pk[0], pk[1], pk[2], pk[3]);
            }
        }
#pragma unroll
        for (int j = 0; j < 63; ++j) {
            const float xj = r[j];
#pragma unroll
            for (int i4 = ((j + 1) & ~3); i4 < 64; i4 += 4) {
                const f32x4 a = *(const f32x4*)(At + j * 64 + i4);
                r[i4] -= a[0] * xj; r[i4 + 1] -= a[1] * xj; r[i4 + 2] -= a[2] * xj; r[i4 + 3] -= a[3] * xj;
            }
        }
        if (tid < 128) {
            bf16_t* U = (bf16_t*)(P.ws + WS_U) + (size_t)u * 64 * 128 + (tid >> 5) * 2048 + (tid & 31);
#pragma unroll
            for (int i = 0; i < 64; ++i) { const int tt = i >> 5, i5 = i & 31, rr = (i5 & 3) + 4 * (i5 >> 3), hh = (i5 >> 2) & 1; U[(tt * 16 + rr) * 64 + hh * 32] = f2bf(r[i]); }
        } else {
            bf16_t* W = (bf16_t*)(P.ws + WS_W) + (size_t)u * 64 * 128 + (tid - 128);
#pragma unroll
            for (int i = 0; i < 64; ++i) W[i * 128] = f2bf(r[i]);
        }
        if (tid == 0) ((float*)(P.ws + WS_EG))[u] = expf(Gs[63]);
    }
}

__device__ __forceinline__ void r1_chunk(const Params& P, int u, unsigned char* smem) {
    const bf16_t* proj = (const bf16_t*)(P.ws + WS_PROJ);
    int tid_ = VTID; asm volatile("" : "+v"(tid_));
    const int tid = tid_, wave = tid >> 6, lane = tid & 63;
    const int b = u >> 9, h = (u >> 6) & 7, c = u & 63;
    const size_t tok0 = (size_t)b * SEQ + c * 64;
    unsigned char* RQ = smem;
    unsigned char* RK = smem + 8192;
    unsigned char* VT = smem + 16384;
    unsigned char* RKT = smem + 32768;
    const float l2g = log2f(1.f - exp2f(-5.f - (float)h));
    unsigned char* VR = smem + 40960;
    __syncthreads();
    bf16_t* QGR = (bf16_t*)(P.ws + WS_QGR) + (size_t)u * 64 * 64;
    {
        uint4 rq[2], rk[2], rv[4];
#pragma unroll
        for (int i = 0; i < 2; ++i) { const int q = tid + 256 * i, row = q >> 3, ch = q & 7;
            rq[i] = *(const uint4*)(proj + (tok0 + row) * NPROJ + C_RQ + h * 64 + ch * 8); rk[i] = *(const uint4*)(proj + (tok0 + row) * NPROJ + C_RK + h * 64 + ch * 8); }
#pragma unroll
        for (int i = 0; i < 4; ++i) { const int q = tid + 256 * i, row = q >> 4, c16 = q & 15; rv[i] = *(const uint4*)(proj + (tok0 + row) * NPROJ + C_RV + h * 128 + c16 * 8); }
#pragma unroll
        for (int i = 0; i < 2; ++i) { const int q = tid + 256 * i, row = q >> 3, ch = q & 7; *(uint4*)(RQ + lds_off(row, ch)) = rq[i]; *(uint4*)(RK + lds_off(row, ch)) = rk[i]; }
#pragma unroll
        for (int i = 0; i < 4; ++i) { const int q = tid + 256 * i, row = q >> 4, c16 = q & 15; *(uint4*)(VR + row * 256 + c16 * 16) = rv[i]; }
    }
    __syncthreads();
#pragma unroll 1
    for (int it = 0; it < 8; ++it) {
        const int e = tid + 256 * it, tok = e >> 5, i = e & 31;
        const size_t t = tok0 + tok;
        const float inv = powf(10000.f, -(float)i / 32.f);
        const float ang = (float)P.positions[t] * inv;
        float sn, cs; sincosf(ang, &sn, &cs);
        bf16_t* q1p = (bf16_t*)(RQ + lds_off(tok, i >> 3) + (i & 7) * 2); bf16_t* q2p = (bf16_t*)(RQ + lds_off(tok, (32 + i) >> 3) + (i & 7) * 2);
        bf16_t* k1p = (bf16_t*)(RK + lds_off(tok, i >> 3) + (i & 7) * 2); bf16_t* k2p = (bf16_t*)(RK + lds_off(tok, (32 + i) >> 3) + (i & 7) * 2);
        const float q1 = bf2f(*q1p), q2 = bf2f(*q2p), k1 = bf2f(*k1p) * 0.125f, k2 = bf2f(*k2p) * 0.125f;
        const float qa = q1 * cs - q2 * sn, qb = q1 * sn + q2 * cs, ka = k1 * cs - k2 * sn, kb = k1 * sn + k2 * cs;
        const float xi = exp2f(l2g * (float)(tok + 1)), zeta = exp2f(l2g * (float)(63 - tok));
        *q1p = f2bf(qa); *q2p = f2bf(qb); *k1p = f2bf(ka); *k2p = f2bf(kb);
        lds_st_bf16(RKT, i, tok, ka * zeta); lds_st_bf16(RKT, 32 + i, tok, kb * zeta);
        QGR[tok * 64 + i] = f2bf(qa * xi); QGR[tok * 64 + 32 + i] = f2bf(qb * xi);
    }
#pragma unroll 4
    for (int it = 0; it < 16; ++it) {
        const int e = tid + 256 * it, tok = e >> 6, dp = e & 63;
        const unsigned pr = *(const unsigned*)(VR + tok * 256 + dp * 4);
        *(bf16_t*)(VT + lds_off(dp * 2, tok >> 3) + (tok & 7) * 2) = (bf16_t)(pr & 0xffff);
        *(bf16_t*)(VT + lds_off(dp * 2 + 1, tok >> 3) + (tok & 7) * 2) = (bf16_t)(pr >> 16);
    }
    __syncthreads();
    {
        bf16_t* VNTR = (bf16_t*)(P.ws + WS_VNTR) + (size_t)u * 128 * 64;
#pragma unroll
        for (int it = 0; it < 4; ++it) { const int q = tid + 256 * it, row = q >> 3, ch = q & 7; *(uint4*)(VNTR + row * 64 + ch * 8) = *(const uint4*)(VT + lds_off(row, ch)); }
    }
    {
        const int wr = wave >> 1, wc = wave & 1;
        f32x16 acc;
#pragma unroll
        for (int r = 0; r < 16; ++r) acc[r] = 0.f;
        if (!(wr == 0 && wc == 1)) {
#pragma unroll
            for (int ks = 0; ks < 4; ++ks) acc = __builtin_amdgcn_mfma_f32_32x32x16_bf16(frag_ld(RQ, wr * 32 + (lane & 31), ks, lane), frag_ld(RK, wc * 32 + (lane & 31), ks, lane), acc, 0, 0, 0);
        }
        const int j = wc * 32 + (lane & 31);
        bf16_t* ATTR = (bf16_t*)(P.ws + WS_ATTR) + (size_t)u * 64 * 64;
#pragma unroll
        for (int r = 0; r < 16; ++r) {
            const int i = wr * 32 + (r & 3) + 8 * (r >> 2) + 4 * (lane >> 5);
            const float dec = (i >= j) ? exp2f(l2g * (float)(i - j)) : 0.f;
            ATTR[i * 64 + j] = f2bf(acc[r] * dec);
        }
    }
    {
        f32x16 acc[2];
#pragma unroll
        for (int j = 0; j < 2; ++j)
#pragma unroll
            for (int r = 0; r < 16; ++r) acc[j][r] = 0.f;
#pragma unroll
        for (int ks = 0; ks < 4; ++ks) {
            const bf16x8 fa = frag_ld(VT, wave * 32 + (lane & 31), ks, lane);
#pragma unroll
            for (int j = 0; j < 2; ++j) acc[j] = __builtin_amdgcn_mfma_f32_32x32x16_bf16(fa, frag_ld(RKT, j * 32 + (lane & 31), ks, lane), acc[j], 0, 0, 0);
        }
        float* KVT = (float*)(P.ws + WS_KVT) + (size_t)u * 128 * 64;
#pragma unroll
        for (int j = 0; j < 2; ++j)
#pragma unroll
            for (int r = 0; r < 16; ++r) { const int dv = wave * 32 + (r & 3) + 8 * (r >> 2) + 4 * (lane >> 5); KVT[dv * 64 + j * 32 + (lane & 31)] = acc[j][r]; }
    }
}

__device__ __forceinline__ void phase_chunk1(const Params& P, int bid, int nb, unsigned char* smem) {
    for (int u = bid; u < 2048; u += nb) { if (u < 1024) d1_chunk(P, u, smem); else r1_chunk(P, u - 1024, smem); }
}

__device__ __forceinline__ void d2_scan(const Params& P, int bh, unsigned char* rsmem) {
    const int tid = fresh_tid(), wave = tid >> 6, lane = tid & 63;
    const bool compute = wave < 4;
    const size_t cb = (size_t)bh * 64;
    const bf16_t* Wg = (const bf16_t*)(P.ws + WS_W); const bf16_t* KDg = (const bf16_t*)(P.ws + WS_KDT);
    const float* Ug = (const float*)(P.ws + WS_U); const float* EGg = (const float*)(P.ws + WS_EG);
    bf16_t* SCg = (bf16_t*)(P.ws + WS_SC); bf16_t* VNg = (bf16_t*)(P.ws + WS_VNT);
    unsigned char* img = rsmem + (wave & 3) * 8192;
    unsigned char* ULDS = rsmem + 32768;
    unsigned char* BUF = rsmem + 65536;
    const int ltid = tid & 255;
    f32x16 S[4];
    uint4 w0a, w0b, w0c, w0d, k0a, k0b, k0c, k0d, u0a, u0b, u0c, u0d;
    uint4 w1a, w1b, w1c, w1d, k1a, k1b, k1c, k1d, u1a, u1b, u1c, u1d;
    const bf16_t* Ug16 = (const bf16_t*)(P.ws + WS_U);
#define D2_LOAD(SET, uu) { const bf16_t* wp = Wg + (uu) * 8192 + ltid * 8; const bf16_t* kp = KDg + (uu) * 8192 + ltid * 8; const bf16_t* up = Ug16 + (uu) * 8192 + ltid * 8; \
        w##SET##a = *(const uint4*)(wp); w##SET##b = *(const uint4*)(wp + 2048); w##SET##c = *(const uint4*)(wp + 4096); w##SET##d = *(const uint4*)(wp + 6144); \
        k##SET##a = *(const uint4*)(kp); k##SET##b = *(const uint4*)(kp + 2048); k##SET##c = *(const uint4*)(kp + 4096); k##SET##d = *(const uint4*)(kp + 6144); \
        u##SET##a = *(const uint4*)(up); u##SET##b = *(const uint4*)(up + 2048); u##SET##c = *(const uint4*)(up + 4096); u##SET##d = *(const uint4*)(up + 6144); }
#define D2_ST1(i, vw, vk, vu, bufp, par) { const int q = ltid + 256 * (i); { const int row = q >> 4, c16 = q & 15; *(uint4*)((bufp) + (c16 >> 3) * 8192 + lds_off(row, c16 & 7)) = (vw); } \
        { const int row = q >> 3, ch = q & 7; *(uint4*)((bufp) + 16384 + lds_off(row, ch)) = (vk); } \
        *(uint4*)(ULDS + (par) * 16384 + q * 16) = (vu); }
#define D2_STORE(SET, par) { unsigned char* bufp = BUF + (par) * 32768; D2_ST1(0, w##SET##a, k##SET##a, u##SET##a, bufp, par) D2_ST1(1, w##SET##b, k##SET##b, u##SET##b, bufp, par) \
        D2_ST1(2, w##SET##c, k##SET##c, u##SET##c, bufp, par) D2_ST1(3, w##SET##d, k##SET##d, u##SET##d, bufp, par) }
    int egl = 0;
    __syncthreads();
    if (compute) {
#pragma unroll
        for (int d = 0; d < 4; ++d)
#pragma unroll
            for (int r = 0; r < 16; ++r) S[d][r] = 0.f;
        egl = __float_as_int(EGg[cb + lane]);
#pragma unroll
        for (int i = 0; i < 8; ++i) { *(uint4*)(img + (lane + 64 * i) * 16) = make_uint4(0u, 0u, 0u, 0u);
            *(uint4*)(SCg + cb * 16384 + wave * 4096 + (lane + 64 * i) * 8) = make_uint4(0u, 0u, 0u, 0u); }
    } else {
        D2_LOAD(0, cb) D2_LOAD(1, cb + 1)
        D2_STORE(0, 0)
        D2_LOAD(0, cb + 2)
    }
    __syncthreads();
#define D2_VN(tt, vv) _Pragma("unroll") for (int g4 = 0; g4 < 4; ++g4) { const int r0 = g4 * 4; \
            const uint2 pkd = make_uint2(pack2(vv[r0], vv[r0 + 1]), pack2(vv[r0 + 2], vv[r0 + 3])); \
            const int tok = (tt) * 32 + 8 * g4 + 4 * (lane >> 5); \
            *(uint2*)(img + lds_off(lane & 31, tok >> 3) + (tok & 7) * 2) = pkd; \
            *(uint2*)(VNg + u * 8192 + ((((wave * 2 + (tt)) * 4 + g4) * 64 + lane) * 4)) = pkd; }
#define D2_COMPUTE(c) { const size_t u = cb + (c); const unsigned char* Wt = BUF + ((c) & 1) * 32768; const unsigned char* KDt = Wt + 16384; \
        const bf16_t* ul = (const bf16_t*)(ULDS + ((c) & 1) * 16384) + wave * 2048 + lane; \
        uint2 pkv[8]; \
        const float eg = __int_as_float(__builtin_amdgcn_readlane(egl, (c))); \
        _Pragma("unroll") for (int tt = 0; tt < 2; ++tt) { f32x16 vn; \
            _Pragma("unroll") for (int r = 0; r < 16; ++r) vn[r] = bf2f(ul[(tt * 16 + r) * 64]); \
            _Pragma("unroll") for (int half = 0; half < 2; ++half) _Pragma("unroll") for (int ks = 0; ks < 4; ++ks) \
                vn = __builtin_amdgcn_mfma_f32_32x32x16_bf16(frag_ld(Wt + half * 8192, tt * 32 + (lane & 31), ks, lane), frag_ld(img + half * 4096, lane & 31, ks, lane), vn, 0, 0, 0); \
            _Pragma("unroll") for (int g4 = 0; g4 < 4; ++g4) { const int r0 = g4 * 4; \
                pkv[tt * 4 + g4] = make_uint2(pack2(vn[r0], vn[r0 + 1]), pack2(vn[r0 + 2], vn[r0 + 3])); } \
            __builtin_amdgcn_sched_barrier(0); } \
        _Pragma("unroll") for (int tt = 0; tt < 2; ++tt) _Pragma("unroll") for (int g4 = 0; g4 < 4; ++g4) { \
            const int tok = tt * 32 + 8 * g4 + 4 * (lane >> 5); \
            *(uint2*)(img + lds_off(lane & 31, tok >> 3) + (tok & 7) * 2) = pkv[tt * 4 + g4]; \
            *(uint2*)(VNg + u * 8192 + ((((wave * 2 + tt) * 4 + g4) * 64 + lane) * 4)) = pkv[tt * 4 + g4]; } \
        _Pragma("unroll") for (int d = 0; d < 4; ++d) _Pragma("unroll") for (int r = 0; r < 16; ++r) S[d][r] *= eg; \
        _Pragma("unroll") for (int ks = 0; ks < 4; ++ks) { const bf16x8 fb = frag_ld(img, lane & 31, ks, lane); \
            _Pragma("unroll") for (int d = 0; d < 4; ++d) S[d] = __builtin_amdgcn_mfma_f32_32x32x16_bf16(frag_ld(KDt, d * 32 + (lane & 31), ks, lane), fb, S[d], 0, 0, 0); } \
        _Pragma("unroll") for (int d = 0; d < 4; ++d) _Pragma("unroll") for (int g4 = 0; g4 < 4; ++g4) { const int r0 = g4 * 4; \
            const uint2 pkd = make_uint2(pack2(S[d][r0], S[d][r0 + 1]), pack2(S[d][r0 + 2], S[d][r0 + 3])); \
            const int kk = (d & 1) * 32 + 8 * g4 + 4 * (lane >> 5); \
            *(uint2*)(img + (d >> 1) * 4096 + lds_off(lane & 31, kk >> 3) + (kk & 7) * 2) = pkd; \
            if ((c) + 1 < 64) *(uint2*)(SCg + (u + 1) * 16384 + ((((wave * 4 + d) * 4 + g4) * 64 + lane) * 4)) = pkd; } }
    for (int c = 0; c < 64; c += 2) {
        if (compute) D2_COMPUTE(c)
        else { D2_STORE(1, 1) if (c + 3 < 64) D2_LOAD(1, cb + c + 3) }
        __syncthreads();
        if (compute) D2_COMPUTE(c + 1)
        else { if (c + 2 < 64) { D2_STORE(0, 0) } if (c + 4 < 64) D2_LOAD(0, cb + c + 4) }
        __syncthreads();
    }
}

__device__ __forceinline__ void r2_scan(const Params& P, int vb, int nvb) {
    const float* KVT = (const float*)(P.ws + WS_KVT); bf16_t* STR = (bf16_t*)(P.ws + WS_STR);
    int tid_ = VTID; asm volatile("" : "+v"(tid_));
    for (int idx = vb * 256 + tid_; idx < 16 * 8192; idx += nvb * 256) {
        const int bh = idx >> 13, e = idx & 8191, h = bh & 7;
        const float cd = exp2f(64.f * log2f(1.f - exp2f(-5.f - (float)h)));
        float S = 0.f;
#pragma unroll 8
        for (int c = 0; c < 64; ++c) {
            const size_t o = ((size_t)bh * 64 + c) * 8192 + e;
            STR[o] = f2bf(S);
            S = cd * S + KVT[o];
        }
    }
}

__device__ __forceinline__ void phase_econv(const Params& P, int bid, int nb, unsigned char* smem);
__device__ __forceinline__ void phase_scan(const Params& P, int bid, int nb, unsigned char* smem, int rbid, int rnb, unsigned char* rsmem, int mode = 0) {
    if (rbid < 16) { if (mode != 2) d2_scan(P, rbid, rsmem); }
    else if (mode != 1) {
        if (rnb != 256) phase_ple(P, rbid - 16, rnb - 16, rsmem);
        r2_scan(P, bid - 32, nb - 32);
        phase_econv(P, bid - 32, nb - 32, smem);
    }
}

template <int K1, bool RET>
__device__ __forceinline__ void chunk_out(const Params& P, int u, unsigned char* smem) {
    int tid_ = VTID; asm volatile("" : "+v"(tid_));
    const int tid = tid_, wave = tid >> 6, lane = tid & 63, wr = wave >> 1, wc = wave & 1;
    const int b = u >> 9, h = (u >> 6) & 7, c = u & 63;
    const size_t tok0 = (size_t)b * SEQ + c * 64;
    const bf16_t* A1 = RET ? (const bf16_t*)(P.ws + WS_QGR) + (size_t)u * 64 * 64 : (const bf16_t*)(P.ws + WS_QG) + (size_t)u * 64 * 128;
    const bf16_t* B1 = RET ? (const bf16_t*)(P.ws + WS_STR) + (size_t)u * 128 * 64 : (const bf16_t*)(P.ws + WS_SC) + (size_t)u * 128 * 128;
    const bf16_t* A2 = RET ? (const bf16_t*)(P.ws + WS_ATTR) + (size_t)u * 64 * 64 : (const bf16_t*)(P.ws + WS_ATT) + (size_t)u * 64 * 64;
    const bf16_t* B2 = RET ? (const bf16_t*)(P.ws + WS_VNTR) + (size_t)u * 128 * 64 : (const bf16_t*)(P.ws + WS_VNT) + (size_t)u * 128 * 64;
    unsigned char* As = smem;
    unsigned char* Bs = smem + 8192;
    float* red = (float*)(smem + 24576);
    f32x16 acc[2];
#pragma unroll
    for (int j = 0; j < 2; ++j)
#pragma unroll
        for (int r = 0; r < 16; ++r) acc[j][r] = 0.f;
    constexpr int NK1 = K1 / 64;
#pragma unroll
    for (int kt = 0; kt <= NK1; ++kt) {
        const bf16_t* Ap = (kt < NK1) ? A1 + kt * 64 : A2; const int lda = (kt < NK1) ? K1 : 64;
        const bf16_t* Bp = (kt < NK1) ? B1 + kt * 64 : B2; const int ldb = lda;
        __syncthreads();
#pragma unroll
        for (int i = 0; i < 2; ++i) { const int q = tid + 256 * i, row = q >> 3, ch = q & 7; *(uint4*)(As + lds_off(row, ch)) = *(const uint4*)(Ap + row * lda + ch * 8); }
        if (RET) {
#pragma unroll
            for (int i = 0; i < 4; ++i) { const int q = tid + 256 * i, row = q >> 3, ch = q & 7; *(uint4*)(Bs + lds_off(row, ch)) = *(const uint4*)(Bp + row * ldb + ch * 8); }
        } else {
#pragma unroll
            for (int i = 0; i < 8; ++i) {
                const int q = tid + 256 * i, ln = q & 63, g4 = (q >> 6) & 3, dd = (q >> 8) & 1, w = q >> 9;
                const size_t piece = (kt < NK1) ? (size_t)(((w * 4 + 2 * kt + dd) * 4 + g4) * 64 + ln) : (size_t)(((w * 2 + dd) * 4 + g4) * 64 + ln);
                const bf16_t* src = (kt < NK1) ? B1 : B2;
                const int kk = dd * 32 + 8 * g4 + 4 * (ln >> 5);
                *(uint2*)(Bs + lds_off(w * 32 + (ln & 31), kk >> 3) + (kk & 7) * 2) = *(const uint2*)(src + piece * 4);
            }
        }
        __syncthreads();
#pragma unroll
        for (int ks = 0; ks < 4; ++ks) {
            const bf16x8 fa = frag_ld(As, wr * 32 + (lane & 31), ks, lane);
#pragma unroll
            for (int j = 0; j < 2; ++j) acc[j] = __builtin_amdgcn_mfma_f32_32x32x16_bf16(fa, frag_ld(Bs, wc * 64 + j * 32 + (lane & 31), ks, lane), acc[j], 0, 0, 0);
        }
    }
#pragma unroll
    for (int r = 0; r < 16; ++r) {
        float s1 = acc[0][r] + acc[1][r], s2 = acc[0][r] * acc[0][r] + acc[1][r] * acc[1][r];
#pragma unroll
        for (int o = 16; o >= 1; o >>= 1) { s1 += __shfl_xor(s1, o); s2 += __shfl_xor(s2, o); }
        if ((lane & 31) == 0) { const int row = wr * 32 + (r & 3) + 8 * (r >> 2) + 4 * (lane >> 5); red[(row * 2 + wc) * 2] = s1; red[(row * 2 + wc) * 2 + 1] = s2; }
    }
    __syncthreads();
    const bf16_t* proj = (const bf16_t*)(P.ws + WS_PROJ); bf16_t* mixed = (bf16_t*)(P.ws + WS_MIXED);
#pragma unroll
    for (int r = 0; r < 16; ++r) {
        const int row = wr * 32 + (r & 3) + 8 * (r >> 2) + 4 * (lane >> 5);
        const float s1 = red[row * 4] + red[row * 4 + 2], s2 = red[row * 4 + 1] + red[row * 4 + 3];
        const size_t t = tok0 + row;
#pragma unroll
        for (int j = 0; j < 2; ++j) {
            const int dv = wc * 64 + j * 32 + (lane & 31);
            float y;
            if (!RET) {
                const float rs = rsqrtf(s2 * (1.f / 128.f) + EPS);
                y = acc[j][r] * rs * P.dn_norm[dv] * silu_f(bf2f(proj[t * NPROJ + C_Z + h * 128 + dv]));
                mixed[t * D + h * 128 + dv] = f2bf(y);
            } else {
                const float mu = s1 * (1.f / 128.f);
                const float var = fmaxf(s2 * (1.f / 128.f) - mu * mu, 0.f);
                const float rs = rsqrtf(var + EPS);
                y = ((acc[j][r] - mu) * rs * P.ret_gn_w[h * 128 + dv] + P.ret_gn_b[h * 128 + dv]) * silu_f(bf2f(proj[t * NPROJ + C_RG + h * 128 + dv]));
                mixed[t * D + 1024 + h * 128 + dv] = f2bf(y);
            }
        }
    }
}

__device__ __forceinline__ void phase_chunk3(const Params& P, int bid, int nb, unsigned char* smem) {
    for (int u = bid; u < 2048; u += nb) { if (u < 1024) chunk_out<128, false>(P, u, smem); else chunk_out<64, true>(P, u - 1024, smem); }
}

__device__ __forceinline__ void ins16(float (&l)[16], float x) {
#pragma unroll
    for (int i = 0; i < 16; ++i) { const float hi = fmaxf(l[i], x); x = fminf(l[i], x); l[i] = hi; }
}
__device__ __forceinline__ void phase_route(const Params& P, int bid, int nb, unsigned char* smem) {
    int* idx = (int*)(P.ws + WS_IDX); float* gates = (float*)(P.ws + WS_GATES);
    const bf16_t* Q = (const bf16_t*)(P.ws + WS_Q); const bf16_t* KEYS = (const bf16_t*)(P.ws + WS_KEYS);
    int tid_ = VTID; asm volatile("" : "+v"(tid_));
    const int tid = tid_, wave = tid >> 6, lane = tid & 63, fr = lane & 15, fq = lane >> 4;
    float* tile = (float*)smem;
    unsigned* L = (unsigned*)(smem + 256 * 33 * 4);
    const float NEG = -3.0e38f;
    for (int u = bid; u < 512; u += nb) {
        const size_t R0 = (size_t)u * 256;
        const size_t t0 = (size_t)u * 16;
        bf16x8 af[4][4];
#pragma unroll
        for (int j = 0; j < 4; ++j)
#pragma unroll
            for (int ks = 0; ks < 4; ++ks) af[j][ks] = *(const bf16x8*)(Q + (t0 + fr) * D + (4 * wave + j) * 128 + ks * 32 + fq * 8);
        float l[16];
#pragma unroll
        for (int i = 0; i < 16; ++i) l[i] = NEG;
        bf16x8 bq[2][2][4];
#define ROUTE_LOADB(chh, j0) _Pragma("unroll") for (int j = 0; j < 2; ++j) _Pragma("unroll") for (int nt = 0; nt < 2; ++nt) _Pragma("unroll") for (int ks = 0; ks < 4; ++ks) \
            bq[j][nt][ks] = *(const bf16x8*)(KEYS + (size_t)((4 * wave + (j0) + j) * 128 + (chh) * 32 + nt * 16 + fr) * 128 + ks * 32 + fq * 8);
#define ROUTE_MMA(j0) _Pragma("unroll") for (int j = 0; j < 2; ++j) _Pragma("unroll") for (int nt = 0; nt < 2; ++nt) { \
            f32x4 acc = {0.f, 0.f, 0.f, 0.f}; \
            _Pragma("unroll") for (int ks = 0; ks < 4; ++ks) acc = __builtin_amdgcn_mfma_f32_16x16x32_bf16(af[(j0) + j][ks], bq[j][nt][ks], acc, 0, 0, 0); \
            _Pragma("unroll") for (int jj = 0; jj < 4; ++jj) tile[((fq * 4 + jj) * 16 + 4 * wave + (j0) + j) * 33 + nt * 16 + fr] = acc[jj]; }
        ROUTE_LOADB(0, 0)
        for (int ch = 0; ch < 4; ++ch) {
            __syncthreads();
            ROUTE_MMA(0)
            ROUTE_LOADB(ch, 2)
            ROUTE_MMA(2)
            if (ch < 3) { ROUTE_LOADB(ch + 1, 0) }
            __syncthreads();
#pragma unroll
            for (int j = 0; j < 32; ++j) {
                const float x = __uint_as_float((__float_as_uint(tile[tid * 33 + j]) & ~0x7Fu) | (unsigned)(ch * 32 + j));
                ins16(l, x);
            }
        }
#pragma unroll
        for (int i = 0; i < 16; ++i) L[tid * 16 + i] = __float_as_uint(l[i]);
        __syncthreads();
        const int pe = tid & ~1, po = tid | 1;
        float s1[16], s2[16];
#pragma unroll
        for (int i = 0; i < 16; ++i) { s1[i] = __uint_as_float(L[pe * 16 + i]); s2[i] = __uint_as_float(L[po * 16 + i]); }
        float m[16];
#pragma unroll
        for (int i = 0; i < 16; ++i) m[i] = NEG;
#pragma unroll
        for (int i = 0; i < 16; ++i)
#pragma unroll
            for (int j = 0; j < 16; ++j)
                if ((i + 1) * (j + 1) <= 16) ins16(m, __uint_as_float((__float_as_uint(s1[i] + s2[j]) & ~0xFFu) | (unsigned)(i * 16 + j)));
        float e[16], sum = 0.f;
#pragma unroll
        for (int r = 0; r < 16; ++r) { e[r] = __expf(m[r] - m[0]); sum += e[r]; }
        const float inv = 1.f / sum;
        const int par = tid & 1;
        const size_t ob = ((R0 + tid) >> 1) * 16 + par * 8;
#pragma unroll
        for (int r = 0; r < 8; ++r) {
            float k_lo = m[r], k_hi = m[r + 8], e_lo = e[r], e_hi = e[r + 8];
            asm volatile("" : "+v"(k_lo), "+v"(k_hi), "+v"(e_lo), "+v"(e_hi));
            const float key = par ? k_hi : k_lo;
            const float ev = par ? e_hi : e_lo;
            const unsigned cand = __float_as_uint(key) & 0xFFu;
            const unsigned i1 = L[pe * 16 + (cand >> 4)] & 0x7Fu, i2 = L[po * 16 + (cand & 15)] & 0x7Fu;
            idx[ob + r] = (int)(i1 * 128 + i2);
            gates[ob + r] = ev * inv;
        }
    }
}

typedef float f32x2 __attribute__((ext_vector_type(2)));
typedef float v32f __attribute__((ext_vector_type(32)));
typedef float v16f __attribute__((ext_vector_type(16)));
typedef unsigned v6u __attribute__((ext_vector_type(6)));
constexpr int EROW = 1536;
__device__ __forceinline__ void fp6_calibrate(int (&sig)[32]) {
    v16f tlo, thi;
#pragma unroll
    for (int i = 0; i < 16; ++i) { tlo[i] = (i < 8) ? 0.125f * i : 1.f + 0.125f * (i - 8); thi[i] = (i < 8) ? 2.f + 0.25f * i : 4.f + 0.5f * (i - 8); }
    asm volatile("" : "+v"(tlo), "+v"(thi));
    const v6u tw = __builtin_amdgcn_cvt_scalef32_2xpk16_fp6_f32(tlo, thi, 1.0f);
    const v32f tr = __builtin_amdgcn_cvt_scalef32_pk32_f32_fp6(tw, 1.0f);
#pragma unroll
    for (int j = 0; j < 32; ++j) {
        const float v = tr[j];
        const int k = v < 2.f ? (int)(v * 8.f + 0.5f) : (v < 4.f ? 16 + (int)((v - 2.f) * 4.f + 0.5f) : 24 + (int)((v - 4.f) * 2.f + 0.5f));
        sig[j] = __builtin_amdgcn_readfirstlane(k) & 31;
    }
}
__device__ __forceinline__ void phase_econv(const Params& P, int bid, int nb, unsigned char* smem) {
    int tid_ = VTID; asm volatile("" : "+v"(tid_));
    const int wave = tid_ >> 6, lane = tid_ & 63;
    float* scales = (float*)(P.ws + WS_ESC);
    float* pad = (float*)smem + wave * (64 * 33 + 64);
    int* tab = (int*)(pad + 64 * 33);
    int inv[32];
    {
        int sig[32]; fp6_calibrate(sig);
#pragma unroll
        for (int j = 0; j < 32; ++j) if (lane == 0) tab[sig[j]] = j;
#pragma unroll
        for (int k = 0; k < 32; ++k) inv[k] = __builtin_amdgcn_readfirstlane(tab[k]) & 31;
    }
    for (int r = bid * 4 + wave; r < 32768; r += nb * 4) {
        const float* src = (r < 16384 ? P.expert_u : P.expert_v) + (size_t)(r & 16383) * D + lane * 32;
        unsigned char* dst = P.ws + WS_EU8 + (size_t)r * EROW + lane * 24;
        f32x4 v[8]; float am = 0.f;
#pragma unroll
        for (int i = 0; i < 8; ++i) { v[i] = *(const f32x4*)(src + i * 4); am = fmaxf(am, fmaxf(fmaxf(fabsf(v[i][0]), fabsf(v[i][1])), fmaxf(fabsf(v[i][2]), fabsf(v[i][3])))); }
        am = wave_max(am);
        const float sc = am > 0.f ? 7.5f / am : 1.f;
#pragma unroll
        for (int j = 0; j < 32; ++j) pad[lane * 33 + j] = v[j >> 2][j & 3] * sc;
        v16f lo, hi;
#pragma unroll
        for (int k = 0; k < 16; ++k) { lo[k] = pad[lane * 33 + inv[k]]; hi[k] = pad[lane * 33 + inv[16 + k]]; }
        const v6u w = __builtin_amdgcn_cvt_scalef32_2xpk16_fp6_f32(lo, hi, 1.0f);
        *(uint2*)(dst) = make_uint2(w[0], w[1]); *(uint2*)(dst + 8) = make_uint2(w[2], w[3]); *(uint2*)(dst + 16) = make_uint2(w[4], w[5]);
        if (lane == 0) scales[r] = am > 0.f ? am * (1.f / 7.5f) : 1.f;
    }
}

__device__ __forceinline__ float gelu_f(float d) { return 0.5f * d * (1.f + erff(d * 0.70710678118654752f)); }

template <bool DRY>
__device__ __forceinline__ void phase_peer(const Params& P, int bid, int nb) {
    const bf16_t* hn = (const bf16_t*)(P.ws + WS_HN); const int* idx = (const int*)(P.ws + WS_IDX); const float* gates = (const float*)(P.ws + WS_GATES);
    float* H = (float*)(P.ws + WS_H);
    const unsigned char* EU = P.ws + WS_EU8; const unsigned char* EV = P.ws + WS_EU8 + (size_t)16384 * EROW; const float* SC = (const float*)(P.ws + WS_ESC);
    const int wave = VTID >> 6, lane = VTID & 63;
    for (int t = bid * 4 + wave; t < T; t += nb * 4) {
        v32f xr, acc;
#pragma unroll
        for (int q = 0; q < 4; ++q) {
            const uint4 v = *(const uint4*)(hn + (size_t)t * D + lane * 32 + q * 8);
            const unsigned ww[4] = {v.x, v.y, v.z, v.w};
#pragma unroll
            for (int j = 0; j < 4; ++j) { xr[q * 8 + 2 * j] = bf2f((bf16_t)(ww[j] & 0xffff)); xr[q * 8 + 2 * j + 1] = bf2f((bf16_t)(ww[j] >> 16)); }
        }
#pragma unroll
        for (int i = 0; i < 32; ++i) acc[i] = 0.f;
        const float rs_t = rsqrtf(((const float*)(P.ws + WS_RSS))[t] * (1.f / 2048.f) + EPS);
        const int   my_i0 = idx[(size_t)t * 128 + lane],   my_i1 = idx[(size_t)t * 128 + 64 + lane];
        const float my_g0 = gates[(size_t)t * 128 + lane], my_g1 = gates[(size_t)t * 128 + 64 + lane];
        uint2 a_u0, a_u1, a_u2, a_v0, a_v1, a_v2, b_u0, b_u1, b_u2, b_v0, b_v1, b_v2, c_u0, c_u1, c_u2, c_v0, c_v1, c_v2;
#define PEER_LOAD1(U0, U1, U2, V0, V1, V2, e) { const uint2* up = (const uint2*)(EU + (size_t)(e) * EROW + lane * 24); U0 = up[0]; U1 = up[1]; U2 = up[2]; \
                                                 const uint2* vp = (const uint2*)(EV + (size_t)(e) * EROW + lane * 24); V0 = vp[0]; V1 = vp[1]; V2 = vp[2]; }
#define PEER_COMP1(U0, U1, U2, V0, V1, V2, e, g) { const v6u uw = {U0.x, U0.y, U1.x, U1.y, U2.x, U2.y}; const v32f uf = __builtin_amdgcn_cvt_scalef32_pk32_f32_fp6(uw, 1.0f); \
        float d = 0.f; _Pragma("unroll") for (int i = 0; i < 32; ++i) d += uf[i] * xr[i]; d = wave_sum(d); \
        const float pre = d * SC[e] * rs_t; const float a = gelu_f(pre) * (g) * SC[16384 + (e)]; \
        const v6u vw = {V0.x, V0.y, V1.x, V1.y, V2.x, V2.y}; const v32f vf = __builtin_amdgcn_cvt_scalef32_pk32_f32_fp6(vw, 1.0f); \
        _Pragma("unroll") for (int i = 0; i < 32; ++i) acc[i] += a * vf[i]; __builtin_amdgcn_sched_barrier(0); }
#define PEER_E(k) ((k) < 64 ? __builtin_amdgcn_readlane(my_i0, (k)) : __builtin_amdgcn_readlane(my_i1, (k) - 64))
#define PEER_G(k) __int_as_float((k) < 64 ? __builtin_amdgcn_readlane(__float_as_int(my_g0), (k)) : __builtin_amdgcn_readlane(__float_as_int(my_g1), (k) - 64))
        { const int e0 = PEER_E(0), e1 = PEER_E(1); PEER_LOAD1(a_u0, a_u1, a_u2, a_v0, a_v1, a_v2, e0) PEER_LOAD1(b_u0, b_u1, b_u2, b_v0, b_v1, b_v2, e1) }
        for (int k = 0; k < 126; k += 3) {
            { const int e2 = PEER_E(k + 2); PEER_LOAD1(c_u0, c_u1, c_u2, c_v0, c_v1, c_v2, e2) }
            { const int e0 = PEER_E(k); const float g0 = PEER_G(k); PEER_COMP1(a_u0, a_u1, a_u2, a_v0, a_v1, a_v2, e0, g0) }
            { const int e3 = PEER_E(k + 3); PEER_LOAD1(a_u0, a_u1, a_u2, a_v0, a_v1, a_v2, e3) }
            { const int e1 = PEER_E(k + 1); const float g1 = PEER_G(k + 1); PEER_COMP1(b_u0, b_u1, b_u2, b_v0, b_v1, b_v2, e1, g1) }
            { const int e4 = PEER_E(k + 4); PEER_LOAD1(b_u0, b_u1, b_u2, b_v0, b_v1, b_v2, e4) }
            { const int e2 = PEER_E(k + 2); const float g2 = PEER_G(k + 2); PEER_COMP1(c_u0, c_u1, c_u2, c_v0, c_v1, c_v2, e2, g2) }
        }
        { const int e0 = PEER_E(126); const float g0 = PEER_G(126); PEER_COMP1(a_u0, a_u1, a_u2, a_v0, a_v1, a_v2, e0, g0) }
        { const int e1 = PEER_E(127); const float g1 = PEER_G(127); PEER_COMP1(b_u0, b_u1, b_u2, b_v0, b_v1, b_v2, e1, g1) }
        if (DRY) {
#pragma unroll
            for (int i = 0; i < 32; ++i) asm volatile("" :: "v"(acc[i]));
            continue;
        }
        float ss = 0.f;
#pragma unroll
        for (int q = 0; q < 8; ++q) {
            f32x4* hp = (f32x4*)(H + (size_t)t * D + lane * 32 + q * 4);
            f32x4 hv = *hp;
#pragma unroll
            for (int j = 0; j < 4; ++j) { hv[j] += acc[q * 4 + j]; acc[q * 4 + j] = hv[j]; ss += hv[j] * hv[j]; }
            *hp = hv;
        }
        ss = wave_sum(ss);
        const float rs = rsqrtf(ss * (1.f / 2048.f) + EPS);
        bf16_t* hn3 = (bf16_t*)(P.ws + WS_HN) + (size_t)t * D + lane * 32;
#pragma unroll
        for (int q = 0; q < 4; ++q) {
            unsigned w[4];
#pragma unroll
            for (int j = 0; j < 4; ++j) { const int col = lane * 32 + q * 8 + 2 * j;
                w[j] = pack2(acc[q * 8 + 2 * j] * rs * P.norm_ple[col], acc[q * 8 + 2 * j + 1] * rs * P.norm_ple[col + 1]); }
            *(uint4*)(hn3 + q * 8) = make_uint4(w[0], w[1], w[2], w[3]);
        }
    }
}

enum { PH_PREP = 0, PH_GEMM1, PH_CHUNK1, PH_SCAN, PH_CHUNK3, PH_GEMM2, PH_GEMM3, PH_ROUTE, PH_PEER, PH_GEMM4, PH_FINAL, PH_COUNT };

#define XB_TMO      128
#define XB_XCNT(j)  (256  + 64 * (j))
#define XB_XSUB(j)  (1280 + 64 * (j))
#define XB_XGEN(j)  (2304 + 64 * (j))
#define XB_TOP      3328
#define XB_TOPGEN   3392
#define XCD_BAR_WORDS 3456
#define XB_SPIN_CAP (1u << 20)
#define LAS __attribute__((address_space(3)))
__device__ __forceinline__ unsigned xb_ld(unsigned* p)              { return __hip_atomic_load(p, __ATOMIC_RELAXED, __HIP_MEMORY_SCOPE_AGENT); }
__device__ __forceinline__ unsigned xb_add(unsigned* p, unsigned v) { return __hip_atomic_fetch_add(p, v, __ATOMIC_RELAXED, __HIP_MEMORY_SCOPE_AGENT); }
__device__ __forceinline__ unsigned xb_xcc_id() { return (unsigned)__builtin_amdgcn_s_getreg((3 << 11) | 20) & 0xFu; }
#define XB_SPIN(cond, bar) do { unsigned _sp = 0; while (cond) { __builtin_amdgcn_s_sleep(1); \
    if ((++_sp & 255u) == 0u) { if (xb_ld(&(bar)[XB_TMO])) break; if (_sp > XB_SPIN_CAP) { atomicAdd(&(bar)[XB_TMO], 1u); break; } } } } while (0)
struct XcdBarrier { unsigned* bar; unsigned x; volatile LAS unsigned* st; };
__device__ __forceinline__ XcdBarrier xcd_barrier_post(unsigned* bar, volatile LAS unsigned* st) {
    XcdBarrier b; b.bar = bar; b.x = xb_xcc_id(); b.st = st;
    if (threadIdx.x == 0) (void)xb_add(&bar[XB_XCNT(b.x)], 1u);
    return b;
}
__device__ __forceinline__ void xcd_barrier_complete(unsigned* bar, unsigned x, unsigned& nloc, unsigned& nx) {
    const unsigned G = gridDim.x * gridDim.y * gridDim.z;
    unsigned sum, cnt, mine, sp = 0u;
    for (;;) {
        sum = 0u; cnt = 0u; mine = 0u;
#pragma unroll
        for (unsigned j = 0; j < 16; ++j) { const unsigned c = xb_ld(&bar[XB_XCNT(j)]); sum += c; cnt += (c > 0u) ? 1u : 0u; mine = (j == x) ? c : mine; }
        if (sum == G) break;
        __builtin_amdgcn_s_sleep(1);
        if ((++sp & 255u) == 0u) { if (xb_ld(&bar[XB_TMO])) break; if (sp > XB_SPIN_CAP) { atomicAdd(&bar[XB_TMO], 1u); break; } }
    }
    nloc = mine > 0u ? mine : 1u; nx = cnt > 0u ? cnt : 1u;
}
__device__ __forceinline__ void xcd_barrier(const XcdBarrier& b) {
    asm volatile("s_waitcnt vmcnt(0)" ::: "memory");
    __syncthreads();
    if (threadIdx.x == 0) {
        unsigned* bar = b.bar;
        __builtin_amdgcn_s_waitcnt(0);
        unsigned nloc = b.st[0], nx = b.st[1];
        if (nloc == 0u) { xcd_barrier_complete(bar, b.x, nloc, nx); b.st[0] = nloc; b.st[1] = nx; }
        const unsigned old = xb_add(&bar[XB_XSUB(b.x)], 1u);
        const unsigned gen = old / nloc;
        if (old + 1u == (gen + 1u) * nloc) {
            __builtin_amdgcn_fence(__ATOMIC_RELEASE, "agent");
            asm volatile("s_waitcnt vmcnt(0)" ::: "memory");
            const unsigned og = xb_add(&bar[XB_TOP], 1u);
            const unsigned tg = og / nx;
            if (og + 1u == (tg + 1u) * nx) xb_add(&bar[XB_TOPGEN], 1u);
            else XB_SPIN(xb_ld(&bar[XB_TOPGEN]) == tg, bar);
            __builtin_amdgcn_fence(__ATOMIC_ACQUIRE, "agent");
            xb_add(&bar[XB_XGEN(b.x)], 1u);
            asm volatile("s_waitcnt vmcnt(0)" ::: "memory");
        } else {
            XB_SPIN(xb_ld(&bar[XB_XGEN(b.x)]) == gen, bar);
            __builtin_amdgcn_fence(__ATOMIC_ACQUIRE, "agent");
            asm volatile("s_waitcnt vmcnt(0)" ::: "memory");
        }
    }
    __syncthreads();
}

__device__ __forceinline__ void run_phase(const Params& P, int ph, int bid, int nb, unsigned char* smem, int rbid, int rnb, unsigned char* rsmem) {
    switch (ph) {
        case PH_PREP:   phase_prep(P, bid, nb, smem); break;
        case PH_GEMM1:  phase_gemm1(P, rbid, rnb, rsmem); break;
        case PH_CHUNK1: phase_chunk1(P, bid, nb, smem); break;
        case PH_SCAN:   phase_scan(P, bid, nb, smem, rbid, rnb, rsmem); break;
        case PH_SCAN + 100: phase_scan(P, bid, nb, smem, rbid, rnb, rsmem, 1); break;
        case PH_SCAN + 200: phase_scan(P, bid, nb, smem, rbid, rnb, rsmem, 2); break;
        case PH_CHUNK3: phase_chunk3(P, bid, nb, smem); break;
        case PH_GEMM2:  phase_gemm2(P, rbid, rnb, rsmem); break;
        case PH_GEMM3:  phase_gemm3(P, rbid, rnb, rsmem); break;
        case PH_ROUTE:  phase_route(P, bid, nb, smem); break;
        case PH_PEER:   phase_peer<false>(P, bid, nb); break;
        case PH_PEER + 100: phase_peer<true>(P, bid, nb); break;
        case PH_GEMM4:  phase_gemm4(P, rbid, rnb, rsmem); break;
        case PH_FINAL:  phase_rownorm<false>((const float*)(P.ws + WS_H), P.norm_final, P.out, bid, nb); break;
    }
}

#ifndef PROBE_A
#define PROBE_A -1
#endif
#ifndef PROBE_B
#define PROBE_B -1
#endif
constexpr int LDS_BYTES = 131072 + 16 + 256;

__global__ void __launch_bounds__(512, 2) fwd_kernel(Params P, int ph_lo, int ph_hi) {
    extern __shared__ __attribute__((aligned(16))) unsigned char rsmem[];
    const int rbid = blockIdx.x, rnb = gridDim.x;
    const int half = __builtin_amdgcn_readfirstlane((int)(threadIdx.x >> 8));
    const int bid = rbid * 2 + half, nb = rnb * 2;
    unsigned char* smem = rsmem + half * 65536;
    volatile LAS unsigned* st = (volatile LAS unsigned*)(rsmem + 131072);
    if (threadIdx.x == 0) { st[0] = 0u; st[1] = 0u; }
    __syncthreads();
    XcdBarrier xb = xcd_barrier_post((unsigned*)(P.ws + WS_BAR), st);
#if PROBE_A >= 0
    unsigned long long* tstamp = (unsigned long long*)(rsmem + 131072 + 16);
    xcd_barrier(xb);
    if (threadIdx.x == 0) tstamp[0] = __builtin_amdgcn_s_memrealtime();
#define RUN(ph) if (ph_lo <= (ph) && (ph) < ph_hi) { run_phase(P, (ph), bid, nb, smem, rbid, rnb, rsmem); xcd_barrier(xb); if (threadIdx.x == 0) tstamp[(ph) + 1] = __builtin_amdgcn_s_memrealtime(); }
#else
#ifndef SCAN_PROBE
#define SCAN_PROBE 0
#endif
#ifndef REPEAT_PH
#define REPEAT_PH -1
#endif
#define RUN(ph) if (ph_lo <= (ph) && (ph) < ph_hi) { if ((ph) == REPEAT_PH && (ph) == PH_PEER) { run_phase(P, PH_PEER + 100, bid, nb, smem, rbid, rnb, rsmem); xcd_barrier(xb); } run_phase(P, (ph), bid, nb, smem, rbid, rnb, rsmem); if ((ph) == REPEAT_PH && (ph) != PH_PEER) { xcd_barrier(xb); run_phase(P, (ph) == PH_SCAN ? PH_SCAN + SCAN_PROBE : (ph), bid, nb, smem, rbid, rnb, rsmem); } if ((ph) + 1 < ph_hi) xcd_barrier(xb); }
#endif
    RUN(PH_PREP) RUN(PH_GEMM1) RUN(PH_CHUNK1) RUN(PH_SCAN) RUN(PH_CHUNK3) RUN(PH_GEMM2) RUN(PH_GEMM3) RUN(PH_ROUTE)
    RUN(PH_PEER) RUN(PH_GEMM4) RUN(PH_FINAL)
#if PROBE_A >= 0
    __syncthreads();
    if (rbid == 0) {
        const float da = (float)(tstamp[PROBE_A + 1] - tstamp[PROBE_A]) * 0.01f;
        if (threadIdx.x == 0) P.out[0] = da;
#if PROBE_B >= 0
        const float db = (float)(tstamp[PROBE_B + 1] - tstamp[PROBE_B]) * 0.01f * (1.f / 16.f);
        for (int i = threadIdx.x; i < 65536; i += 512) P.out[65536 + i] = db;
#endif
    }
#endif
}

extern "C" void kernel_launch(void* const* d_in, const int* in_sizes, int n_in, void* d_out, int out_size, void* d_ws, size_t ws_size, hipStream_t stream) {
    static int grid = 0;
    if (grid == 0) {
        if (n_in != 21 || out_size != T * D || ws_size < WS_END) { fprintf(stderr, "kernel_launch: unexpected shapes: n_in %d out %d ws %zu (need %zu)\n", n_in, out_size, ws_size, (size_t)WS_END); grid = -1; return; }
        if (hipFuncSetAttribute((const void*)fwd_kernel, hipFuncAttributeMaxDynamicSharedMemorySize, LDS_BYTES) != hipSuccess) { fprintf(stderr, "kernel_launch: hipFuncSetAttribute failed\n"); grid = -1; return; }
        int dev = 0, cus = 0, per_cu = 0;
        hipGetDevice(&dev); hipDeviceGetAttribute(&cus, hipDeviceAttributeMultiprocessorCount, dev);
        if (hipOccupancyMaxActiveBlocksPerMultiprocessor(&per_cu, (const void*)fwd_kernel, 512, LDS_BYTES) != hipSuccess || per_cu < 1) { fprintf(stderr, "kernel_launch: occupancy query failed (%d)\n", per_cu); grid = -1; return; }
        if (per_cu > 1) per_cu = 1;
        grid = cus * per_cu;
        fprintf(stderr, "kernel_launch: grid %d (%d CUs x %d)\n", grid, cus, per_cu);
    }
    if (grid < 0) return;
    Params P{};
    P.x = (const float*)d_in[0]; P.p = (const float*)d_in[1]; P.positions = (const int*)d_in[2]; P.norm_mix = (const float*)d_in[3]; P.w_in = (const float*)d_in[4];
    P.conv_w = (const float*)d_in[5]; P.a_log = (const float*)d_in[6]; P.dt_bias = (const float*)d_in[7]; P.dn_norm = (const float*)d_in[8]; P.ret_gn_w = (const float*)d_in[9];
    P.ret_gn_b = (const float*)d_in[10]; P.w_out = (const float*)d_in[11]; P.norm_ffn = (const float*)d_in[12]; P.w_pq = (const float*)d_in[13]; P.sub_keys = (const float*)d_in[14];
    P.expert_u = (const float*)d_in[15]; P.expert_v = (const float*)d_in[16]; P.norm_ple = (const float*)d_in[17]; P.w_ple_gate = (const float*)d_in[18]; P.w_ple_proj = (const float*)d_in[19];
    P.norm_final = (const float*)d_in[20]; P.out = (float*)d_out; P.ws = (unsigned char*)d_ws;
    (void)hipMemsetAsync((unsigned char*)d_ws + WS_BAR, 0, XCD_BAR_WORDS * 4, stream);
    int lo = 0, hi = PH_COUNT;
    void* args[] = {&P, &lo, &hi};
    hipError_t e = hipLaunchCooperativeKernel((const void*)fwd_kernel, dim3(grid), dim3(512), args, LDS_BYTES, stream);
    if (e != hipSuccess) fprintf(stderr, "kernel_launch: cooperative launch failed: %s (grid %d)\n", hipGetErrorString(e), grid);
}
```

```cpp
#include <hip/hip_runtime.h>
#include <cstdio>
#include <cstdint>

typedef unsigned short bf16_t;
typedef short bf16x8 __attribute__((ext_vector_type(8)));
typedef float f32x16 __attribute__((ext_vector_type(16)));
typedef float f32x4 __attribute__((ext_vector_type(4)));
__device__ __forceinline__ int fresh_tid() { int t = (int)threadIdx.x; asm volatile("" : "+v"(t)); return t; }
#define VTID (fresh_tid() & 255)

constexpr int T = 8192, D = 2048, SEQ = 4096;
constexpr int NPROJ = 7424;
constexpr int C_Z = 3072, C_RQ = 4096, C_RK = 4608, C_RV = 5120, C_RG = 6144, C_A = 7168, C_B = 7176;
constexpr int IN_COLS = 7184;
constexpr float EPS = 1e-6f;

constexpr size_t WS_HN    = 0;
constexpr size_t WS_KVT   = WS_HN;
constexpr size_t WS_WTIN  = WS_HN + (size_t)T * D * 2;
constexpr size_t WS_STR   = WS_WTIN;
constexpr size_t WS_ATTR  = WS_STR + (size_t)1024 * 128 * 64 * 2;
constexpr size_t WS_WTOUT = WS_WTIN + (size_t)NPROJ * D * 2;
constexpr size_t WS_WTPQ  = WS_WTOUT + (size_t)D * D * 2;
constexpr size_t WS_WTG   = WS_WTPQ + (size_t)D * D * 2;
constexpr size_t WS_WTPP  = WS_WTG + (size_t)D * D * 2;
constexpr size_t WS_KEYS  = WS_WTPP + (size_t)D * 256 * 2;
constexpr size_t WS_PBF   = WS_KEYS + (size_t)16 * 128 * 128 * 2;
constexpr size_t WS_PROJ  = WS_PBF + (size_t)T * 256 * 2;
constexpr size_t WS_Q     = WS_PROJ;
constexpr size_t WS_SCORES= WS_PROJ + (size_t)T * D * 2;
constexpr size_t WS_MIXED = WS_PROJ + (size_t)T * NPROJ * 2;
constexpr size_t WS_H     = WS_MIXED + (size_t)T * D * 2;
constexpr size_t WS_IDX   = WS_H + (size_t)T * D * 4;
constexpr size_t WS_GATES = WS_IDX + (size_t)T * 128 * 4;
constexpr size_t WS_U     = WS_GATES + (size_t)T * 128 * 4;
constexpr size_t WS_W     = WS_U + (size_t)1024 * 64 * 128 * 4;
constexpr size_t WS_KDT   = WS_W + (size_t)1024 * 64 * 128 * 2;
constexpr size_t WS_QG    = WS_KDT + (size_t)1024 * 128 * 64 * 2;
constexpr size_t WS_ATT   = WS_QG + (size_t)1024 * 64 * 128 * 2;
constexpr size_t WS_QGR   = WS_ATT + (size_t)1024 * 64 * 64 * 2;
constexpr size_t WS_EU8   = WS_QGR + (size_t)1024 * 64 * 64 * 2;
constexpr size_t WS_EV4   = WS_EU8 + (size_t)16384 * 2048;
constexpr size_t WS_ESC   = WS_EV4 + (size_t)16384 * 2048;
constexpr size_t WS_EG    = WS_ESC + (size_t)2 * 16384 * 4;
constexpr size_t WS_RSS   = WS_EG + 4096;
constexpr size_t WS_BAR   = WS_RSS + (size_t)T * 4;
constexpr size_t WS_END   = WS_BAR + 16384;
constexpr size_t WS_VNT   = WS_H;
constexpr size_t WS_SC    = WS_VNT + (size_t)1024 * 128 * 64 * 2;
constexpr size_t WS_VNTR  = WS_SC + (size_t)1024 * 128 * 128 * 2;
static_assert(WS_VNTR + (size_t)1024 * 128 * 64 * 2 == WS_H + (size_t)T * D * 4, "chunk buffers must fit the H region");

struct Params {
    const float *x, *p; const int* positions;
    const float *norm_mix, *w_in, *conv_w, *a_log, *dt_bias, *dn_norm, *ret_gn_w, *ret_gn_b, *w_out, *norm_ffn, *w_pq, *sub_keys,
                *expert_u, *expert_v, *norm_ple, *w_ple_gate, *w_ple_proj, *norm_final;
    float* out; unsigned char* ws;
};

typedef __bf16 bf16v2_t __attribute__((ext_vector_type(2)));
typedef float f32v2_t __attribute__((ext_vector_type(2)));
__device__ __forceinline__ bf16_t f2bf(float f) { return __builtin_bit_cast(bf16_t, (__bf16)f); }
__device__ __forceinline__ float bf2f(bf16_t h) { return __uint_as_float(((unsigned)h) << 16); }
__device__ __forceinline__ unsigned pack2(float a, float b) { const f32v2_t v = {a, b}; return __builtin_bit_cast(unsigned, __builtin_convertvector(v, bf16v2_t)); }
__device__ __forceinline__ float wave_sum(float v) {
#pragma unroll
    for (int o = 32; o >= 1; o >>= 1) v += __shfl_xor(v, o);
    return v;
}
__device__ __forceinline__ float wave_max(float v) {
#pragma unroll
    for (int o = 32; o >= 1; o >>= 1) v = fmaxf(v, __shfl_xor(v, o));
    return v;
}
__device__ __forceinline__ float silu_f(float x) { return x / (1.f + __expf(-x)); }
__device__ __forceinline__ float sigmoid_f(float x) { return 1.f / (1.f + __expf(-x)); }

template <bool MAPIN>
__device__ __forceinline__ void transpose_tile(const float* __restrict__ W, int ldw, int K, bf16_t* __restrict__ Wt, int kt, int nt, float* tile  ) {
    const int tid = VTID;
    __syncthreads();
#pragma unroll
    for (int i = 0; i < 4; ++i) {
        const int idx = tid + 256 * i, kr = idx >> 4, c4 = idx & 15;
        const int n = nt * 64 + c4 * 4;
        int c = n; bool valid = true;
        if (MAPIN) { if (n < 4096) c = n; else if (n < 7168) c = n + 16; else if (n < 7184) c = n - 3072; else valid = false; }
        f32x4 v = {0.f, 0.f, 0.f, 0.f};
        if (valid) v = *(const f32x4*)(W + (size_t)(kt * 64 + kr) * ldw + c);
        float* d = tile + kr * 65 + c4 * 4;
        d[0] = v[0]; d[1] = v[1]; d[2] = v[2]; d[3] = v[3];
    }
    __syncthreads();
#pragma unroll
    for (int i = 0; i < 2; ++i) {
        const int ch = tid + 256 * i, n = ch >> 3, kc = ch & 7;
        unsigned w[4];
#pragma unroll
        for (int j = 0; j < 4; ++j) w[j] = pack2(tile[(kc * 8 + 2 * j) * 65 + n], tile[(kc * 8 + 2 * j + 1) * 65 + n]);
        uint4 o = make_uint4(w[0], w[1], w[2], w[3]);
        *(uint4*)(Wt + (size_t)(nt * 64 + n) * K + kt * 64 + kc * 8) = o;
    }
}

template <bool OUT_BF16>
__device__ __forceinline__ void rmsnorm_row(const float* __restrict__ in, const float* __restrict__ w, void* __restrict__ out, int lane) {
    f32x4 v[8]; float ss = 0.f;
#pragma unroll
    for (int i = 0; i < 8; ++i) { v[i] = *(const f32x4*)(in + (i * 64 + lane) * 4); ss += v[i][0] * v[i][0] + v[i][1] * v[i][1] + v[i][2] * v[i][2] + v[i][3] * v[i][3]; }
    ss = wave_sum(ss);
    const float r = rsqrtf(ss * (1.f / 2048.f) + EPS);
#pragma unroll
    for (int i = 0; i < 8; ++i) {
        const f32x4 g = *(const f32x4*)(w + (i * 64 + lane) * 4);
        const float a = v[i][0] * r * g[0], b = v[i][1] * r * g[1], c = v[i][2] * r * g[2], d = v[i][3] * r * g[3];
        if (OUT_BF16) { uint2 o = make_uint2(pack2(a, b), pack2(c, d)); *(uint2*)((bf16_t*)out + (i * 64 + lane) * 4) = o; }
        else { f32x4 o = {a, b, c, d}; *(f32x4*)((float*)out + (i * 64 + lane) * 4) = o; }
    }
}

__device__ __forceinline__ void phase_prep(const Params& P, int bid, int nb, unsigned char* smem) {
    float* tile = (float*)smem;
    const int tid = VTID;
    const int n_in = 32 * 116, n_sq = 32 * 32, n_pp = 4 * 32;
    const int n_tr = n_in + 3 * n_sq + n_pp;
    for (int u = bid; u < n_tr; u += nb) {
        if (u < n_in) transpose_tile<true>(P.w_in, IN_COLS, D, (bf16_t*)(P.ws + WS_WTIN), u % 32, u / 32, tile);
        else if (u < n_in + n_sq) { const int v = u - n_in; transpose_tile<false>(P.w_out, D, D, (bf16_t*)(P.ws + WS_WTOUT), v % 32, v / 32, tile); }
        else if (u < n_in + 2 * n_sq) { const int v = u - n_in - n_sq; transpose_tile<false>(P.w_pq, D, D, (bf16_t*)(P.ws + WS_WTPQ), v % 32, v / 32, tile); }
        else if (u < n_in + 3 * n_sq) { const int v = u - n_in - 2 * n_sq; transpose_tile<false>(P.w_ple_gate, D, D, (bf16_t*)(P.ws + WS_WTG), v % 32, v / 32, tile); }
        else { const int v = u - n_in - 3 * n_sq; transpose_tile<false>(P.w_ple_proj, D, 256, (bf16_t*)(P.ws + WS_WTPP), v % 4, v / 4, tile); }
    }
    {
        bf16_t* keys = (bf16_t*)(P.ws + WS_KEYS); bf16_t* pbf = (bf16_t*)(P.ws + WS_PBF);
        const int n4a = 262144 / 4, n4b = T * 256 / 4;
        for (int i = bid * 256 + tid; i < n4a + n4b; i += nb * 256) {
            const bool a = i < n4a; const int j = a ? i : i - n4a;
            const f32x4 v = *(const f32x4*)((a ? P.sub_keys : P.p) + (size_t)j * 4);
            *(uint2*)((a ? keys : pbf) + (size_t)j * 4) = make_uint2(pack2(v[0], v[1]), pack2(v[2], v[3]));
        }
    }
    { float* rss = (float*)(P.ws + WS_RSS); for (int i = bid * 256 + tid; i < T; i += nb * 256) rss[i] = 0.f; }
    {
        const int wave = tid >> 6, lane = tid & 63;
        bf16_t* hn = (bf16_t*)(P.ws + WS_HN);
        for (int r = bid * 4 + wave; r < T; r += nb * 4) rmsnorm_row<true>(P.x + (size_t)r * D, P.norm_mix, hn + (size_t)r * D, lane);
    }
}

__device__ __forceinline__ int lds_off(int row, int ch) { return row * 128 + ((ch ^ ((row >> 1) & 7)) << 4); }

__device__ __forceinline__ void gemm_mainloop(const bf16_t* __restrict__ A, int lda, const bf16_t* __restrict__ Bt, int ldb, int K,
                                              f32x16 (&acc)[2][2], unsigned char* smem) {
    const int tid = VTID, wave = tid >> 6, lane = tid & 63, wr = wave >> 1, wc = wave & 1;
    const int nk = K / 64;
    uint4 ra[4], rb[4];
    __syncthreads();
#pragma unroll
    for (int i = 0; i < 4; ++i) { const int c = tid + 256 * i, row = c >> 3, ch = c & 7;
        ra[i] = *(const uint4*)(A + (size_t)row * lda + ch * 8); rb[i] = *(const uint4*)(Bt + (size_t)row * ldb + ch * 8); }
#pragma unroll
    for (int i = 0; i < 4; ++i) { const int c = tid + 256 * i, row = c >> 3, ch = c & 7;
        *(uint4*)(smem + lds_off(row, ch)) = ra[i]; *(uint4*)(smem + 16384 + lds_off(row, ch)) = rb[i]; }
    __syncthreads();
    for (int kt = 0; kt < nk; ++kt) {
        unsigned char* cur = smem + (kt & 1) * 32768;
        unsigned char* nxt = smem + ((kt + 1) & 1) * 32768;
        const bool more = kt + 1 < nk;
        if (more) {
#pragma unroll
            for (int i = 0; i < 4; ++i) { const int c = tid + 256 * i, row = c >> 3, ch = c & 7;
                ra[i] = *(const uint4*)(A + (size_t)row * lda + (kt + 1) * 64 + ch * 8); rb[i] = *(const uint4*)(Bt + (size_t)row * ldb + (kt + 1) * 64 + ch * 8); }
        }
#pragma unroll
        for (int ks = 0; ks < 4; ++ks) {
            bf16x8 af[2], bfr[2];
#pragma unroll
            for (int i = 0; i < 2; ++i) { const int row = wr * 64 + i * 32 + (lane & 31); af[i] = *(const bf16x8*)(cur + lds_off(row, ks * 2 + (lane >> 5))); }
#pragma unroll
            for (int j = 0; j < 2; ++j) { const int row = wc * 64 + j * 32 + (lane & 31); bfr[j] = *(const bf16x8*)(cur + 16384 + lds_off(row, ks * 2 + (lane >> 5))); }
#pragma unroll
            for (int i = 0; i < 2; ++i)
#pragma unroll
                for (int j = 0; j < 2; ++j) acc[i][j] = __builtin_amdgcn_mfma_f32_32x32x16_bf16(af[i], bfr[j], acc[i][j], 0, 0, 0);
        }
        if (more) {
#pragma unroll
            for (int i = 0; i < 4; ++i) { const int c = tid + 256 * i, row = c >> 3, ch = c & 7;
                *(uint4*)(nxt + lds_off(row, ch)) = ra[i]; *(uint4*)(nxt + 16384 + lds_off(row, ch)) = rb[i]; }
        }
        __syncthreads();
    }
}
#define ACC_FOREACH(body)                                                                                   \
    { const int _tid = VTID, _wave = _tid >> 6, _lane = _tid & 63, _wr = _wave >> 1, _wc = _wave & 1; \
      _Pragma("unroll") for (int i = 0; i < 2; ++i) _Pragma("unroll") for (int j = 0; j < 2; ++j)          \
      _Pragma("unroll") for (int r = 0; r < 16; ++r) {                                                     \
          const int row = _wr * 64 + i * 32 + (r & 3) + 8 * (r >> 2) + 4 * (_lane >> 5);                   \
          const int col = _wc * 64 + j * 32 + (_lane & 31); body } }

__device__ __forceinline__ void zero_acc(f32x16 (&acc)[2][2]) {
#pragma unroll
    for (int i = 0; i < 2; ++i)
#pragma unroll
        for (int j = 0; j < 2; ++j)
#pragma unroll
            for (int r = 0; r < 16; ++r) acc[i][j][r] = 0.f;
}

__device__ __forceinline__ void phase_scores(const Params& P, int bid, int nb, unsigned char* smem) {
    const bf16_t* A = (const bf16_t*)(P.ws + WS_Q); const bf16_t* Bt = (const bf16_t*)(P.ws + WS_KEYS); float* C = (float*)(P.ws + WS_SCORES);
    const int nmt = T / 128, nnt = 16;
    for (int t = bid; t < nmt * nnt; t += nb) {
        const int mt = t % nmt, nt = t / nmt;
        f32x16 acc[2][2]; zero_acc(acc);
        gemm_mainloop(A + (size_t)mt * 128 * D + nt * 128, D, Bt + (size_t)nt * 128 * 128, 128, 128, acc, smem);
        ACC_FOREACH({ C[(size_t)(mt * 128 + row) * D + nt * 128 + col] = acc[i][j][r]; })
    }
}
__device__ __forceinline__ int g2_lds_byte(int r, int c) { const int st = (r >> 4) * 2 + (c >> 5), ob = (r & 15) * 64 + (c & 31) * 2; return st * 1024 + (ob ^ (((ob >> 9) & 1) << 5)); }
__device__ __forceinline__ void g2_stage_rc(int b, int& R, int& C) { const int st = b >> 10, sb = b & 1023, swz = sb ^ (((sb >> 9) & 1) << 5); R = (st >> 1) * 16 + (swz >> 6); C = (st & 1) * 32 + ((swz & 63) >> 1); }
__device__ __forceinline__ void g2_zero(f32x4 (&acc)[8][4]) {
#pragma unroll
    for (int m = 0; m < 8; ++m)
#pragma unroll
        for (int n = 0; n < 4; ++n) acc[m][n] = (f32x4){0.f, 0.f, 0.f, 0.f};
}
__device__ __forceinline__ void g2_mainloop(const bf16_t* __restrict__ Ab, int lda, const bf16_t* __restrict__ Bb, int ldb, int K, f32x4 (&acc)[8][4], unsigned char* shm) {
    const int tid = fresh_tid(), wid = tid >> 6, lane = tid & 63, wr = wid >> 2, wc = wid & 3, fr = lane & 15, fq = lane >> 4;
    int sR[4], sC[4];
#pragma unroll
    for (int i = 0; i < 4; ++i) g2_stage_rc(wid * 1024 + i * 8192 + lane * 16, sR[i], sC[i]);
#define G2_STAGE(buf, kt) { _Pragma("unroll") for (int i = 0; i < 4; ++i) { \
        __builtin_amdgcn_global_load_lds((const unsigned*)(Ab + (size_t)sR[i] * lda + (kt) * 64 + sC[i]), (unsigned*)(shm + (buf) * 65536 + wid * 1024 + i * 8192), 16, 0, 0); \
        __builtin_amdgcn_global_load_lds((const unsigned*)(Bb + (size_t)sR[i] * ldb + (kt) * 64 + sC[i]), (unsigned*)(shm + (buf) * 65536 + 32768 + wid * 1024 + i * 8192), 16, 0, 0); } }
    const int nt = K / 64;
    __syncthreads();
    G2_STAGE(0, 0)
    asm volatile("s_waitcnt vmcnt(0)" ::: "memory");
    __syncthreads();
    for (int t = 0; t < nt; ++t) {
        const int cur = t & 1;
        if (t + 1 < nt) G2_STAGE(cur ^ 1, t + 1)
        const unsigned char* SA = shm + cur * 65536; const unsigned char* SB = SA + 32768;
#pragma unroll
        for (int ks = 0; ks < 2; ++ks) {
            bf16x8 At[8], Bf[4];
#pragma unroll
            for (int m = 0; m < 8; ++m) At[m] = *(const bf16x8*)(SA + g2_lds_byte(wr * 128 + m * 16 + fr, ks * 32 + fq * 8));
#pragma unroll
            for (int n = 0; n < 4; ++n) Bf[n] = *(const bf16x8*)(SB + g2_lds_byte(wc * 64 + n * 16 + fr, ks * 32 + fq * 8));
#pragma unroll
            for (int m = 0; m < 8; ++m)
#pragma unroll
                for (int n = 0; n < 4; ++n) acc[m][n] = __builtin_amdgcn_mfma_f32_16x16x32_bf16(At[m], Bf[n], acc[m][n], 0, 0, 0);
            __builtin_amdgcn_sched_barrier(0);
        }
        asm volatile("s_waitcnt vmcnt(0)" ::: "memory");
        __syncthreads();
    }
}
#define G2_FOREACH(body)                                                                                       \
    { const int _tid = fresh_tid(), _wid = _tid >> 6, _lane = _tid & 63, _wr = _wid >> 2, _wc = _wid & 3, _fr = _lane & 15, _fq = _lane >> 4; \
      _Pragma("unroll") for (int m = 0; m < 8; ++m) _Pragma("unroll") for (int n = 0; n < 4; ++n)             \
      _Pragma("unroll") for (int j = 0; j < 4; ++j) {                                                         \
          const int row = _wr * 128 + m * 16 + _fq * 4 + j; const int col = _wc * 64 + n * 16 + _fr; const float val = acc[m][n][j]; body } }
#define G8_HT (128 * 64)
__device__ __forceinline__ void g8_mainloop(const bf16_t* __restrict__ A, const bf16_t* __restrict__ Bt, int K, int brow, int bcol, f32x4 (&acc)[2][2][4][2], unsigned char* shmb) {
    bf16_t* shm = (bf16_t*)shmb;
    const int tid = fresh_tid();
    const int wid = tid >> 6, lane = tid & 63, wr = wid >> 2, wc = wid & 3, fr = lane & 15, fq = lane >> 4;
#define G8_SA(b, h) (shm + ((b) * 2 + (h)) * G8_HT)
#define G8_SB(b, h) (shm + (4 + (b) * 2 + (h)) * G8_HT)
#define G8_STAGE(Pp, BASE, br, kt) do { const long _g = (long)(br) * K + (long)(kt) * 64; \
    _Pragma("unroll") for (int _i = 0; _i < 2; ++_i) { const int _b = tid * 16 + _i * 8192; int _r, _c; g2_stage_rc(_b, _r, _c); \
      __builtin_amdgcn_global_load_lds((const unsigned*)(BASE + _g + (long)_r * K + _c), (unsigned*)((char*)(Pp) + _b), 16, 0, 0); } } while (0)
#define G8_LDA(dst, b, h) _Pragma("unroll") for (int m = 0; m < 4; ++m) _Pragma("unroll") for (int k = 0; k < 2; ++k) \
    dst[m][k] = *reinterpret_cast<const bf16x8*>((const char*)G8_SA(b, h) + g2_lds_byte(wr * 64 + m * 16 + fr, k * 32 + fq * 8))
#define G8_LDB(dst, b, h) _Pragma("unroll") for (int n = 0; n < 2; ++n) _Pragma("unroll") for (int k = 0; k < 2; ++k) \
    dst[n][k] = *reinterpret_cast<const bf16x8*>((const char*)G8_SB(b, h) + g2_lds_byte(wc * 32 + n * 16 + fr, k * 32 + fq * 8))
#define G8_MMA(ai, bj, At_, Bt_) do { __builtin_amdgcn_s_setprio(1); \
    _Pragma("unroll") for (int m = 0; m < 4; ++m) _Pragma("unroll") for (int n = 0; n < 2; ++n) _Pragma("unroll") for (int k = 0; k < 2; ++k) \
      acc[ai][bj][m][n] = __builtin_amdgcn_mfma_f32_16x16x32_bf16(At_[m][k], Bt_[n][k], acc[ai][bj][m][n], 0, 0, 0); \
    __builtin_amdgcn_s_setprio(0); } while (0)
#define G8_WAIT_V(n) asm volatile("s_waitcnt vmcnt(" #n ")" ::: "memory")
#define G8_WAIT_L(n) asm volatile("s_waitcnt lgkmcnt(" #n ")" ::: "memory")
#define G8_BAR __builtin_amdgcn_s_barrier()
#define G8_SCHED __builtin_amdgcn_sched_barrier(0)
    bf16x8 At[4][2], B0[2][2], B1[2][2];
    const int nt = K / 64;
    __syncthreads();
    G8_STAGE(G8_SB(0, 0), Bt, bcol, 0); G8_STAGE(G8_SA(0, 0), A, brow, 0);
    G8_STAGE(G8_SB(0, 1), Bt, bcol + 128, 0); G8_STAGE(G8_SA(0, 1), A, brow + 128, 0);
    if (wr == 1) G8_BAR;
    G8_WAIT_V(4); G8_BAR;
    G8_STAGE(G8_SB(1, 0), Bt, bcol, 1); G8_STAGE(G8_SA(1, 0), A, brow, 1); G8_STAGE(G8_SB(1, 1), Bt, bcol + 128, 1);
    G8_WAIT_V(6); G8_BAR;
    for (int t = 0; t < nt - 2; t += 2) {
        G8_LDB(B0, 0, 0); G8_SCHED; G8_LDA(At, 0, 0); G8_STAGE(G8_SA(1, 1), A, brow + 128, t + 1);
        G8_WAIT_L(8); G8_BAR; G8_WAIT_L(0); G8_MMA(0, 0, At, B0); G8_BAR; G8_SCHED;
        G8_LDB(B1, 0, 1); G8_STAGE(G8_SB(0, 0), Bt, bcol, t + 2);
        G8_BAR; G8_WAIT_L(0); G8_MMA(0, 1, At, B1); G8_BAR;
        G8_LDA(At, 0, 1); G8_STAGE(G8_SA(0, 0), A, brow, t + 2);
        G8_BAR; G8_WAIT_L(0); G8_MMA(1, 0, At, B0); G8_BAR; G8_SCHED;
        G8_STAGE(G8_SB(0, 1), Bt, bcol + 128, t + 2);
        G8_WAIT_V(6); G8_BAR; G8_MMA(1, 1, At, B1); G8_BAR;
        G8_LDB(B0, 1, 0); G8_SCHED; G8_LDA(At, 1, 0); G8_STAGE(G8_SA(0, 1), A, brow + 128, t + 2);
        G8_WAIT_L(8); G8_BAR; G8_WAIT_L(0); G8_MMA(0, 0, At, B0); G8_BAR; G8_SCHED;
        G8_LDB(B1, 1, 1); G8_STAGE(G8_SB(1, 0), Bt, bcol, t + 3);
        G8_BAR; G8_WAIT_L(0); G8_MMA(0, 1, At, B1); G8_BAR;
        G8_LDA(At, 1, 1); G8_STAGE(G8_SA(1, 0), A, brow, t + 3);
        G8_BAR; G8_WAIT_L(0); G8_MMA(1, 0, At, B0); G8_BAR; G8_SCHED;
        G8_STAGE(G8_SB(1, 1), Bt, bcol + 128, t + 3);
        G8_WAIT_V(6); G8_BAR; G8_MMA(1, 1, At, B1); G8_BAR;
    }
    { G8_LDB(B0, 0, 0); G8_LDA(At, 0, 0); G8_STAGE(G8_SA(1, 1), A, brow + 128, nt - 1);
      G8_BAR; G8_WAIT_L(0); G8_MMA(0, 0, At, B0); G8_BAR;
      G8_LDB(B1, 0, 1); G8_BAR; G8_WAIT_L(0); G8_MMA(0, 1, At, B1); G8_BAR;
      G8_LDA(At, 0, 1); G8_WAIT_V(4); G8_BAR; G8_WAIT_L(0); G8_MMA(1, 0, At, B0); G8_MMA(1, 1, At, B1); G8_BAR; }
    { G8_LDB(B0, 1, 0); G8_LDA(At, 1, 0); G8_WAIT_V(2); G8_BAR; G8_WAIT_L(0); G8_MMA(0, 0, At, B0); G8_BAR;
      G8_LDB(B1, 1, 1); G8_WAIT_V(0); G8_BAR; G8_WAIT_L(0); G8_MMA(0, 1, At, B1); G8_BAR;
      G8_LDA(At, 1, 1); G8_BAR; G8_WAIT_L(0); G8_MMA(1, 0, At, B0); G8_MMA(1, 1, At, B1); G8_BAR; }
    if (wr == 0) G8_BAR;
}
__device__ __forceinline__ void g8_zero(f32x4 (&acc)[2][2][4][2]) {
#pragma unroll
    for (int a = 0; a < 2; ++a)
#pragma unroll
        for (int b = 0; b < 2; ++b)
#pragma unroll
            for (int m = 0; m < 4; ++m)
#pragma unroll
                for (int n = 0; n < 2; ++n) acc[a][b][m][n] = (f32x4){0.f, 0.f, 0.f, 0.f};
}
#define G8_FOREACH(body)                                                                                       \
    { const int _tid = fresh_tid(), _wid = _tid >> 6, _lane = _tid & 63, _wr = _wid >> 2, _wc = _wid & 3, _fr = _lane & 15, _fq = _lane >> 4; \
      _Pragma("unroll") for (int ai = 0; ai < 2; ++ai) _Pragma("unroll") for (int bj = 0; bj < 2; ++bj)       \
      _Pragma("unroll") for (int m = 0; m < 4; ++m) _Pragma("unroll") for (int n = 0; n < 2; ++n)             \
      _Pragma("unroll") for (int j = 0; j < 4; ++j) {                                                         \
          const int row = ai * 128 + _wr * 64 + m * 16 + _fq * 4 + j; const int col = bj * 128 + _wc * 32 + n * 16 + _fr; const float val = acc[ai][bj][m][n][j]; body } }

__device__ __forceinline__ bool g2_tile(int bid, int nb, int it, int nM, int nN, int& pm, int& pn) {
    if (nb == 256 && nM == 32) { const int xcd = bid & 7, jj = bid >> 3; pm = 4 * xcd + (jj & 3); pn = 8 * it + (jj >> 2); return pn < nN; }
    const int t = bid + it * nb; pm = t % nM; pn = t / nM; return t < nM * nN;
}

__device__ __forceinline__ void phase_ple(const Params& P, int bid, int nb, unsigned char* smem) {
    const bf16_t* A = (const bf16_t*)(P.ws + WS_PBF); const bf16_t* Bt = (const bf16_t*)(P.ws + WS_WTPP); bf16_t* C = (bf16_t*)P.out;
    for (int t = bid; t < 256; t += nb) {
        const int pm = t & 31, pn = t >> 5;
        f32x4 acc[8][4]; g2_zero(acc);
        g2_mainloop(A + (size_t)pm * 256 * 256, 256, Bt + (size_t)pn * 256 * 256, 256, 256, acc, smem);
        G2_FOREACH({ C[(size_t)(pm * 256 + row) * D + pn * 256 + col] = f2bf(val); })
    }
}
__device__ __forceinline__ void phase_gemm1(const Params& P, int bid, int nb, unsigned char* smem) {
    const bf16_t* A = (const bf16_t*)(P.ws + WS_HN); const bf16_t* Bt = (const bf16_t*)(P.ws + WS_WTIN); bf16_t* C = (bf16_t*)(P.ws + WS_PROJ);
    int pm, pn;
    for (int it = 0; g2_tile(bid, nb, it, T / 256, NPROJ / 256, pm, pn); ++it) {
        f32x4 acc[2][2][4][2]; g8_zero(acc);
        g8_mainloop(A, Bt, D, pm * 256, pn * 256, acc, smem);
        G8_FOREACH({ C[(size_t)(pm * 256 + row) * NPROJ + pn * 256 + col] = f2bf(val); })
    }
    if (nb == 256 && bid >= 160) phase_ple(P, bid - 160, 96, smem);
}
__device__ __forceinline__ void phase_gemm2(const Params& P, int bid, int nb, unsigned char* smem) {
    const bf16_t* A = (const bf16_t*)(P.ws + WS_MIXED); const bf16_t* Bt = (const bf16_t*)(P.ws + WS_WTOUT); float* H = (float*)(P.ws + WS_H);
    bf16_t* HW = (bf16_t*)(P.ws + WS_HN); float* rss = (float*)(P.ws + WS_RSS);
    int pm, pn;
    for (int it = 0; g2_tile(bid, nb, it, T / 256, D / 256, pm, pn); ++it) {
        f32x4 acc[2][2][4][2]; g8_zero(acc);
        g8_mainloop(A, Bt, D, pm * 256, pn * 256, acc, smem);
        const int tid = fresh_tid(), wid = tid >> 6, lane = tid & 63, wr = wid >> 2, wc = wid & 3, fr = lane & 15, fq = lane >> 4;
#pragma unroll
        for (int ai = 0; ai < 2; ++ai)
#pragma unroll
            for (int m = 0; m < 4; ++m)
#pragma unroll
                for (int j = 0; j < 4; ++j) {
                    const int row = pm * 256 + ai * 128 + wr * 64 + m * 16 + fq * 4 + j;
                    float ss = 0.f;
#pragma unroll
                    for (int bj = 0; bj < 2; ++bj)
#pragma unroll
                        for (int n = 0; n < 2; ++n) {
                            const int col = pn * 256 + bj * 128 + wc * 32 + n * 16 + fr;
                            const size_t o = (size_t)row * D + col;
                            const float v = P.x[o] + acc[ai][bj][m][n][j];
                            H[o] = v; HW[o] = f2bf(v * P.norm_ffn[col]); ss += v * v;
                        }
                    ss += __shfl_xor(ss, 1); ss += __shfl_xor(ss, 2); ss += __shfl_xor(ss, 4); ss += __shfl_xor(ss, 8);
                    if (fr == 0) atomicAdd(rss + row, ss);
                }
    }
}
__device__ __forceinline__ void phase_gemm3(const Params& P, int bid, int nb, unsigned char* smem) {
    const bf16_t* A = (const bf16_t*)(P.ws + WS_HN); const bf16_t* Bt = (const bf16_t*)(P.ws + WS_WTPQ); bf16_t* C = (bf16_t*)(P.ws + WS_Q);
    int pm, pn;
    for (int it = 0; g2_tile(bid, nb, it, T / 256, D / 256, pm, pn); ++it) {
        f32x4 acc[2][2][4][2]; g8_zero(acc);
        g8_mainloop(A, Bt, D, pm * 256, pn * 256, acc, smem);
        const float* rss = (const float*)(P.ws + WS_RSS);
        G8_FOREACH({ const float rs = rsqrtf(rss[pm * 256 + row] * (1.f / 2048.f) + EPS); C[(size_t)(pm * 256 + row) * D + pn * 256 + col] = f2bf(val * rs); })
    }
}
__device__ __forceinline__ void phase_gemm4(const Params& P, int bid, int nb, unsigned char* smem) {
    const bf16_t* A = (const bf16_t*)(P.ws + WS_HN); const bf16_t* Bt = (const bf16_t*)(P.ws + WS_WTG);
    const bf16_t* ple = (const bf16_t*)P.out; float* H = (float*)(P.ws + WS_H);
    int pm, pn;
    for (int it = 0; g2_tile(bid, nb, it, T / 256, D / 256, pm, pn); ++it) {
        f32x4 acc[2][2][4][2]; g8_zero(acc);
        g8_mainloop(A, Bt, D, pm * 256, pn * 256, acc, smem);
        G8_FOREACH({ const size_t o = (size_t)(pm * 256 + row) * D + pn * 256 + col; H[o] = H[o] + sigmoid_f(val) * bf2f(ple[o]); })
    }
}

template <bool OUT_BF16>
__device__ __forceinline__ void phase_rownorm(const float* in, const float* w, void* out, int bid, int nb) {
    const int wave = VTID >> 6, lane = VTID & 63;
    for (int r = bid * 4 + wave; r < T; r += nb * 4) {
        if (OUT_BF16) rmsnorm_row<true>(in + (size_t)r * D, w, (bf16_t*)out + (size_t)r * D, lane);
        else rmsnorm_row<false>(in + (size_t)r * D, w, (float*)out + (size_t)r * D, lane);
    }
}

__device__ __forceinline__ bf16x8 frag_ld(const unsigned char* tile, int row, int ks, int lane) { return *(const bf16x8*)(tile + lds_off(row, ks * 2 + (lane >> 5))); }
__device__ __forceinline__ void lds_st_bf16(unsigned char* tile, int row, int k, float v) { *(bf16_t*)(tile + lds_off(row, k >> 3) + (k & 7) * 2) = f2bf(v); }

__device__ __forceinline__ void d1_chunk(const Params& P, int u, unsigned char* smem) {
    const bf16_t* proj = (const bf16_t*)(P.ws + WS_PROJ);
    int tid_ = VTID; asm volatile("" : "+v"(tid_));
    const int tid = tid_, wave = tid >> 6, lane = tid & 63;
    const int b = u >> 9, h = (u >> 6) & 7, c = u & 63;
    const size_t tok0 = (size_t)b * SEQ + c * 64;
    unsigned char* Ks = smem;
    unsigned char* Qs = smem + 16384;
    unsigned char* Vraw = smem + 16384;
    float* At = (float*)(smem + 34816);
    float* Gs = (float*)(smem + 51200);
    float* Bs = Gs + 64;
    __syncthreads();
    if (wave == 0) {
        const size_t t = tok0 + lane;
        const float a = bf2f(proj[t * NPROJ + C_A + h]), bb = bf2f(proj[t * NPROJ + C_B + h]);
        const float xs = a + P.dt_bias[h];
        const float sp = xs > 20.f ? xs : log1pf(expf(xs));
        float g = -expf(P.a_log[h]) * sp;
#pragma unroll
        for (int o = 1; o < 64; o <<= 1) { const float n = __shfl_up(g, o); if (lane >= o) g += n; }
        Gs[lane] = g; Bs[lane] = 1.f / (1.f + expf(-bb));
    }
    bf16_t* QG = (bf16_t*)(P.ws + WS_QG) + (size_t)u * 64 * 128;
    unsigned char* RAW = smem + 32768;
#pragma unroll 1
    for (int isk = 0; isk < 2; ++isk) {
        const int chb = (isk ? 1024 : 0) + h * 128;
        for (int q = tid; q < 67 * 16; q += 256) {
            const int row = q >> 4, c16 = q & 15;
            uint4 v = make_uint4(0u, 0u, 0u, 0u);
            if (c > 0 || row >= 3) v = *(const uint4*)(proj + (tok0 + row - 3) * NPROJ + chb + c16 * 8);
            *(uint4*)(RAW + row * 256 + c16 * 16) = v;
        }
        const int ch0 = chb + lane * 2;
        const f32x4 cw0 = *(const f32x4*)(P.conv_w + ch0 * 4), cw1 = *(const f32x4*)(P.conv_w + ch0 * 4 + 4);
        __syncthreads();
        for (int tok = wave; tok < 64; tok += 4) {
            float y0 = 0.f, y1 = 0.f;
#pragma unroll
            for (int j = 0; j < 4; ++j) {
                const unsigned pr = *(const unsigned*)(RAW + (tok + j) * 256 + lane * 4);
                y0 += bf2f((bf16_t)(pr & 0xffff)) * cw0[j];
                y1 += bf2f((bf16_t)(pr >> 16)) * cw1[j];
            }
            y0 = silu_f(y0); y1 = silu_f(y1);
            float r = rsqrtf(wave_sum(y0 * y0 + y1 * y1) + EPS);
            if (!isk) r *= 0.08838834764831845f;
            y0 *= r; y1 *= r;
            const int k = lane * 2, half = k >> 6, kk = k & 63;
            *(unsigned*)((isk ? Ks : Qs) + half * 8192 + lds_off(tok, kk >> 3) + (kk & 7) * 2) = pack2(y0, y1);
            if (!isk) { const float eg = expf(Gs[tok]); *(unsigned*)(QG + tok * 128 + k) = pack2(y0 * eg, y1 * eg); }
        }
        __syncthreads();
    }
    {
        const int wr = wave >> 1, wc = wave & 1;
        f32x16 akk, aqk;
#pragma unroll
        for (int r = 0; r < 16; ++r) { akk[r] = 0.f; aqk[r] = 0.f; }
        if (!(wr == 0 && wc == 1)) {
#pragma unroll
            for (int half = 0; half < 2; ++half)
#pragma unroll
                for (int ks = 0; ks < 4; ++ks) {
                    const bf16x8 fk = frag_ld(Ks + half * 8192, wr * 32 + (lane & 31), ks, lane);
                    const bf16x8 fq = frag_ld(Qs + half * 8192, wr * 32 + (lane & 31), ks, lane);
                    const bf16x8 fb = frag_ld(Ks + half * 8192, wc * 32 + (lane & 31), ks, lane);
                    akk = __builtin_amdgcn_mfma_f32_32x32x16_bf16(fk, fb, akk, 0, 0, 0);
                    aqk = __builtin_amdgcn_mfma_f32_32x32x16_bf16(fq, fb, aqk, 0, 0, 0);
                }
        }
        const int j = wc * 32 + (lane & 31); const float Gj = Gs[j];
        bf16_t* ATT = (bf16_t*)(P.ws + WS_ATT) + (size_t)u * 64 * 64;
#pragma unroll
        for (int g4 = 0; g4 < 4; ++g4) {
            const int i0 = wr * 32 + 8 * g4 + 4 * (lane >> 5);
            f32x4 av;
#pragma unroll
            for (int e = 0; e < 4; ++e) {
                const int i = i0 + e, r = g4 * 4 + e;
                const float dec = (i >= j) ? expf(Gs[i] - Gj) : 0.f;
                av[e] = (i > j) ? Bs[i] * akk[r] * dec : 0.f;
                ATT[i * 64 + j] = f2bf(aqk[r] * dec);
            }
            *(f32x4*)(At + j * 64 + i0) = av;
        }
    }
    __syncthreads();
    {
        for (int q = tid; q < 67 * 16; q += 256) {
            const int row = q >> 4, c16 = q & 15;
            uint4 v = make_uint4(0u, 0u, 0u, 0u);
            if (c > 0 || row >= 3) v = *(const uint4*)(proj + (tok0 + row - 3) * NPROJ + 2048 + h * 128 + c16 * 8);
            *(uint4*)(Vraw + row * 256 + c16 * 16) = v;
        }
    }
    __syncthreads();
    {
        float r[64];
        if (tid < 128) {
            const int ch = 2048 + h * 128 + tid;
            const float w0 = P.conv_w[ch * 4 + 0], w1 = P.conv_w[ch * 4 + 1], w2 = P.conv_w[ch * 4 + 2], w3 = P.conv_w[ch * 4 + 3];
            const bf16_t* vcol = (const bf16_t*)Vraw + tid;
            float xm3 = bf2f(vcol[0]), xm2 = bf2f(vcol[128]), xm1 = bf2f(vcol[256]);
#pragma unroll
            for (int i = 0; i < 64; ++i) {
                const float x0 = bf2f(vcol[(i + 3) * 128]);
                const float y = w0 * xm3 + w1 * xm2 + w2 * xm1 + w3 * x0;
                r[i] = Bs[i] * silu_f(y);
                xm3 = xm2; xm2 = xm1; xm1 = x0;
            }
        } else {
            const int dk = tid - 128, half = dk >> 6, kk = dk & 63;
            const float G63 = Gs[63];
            bf16_t* KDT = (bf16_t*)(P.ws + WS_KDT) + (size_t)u * 128 * 64 + dk * 64;
#pragma unroll
            for (int i8 = 0; i8 < 8; ++i8) {
                unsigned pk[4];
#pragma unroll
                for (int e2 = 0; e2 < 4; ++e2) {
                    float kd[2];
#pragma unroll
                    for (int e = 0; e < 2; ++e) {
                        const int i = i8 * 8 + e2 * 2 + e;
                        const float kv = bf2f(*(const bf16_t*)(Ks + half * 8192 + lds_off(i, kk >> 3) + (kk & 7) * 2));
                        const float Gi = Gs[i];
                        r[i] = -Bs[i] * expf(Gi) * kv;
                        kd[e] = kv * expf(G63 - Gi);
                    }
                    pk[e2] = pack2(kd[0], kd[1]);
                }
                *(uint4*)(KDT + i8 * 8) = make_uint4(pk[0], pk[1], pk[2], pk[3]);
            }
        }
#pragma unroll
        for (int j = 0; j < 63; ++j) {
            const float xj = r[j];
#pragma unroll
            for (int i4 = ((j + 1) & ~3); i4 < 64; i4 += 4) {
                const f32x4 a = *(const f32x4*)(At + j * 64 + i4);
                r[i4] -= a[0] * xj; r[i4 + 1] -= a[1] * xj; r[i4 + 2] -= a[2] * xj; r[i4 + 3] -= a[3] * xj;
            }
        }
        if (tid < 128) {
            bf16_t* U = (bf16_t*)(P.ws + WS_U) + (size_t)u * 64 * 128 + (tid >> 5) * 2048 + (tid & 31);
#pragma unroll
            for (int i = 0; i < 64; ++i) { const int tt = i >> 5, i5 = i & 31, rr = (i5 & 3) + 4 * (i5 >> 3), hh = (i5 >> 2) & 1; U[(tt * 16 + rr) * 64 + hh * 32] = f2bf(r[i]); }
        } else {
            bf16_t* W = (bf16_t*)(P.ws + WS_W) + (size_t)u * 64 * 128 + (tid - 128);
#pragma unroll
            for (int i = 0; i < 64; ++i) W[i * 128] = f2bf(r[i]);
        }
        if (tid == 0) ((float*)(P.ws + WS_EG))[u] = expf(Gs[63]);
    }
}

__device__ __forceinline__ void r1_chunk(const Params& P, int u, unsigned char* smem) {
    const bf16_t* proj = (const bf16_t*)(P.ws + WS_PROJ);
    int tid_ = VTID; asm volatile("" : "+v"(tid_));
    const int tid = tid_, wave = tid >> 6, lane = tid & 63;
    const int b = u >> 9, h = (u >> 6) & 7, c = u & 63;
    const size_t tok0 = (size_t)b * SEQ + c * 64;
    unsigned char* RQ = smem;
    unsigned char* RK = smem + 8192;
    unsigned char* VT = smem + 16384;
    unsigned char* RKT = smem + 32768;
    const float l2g = log2f(1.f - exp2f(-5.f - (float)h));
    unsigned char* VR = smem + 40960;
    __syncthreads();
    bf16_t* QGR = (bf16_t*)(P.ws + WS_QGR) + (size_t)u * 64 * 64;
    {
        uint4 rq[2], rk[2], rv[4];
#pragma unroll
        for (int i = 0; i < 2; ++i) { const int q = tid + 256 * i, row = q >> 3, ch = q & 7;
            rq[i] = *(const uint4*)(proj + (tok0 + row) * NPROJ + C_RQ + h * 64 + ch * 8); rk[i] = *(const uint4*)(proj + (tok0 + row) * NPROJ + C_RK + h * 64 + ch * 8); }
#pragma unroll
        for (int i = 0; i < 4; ++i) { const int q = tid + 256 * i, row = q >> 4, c16 = q & 15; rv[i] = *(const uint4*)(proj + (tok0 + row) * NPROJ + C_RV + h * 128 + c16 * 8); }
#pragma unroll
        for (int i = 0; i < 2; ++i) { const int q = tid + 256 * i, row = q >> 3, ch = q & 7; *(uint4*)(RQ + lds_off(row, ch)) = rq[i]; *(uint4*)(RK + lds_off(row, ch)) = rk[i]; }
#pragma unroll
        for (int i = 0; i < 4; ++i) { const int q = tid + 256 * i, row = q >> 4, c16 = q & 15; *(uint4*)(VR + row * 256 + c16 * 16) = rv[i]; }
    }
    __syncthreads();
#pragma unroll 1
    for (int it = 0; it < 8; ++it) {
        const int e = tid + 256 * it, tok = e >> 5, i = e & 31;
        const size_t t = tok0 + tok;
        const float inv = powf(10000.f, -(float)i / 32.f);
        const float ang = (float)P.positions[t] * inv;
        float sn, cs; sincosf(ang, &sn, &cs);
        bf16_t* q1p = (bf16_t*)(RQ + lds_off(tok, i >> 3) + (i & 7) * 2); bf16_t* q2p = (bf16_t*)(RQ + lds_off(tok, (32 + i) >> 3) + (i & 7) * 2);
        bf16_t* k1p = (bf16_t*)(RK + lds_off(tok, i >> 3) + (i & 7) * 2); bf16_t* k2p = (bf16_t*)(RK + lds_off(tok, (32 + i) >> 3) + (i & 7) * 2);
        const float q1 = bf2f(*q1p), q2 = bf2f(*q2p), k1 = bf2f(*k1p) * 0.125f, k2 = bf2f(*k2p) * 0.125f;
        const float qa = q1 * cs - q2 * sn, qb = q1 * sn + q2 * cs, ka = k1 * cs - k2 * sn, kb = k1 * sn + k2 * cs;
        const float xi = exp2f(l2g * (float)(tok + 1)), zeta = exp2f(l2g * (float)(63 - tok));
        *q1p = f2bf(qa); *q2p = f2bf(qb); *k1p = f2bf(ka); *k2p = f2bf(kb);
        lds_st_bf16(RKT, i, tok, ka * zeta); lds_st_bf16(RKT, 32 + i, tok, kb * zeta);
        QGR[tok * 64 + i] = f2bf(qa * xi); QGR[tok * 64 + 32 + i] = f2bf(qb * xi);
    }
#pragma unroll 4
    for (int it = 0; it < 16; ++it) {
        const int e = tid + 256 * it, tok = e >> 6, dp = e & 63;
        const unsigned pr = *(const unsigned*)(VR + tok * 256 + dp * 4);
        *(bf16_t*)(VT + lds_off(dp * 2, tok >> 3) + (tok & 7) * 2) = (bf16_t)(pr & 0xffff);
        *(bf16_t*)(VT + lds_off(dp * 2 + 1, tok >> 3) + (tok & 7) * 2) = (bf16_t)(pr >> 16);
    }
    __syncthreads();
    {
        bf16_t* VNTR = (bf16_t*)(P.ws + WS_VNTR) + (size_t)u * 128 * 64;
#pragma unroll
        for (int it = 0; it < 4; ++it) { const int q = tid + 256 * it, row = q >> 3, ch = q & 7; *(uint4*)(VNTR + row * 64 + ch * 8) = *(const uint4*)(VT + lds_off(row, ch)); }
    }
    {
        const int wr = wave >> 1, wc = wave & 1;
        f32x16 acc;
#pragma unroll
        for (int r = 0; r < 16; ++r) acc[r] = 0.f;
        if (!(wr == 0 && wc == 1)) {
#pragma unroll
            for (int ks = 0; ks < 4; ++ks) acc = __builtin_amdgcn_mfma_f32_32x32x16_bf16(frag_ld(RQ, wr * 32 + (lane & 31), ks, lane), frag_ld(RK, wc * 32 + (lane & 31), ks, lane), acc, 0, 0, 0);
        }
        const int j = wc * 32 + (lane & 31);
        bf16_t* ATTR = (bf16_t*)(P.ws + WS_ATTR) + (size_t)u * 64 * 64;
#pragma unroll
        for (int r = 0; r < 16; ++r) {
            const int i = wr * 32 + (r & 3) + 8 * (r >> 2) + 4 * (lane >> 5);
            const float dec = (i >= j) ? exp2f(l2g * (float)(i - j)) : 0.f;
            ATTR[i * 64 + j] = f2bf(acc[r] * dec);
        }
    }
    {
        f32x16 acc[2];
#pragma unroll
        for (int j = 0; j < 2; ++j)
#pragma unroll
            for (int r = 0; r < 16; ++r) acc[j][r] = 0.f;
#pragma unroll
        for (int ks = 0; ks < 4; ++ks) {
            const bf16x8 fa = frag_ld(VT, wave * 32 + (lane & 31), ks, lane);
#pragma unroll
            for (int j = 0; j < 2; ++j) acc[j] = __builtin_amdgcn_mfma_f32_32x32x16_bf16(fa, frag_ld(RKT, j * 32 + (lane & 31), ks, lane), acc[j], 0, 0, 0);
        }
        float* KVT = (float*)(P.ws + WS_KVT) + (size_t)u * 128 * 64;
#pragma unroll
        for (int j = 0; j < 2; ++j)
#pragma unroll
            for (int r = 0; r < 16; ++r) { const int dv = wave * 32 + (r & 3) + 8 * (r >> 2) + 4 * (lane >> 5); KVT[dv * 64 + j * 32 + (lane & 31)] = acc[j][r]; }
    }
}

__device__ __forceinline__ void phase_chunk1(const Params& P, int bid, int nb, unsigned char* smem) {
    for (int u = bid; u < 2048; u += nb) { if (u < 1024) d1_chunk(P, u, smem); else r1_chunk(P, u - 1024, smem); }
}

__device__ __forceinline__ void d2_scan(const Params& P, int bh, unsigned char* rsmem) {
    const int tid = fresh_tid(), wave = tid >> 6, lane = tid & 63;
    const bool compute = wave < 4;
    const size_t cb = (size_t)bh * 64;
    const bf16_t* Wg = (const bf16_t*)(P.ws + WS_W); const bf16_t* KDg = (const bf16_t*)(P.ws + WS_KDT);
    const float* Ug = (const float*)(P.ws + WS_U); const float* EGg = (const float*)(P.ws + WS_EG);
    bf16_t* SCg = (bf16_t*)(P.ws + WS_SC); bf16_t* VNg = (bf16_t*)(P.ws + WS_VNT);
    unsigned char* img = rsmem + (wave & 3) * 8192;
    unsigned char* ULDS = rsmem + 32768;
    unsigned char* BUF = rsmem + 65536;
    const int ltid = tid & 255;
    f32x16 S[4];
    uint4 w0a, w0b, w0c, w0d, k0a, k0b, k0c, k0d, u0a, u0b, u0c, u0d;
    uint4 w1a, w1b, w1c, w1d, k1a, k1b, k1c, k1d, u1a, u1b, u1c, u1d;
    const bf16_t* Ug16 = (const bf16_t*)(P.ws + WS_U);
#define D2_LOAD(SET, uu) { const bf16_t* wp = Wg + (uu) * 8192 + ltid * 8; const bf16_t* kp = KDg + (uu) * 8192 + ltid * 8; const bf16_t* up = Ug16 + (uu) * 8192 + ltid * 8; \
        w##SET##a = *(const uint4*)(wp); w##SET##b = *(const uint4*)(wp + 2048); w##SET##c = *(const uint4*)(wp + 4096); w##SET##d = *(const uint4*)(wp + 6144); \
        k##SET##a = *(const uint4*)(kp); k##SET##b = *(const uint4*)(kp + 2048); k##SET##c = *(const uint4*)(kp + 4096); k##SET##d = *(const uint4*)(kp + 6144); \
        u##SET##a = *(const uint4*)(up); u##SET##b = *(const uint4*)(up + 2048); u##SET##c = *(const uint4*)(up + 4096); u##SET##d = *(const uint4*)(up + 6144); }
#define D2_ST1(i, vw, vk, vu, bufp, par) { const int q = ltid + 256 * (i); { const int row = q >> 4, c16 = q & 15; *(uint4*)((bufp) + (c16 >> 3) * 8192 + lds_off(row, c16 & 7)) = (vw); } \
        { const int row = q >> 3, ch = q & 7; *(uint4*)((bufp) + 16384 + lds_off(row, ch)) = (vk); } \
        *(uint4*)(ULDS + (par) * 16384 + q * 16) = (vu); }
#define D2_STORE(SET, par) { unsigned char* bufp = BUF + (par) * 32768; D2_ST1(0, w##SET##a, k##SET##a, u##SET##a, bufp, par) D2_ST1(1, w##SET##b, k##SET##b, u##SET##b, bufp, par) \
        D2_ST1(2, w##SET##c, k##SET##c, u##SET##c, bufp, par) D2_ST1(3, w##SET##d, k##SET##d, u##SET##d, bufp, par) }
    int egl = 0;
    __syncthreads();
    if (compute) {
#pragma unroll
        for (int d = 0; d < 4; ++d)
#pragma unroll
            for (int r = 0; r < 16; ++r) S[d][r] = 0.f;
        egl = __float_as_int(EGg[cb + lane]);
#pragma unroll
        for (int i = 0; i < 8; ++i) { *(uint4*)(img + (lane + 64 * i) * 16) = make_uint4(0u, 0u, 0u, 0u);
            *(uint4*)(SCg + cb * 16384 + wave * 4096 + (lane + 64 * i) * 8) = make_uint4(0u, 0u, 0u, 0u); }
    } else {
        D2_LOAD(0, cb) D2_LOAD(1, cb + 1)
        D2_STORE(0, 0)
        D2_LOAD(0, cb + 2)
    }
    __syncthreads();
#define D2_VN(tt, vv) _Pragma("unroll") for (int g4 = 0; g4 < 4; ++g4) { const int r0 = g4 * 4; \
            const uint2 pkd = make_uint2(pack2(vv[r0], vv[r0 + 1]), pack2(vv[r0 + 2], vv[r0 + 3])); \
            const int tok = (tt) * 32 + 8 * g4 + 4 * (lane >> 5); \
            *(uint2*)(img + lds_off(lane & 31, tok >> 3) + (tok & 7) * 2) = pkd; \
            *(uint2*)(VNg + u * 8192 + ((((wave * 2 + (tt)) * 4 + g4) * 64 + lane) * 4)) = pkd; }
#define D2_COMPUTE(c) { const size_t u = cb + (c); const unsigned char* Wt = BUF + ((c) & 1) * 32768; const unsigned char* KDt = Wt + 16384; \
        const bf16_t* ul = (const bf16_t*)(ULDS + ((c) & 1) * 16384) + wave * 2048 + lane; \
        uint2 pkv[8]; \
        const float eg = __int_as_float(__builtin_amdgcn_readlane(egl, (c))); \
        _Pragma("unroll") for (int tt = 0; tt < 2; ++tt) { f32x16 vn; \
            _Pragma("unroll") for (int r = 0; r < 16; ++r) vn[r] = bf2f(ul[(tt * 16 + r) * 64]); \
            _Pragma("unroll") for (int half = 0; half < 2; ++half) _Pragma("unroll") for (int ks = 0; ks < 4; ++ks) \
                vn = __builtin_amdgcn_mfma_f32_32x32x16_bf16(frag_ld(Wt + half * 8192, tt * 32 + (lane & 31), ks, lane), frag_ld(img + half * 4096, lane & 31, ks, lane), vn, 0, 0, 0); \
            _Pragma("unroll") for (int g4 = 0; g4 < 4; ++g4) { const int r0 = g4 * 4; \
                pkv[tt * 4 + g4] = make_uint2(pack2(vn[r0], vn[r0 + 1]), pack2(vn[r0 + 2], vn[r0 + 3])); } \
            __builtin_amdgcn_sched_barrier(0); } \
        _Pragma("unroll") for (int tt = 0; tt < 2; ++tt) _Pragma("unroll") for (int g4 = 0; g4 < 4; ++g4) { \
            const int tok = tt * 32 + 8 * g4 + 4 * (lane >> 5); \
            *(uint2*)(img + lds_off(lane & 31, tok >> 3) + (tok & 7) * 2) = pkv[tt * 4 + g4]; \
            *(uint2*)(VNg + u * 8192 + ((((wave * 2 + tt) * 4 + g4) * 64 + lane) * 4)) = pkv[tt * 4 + g4]; } \
        _Pragma("unroll") for (int d = 0; d < 4; ++d) _Pragma("unroll") for (int r = 0; r < 16; ++r) S[d][r] *= eg; \
        _Pragma("unroll") for (int ks = 0; ks < 4; ++ks) { const bf16x8 fb = frag_ld(img, lane & 31, ks, lane); \
            _Pragma("unroll") for (int d = 0; d < 4; ++d) S[d] = __builtin_amdgcn_mfma_f32_32x32x16_bf16(frag_ld(KDt, d * 32 + (lane & 31), ks, lane), fb, S[d], 0, 0, 0); } \
        _Pragma("unroll") for (int d = 0; d < 4; ++d) _Pragma("unroll") for (int g4 = 0; g4 < 4; ++g4) { const int r0 = g4 * 4; \
            const uint2 pkd = make_uint2(pack2(S[d][r0], S[d][r0 + 1]), pack2(S[d][r0 + 2], S[d][r0 + 3])); \
            const int kk = (d & 1) * 32 + 8 * g4 + 4 * (lane >> 5); \
            *(uint2*)(img + (d >> 1) * 4096 + lds_off(lane & 31, kk >> 3) + (kk & 7) * 2) = pkd; \
            if ((c) + 1 < 64) *(uint2*)(SCg + (u + 1) * 16384 + ((((wave * 4 + d) * 4 + g4) * 64 + lane) * 4)) = pkd; } }
    for (int c = 0; c < 64; c += 2) {
        if (compute) D2_COMPUTE(c)
        else { D2_STORE(1, 1) if (c + 3 < 64) D2_LOAD(1, cb + c + 3) }
        __syncthreads();
        if (compute) D2_COMPUTE(c + 1)
        else { if (c + 2 < 64) { D2_STORE(0, 0) } if (c + 4 < 64) D2_LOAD(0, cb + c + 4) }
        __syncthreads();
    }
}

__device__ __forceinline__ void r2_scan(const Params& P, int vb, int nvb) {
    const float* KVT = (const float*)(P.ws + WS_KVT); bf16_t* STR = (bf16_t*)(P.ws + WS_STR);
    int tid_ = VTID; asm volatile("" : "+v"(tid_));
    for (int idx = vb * 256 + tid_; idx < 16 * 8192; idx += nvb * 256) {
        const int bh = idx >> 13, e = idx & 8191, h = bh & 7;
        const float cd = exp2f(64.f * log2f(1.f - exp2f(-5.f - (float)h)));
        float S = 0.f;
#pragma unroll 8
        for (int c = 0; c < 64; ++c) {
            const size_t o = ((size_t)bh * 64 + c) * 8192 + e;
            STR[o] = f2bf(S);
            S = cd * S + KVT[o];
        }
    }
}

__device__ __forceinline__ void phase_econv(const Params& P, int bid, int nb, unsigned char* smem);
__device__ __forceinline__ void phase_scan(const Params& P, int bid, int nb, unsigned char* smem, int rbid, int rnb, unsigned char* rsmem, int mode = 0) {
    if (rbid < 16) { if (mode != 2) d2_scan(P, rbid, rsmem); }
    else if (mode != 1) {
        if (rnb != 256) phase_ple(P, rbid - 16, rnb - 16, rsmem);
        r2_scan(P, bid - 32, nb - 32);
        phase_econv(P, bid - 32, nb - 32, smem);
    }
}

template <int K1, bool RET>
__device__ __forceinline__ void chunk_out(const Params& P, int u, unsigned char* smem) {
    int tid_ = VTID; asm volatile("" : "+v"(tid_));
    const int tid = tid_, wave = tid >> 6, lane = tid & 63, wr = wave >> 1, wc = wave & 1;
    const int b = u >> 9, h = (u >> 6) & 7, c = u & 63;
    const size_t tok0 = (size_t)b * SEQ + c * 64;
    const bf16_t* A1 = RET ? (const bf16_t*)(P.ws + WS_QGR) + (size_t)u * 64 * 64 : (const bf16_t*)(P.ws + WS_QG) + (size_t)u * 64 * 128;
    const bf16_t* B1 = RET ? (const bf16_t*)(P.ws + WS_STR) + (size_t)u * 128 * 64 : (const bf16_t*)(P.ws + WS_SC) + (size_t)u * 128 * 128;
    const bf16_t* A2 = RET ? (const bf16_t*)(P.ws + WS_ATTR) + (size_t)u * 64 * 64 : (const bf16_t*)(P.ws + WS_ATT) + (size_t)u * 64 * 64;
    const bf16_t* B2 = RET ? (const bf16_t*)(P.ws + WS_VNTR) + (size_t)u * 128 * 64 : (const bf16_t*)(P.ws + WS_VNT) + (size_t)u * 128 * 64;
    unsigned char* As = smem;
    unsigned char* Bs = smem + 8192;
    float* red = (float*)(smem + 24576);
    f32x16 acc[2];
#pragma unroll
    for (int j = 0; j < 2; ++j)
#pragma unroll
        for (int r = 0; r < 16; ++r) acc[j][r] = 0.f;
    constexpr int NK1 = K1 / 64;
#pragma unroll
    for (int kt = 0; kt <= NK1; ++kt) {
        const bf16_t* Ap = (kt < NK1) ? A1 + kt * 64 : A2; const int lda = (kt < NK1) ? K1 : 64;
        const bf16_t* Bp = (kt < NK1) ? B1 + kt * 64 : B2; const int ldb = lda;
        __syncthreads();
#pragma unroll
        for (int i = 0; i < 2; ++i) { const int q = tid + 256 * i, row = q >> 3, ch = q & 7; *(uint4*)(As + lds_off(row, ch)) = *(const uint4*)(Ap + row * lda + ch * 8); }
        if (RET) {
#pragma unroll
            for (int i = 0; i < 4; ++i) { const int q = tid + 256 * i, row = q >> 3, ch = q & 7; *(uint4*)(Bs + lds_off(row, ch)) = *(const uint4*)(Bp + row * ldb + ch * 8); }
        } else {
#pragma unroll
            for (int i = 0; i < 8; ++i) {
                const int q = tid + 256 * i, ln = q & 63, g4 = (q >> 6) & 3, dd = (q >> 8) & 1, w = q >> 9;
                const size_t piece = (kt < NK1) ? (size_t)(((w * 4 + 2 * kt + dd) * 4 + g4) * 64 + ln) : (size_t)(((w * 2 + dd) * 4 + g4) * 64 + ln);
                const bf16_t* src = (kt < NK1) ? B1 : B2;
                const int kk = dd * 32 + 8 * g4 + 4 * (ln >> 5);
                *(uint2*)(Bs + lds_off(w * 32 + (ln & 31), kk >> 3) + (kk & 7) * 2) = *(const uint2*)(src + piece * 4);
            }
        }
        __syncthreads();
#pragma unroll
        for (int ks = 0; ks < 4; ++ks) {
            const bf16x8 fa = frag_ld(As, wr * 32 + (lane & 31), ks, lane);
#pragma unroll
            for (int j = 0; j < 2; ++j) acc[j] = __builtin_amdgcn_mfma_f32_32x32x16_bf16(fa, frag_ld(Bs, wc * 64 + j * 32 + (lane & 31), ks, lane), acc[j], 0, 0, 0);
        }
    }
#pragma unroll
    for (int r = 0; r < 16; ++r) {
        float s1 = acc[0][r] + acc[1][r], s2 = acc[0][r] * acc[0][r] + acc[1][r] * acc[1][r];
#pragma unroll
        for (int o = 16; o >= 1; o >>= 1) { s1 += __shfl_xor(s1, o); s2 += __shfl_xor(s2, o); }
        if ((lane & 31) == 0) { const int row = wr * 32 + (r & 3) + 8 * (r >> 2) + 4 * (lane >> 5); red[(row * 2 + wc) * 2] = s1; red[(row * 2 + wc) * 2 + 1] = s2; }
    }
    __syncthreads();
    const bf16_t* proj = (const bf16_t*)(P.ws + WS_PROJ); bf16_t* mixed = (bf16_t*)(P.ws + WS_MIXED);
#pragma unroll
    for (int r = 0; r < 16; ++r) {
        const int row = wr * 32 + (r & 3) + 8 * (r >> 2) + 4 * (lane >> 5);
        const float s1 = red[row * 4] + red[row * 4 + 2], s2 = red[row * 4 + 1] + red[row * 4 + 3];
        const size_t t = tok0 + row;
#pragma unroll
        for (int j = 0; j < 2; ++j) {
            const int dv = wc * 64 + j * 32 + (lane & 31);
            float y;
            if (!RET) {
                const float rs = rsqrtf(s2 * (1.f / 128.f) + EPS);
                y = acc[j][r] * rs * P.dn_norm[dv] * silu_f(bf2f(proj[t * NPROJ + C_Z + h * 128 + dv]));
                mixed[t * D + h * 128 + dv] = f2bf(y);
            } else {
                const float mu = s1 * (1.f / 128.f);
                const float var = fmaxf(s2 * (1.f / 128.f) - mu * mu, 0.f);
                const float rs = rsqrtf(var + EPS);
                y = ((acc[j][r] - mu) * rs * P.ret_gn_w[h * 128 + dv] + P.ret_gn_b[h * 128 + dv]) * silu_f(bf2f(proj[t * NPROJ + C_RG + h * 128 + dv]));
                mixed[t * D + 1024 + h * 128 + dv] = f2bf(y);
            }
        }
    }
}

__device__ __forceinline__ void phase_chunk3(const Params& P, int bid, int nb, unsigned char* smem) {
    for (int u = bid; u < 2048; u += nb) { if (u < 1024) chunk_out<128, false>(P, u, smem); else chunk_out<64, true>(P, u - 1024, smem); }
}

__device__ __forceinline__ void ins16(float (&l)[16], float x) {
#pragma unroll
    for (int i = 0; i < 16; ++i) { const float hi = fmaxf(l[i], x); x = fminf(l[i], x); l[i] = hi; }
}
__device__ __forceinline__ void phase_route(const Params& P, int bid, int nb, unsigned char* smem) {
    int* idx = (int*)(P.ws + WS_IDX); float* gates = (float*)(P.ws + WS_GATES);
    const bf16_t* Q = (const bf16_t*)(P.ws + WS_Q); const bf16_t* KEYS = (const bf16_t*)(P.ws + WS_KEYS);
    int tid_ = VTID; asm volatile("" : "+v"(tid_));
    const int tid = tid_, wave = tid >> 6, lane = tid & 63, fr = lane & 15, fq = lane >> 4;
    float* tile = (float*)smem;
    unsigned* L = (unsigned*)(smem + 256 * 33 * 4);
    const float NEG = -3.0e38f;
    for (int u = bid; u < 512; u += nb) {
        const size_t R0 = (size_t)u * 256;
        const size_t t0 = (size_t)u * 16;
        bf16x8 af[4][4];
#pragma unroll
        for (int j = 0; j < 4; ++j)
#pragma unroll
            for (int ks = 0; ks < 4; ++ks) af[j][ks] = *(const bf16x8*)(Q + (t0 + fr) * D + (4 * wave + j) * 128 + ks * 32 + fq * 8);
        float l[16];
#pragma unroll
        for (int i = 0; i < 16; ++i) l[i] = NEG;
        bf16x8 bq[2][2][4];
#define ROUTE_LOADB(chh, j0) _Pragma("unroll") for (int j = 0; j < 2; ++j) _Pragma("unroll") for (int nt = 0; nt < 2; ++nt) _Pragma("unroll") for (int ks = 0; ks < 4; ++ks) \
            bq[j][nt][ks] = *(const bf16x8*)(KEYS + (size_t)((4 * wave + (j0) + j) * 128 + (chh) * 32 + nt * 16 + fr) * 128 + ks * 32 + fq * 8);
#define ROUTE_MMA(j0) _Pragma("unroll") for (int j = 0; j < 2; ++j) _Pragma("unroll") for (int nt = 0; nt < 2; ++nt) { \
            f32x4 acc = {0.f, 0.f, 0.f, 0.f}; \
            _Pragma("unroll") for (int ks = 0; ks < 4; ++ks) acc = __builtin_amdgcn_mfma_f32_16x16x32_bf16(af[(j0) + j][ks], bq[j][nt][ks], acc, 0, 0, 0); \
            _Pragma("unroll") for (int jj = 0; jj < 4; ++jj) tile[((fq * 4 + jj) * 16 + 4 * wave + (j0) + j) * 33 + nt * 16 + fr] = acc[jj]; }
        ROUTE_LOADB(0, 0)
        for (int ch = 0; ch < 4; ++ch) {
            __syncthreads();
            ROUTE_MMA(0)
            ROUTE_LOADB(ch, 2)
            ROUTE_MMA(2)
            if (ch < 3) { ROUTE_LOADB(ch + 1, 0) }
            __syncthreads();
#pragma unroll
            for (int j = 0; j < 32; ++j) {
                const float x = __uint_as_float((__float_as_uint(tile[tid * 33 + j]) & ~0x7Fu) | (unsigned)(ch * 32 + j));
                ins16(l, x);
            }
        }
#pragma unroll
        for (int i = 0; i < 16; ++i) L[tid * 16 + i] = __float_as_uint(l[i]);
        __syncthreads();
        const int pe = tid & ~1, po = tid | 1;
        float s1[16], s2[16];
#pragma unroll
        for (int i = 0; i < 16; ++i) { s1[i] = __uint_as_float(L[pe * 16 + i]); s2[i] = __uint_as_float(L[po * 16 + i]); }
        float m[16];
#pragma unroll
        for (int i = 0; i < 16; ++i) m[i] = NEG;
#pragma unroll
        for (int i = 0; i < 16; ++i)
#pragma unroll
            for (int j = 0; j < 16; ++j)
                if ((i + 1) * (j + 1) <= 16) ins16(m, __uint_as_float((__float_as_uint(s1[i] + s2[j]) & ~0xFFu) | (unsigned)(i * 16 + j)));
        float e[16], sum = 0.f;
#pragma unroll
        for (int r = 0; r < 16; ++r) { e[r] = __expf(m[r] - m[0]); sum += e[r]; }
        const float inv = 1.f / sum;
        const int par = tid & 1;
        const size_t ob = ((R0 + tid) >> 1) * 16 + par * 8;
#pragma unroll
        for (int r = 0; r < 8; ++r) {
            float k_lo = m[r], k_hi = m[r + 8], e_lo = e[r], e_hi = e[r + 8];
            asm volatile("" : "+v"(k_lo), "+v"(k_hi), "+v"(e_lo), "+v"(e_hi));
            const float key = par ? k_hi : k_lo;
            const float ev = par ? e_hi : e_lo;
            const unsigned cand = __float_as_uint(key) & 0xFFu;
            const unsigned i1 = L[pe * 16 + (cand >> 4)] & 0x7Fu, i2 = L[po * 16 + (cand & 15)] & 0x7Fu;
            idx[ob + r] = (int)(i1 * 128 + i2);
            gates[ob + r] = ev * inv;
        }
    }
}

typedef float f32x2 __attribute__((ext_vector_type(2)));
typedef float v32f __attribute__((ext_vector_type(32)));
typedef float v16f __attribute__((ext_vector_type(16)));
typedef unsigned v6u __attribute__((ext_vector_type(6)));
constexpr int EROW = 1536;
__device__ __forceinline__ void fp6_calibrate(int (&sig)[32]) {
    v16f tlo, thi;
#pragma unroll
    for (int i = 0; i < 16; ++i) { tlo[i] = (i < 8) ? 0.125f * i : 1.f + 0.125f * (i - 8); thi[i] = (i < 8) ? 2.f + 0.25f * i : 4.f + 0.5f * (i - 8); }
    asm volatile("" : "+v"(tlo), "+v"(thi));
    const v6u tw = __builtin_amdgcn_cvt_scalef32_2xpk16_fp6_f32(tlo, thi, 1.0f);
    const v32f tr = __builtin_amdgcn_cvt_scalef32_pk32_f32_fp6(tw, 1.0f);
#pragma unroll
    for (int j = 0; j < 32; ++j) {
        const float v = tr[j];
        const int k = v < 2.f ? (int)(v * 8.f + 0.5f) : (v < 4.f ? 16 + (int)((v - 2.f) * 4.f + 0.5f) : 24 + (int)((v - 4.f) * 2.f + 0.5f));
        sig[j] = __builtin_amdgcn_readfirstlane(k) & 31;
    }
}
__device__ __forceinline__ void phase_econv(const Params& P, int bid, int nb, unsigned char* smem) {
    int tid_ = VTID; asm volatile("" : "+v"(tid_));
    const int wave = tid_ >> 6, lane = tid_ & 63;
    float* scales = (float*)(P.ws + WS_ESC);
    float* pad = (float*)smem + wave * (64 * 33 + 64);
    int* tab = (int*)(pad + 64 * 33);
    int inv[32];
    {
        int sig[32]; fp6_calibrate(sig);
#pragma unroll
        for (int j = 0; j < 32; ++j) if (lane == 0) tab[sig[j]] = j;
#pragma unroll
        for (int k = 0; k < 32; ++k) inv[k] = __builtin_amdgcn_readfirstlane(tab[k]) & 31;
    }
    bool fp4_natural;
    { float ta = 1.0f, tb = 2.0f; asm volatile("" : "+v"(ta), "+v"(tb));
      const unsigned tw = __builtin_amdgcn_cvt_scalef32_pk_fp4_f32(0u, ta, tb, 1.0f, 0);
      const f32x2 tr = __builtin_amdgcn_cvt_scalef32_pk_f32_fp4(tw, 1.0f, 0);
      fp4_natural = __builtin_amdgcn_readfirstlane(tr[0] == 1.0f ? 1 : 0) != 0; }
    for (int r = bid * 4 + wave; r < 32768; r += nb * 4) {
        const bool isv = r >= 16384;
        const float* src = (isv ? P.expert_v : P.expert_u) + (size_t)(r & 16383) * D + lane * 32;
        f32x4 v[8]; float am = 0.f;
#pragma unroll
        for (int i = 0; i < 8; ++i) { v[i] = *(const f32x4*)(src + i * 4); am = fmaxf(am, fmaxf(fmaxf(fabsf(v[i][0]), fabsf(v[i][1])), fmaxf(fabsf(v[i][2]), fabsf(v[i][3])))); }
        am = wave_max(am);
        if (!isv) {
            unsigned char* dst = P.ws + WS_EU8 + (size_t)r * EROW + lane * 24;
            const float sc = am > 0.f ? 7.5f / am : 1.f;
#pragma unroll
            for (int j = 0; j < 32; ++j) pad[lane * 33 + j] = v[j >> 2][j & 3] * sc;
            v16f lo, hi;
#pragma unroll
            for (int k = 0; k < 16; ++k) { lo[k] = pad[lane * 33 + inv[k]]; hi[k] = pad[lane * 33 + inv[16 + k]]; }
            const v6u w = __builtin_amdgcn_cvt_scalef32_2xpk16_fp6_f32(lo, hi, 1.0f);
            *(uint2*)(dst) = make_uint2(w[0], w[1]); *(uint2*)(dst + 8) = make_uint2(w[2], w[3]); *(uint2*)(dst + 16) = make_uint2(w[4], w[5]);
            if (lane == 0) scales[r] = am > 0.f ? am * (1.f / 7.5f) : 1.f;
        } else {
            unsigned char* dst = P.ws + WS_EV4 + (size_t)(r - 16384) * 1024 + lane * 16;
            const float sc = am > 0.f ? 6.0f / (0.8f * am) : 1.f;
            unsigned w[4] = {0u, 0u, 0u, 0u};
#define FP4_PK(i, bs) { const float a = v[(i) >> 1][((i) & 1) * 2] * sc, b = v[(i) >> 1][((i) & 1) * 2 + 1] * sc; \
                w[(i) >> 2] = __builtin_amdgcn_cvt_scalef32_pk_fp4_f32(w[(i) >> 2], fp4_natural ? a : b, fp4_natural ? b : a, 1.0f, bs); }
            FP4_PK(0, 0) FP4_PK(1, 1) FP4_PK(2, 2) FP4_PK(3, 3) FP4_PK(4, 0) FP4_PK(5, 1) FP4_PK(6, 2) FP4_PK(7, 3)
            FP4_PK(8, 0) FP4_PK(9, 1) FP4_PK(10, 2) FP4_PK(11, 3) FP4_PK(12, 0) FP4_PK(13, 1) FP4_PK(14, 2) FP4_PK(15, 3)
            *(uint4*)dst = make_uint4(w[0], w[1], w[2], w[3]);
            if (lane == 0) scales[r] = am > 0.f ? (0.8f * am) * (1.f / 6.0f) : 1.f;
        }
    }
}

__device__ __forceinline__ float gelu_f(float d) { return 0.5f * d * (1.f + erff(d * 0.70710678118654752f)); }

template <bool DRY>
__device__ __forceinline__ void phase_peer(const Params& P, int bid, int nb) {
    const bf16_t* hn = (const bf16_t*)(P.ws + WS_HN); const int* idx = (const int*)(P.ws + WS_IDX); const float* gates = (const float*)(P.ws + WS_GATES);
    float* H = (float*)(P.ws + WS_H);
    const unsigned char* EU = P.ws + WS_EU8; const unsigned char* EV = P.ws + WS_EV4; const float* SC = (const float*)(P.ws + WS_ESC);
    const int wave = VTID >> 6, lane = VTID & 63;
    for (int t = bid * 4 + wave; t < T; t += nb * 4) {
        v32f acc; unsigned xp[16];
#pragma unroll
        for (int q = 0; q < 4; ++q) {
            const uint4 v = *(const uint4*)(hn + (size_t)t * D + lane * 32 + q * 8);
            xp[q * 4] = v.x; xp[q * 4 + 1] = v.y; xp[q * 4 + 2] = v.z; xp[q * 4 + 3] = v.w;
        }
#pragma unroll
        for (int i = 0; i < 32; ++i) acc[i] = 0.f;
        const float rs_t = rsqrtf(((const float*)(P.ws + WS_RSS))[t] * (1.f / 2048.f) + EPS);
        const int   my_i0 = idx[(size_t)t * 128 + lane],   my_i1 = idx[(size_t)t * 128 + 64 + lane];
        const float my_g0 = gates[(size_t)t * 128 + lane], my_g1 = gates[(size_t)t * 128 + 64 + lane];
        uint2 U0a, U0b, U0c, U1a, U1b, U1c, U2a, U2b, U2c, U3a, U3b, U3c, U4a, U4b, U4c, U5a, U5b, U5c, U6a, U6b, U6c, U7a, U7b, U7c;
        uint4 V0, V1, V2, V3, V4, V5, V6, V7;
#define PEER_E(k) ((k) < 64 ? __builtin_amdgcn_readlane(my_i0, (k)) : __builtin_amdgcn_readlane(my_i1, (k) - 64))
#define PEER_LDU(j, kk) { const unsigned o_ = (unsigned)PEER_E(kk) * (unsigned)EROW + lane24; U##j##a = *(const uint2*)(EU + o_); U##j##b = *(const uint2*)(EU + o_ + 8); U##j##c = *(const uint2*)(EU + o_ + 16); }
#define PEER_LDV(j, kk) { const unsigned o_ = (unsigned)PEER_E(kk) * 1024u + lane16; V##j = *(const uint4*)(EV + o_); }
#define PEER_DOT(j, dst) { const v6u uw = {U##j##a.x, U##j##a.y, U##j##b.x, U##j##b.y, U##j##c.x, U##j##c.y}; const v32f uf = __builtin_amdgcn_cvt_scalef32_pk32_f32_fp6(uw, 1.0f); \
        float d = 0.f; _Pragma("unroll") for (int i = 0; i < 16; ++i) d += uf[2 * i] * __uint_as_float(xp[i] << 16) + uf[2 * i + 1] * __uint_as_float(xp[i] & 0xffff0000u); dst = d; __builtin_amdgcn_sched_barrier(0); }
#define PEER_AXPY(j, aj) { const unsigned vw[4] = {V##j.x, V##j.y, V##j.z, V##j.w}; \
        _Pragma("unroll") for (int q = 0; q < 4; ++q) { \
            const f32x2 f0 = __builtin_amdgcn_cvt_scalef32_pk_f32_fp4(vw[q], 1.0f, 0), f1 = __builtin_amdgcn_cvt_scalef32_pk_f32_fp4(vw[q], 1.0f, 1), \
                        f2 = __builtin_amdgcn_cvt_scalef32_pk_f32_fp4(vw[q], 1.0f, 2), f3 = __builtin_amdgcn_cvt_scalef32_pk_f32_fp4(vw[q], 1.0f, 3); \
            acc[q * 8] += (aj) * f0[0]; acc[q * 8 + 1] += (aj) * f0[1]; acc[q * 8 + 2] += (aj) * f1[0]; acc[q * 8 + 3] += (aj) * f1[1]; \
            acc[q * 8 + 4] += (aj) * f2[0]; acc[q * 8 + 5] += (aj) * f2[1]; acc[q * 8 + 6] += (aj) * f3[0]; acc[q * 8 + 7] += (aj) * f3[1]; } __builtin_amdgcn_sched_barrier(0); }
        const unsigned lane24 = (unsigned)lane * 24u, lane16 = (unsigned)lane * 16u;
        PEER_LDU(0, 0) PEER_LDU(1, 1) PEER_LDU(2, 2) PEER_LDU(3, 3) PEER_LDU(4, 4) PEER_LDU(5, 5) PEER_LDU(6, 6) PEER_LDU(7, 7)
        PEER_LDV(0, 0) PEER_LDV(1, 1) PEER_LDV(2, 2) PEER_LDV(3, 3) PEER_LDV(4, 4) PEER_LDV(5, 5) PEER_LDV(6, 6) PEER_LDV(7, 7)
        const bool b5 = (lane & 32) != 0, b4 = (lane & 16) != 0, b3 = (lane & 8) != 0;
        for (int k0 = 0; k0 < 128; k0 += 8) {
            const bool more = k0 + 8 < 128;
            float p0, p1, p2, p3, p4, p5, p6, p7;
            PEER_DOT(0, p0)
            PEER_DOT(1, p1)
            PEER_DOT(2, p2)
            PEER_DOT(3, p3)
            PEER_DOT(4, p4)
            PEER_DOT(5, p5)
            PEER_DOT(6, p6)
            PEER_DOT(7, p7)
            const float q0 = (b5 ? p4 : p0) + __shfl_xor(b5 ? p0 : p4, 32), q1 = (b5 ? p5 : p1) + __shfl_xor(b5 ? p1 : p5, 32);
            const float q2 = (b5 ? p6 : p2) + __shfl_xor(b5 ? p2 : p6, 32), q3 = (b5 ? p7 : p3) + __shfl_xor(b5 ? p3 : p7, 32);
            const float r0 = (b4 ? q2 : q0) + __shfl_xor(b4 ? q0 : q2, 16), r1 = (b4 ? q3 : q1) + __shfl_xor(b4 ? q1 : q3, 16);
            float dt = (b3 ? r1 : r0) + __shfl_xor(b3 ? r0 : r1, 8);
            dt += __shfl_xor(dt, 4); dt += __shfl_xor(dt, 2); dt += __shfl_xor(dt, 1);
            const int src_lane = (k0 & 63) + (lane >> 3);
            const int e_l = __shfl(k0 < 64 ? my_i0 : my_i1, src_lane);
            const float g_l = __shfl(k0 < 64 ? my_g0 : my_g1, src_lane);
            const float pre = dt * SC[e_l] * rs_t;
            const int a_l = __float_as_int(gelu_f(pre) * g_l * SC[16384 + e_l]);
            { const float a0 = __int_as_float(__builtin_amdgcn_readlane(a_l, 0));  PEER_AXPY(0, a0) if (more) { PEER_LDV(0, k0 + 8) PEER_LDU(0, k0 + 8) } }
            { const float a1 = __int_as_float(__builtin_amdgcn_readlane(a_l, 8));  PEER_AXPY(1, a1) if (more) { PEER_LDV(1, k0 + 9) PEER_LDU(1, k0 + 9) } }
            { const float a2 = __int_as_float(__builtin_amdgcn_readlane(a_l, 16)); PEER_AXPY(2, a2) if (more) { PEER_LDV(2, k0 + 10) PEER_LDU(2, k0 + 10) } }
            { const float a3 = __int_as_float(__builtin_amdgcn_readlane(a_l, 24)); PEER_AXPY(3, a3) if (more) { PEER_LDV(3, k0 + 11) PEER_LDU(3, k0 + 11) } }
            { const float a4 = __int_as_float(__builtin_amdgcn_readlane(a_l, 32)); PEER_AXPY(4, a4) if (more) { PEER_LDV(4, k0 + 12) PEER_LDU(4, k0 + 12) } }
            { const float a5 = __int_as_float(__builtin_amdgcn_readlane(a_l, 40)); PEER_AXPY(5, a5) if (more) { PEER_LDV(5, k0 + 13) PEER_LDU(5, k0 + 13) } }
            { const float a6 = __int_as_float(__builtin_amdgcn_readlane(a_l, 48)); PEER_AXPY(6, a6) if (more) { PEER_LDV(6, k0 + 14) PEER_LDU(6, k0 + 14) } }
            { const float a7 = __int_as_float(__builtin_amdgcn_readlane(a_l, 56)); PEER_AXPY(7, a7) if (more) { PEER_LDV(7, k0 + 15) PEER_LDU(7, k0 + 15) } }
        }
        if (DRY) {
#pragma unroll
            for (int i = 0; i < 32; ++i) asm volatile("" :: "v"(acc[i]));
            continue;
        }
        float ss = 0.f;
#pragma unroll
        for (int q = 0; q < 8; ++q) {
            f32x4* hp = (f32x4*)(H + (size_t)t * D + lane * 32 + q * 4);
            f32x4 hv = *hp;
#pragma unroll
            for (int j = 0; j < 4; ++j) { hv[j] += acc[q * 4 + j]; acc[q * 4 + j] = hv[j]; ss += hv[j] * hv[j]; }
            *hp = hv;
        }
        ss = wave_sum(ss);
        const float rs = rsqrtf(ss * (1.f / 2048.f) + EPS);
        bf16_t* hn3 = (bf16_t*)(P.ws + WS_HN) + (size_t)t * D + lane * 32;
#pragma unroll
        for (int q = 0; q < 4; ++q) {
            unsigned w[4];
#pragma unroll
            for (int j = 0; j < 4; ++j) { const int col = lane * 32 + q * 8 + 2 * j;
                w[j] = pack2(acc[q * 8 + 2 * j] * rs * P.norm_ple[col], acc[q * 8 + 2 * j + 1] * rs * P.norm_ple[col + 1]); }
            *(uint4*)(hn3 + q * 8) = make_uint4(w[0], w[1], w[2], w[3]);
        }
    }
}

enum { PH_PREP = 0, PH_GEMM1, PH_CHUNK1, PH_SCAN, PH_CHUNK3, PH_GEMM2, PH_GEMM3, PH_ROUTE, PH_PEER, PH_GEMM4, PH_FINAL, PH_COUNT };

#define XB_TMO      128
#define XB_XCNT(j)  (256  + 64 * (j))
#define XB_XSUB(j)  (1280 + 64 * (j))
#define XB_XGEN(j)  (2304 + 64 * (j))
#define XB_TOP      3328
#define XB_TOPGEN   3392
#define XCD_BAR_WORDS 3456
#define XB_SPIN_CAP (1u << 20)
#define LAS __attribute__((address_space(3)))
__device__ __forceinline__ unsigned xb_ld(unsigned* p)              { return __hip_atomic_load(p, __ATOMIC_RELAXED, __HIP_MEMORY_SCOPE_AGENT); }
__device__ __forceinline__ unsigned xb_add(unsigned* p, unsigned v) { return __hip_atomic_fetch_add(p, v, __ATOMIC_RELAXED, __HIP_MEMORY_SCOPE_AGENT); }
__device__ __forceinline__ unsigned xb_xcc_id() { return (unsigned)__builtin_amdgcn_s_getreg((3 << 11) | 20) & 0xFu; }
#define XB_SPIN(cond, bar) do { unsigned _sp = 0; while (cond) { __builtin_amdgcn_s_sleep(1); \
    if ((++_sp & 255u) == 0u) { if (xb_ld(&(bar)[XB_TMO])) break; if (_sp > XB_SPIN_CAP) { atomicAdd(&(bar)[XB_TMO], 1u); break; } } } } while (0)
struct XcdBarrier { unsigned* bar; unsigned x; volatile LAS unsigned* st; };
__device__ __forceinline__ XcdBarrier xcd_barrier_post(unsigned* bar, volatile LAS unsigned* st) {
    XcdBarrier b; b.bar = bar; b.x = xb_xcc_id(); b.st = st;
    if (threadIdx.x == 0) (void)xb_add(&bar[XB_XCNT(b.x)], 1u);
    return b;
}
__device__ __forceinline__ void xcd_barrier_complete(unsigned* bar, unsigned x, unsigned& nloc, unsigned& nx) {
    const unsigned G = gridDim.x * gridDim.y * gridDim.z;
    unsigned sum, cnt, mine, sp = 0u;
    for (;;) {
        sum = 0u; cnt = 0u; mine = 0u;
#pragma unroll
        for (unsigned j = 0; j < 16; ++j) { const unsigned c = xb_ld(&bar[XB_XCNT(j)]); sum += c; cnt += (c > 0u) ? 1u : 0u; mine = (j == x) ? c : mine; }
        if (sum == G) break;
        __builtin_amdgcn_s_sleep(1);
        if ((++sp & 255u) == 0u) { if (xb_ld(&bar[XB_TMO])) break; if (sp > XB_SPIN_CAP) { atomicAdd(&bar[XB_TMO], 1u); break; } }
    }
    nloc = mine > 0u ? mine : 1u; nx = cnt > 0u ? cnt : 1u;
}
__device__ __forceinline__ void xcd_barrier(const XcdBarrier& b) {
    asm volatile("s_waitcnt vmcnt(0)" ::: "memory");
    __syncthreads();
    if (threadIdx.x == 0) {
        unsigned* bar = b.bar;
        __builtin_amdgcn_s_waitcnt(0);
        unsigned nloc = b.st[0], nx = b.st[1];
        if (nloc == 0u) { xcd_barrier_complete(bar, b.x, nloc, nx); b.st[0] = nloc; b.st[1] = nx; }
        const unsigned old = xb_add(&bar[XB_XSUB(b.x)], 1u);
        const unsigned gen = old / nloc;
        if (old + 1u == (gen + 1u) * nloc) {
            __builtin_amdgcn_fence(__ATOMIC_RELEASE, "agent");
            asm volatile("s_waitcnt vmcnt(0)" ::: "memory");
            const unsigned og = xb_add(&bar[XB_TOP], 1u);
            const unsigned tg = og / nx;
            if (og + 1u == (tg + 1u) * nx) xb_add(&bar[XB_TOPGEN], 1u);
            else XB_SPIN(xb_ld(&bar[XB_TOPGEN]) == tg, bar);
            __builtin_amdgcn_fence(__ATOMIC_ACQUIRE, "agent");
            xb_add(&bar[XB_XGEN(b.x)], 1u);
            asm volatile("s_waitcnt vmcnt(0)" ::: "memory");
        } else {
            XB_SPIN(xb_ld(&bar[XB_XGEN(b.x)]) == gen, bar);
            __builtin_amdgcn_fence(__ATOMIC_ACQUIRE, "agent");
            asm volatile("s_waitcnt vmcnt(0)" ::: "memory");
        }
    }
    __syncthreads();
}

__device__ __forceinline__ void run_phase(const Params& P, int ph, int bid, int nb, unsigned char* smem, int rbid, int rnb, unsigned char* rsmem) {
    switch (ph) {
        case PH_PREP:   phase_prep(P, bid, nb, smem); break;
        case PH_GEMM1:  phase_gemm1(P, rbid, rnb, rsmem); break;
        case PH_CHUNK1: phase_chunk1(P, bid, nb, smem); break;
        case PH_SCAN:   phase_scan(P, bid, nb, smem, rbid, rnb, rsmem); break;
        case PH_SCAN + 100: phase_scan(P, bid, nb, smem, rbid, rnb, rsmem, 1); break;
        case PH_SCAN + 200: phase_scan(P, bid, nb, smem, rbid, rnb, rsmem, 2); break;
        case PH_CHUNK3: phase_chunk3(P, bid, nb, smem); break;
        case PH_GEMM2:  phase_gemm2(P, rbid, rnb, rsmem); break;
        case PH_GEMM3:  phase_gemm3(P, rbid, rnb, rsmem); break;
        case PH_ROUTE:  phase_route(P, bid, nb, smem); break;
        case PH_PEER:   phase_peer<false>(P, bid, nb); break;
        case PH_PEER + 100: phase_peer<true>(P, bid, nb); break;
        case PH_GEMM4:  phase_gemm4(P, rbid, rnb, rsmem); break;
        case PH_FINAL:  phase_rownorm<false>((const float*)(P.ws + WS_H), P.norm_final, P.out, bid, nb); break;
    }
}

#ifndef PROBE_A
#define PROBE_A -1
#endif
#ifndef PROBE_B
#define PROBE_B -1
#endif
constexpr int LDS_BYTES = 131072 + 16 + 256;

__global__ void __launch_bounds__(512, 2) fwd_kernel(Params P, int ph_lo, int ph_hi) {
    extern __shared__ __attribute__((aligned(16))) unsigned char rsmem[];
    const int rbid = blockIdx.x, rnb = gridDim.x;
    const int half = __builtin_amdgcn_readfirstlane((int)(threadIdx.x >> 8));
    const int bid = rbid * 2 + half, nb = rnb * 2;
    unsigned char* smem = rsmem + half * 65536;
    volatile LAS unsigned* st = (volatile LAS unsigned*)(rsmem + 131072);
    if (threadIdx.x == 0) { st[0] = 0u; st[1] = 0u; }
    __syncthreads();
    XcdBarrier xb = xcd_barrier_post((unsigned*)(P.ws + WS_BAR), st);
#if PROBE_A >= 0
    unsigned long long* tstamp = (unsigned long long*)(rsmem + 131072 + 16);
    xcd_barrier(xb);
    if (threadIdx.x == 0) tstamp[0] = __builtin_amdgcn_s_memrealtime();
#define RUN(ph) if (ph_lo <= (ph) && (ph) < ph_hi) { run_phase(P, (ph), bid, nb, smem, rbid, rnb, rsmem); xcd_barrier(xb); if (threadIdx.x == 0) tstamp[(ph) + 1] = __builtin_amdgcn_s_memrealtime(); }
#else
#ifndef SCAN_PROBE
#define SCAN_PROBE 0
#endif
#ifndef REPEAT_PH
#define REPEAT_PH -1
#endif
#define RUN(ph) if (ph_lo <= (ph) && (ph) < ph_hi) { if ((ph) == REPEAT_PH && (ph) == PH_PEER) { run_phase(P, PH_PEER + 100, bid, nb, smem, rbid, rnb, rsmem); xcd_barrier(xb); } run_phase(P, (ph), bid, nb, smem, rbid, rnb, rsmem); if ((ph) == REPEAT_PH && (ph) != PH_PEER) { xcd_barrier(xb); run_phase(P, (ph) == PH_SCAN ? PH_SCAN + SCAN_PROBE : (ph), bid, nb, smem, rbid, rnb, rsmem); } if ((ph) + 1 < ph_hi) xcd_barrier(xb); }
#endif
    RUN(PH_PREP) RUN(PH_GEMM1) RUN(PH_CHUNK1) RUN(PH_SCAN) RUN(PH_CHUNK3) RUN(PH_GEMM2) RUN(PH_GEMM3) RUN(PH_ROUTE)
    RUN(PH_PEER) RUN(PH_GEMM4) RUN(PH_FINAL)
#if PROBE_A >= 0
    __syncthreads();
    if (rbid == 0) {
        const float da = (float)(tstamp[PROBE_A + 1] - tstamp[PROBE_A]) * 0.01f;
        if (threadIdx.x == 0) P.out[0] = da;
#if PROBE_B >= 0
        const float db = (float)(tstamp[PROBE_B + 1] - tstamp[PROBE_B]) * 0.01f * (1.f / 16.f);
        for (int i = threadIdx.x; i < 65536; i += 512) P.out[65536 + i] = db;
#endif
    }
#endif
}

extern "C" void kernel_launch(void* const* d_in, const int* in_sizes, int n_in, void* d_out, int out_size, void* d_ws, size_t ws_size, hipStream_t stream) {
    static int grid = 0;
    if (grid == 0) {
        if (n_in != 21 || out_size != T * D || ws_size < WS_END) { fprintf(stderr, "kernel_launch: unexpected shapes: n_in %d out %d ws %zu (need %zu)\n", n_in, out_size, ws_size, (size_t)WS_END); grid = -1; return; }
        if (hipFuncSetAttribute((const void*)fwd_kernel, hipFuncAttributeMaxDynamicSharedMemorySize, LDS_BYTES) != hipSuccess) { fprintf(stderr, "kernel_launch: hipFuncSetAttribute failed\n"); grid = -1; return; }
        int dev = 0, cus = 0, per_cu = 0;
        hipGetDevice(&dev); hipDeviceGetAttribute(&cus, hipDeviceAttributeMultiprocessorCount, dev);
        if (hipOccupancyMaxActiveBlocksPerMultiprocessor(&per_cu, (const void*)fwd_kernel, 512, LDS_BYTES) != hipSuccess || per_cu < 1) { fprintf(stderr, "kernel_launch: occupancy query failed (%d)\n", per_cu); grid = -1; return; }
        if (per_cu > 1) per_cu = 1;
        grid = cus * per_cu;
        fprintf(stderr, "kernel_launch: grid %d (%d CUs x %d)\n", grid, cus, per_cu);
    }
    if (grid < 0) return;
    Params P{};
    P.x = (const float*)d_in[0]; P.p = (const float*)d_in[1]; P.positions = (const int*)d_in[2]; P.norm_mix = (const float*)d_in[3]; P.w_in = (const float*)d_in[4];
    P.conv_w = (const float*)d_in[5]; P.a_log = (const float*)d_in[6]; P.dt_bias = (const float*)d_in[7]; P.dn_norm = (const float*)d_in[8]; P.ret_gn_w = (const float*)d_in[9];
    P.ret_gn_b = (const float*)d_in[10]; P.w_out = (const float*)d_in[11]; P.norm_ffn = (const float*)d_in[12]; P.w_pq = (const float*)d_in[13]; P.sub_keys = (const float*)d_in[14];
    P.expert_u = (const float*)d_in[15]; P.expert_v = (const float*)d_in[16]; P.norm_ple = (const float*)d_in[17]; P.w_ple_gate = (const float*)d_in[18]; P.w_ple_proj = (const float*)d_in[19];
    P.norm_final = (const float*)d_in[20]; P.out = (float*)d_out; P.ws = (unsigned char*)d_ws;
    (void)hipMemsetAsync((unsigned char*)d_ws + WS_BAR, 0, XCD_BAR_WORDS * 4, stream);
    int lo = 0, hi = PH_COUNT;
    void* args[] = {&P, &lo, &hi};
    hipError_t e = hipLaunchCooperativeKernel((const void*)fwd_kernel, dim3(grid), dim3(512), args, LDS_BYTES, stream);
    if (e != hipSuccess) fprintf(stderr, "kernel_launch: cooperative launch failed: %s (grid %d)\n", hipGetErrorString(e), grid);
}
```

```cpp
#include <hip/hip_runtime.h>
#include <cstdio>
#include <cstdint>

typedef unsigned short bf16_t;
typedef short bf16x8 __attribute__((ext_vector_type(8)));
typedef float f32x16 __attribute__((ext_vector_type(16)));
typedef float f32x4 __attribute__((ext_vector_type(4)));
__device__ __forceinline__ int fresh_tid() { int t = (int)threadIdx.x; asm volatile("" : "+v"(t)); return t; }
#define VTID (fresh_tid() & 255)

constexpr int T = 8192, D = 2048, SEQ = 4096;
constexpr int NPROJ = 7424;
constexpr int C_Z = 3072, C_RQ = 4096, C_RK = 4608, C_RV = 5120, C_RG = 6144, C_A = 7168, C_B = 7176;
constexpr int IN_COLS = 7184;
constexpr float EPS = 1e-6f;

constexpr size_t WS_HN    = 0;
constexpr size_t WS_KVT   = WS_HN;
constexpr size_t WS_WTIN  = WS_HN + (size_t)T * D * 2;
constexpr size_t WS_STR   = WS_WTIN;
constexpr size_t WS_ATTR  = WS_STR + (size_t)1024 * 128 * 64 * 2;
constexpr size_t WS_WTOUT = WS_WTIN + (size_t)NPROJ * D * 2;
constexpr size_t WS_WTPQ  = WS_WTOUT + (size_t)D * D * 2;
constexpr size_t WS_WTG   = WS_WTPQ + (size_t)D * D * 2;
constexpr size_t WS_WTPP  = WS_WTG + (size_t)D * D * 2;
constexpr size_t WS_KEYS  = WS_WTPP + (size_t)D * 256 * 2;
constexpr size_t WS_PBF   = WS_KEYS + (size_t)16 * 128 * 128 * 2;
constexpr size_t WS_PROJ  = WS_PBF + (size_t)T * 256 * 2;
constexpr size_t WS_Q     = WS_PROJ;
constexpr size_t WS_SCORES= WS_PROJ + (size_t)T * D * 2;
constexpr size_t WS_MIXED = WS_PROJ + (size_t)T * NPROJ * 2;
constexpr size_t WS_H     = WS_MIXED + (size_t)T * D * 2;
constexpr size_t WS_IDX   = WS_H + (size_t)T * D * 4;
constexpr size_t WS_GATES = WS_IDX + (size_t)T * 128 * 4;
constexpr size_t WS_U     = WS_GATES + (size_t)T * 128 * 4;
constexpr size_t WS_W     = WS_U + (size_t)1024 * 64 * 128 * 4;
constexpr size_t WS_KDT   = WS_W + (size_t)1024 * 64 * 128 * 2;
constexpr size_t WS_QG    = WS_KDT + (size_t)1024 * 128 * 64 * 2;
constexpr size_t WS_ATT   = WS_QG + (size_t)1024 * 64 * 128 * 2;
constexpr size_t WS_QGR   = WS_ATT + (size_t)1024 * 64 * 64 * 2;
constexpr size_t WS_EU8   = WS_QGR + (size_t)1024 * 64 * 64 * 2;
constexpr size_t WS_EV4   = WS_EU8 + (size_t)16384 * 2048;
constexpr size_t WS_ESC   = WS_EV4 + (size_t)16384 * 2048;
constexpr size_t WS_EG    = WS_ESC + (size_t)2 * 16384 * 4;
constexpr size_t WS_RSS   = WS_EG + 4096;
constexpr size_t WS_BAR   = WS_RSS + (size_t)T * 4;
constexpr size_t WS_CS    = WS_BAR + 16384;
constexpr size_t WS_DUMMY = WS_CS + (size_t)T * 32 * 8;
constexpr size_t WS_END   = WS_DUMMY + 32768;
constexpr size_t WS_VNT   = WS_H;
constexpr size_t WS_SC    = WS_VNT + (size_t)1024 * 128 * 64 * 2;
constexpr size_t WS_VNTR  = WS_SC + (size_t)1024 * 128 * 128 * 2;
static_assert(WS_VNTR + (size_t)1024 * 128 * 64 * 2 == WS_H + (size_t)T * D * 4, "chunk buffers must fit the H region");

struct Params {
    const float *x, *p; const int* positions;
    const float *norm_mix, *w_in, *conv_w, *a_log, *dt_bias, *dn_norm, *ret_gn_w, *ret_gn_b, *w_out, *norm_ffn, *w_pq, *sub_keys,
                *expert_u, *expert_v, *norm_ple, *w_ple_gate, *w_ple_proj, *norm_final;
    float* out; unsigned char* ws;
};

typedef __bf16 bf16v2_t __attribute__((ext_vector_type(2)));
typedef float f32v2_t __attribute__((ext_vector_type(2)));
__device__ __forceinline__ bf16_t f2bf(float f) { return __builtin_bit_cast(bf16_t, (__bf16)f); }
__device__ __forceinline__ float bf2f(bf16_t h) { return __uint_as_float(((unsigned)h) << 16); }
__device__ __forceinline__ unsigned pack2(float a, float b) { const f32v2_t v = {a, b}; return __builtin_bit_cast(unsigned, __builtin_convertvector(v, bf16v2_t)); }
__device__ __forceinline__ float wave_sum(float v) {
#pragma unroll
    for (int o = 32; o >= 1; o >>= 1) v += __shfl_xor(v, o);
    return v;
}
__device__ __forceinline__ float wave_max(float v) {
#pragma unroll
    for (int o = 32; o >= 1; o >>= 1) v = fmaxf(v, __shfl_xor(v, o));
    return v;
}
__device__ __forceinline__ float silu_f(float x) { return x * __builtin_amdgcn_rcpf(1.f + __expf(-x)); }
__device__ __forceinline__ float sigmoid_f(float x) { return __builtin_amdgcn_rcpf(1.f + __expf(-x)); }

#define LASP __attribute__((address_space(3)))
__device__ __forceinline__ void half_sync(const unsigned char* smem) {
    asm volatile("s_waitcnt lgkmcnt(0)" ::: "memory");
    const unsigned half = (((unsigned)(size_t)smem) >> 16) & 1u;
    LASP unsigned* cnt = (LASP unsigned*)(size_t)(131072u + 288u + 64u * half);
    unsigned old = 0u;
    if ((threadIdx.x & 63u) == 0u) old = __hip_atomic_fetch_add(cnt, 1u, __ATOMIC_RELAXED, __HIP_MEMORY_SCOPE_WORKGROUP);
    old = (unsigned)__builtin_amdgcn_readfirstlane((int)old);
    const unsigned tgt = (old / 4u + 1u) * 4u;
    while (__hip_atomic_load(cnt, __ATOMIC_RELAXED, __HIP_MEMORY_SCOPE_WORKGROUP) < tgt) __builtin_amdgcn_s_sleep(1);
    asm volatile("" ::: "memory");
}
#define HSYNC() half_sync(smem)

template <bool MAPIN>
__device__ __forceinline__ void transpose_tile(const float* __restrict__ W, int ldw, int K, bf16_t* __restrict__ Wt, int kt, int nt, float* tile  ) {
    const int tid = VTID;
    half_sync((const unsigned char*)tile);
#pragma unroll
    for (int i = 0; i < 4; ++i) {
        const int idx = tid + 256 * i, kr = idx >> 4, c4 = idx & 15;
        const int n = nt * 64 + c4 * 4;
        int c = n; bool valid = true;
        if (MAPIN) { if (n < 4096) c = n; else if (n < 7168) c = n + 16; else if (n < 7184) c = n - 3072; else valid = false; }
        f32x4 v = {0.f, 0.f, 0.f, 0.f};
        if (valid) v = *(const f32x4*)(W + (size_t)(kt * 64 + kr) * ldw + c);
        float* d = tile + kr * 65 + c4 * 4;
        d[0] = v[0]; d[1] = v[1]; d[2] = v[2]; d[3] = v[3];
    }
    half_sync((const unsigned char*)tile);
#pragma unroll
    for (int i = 0; i < 2; ++i) {
        const int ch = tid + 256 * i, n = ch >> 3, kc = ch & 7;
        unsigned w[4];
#pragma unroll
        for (int j = 0; j < 4; ++j) w[j] = pack2(tile[(kc * 8 + 2 * j) * 65 + n], tile[(kc * 8 + 2 * j + 1) * 65 + n]);
        uint4 o = make_uint4(w[0], w[1], w[2], w[3]);
        *(uint4*)(Wt + (size_t)(nt * 64 + n) * K + kt * 64 + kc * 8) = o;
    }
}

template <bool OUT_BF16>
__device__ __forceinline__ void rmsnorm_row(const float* __restrict__ in, const float* __restrict__ w, void* __restrict__ out, int lane) {
    f32x4 v[8]; float ss = 0.f;
#pragma unroll
    for (int i = 0; i < 8; ++i) { v[i] = *(const f32x4*)(in + (i * 64 + lane) * 4); ss += v[i][0] * v[i][0] + v[i][1] * v[i][1] + v[i][2] * v[i][2] + v[i][3] * v[i][3]; }
    ss = wave_sum(ss);
    const float r = rsqrtf(ss * (1.f / 2048.f) + EPS);
#pragma unroll
    for (int i = 0; i < 8; ++i) {
        const f32x4 g = *(const f32x4*)(w + (i * 64 + lane) * 4);
        const float a = v[i][0] * r * g[0], b = v[i][1] * r * g[1], c = v[i][2] * r * g[2], d = v[i][3] * r * g[3];
        if (OUT_BF16) { uint2 o = make_uint2(pack2(a, b), pack2(c, d)); *(uint2*)((bf16_t*)out + (i * 64 + lane) * 4) = o; }
        else { f32x4 o = {a, b, c, d}; *(f32x4*)((float*)out + (i * 64 + lane) * 4) = o; }
    }
}

__device__ __forceinline__ void phase_prep(const Params& P, int bid, int nb, unsigned char* smem) {
    float* tile = (float*)smem;
    const int tid = VTID;
    const int n_in = 32 * 116, n_sq = 32 * 32, n_pp = 4 * 32;
    const int n_tr = n_in + 3 * n_sq + n_pp;
    for (int u = bid; u < n_tr; u += nb) {
        if (u < n_in) transpose_tile<true>(P.w_in, IN_COLS, D, (bf16_t*)(P.ws + WS_WTIN), u % 32, u / 32, tile);
        else if (u < n_in + n_sq) { const int v = u - n_in; transpose_tile<false>(P.w_out, D, D, (bf16_t*)(P.ws + WS_WTOUT), v % 32, v / 32, tile); }
        else if (u < n_in + 2 * n_sq) { const int v = u - n_in - n_sq; transpose_tile<false>(P.w_pq, D, D, (bf16_t*)(P.ws + WS_WTPQ), v % 32, v / 32, tile); }
        else if (u < n_in + 3 * n_sq) { const int v = u - n_in - 2 * n_sq; transpose_tile<false>(P.w_ple_gate, D, D, (bf16_t*)(P.ws + WS_WTG), v % 32, v / 32, tile); }
        else { const int v = u - n_in - 3 * n_sq; transpose_tile<false>(P.w_ple_proj, D, 256, (bf16_t*)(P.ws + WS_WTPP), v % 4, v / 4, tile); }
    }
    {
        bf16_t* keys = (bf16_t*)(P.ws + WS_KEYS); bf16_t* pbf = (bf16_t*)(P.ws + WS_PBF);
        const int n4a = 262144 / 4, n4b = T * 256 / 4;
        for (int i = bid * 256 + tid; i < n4a + n4b; i += nb * 256) {
            const bool a = i < n4a; const int j = a ? i : i - n4a;
            const f32x4 v = *(const f32x4*)((a ? P.sub_keys : P.p) + (size_t)j * 4);
            *(uint2*)((a ? keys : pbf) + (size_t)j * 4) = make_uint2(pack2(v[0], v[1]), pack2(v[2], v[3]));
        }
    }
    { float* rss = (float*)(P.ws + WS_RSS); for (int i = bid * 256 + tid; i < T; i += nb * 256) rss[i] = 0.f; }
    {
        float2* cs = (float2*)(P.ws + WS_CS);
        for (int e = bid * 256 + tid; e < T * 32; e += nb * 256) {
            const int t = e >> 5, i = e & 31;
            const float ang = (float)P.positions[t] * powf(10000.f, -(float)i / 32.f);
            float sn, c0; sincosf(ang, &sn, &c0);
            cs[e] = make_float2(c0, sn);
        }
    }
    {
        const int wave = tid >> 6, lane = tid & 63;
        bf16_t* hn = (bf16_t*)(P.ws + WS_HN);
        for (int r = bid * 4 + wave; r < T; r += nb * 4) rmsnorm_row<true>(P.x + (size_t)r * D, P.norm_mix, hn + (size_t)r * D, lane);
    }
}

__device__ __forceinline__ int lds_off(int row, int ch) { return row * 128 + ((ch ^ ((row >> 1) & 7)) << 4); }

__device__ __forceinline__ void gemm_mainloop(const bf16_t* __restrict__ A, int lda, const bf16_t* __restrict__ Bt, int ldb, int K,
                                              f32x16 (&acc)[2][2], unsigned char* smem) {
    const int tid = VTID, wave = tid >> 6, lane = tid & 63, wr = wave >> 1, wc = wave & 1;
    const int nk = K / 64;
    uint4 ra[4], rb[4];
    __syncthreads();
#pragma unroll
    for (int i = 0; i < 4; ++i) { const int c = tid + 256 * i, row = c >> 3, ch = c & 7;
        ra[i] = *(const uint4*)(A + (size_t)row * lda + ch * 8); rb[i] = *(const uint4*)(Bt + (size_t)row * ldb + ch * 8); }
#pragma unroll
    for (int i = 0; i < 4; ++i) { const int c = tid + 256 * i, row = c >> 3, ch = c & 7;
        *(uint4*)(smem + lds_off(row, ch)) = ra[i]; *(uint4*)(smem + 16384 + lds_off(row, ch)) = rb[i]; }
    __syncthreads();
    for (int kt = 0; kt < nk; ++kt) {
        unsigned char* cur = smem + (kt & 1) * 32768;
        unsigned char* nxt = smem + ((kt + 1) & 1) * 32768;
        const bool more = kt + 1 < nk;
        if (more) {
#pragma unroll
            for (int i = 0; i < 4; ++i) { const int c = tid + 256 * i, row = c >> 3, ch = c & 7;
                ra[i] = *(const uint4*)(A + (size_t)row * lda + (kt + 1) * 64 + ch * 8); rb[i] = *(const uint4*)(Bt + (size_t)row * ldb + (kt + 1) * 64 + ch * 8); }
        }
#pragma unroll
        for (int ks = 0; ks < 4; ++ks) {
            bf16x8 af[2], bfr[2];
#pragma unroll
            for (int i = 0; i < 2; ++i) { const int row = wr * 64 + i * 32 + (lane & 31); af[i] = *(const bf16x8*)(cur + lds_off(row, ks * 2 + (lane >> 5))); }
#pragma unroll
            for (int j = 0; j < 2; ++j) { const int row = wc * 64 + j * 32 + (lane & 31); bfr[j] = *(const bf16x8*)(cur + 16384 + lds_off(row, ks * 2 + (lane >> 5))); }
#pragma unroll
            for (int i = 0; i < 2; ++i)
#pragma unroll
                for (int j = 0; j < 2; ++j) acc[i][j] = __builtin_amdgcn_mfma_f32_32x32x16_bf16(af[i], bfr[j], acc[i][j], 0, 0, 0);
        }
        if (more) {
#pragma unroll
            for (int i = 0; i < 4; ++i) { const int c = tid + 256 * i, row = c >> 3, ch = c & 7;
                *(uint4*)(nxt + lds_off(row, ch)) = ra[i]; *(uint4*)(nxt + 16384 + lds_off(row, ch)) = rb[i]; }
        }
        __syncthreads();
    }
}
#define ACC_FOREACH(body)                                                                                   \
    { const int _tid = VTID, _wave = _tid >> 6, _lane = _tid & 63, _wr = _wave >> 1, _wc = _wave & 1; \
      _Pragma("unroll") for (int i = 0; i < 2; ++i) _Pragma("unroll") for (int j = 0; j < 2; ++j)          \
      _Pragma("unroll") for (int r = 0; r < 16; ++r) {                                                     \
          const int row = _wr * 64 + i * 32 + (r & 3) + 8 * (r >> 2) + 4 * (_lane >> 5);                   \
          const int col = _wc * 64 + j * 32 + (_lane & 31); body } }

__device__ __forceinline__ void zero_acc(f32x16 (&acc)[2][2]) {
#pragma unroll
    for (int i = 0; i < 2; ++i)
#pragma unroll
        for (int j = 0; j < 2; ++j)
#pragma unroll
            for (int r = 0; r < 16; ++r) acc[i][j][r] = 0.f;
}

__device__ __forceinline__ void phase_scores(const Params& P, int bid, int nb, unsigned char* smem) {
    const bf16_t* A = (const bf16_t*)(P.ws + WS_Q); const bf16_t* Bt = (const bf16_t*)(P.ws + WS_KEYS); float* C = (float*)(P.ws + WS_SCORES);
    const int nmt = T / 128, nnt = 16;
    for (int t = bid; t < nmt * nnt; t += nb) {
        const int mt = t % nmt, nt = t / nmt;
        f32x16 acc[2][2]; zero_acc(acc);
        gemm_mainloop(A + (size_t)mt * 128 * D + nt * 128, D, Bt + (size_t)nt * 128 * 128, 128, 128, acc, smem);
        ACC_FOREACH({ C[(size_t)(mt * 128 + row) * D + nt * 128 + col] = acc[i][j][r]; })
    }
}
__device__ __forceinline__ int g2_lds_byte(int r, int c) { const int st = (r >> 4) * 2 + (c >> 5), ob = (r & 15) * 64 + (c & 31) * 2; return st * 1024 + (ob ^ (((ob >> 9) & 1) << 5)); }
__device__ __forceinline__ void g2_stage_rc(int b, int& R, int& C) { const int st = b >> 10, sb = b & 1023, swz = sb ^ (((sb >> 9) & 1) << 5); R = (st >> 1) * 16 + (swz >> 6); C = (st & 1) * 32 + ((swz & 63) >> 1); }
__device__ __forceinline__ void g2_zero(f32x4 (&acc)[8][4]) {
#pragma unroll
    for (int m = 0; m < 8; ++m)
#pragma unroll
        for (int n = 0; n < 4; ++n) acc[m][n] = (f32x4){0.f, 0.f, 0.f, 0.f};
}
__device__ __forceinline__ void g2_mainloop(const bf16_t* __restrict__ Ab, int lda, const bf16_t* __restrict__ Bb, int ldb, int K, f32x4 (&acc)[8][4], unsigned char* shm) {
    const int tid = fresh_tid(), wid = tid >> 6, lane = tid & 63, wr = wid >> 2, wc = wid & 3, fr = lane & 15, fq = lane >> 4;
    int sR[4], sC[4];
#pragma unroll
    for (int i = 0; i < 4; ++i) g2_stage_rc(wid * 1024 + i * 8192 + lane * 16, sR[i], sC[i]);
#define G2_STAGE(buf, kt) { _Pragma("unroll") for (int i = 0; i < 4; ++i) { \
        __builtin_amdgcn_global_load_lds((const unsigned*)(Ab + (size_t)sR[i] * lda + (kt) * 64 + sC[i]), (unsigned*)(shm + (buf) * 65536 + wid * 1024 + i * 8192), 16, 0, 0); \
        __builtin_amdgcn_global_load_lds((const unsigned*)(Bb + (size_t)sR[i] * ldb + (kt) * 64 + sC[i]), (unsigned*)(shm + (buf) * 65536 + 32768 + wid * 1024 + i * 8192), 16, 0, 0); } }
    const int nt = K / 64;
    __syncthreads();
    G2_STAGE(0, 0)
    asm volatile("s_waitcnt vmcnt(0)" ::: "memory");
    __syncthreads();
    for (int t = 0; t < nt; ++t) {
        const int cur = t & 1;
        if (t + 1 < nt) G2_STAGE(cur ^ 1, t + 1)
        const unsigned char* SA = shm + cur * 65536; const unsigned char* SB = SA + 32768;
#pragma unroll
        for (int ks = 0; ks < 2; ++ks) {
            bf16x8 At[8], Bf[4];
#pragma unroll
            for (int m = 0; m < 8; ++m) At[m] = *(const bf16x8*)(SA + g2_lds_byte(wr * 128 + m * 16 + fr, ks * 32 + fq * 8));
#pragma unroll
            for (int n = 0; n < 4; ++n) Bf[n] = *(const bf16x8*)(SB + g2_lds_byte(wc * 64 + n * 16 + fr, ks * 32 + fq * 8));
#pragma unroll
            for (int m = 0; m < 8; ++m)
#pragma unroll
                for (int n = 0; n < 4; ++n) acc[m][n] = __builtin_amdgcn_mfma_f32_16x16x32_bf16(At[m], Bf[n], acc[m][n], 0, 0, 0);
            __builtin_amdgcn_sched_barrier(0);
        }
        asm volatile("s_waitcnt vmcnt(0)" ::: "memory");
        __syncthreads();
    }
}
#define G2_FOREACH(body)                                                                                       \
    { const int _tid = fresh_tid(), _wid = _tid >> 6, _lane = _tid & 63, _wr = _wid >> 2, _wc = _wid & 3, _fr = _lane & 15, _fq = _lane >> 4; \
      _Pragma("unroll") for (int m = 0; m < 8; ++m) _Pragma("unroll") for (int n = 0; n < 4; ++n)             \
      _Pragma("unroll") for (int j = 0; j < 4; ++j) {                                                         \
          const int row = _wr * 128 + m * 16 + _fq * 4 + j; const int col = _wc * 64 + n * 16 + _fr; const float val = acc[m][n][j]; body } }
#define G8_HT (128 * 64)
__device__ __forceinline__ void g8_mainloop(const bf16_t* __restrict__ A, const bf16_t* __restrict__ Bt, int K, int brow, int bcol, f32x4 (&acc)[2][2][4][2], unsigned char* shmb) {
    bf16_t* shm = (bf16_t*)shmb;
    const int tid = fresh_tid();
    const int wid = tid >> 6, lane = tid & 63, wr = wid >> 2, wc = wid & 3, fr = lane & 15, fq = lane >> 4;
#define G8_SA(b, h) (shm + ((b) * 2 + (h)) * G8_HT)
#define G8_SB(b, h) (shm + (4 + (b) * 2 + (h)) * G8_HT)
#define G8_STAGE(Pp, BASE, br, kt) do { const long _g = (long)(br) * K + (long)(kt) * 64; \
    _Pragma("unroll") for (int _i = 0; _i < 2; ++_i) { const int _b = tid * 16 + _i * 8192; int _r, _c; g2_stage_rc(_b, _r, _c); \
      __builtin_amdgcn_global_load_lds((const unsigned*)(BASE + _g + (long)_r * K + _c), (unsigned*)((char*)(Pp) + _b), 16, 0, 0); } } while (0)
#define G8_LDA(dst, b, h) _Pragma("unroll") for (int m = 0; m < 4; ++m) _Pragma("unroll") for (int k = 0; k < 2; ++k) \
    dst[m][k] = *reinterpret_cast<const bf16x8*>((const char*)G8_SA(b, h) + g2_lds_byte(wr * 64 + m * 16 + fr, k * 32 + fq * 8))
#define G8_LDB(dst, b, h) _Pragma("unroll") for (int n = 0; n < 2; ++n) _Pragma("unroll") for (int k = 0; k < 2; ++k) \
    dst[n][k] = *reinterpret_cast<const bf16x8*>((const char*)G8_SB(b, h) + g2_lds_byte(wc * 32 + n * 16 + fr, k * 32 + fq * 8))
#define G8_MMA(ai, bj, At_, Bt_) do { __builtin_amdgcn_s_setprio(1); \
    _Pragma("unroll") for (int m = 0; m < 4; ++m) _Pragma("unroll") for (int n = 0; n < 2; ++n) _Pragma("unroll") for (int k = 0; k < 2; ++k) \
      acc[ai][bj][m][n] = __builtin_amdgcn_mfma_f32_16x16x32_bf16(At_[m][k], Bt_[n][k], acc[ai][bj][m][n], 0, 0, 0); \
    __builtin_amdgcn_s_setprio(0); } while (0)
#define G8_WAIT_V(n) asm volatile("s_waitcnt vmcnt(" #n ")" ::: "memory")
#define G8_WAIT_L(n) asm volatile("s_waitcnt lgkmcnt(" #n ")" ::: "memory")
#define G8_BAR __builtin_amdgcn_s_barrier()
#define G8_SCHED __builtin_amdgcn_sched_barrier(0)
    bf16x8 At[4][2], B0[2][2], B1[2][2];
    const int nt = K / 64;
    __syncthreads();
    G8_STAGE(G8_SB(0, 0), Bt, bcol, 0); G8_STAGE(G8_SA(0, 0), A, brow, 0);
    G8_STAGE(G8_SB(0, 1), Bt, bcol + 128, 0); G8_STAGE(G8_SA(0, 1), A, brow + 128, 0);
    if (wr == 1) G8_BAR;
    G8_WAIT_V(4); G8_BAR;
    G8_STAGE(G8_SB(1, 0), Bt, bcol, 1); G8_STAGE(G8_SA(1, 0), A, brow, 1); G8_STAGE(G8_SB(1, 1), Bt, bcol + 128, 1);
    G8_WAIT_V(6); G8_BAR;
    for (int t = 0; t < nt - 2; t += 2) {
        G8_LDB(B0, 0, 0); G8_SCHED; G8_LDA(At, 0, 0); G8_STAGE(G8_SA(1, 1), A, brow + 128, t + 1);
        G8_WAIT_L(8); G8_BAR; G8_WAIT_L(0); G8_MMA(0, 0, At, B0); G8_BAR; G8_SCHED;
        G8_LDB(B1, 0, 1); G8_STAGE(G8_SB(0, 0), Bt, bcol, t + 2);
        G8_BAR; G8_WAIT_L(0); G8_MMA(0, 1, At, B1); G8_BAR;
        G8_LDA(At, 0, 1); G8_STAGE(G8_SA(0, 0), A, brow, t + 2);
        G8_BAR; G8_WAIT_L(0); G8_MMA(1, 0, At, B0); G8_BAR; G8_SCHED;
        G8_STAGE(G8_SB(0, 1), Bt, bcol + 128, t + 2);
        G8_WAIT_V(6); G8_BAR; G8_MMA(1, 1, At, B1); G8_BAR;
        G8_LDB(B0, 1, 0); G8_SCHED; G8_LDA(At, 1, 0); G8_STAGE(G8_SA(0, 1), A, brow + 128, t + 2);
        G8_WAIT_L(8); G8_BAR; G8_WAIT_L(0); G8_MMA(0, 0, At, B0); G8_BAR; G8_SCHED;
        G8_LDB(B1, 1, 1); G8_STAGE(G8_SB(1, 0), Bt, bcol, t + 3);
        G8_BAR; G8_WAIT_L(0); G8_MMA(0, 1, At, B1); G8_BAR;
        G8_LDA(At, 1, 1); G8_STAGE(G8_SA(1, 0), A, brow, t + 3);
        G8_BAR; G8_WAIT_L(0); G8_MMA(1, 0, At, B0); G8_BAR; G8_SCHED;
        G8_STAGE(G8_SB(1, 1), Bt, bcol + 128, t + 3);
        G8_WAIT_V(6); G8_BAR; G8_MMA(1, 1, At, B1); G8_BAR;
    }
    { G8_LDB(B0, 0, 0); G8_LDA(At, 0, 0); G8_STAGE(G8_SA(1, 1), A, brow + 128, nt - 1);
      G8_BAR; G8_WAIT_L(0); G8_MMA(0, 0, At, B0); G8_BAR;
      G8_LDB(B1, 0, 1); G8_BAR; G8_WAIT_L(0); G8_MMA(0, 1, At, B1); G8_BAR;
      G8_LDA(At, 0, 1); G8_WAIT_V(4); G8_BAR; G8_WAIT_L(0); G8_MMA(1, 0, At, B0); G8_MMA(1, 1, At, B1); G8_BAR; }
    { G8_LDB(B0, 1, 0); G8_LDA(At, 1, 0); G8_WAIT_V(2); G8_BAR; G8_WAIT_L(0); G8_MMA(0, 0, At, B0); G8_BAR;
      G8_LDB(B1, 1, 1); G8_WAIT_V(0); G8_BAR; G8_WAIT_L(0); G8_MMA(0, 1, At, B1); G8_BAR;
      G8_LDA(At, 1, 1); G8_BAR; G8_WAIT_L(0); G8_MMA(1, 0, At, B0); G8_MMA(1, 1, At, B1); G8_BAR; }
    if (wr == 0) G8_BAR;
}
__device__ __forceinline__ void g8_zero(f32x4 (&acc)[2][2][4][2]) {
#pragma unroll
    for (int a = 0; a < 2; ++a)
#pragma unroll
        for (int b = 0; b < 2; ++b)
#pragma unroll
            for (int m = 0; m < 4; ++m)
#pragma unroll
                for (int n = 0; n < 2; ++n) acc[a][b][m][n] = (f32x4){0.f, 0.f, 0.f, 0.f};
}
#define G8_FOREACH(body)                                                                                       \
    { const int _tid = fresh_tid(), _wid = _tid >> 6, _lane = _tid & 63, _wr = _wid >> 2, _wc = _wid & 3, _fr = _lane & 15, _fq = _lane >> 4; \
      _Pragma("unroll") for (int ai = 0; ai < 2; ++ai) _Pragma("unroll") for (int bj = 0; bj < 2; ++bj)       \
      _Pragma("unroll") for (int m = 0; m < 4; ++m) _Pragma("unroll") for (int n = 0; n < 2; ++n)             \
      _Pragma("unroll") for (int j = 0; j < 4; ++j) {                                                         \
          const int row = ai * 128 + _wr * 64 + m * 16 + _fq * 4 + j; const int col = bj * 128 + _wc * 32 + n * 16 + _fr; const float val = acc[ai][bj][m][n][j]; body } }

__device__ __forceinline__ bool g2_tile(int bid, int nb, int it, int nM, int nN, int& pm, int& pn) {
    if (nb == 256 && nM == 32) { const int xcd = bid & 7, jj = bid >> 3; pm = 4 * xcd + (jj & 3); pn = 8 * it + (jj >> 2); return pn < nN; }
    const int t = bid + it * nb; pm = t % nM; pn = t / nM; return t < nM * nN;
}

__device__ __forceinline__ void phase_ple(const Params& P, int bid, int nb, unsigned char* smem) {
    const bf16_t* A = (const bf16_t*)(P.ws + WS_PBF); const bf16_t* Bt = (const bf16_t*)(P.ws + WS_WTPP); bf16_t* C = (bf16_t*)P.out;
    for (int t = bid; t < 256; t += nb) {
        const int pm = t & 31, pn = t >> 5;
        f32x4 acc[8][4]; g2_zero(acc);
        g2_mainloop(A + (size_t)pm * 256 * 256, 256, Bt + (size_t)pn * 256 * 256, 256, 256, acc, smem);
        G2_FOREACH({ C[(size_t)(pm * 256 + row) * D + pn * 256 + col] = f2bf(val); })
    }
}
__device__ __forceinline__ void phase_gemm1(const Params& P, int bid, int nb, unsigned char* smem) {
    const bf16_t* A = (const bf16_t*)(P.ws + WS_HN); const bf16_t* Bt = (const bf16_t*)(P.ws + WS_WTIN); bf16_t* C = (bf16_t*)(P.ws + WS_PROJ);
    int pm, pn;
    for (int it = 0; g2_tile(bid, nb, it, T / 256, NPROJ / 256, pm, pn); ++it) {
        f32x4 acc[2][2][4][2]; g8_zero(acc);
        g8_mainloop(A, Bt, D, pm * 256, pn * 256, acc, smem);
        G8_FOREACH({ C[(size_t)(pm * 256 + row) * NPROJ + pn * 256 + col] = f2bf(val); })
    }
    if (nb == 256 && bid >= 160) phase_ple(P, bid - 160, 96, smem);
}
__device__ __forceinline__ void phase_gemm2(const Params& P, int bid, int nb, unsigned char* smem) {
    const bf16_t* A = (const bf16_t*)(P.ws + WS_MIXED); const bf16_t* Bt = (const bf16_t*)(P.ws + WS_WTOUT); bf16_t* H = (bf16_t*)(P.ws + WS_H);
    bf16_t* HW = (bf16_t*)(P.ws + WS_HN); float* rss = (float*)(P.ws + WS_RSS);
    int pm, pn;
    for (int it = 0; g2_tile(bid, nb, it, T / 256, D / 256, pm, pn); ++it) {
        f32x4 acc[2][2][4][2]; g8_zero(acc);
        g8_mainloop(A, Bt, D, pm * 256, pn * 256, acc, smem);
        const int tid = fresh_tid(), wid = tid >> 6, lane = tid & 63, wr = wid >> 2, wc = wid & 3, fr = lane & 15, fq = lane >> 4;
#pragma unroll
        for (int ai = 0; ai < 2; ++ai)
#pragma unroll
            for (int m = 0; m < 4; ++m)
#pragma unroll
                for (int j = 0; j < 4; ++j) {
                    const int row = pm * 256 + ai * 128 + wr * 64 + m * 16 + fq * 4 + j;
                    float ss = 0.f;
#pragma unroll
                    for (int bj = 0; bj < 2; ++bj)
#pragma unroll
                        for (int n = 0; n < 2; ++n) {
                            const int col = pn * 256 + bj * 128 + wc * 32 + n * 16 + fr;
                            const size_t o = (size_t)row * D + col;
                            const float v = P.x[o] + acc[ai][bj][m][n][j];
                            H[o] = f2bf(v); HW[o] = f2bf(v * P.norm_ffn[col]); ss += v * v;
                        }
                    ss += __shfl_xor(ss, 1); ss += __shfl_xor(ss, 2); ss += __shfl_xor(ss, 4); ss += __shfl_xor(ss, 8);
                    if (fr == 0) atomicAdd(rss + row, ss);
                }
    }
}
__device__ __forceinline__ void phase_gemm3(const Params& P, int bid, int nb, unsigned char* smem) {
    const bf16_t* A = (const bf16_t*)(P.ws + WS_HN); const bf16_t* Bt = (const bf16_t*)(P.ws + WS_WTPQ); bf16_t* C = (bf16_t*)(P.ws + WS_Q);
    int pm, pn;
    for (int it = 0; g2_tile(bid, nb, it, T / 256, D / 256, pm, pn); ++it) {
        f32x4 acc[2][2][4][2]; g8_zero(acc);
        g8_mainloop(A, Bt, D, pm * 256, pn * 256, acc, smem);
        const float* rss = (const float*)(P.ws + WS_RSS);
        G8_FOREACH({ const float rs = rsqrtf(rss[pm * 256 + row] * (1.f / 2048.f) + EPS); C[(size_t)(pm * 256 + row) * D + pn * 256 + col] = f2bf(val * rs); })
    }
}
__device__ __forceinline__ void phase_gemm4(const Params& P, int bid, int nb, unsigned char* smem) {
    const bf16_t* A = (const bf16_t*)(P.ws + WS_HN); const bf16_t* Bt = (const bf16_t*)(P.ws + WS_WTG);
    const bf16_t* ple = (const bf16_t*)P.out; bf16_t* H = (bf16_t*)(P.ws + WS_H);
    int pm, pn;
    for (int it = 0; g2_tile(bid, nb, it, T / 256, D / 256, pm, pn); ++it) {
        f32x4 acc[2][2][4][2]; g8_zero(acc);
        g8_mainloop(A, Bt, D, pm * 256, pn * 256, acc, smem);
        G8_FOREACH({ const size_t o = (size_t)(pm * 256 + row) * D + pn * 256 + col; H[o] = f2bf(bf2f(H[o]) + sigmoid_f(val) * bf2f(ple[o])); })
    }
}

template <bool OUT_BF16>
__device__ __forceinline__ void phase_rownorm(const float* in, const float* w, void* out, int bid, int nb) {
    const int wave = VTID >> 6, lane = VTID & 63;
    for (int r = bid * 4 + wave; r < T; r += nb * 4) {
        if (OUT_BF16) rmsnorm_row<true>(in + (size_t)r * D, w, (bf16_t*)out + (size_t)r * D, lane);
        else rmsnorm_row<false>(in + (size_t)r * D, w, (float*)out + (size_t)r * D, lane);
    }
}

__device__ __forceinline__ void phase_final(const Params& P, int bid, int nb) {
    const bf16_t* H = (const bf16_t*)(P.ws + WS_H);
    const int wave = VTID >> 6, lane = VTID & 63;
    for (int r = bid * 4 + wave; r < T; r += nb * 4) {
        float v[32]; float ss = 0.f;
#pragma unroll
        for (int i = 0; i < 4; ++i) {
            const uint4 hv = *(const uint4*)(H + (size_t)r * D + (i * 64 + lane) * 8); const unsigned hw[4] = {hv.x, hv.y, hv.z, hv.w};
#pragma unroll
            for (int j = 0; j < 4; ++j) { v[i * 8 + 2 * j] = __uint_as_float(hw[j] << 16); v[i * 8 + 2 * j + 1] = __uint_as_float(hw[j] & 0xffff0000u); ss += v[i * 8 + 2 * j] * v[i * 8 + 2 * j] + v[i * 8 + 2 * j + 1] * v[i * 8 + 2 * j + 1]; }
        }
        ss = wave_sum(ss);
        const float rs = rsqrtf(ss * (1.f / 2048.f) + EPS);
#pragma unroll
        for (int i = 0; i < 4; ++i)
#pragma unroll
            for (int q = 0; q < 2; ++q) {
                const int col = (i * 64 + lane) * 8 + q * 4;
                const f32x4 g = *(const f32x4*)(P.norm_final + col);
                f32x4 o = {v[i * 8 + q * 4] * rs * g[0], v[i * 8 + q * 4 + 1] * rs * g[1], v[i * 8 + q * 4 + 2] * rs * g[2], v[i * 8 + q * 4 + 3] * rs * g[3]};
                *(f32x4*)(P.out + (size_t)r * D + col) = o;
            }
    }
}

__device__ __forceinline__ bf16x8 frag_ld(const unsigned char* tile, int row, int ks, int lane) { return *(const bf16x8*)(tile + lds_off(row, ks * 2 + (lane >> 5))); }
__device__ __forceinline__ void lds_st_bf16(unsigned char* tile, int row, int k, float v) { *(bf16_t*)(tile + lds_off(row, k >> 3) + (k & 7) * 2) = f2bf(v); }

__device__ __forceinline__ void d1_chunk(const Params& P, int u, unsigned char* smem) {
    const bf16_t* proj = (const bf16_t*)(P.ws + WS_PROJ);
    int tid_ = VTID; asm volatile("" : "+v"(tid_));
    const int tid = tid_, wave = tid >> 6, lane = tid & 63;
    const int b = u >> 9, h = (u >> 6) & 7, c = u & 63;
    const size_t tok0 = (size_t)b * SEQ + c * 64;
    unsigned char* Ks = smem;
    unsigned char* Qs = smem + 16384;
    unsigned char* Vraw = smem + 16384;
    float* At = (float*)(smem + 34816);
    float* Gs = (float*)(smem + 51200);
    float* Bs = Gs + 64;
    float* Es = Gs + 128;
    float* Xs = Gs + 192;
    HSYNC();
    if (wave == 0) {
        const size_t t = tok0 + lane;
        const float a = bf2f(proj[t * NPROJ + C_A + h]), bb = bf2f(proj[t * NPROJ + C_B + h]);
        const float xs = a + P.dt_bias[h];
        const float sp = xs > 20.f ? xs : log1pf(expf(xs));
        float g = -expf(P.a_log[h]) * sp;
#pragma unroll
        for (int o = 1; o < 64; o <<= 1) { const float n = __shfl_up(g, o); if (lane >= o) g += n; }
        Gs[lane] = g; Bs[lane] = 1.f / (1.f + expf(-bb));
        Es[lane] = __expf(g); Xs[lane] = __expf(__shfl(g, 63) - g);
    }
    bf16_t* QG = (bf16_t*)(P.ws + WS_QG) + (size_t)u * 64 * 128;
    unsigned char* RAW = smem + 32768;
    uint4 rq[5], rk[5], rv[5];
#pragma unroll
    for (int i = 0; i < 5; ++i) {
        const int q = tid + 256 * i, row = q >> 4, c16 = q & 15;
        rq[i] = make_uint4(0u, 0u, 0u, 0u); rk[i] = rq[i]; rv[i] = rq[i];
        if (q < 67 * 16 && (c > 0 || row >= 3)) {
            const bf16_t* src = proj + (tok0 + row - 3) * NPROJ + h * 128 + c16 * 8;
            rq[i] = *(const uint4*)(src); rk[i] = *(const uint4*)(src + 1024); rv[i] = *(const uint4*)(src + 2048);
        }
    }
#pragma unroll
    for (int isk = 0; isk < 2; ++isk) {
        const int chb = (isk ? 1024 : 0) + h * 128;
#pragma unroll
        for (int i = 0; i < 5; ++i) { const int q = tid + 256 * i, row = q >> 4, c16 = q & 15; if (q < 67 * 16) *(uint4*)(RAW + row * 256 + c16 * 16) = isk ? rk[i] : rq[i]; }
        const int ch0 = chb + lane * 2;
        const f32x4 cw0 = *(const f32x4*)(P.conv_w + ch0 * 4), cw1 = *(const f32x4*)(P.conv_w + ch0 * 4 + 4);
        HSYNC();
        float y0[16], y1[16], ss[16];
#pragma unroll
        for (int j = 0; j < 16; ++j) {
            const int tok = wave + 4 * j;
            float a0 = 0.f, a1 = 0.f;
#pragma unroll
            for (int t4 = 0; t4 < 4; ++t4) {
                const unsigned pr = *(const unsigned*)(RAW + (tok + t4) * 256 + lane * 4);
                a0 += bf2f((bf16_t)(pr & 0xffff)) * cw0[t4];
                a1 += bf2f((bf16_t)(pr >> 16)) * cw1[t4];
            }
            y0[j] = silu_f(a0); y1[j] = silu_f(a1); ss[j] = y0[j] * y0[j] + y1[j] * y1[j];
        }
        const bool b5 = (lane & 32) != 0, b4 = (lane & 16) != 0, b3 = (lane & 8) != 0, b2 = (lane & 4) != 0;
        float q8[8], q4[4], q2[2];
#pragma unroll
        for (int j = 0; j < 8; ++j) q8[j] = (b5 ? ss[j + 8] : ss[j]) + __shfl_xor(b5 ? ss[j] : ss[j + 8], 32);
#pragma unroll
        for (int j = 0; j < 4; ++j) q4[j] = (b4 ? q8[j + 4] : q8[j]) + __shfl_xor(b4 ? q8[j] : q8[j + 4], 16);
#pragma unroll
        for (int j = 0; j < 2; ++j) q2[j] = (b3 ? q4[j + 2] : q4[j]) + __shfl_xor(b3 ? q4[j] : q4[j + 2], 8);
        float st = (b2 ? q2[1] : q2[0]) + __shfl_xor(b2 ? q2[0] : q2[1], 4);
        st += __shfl_xor(st, 2); st += __shfl_xor(st, 1);
        float rl = rsqrtf(st + EPS); if (!isk) rl *= 0.08838834764831845f;
        const int rli = __float_as_int(rl);
#pragma unroll
        for (int j = 0; j < 16; ++j) {
            const int tok = wave + 4 * j;
            const float r = __int_as_float(__builtin_amdgcn_readlane(rli, 4 * j));
            const float z0 = y0[j] * r, z1 = y1[j] * r;
            const int k = lane * 2, half = k >> 6, kk = k & 63;
            *(unsigned*)((isk ? Ks : Qs) + half * 8192 + lds_off(tok, kk >> 3) + (kk & 7) * 2) = pack2(z0, z1);
            if (!isk) { const float eg = Es[tok]; *(unsigned*)(QG + tok * 128 + k) = pack2(z0 * eg, z1 * eg); }
        }
        HSYNC();
    }
    {
        const int wr = wave >> 1, wc = wave & 1;
        f32x16 akk, aqk;
#pragma unroll
        for (int r = 0; r < 16; ++r) { akk[r] = 0.f; aqk[r] = 0.f; }
        if (!(wr == 0 && wc == 1)) {
#pragma unroll
            for (int half = 0; half < 2; ++half)
#pragma unroll
                for (int ks = 0; ks < 4; ++ks) {
                    const bf16x8 fk = frag_ld(Ks + half * 8192, wr * 32 + (lane & 31), ks, lane);
                    const bf16x8 fq = frag_ld(Qs + half * 8192, wr * 32 + (lane & 31), ks, lane);
                    const bf16x8 fb = frag_ld(Ks + half * 8192, wc * 32 + (lane & 31), ks, lane);
                    akk = __builtin_amdgcn_mfma_f32_32x32x16_bf16(fk, fb, akk, 0, 0, 0);
                    aqk = __builtin_amdgcn_mfma_f32_32x32x16_bf16(fq, fb, aqk, 0, 0, 0);
                }
        }
        const int j = wc * 32 + (lane & 31); const float Gj = Gs[j];
        bf16_t* ATT = (bf16_t*)(P.ws + WS_ATT) + (size_t)u * 64 * 64;
#pragma unroll
        for (int g4 = 0; g4 < 4; ++g4) {
            const int i0 = wr * 32 + 8 * g4 + 4 * (lane >> 5);
            f32x4 av;
#pragma unroll
            for (int e = 0; e < 4; ++e) {
                const int i = i0 + e, r = g4 * 4 + e;
                const float dec = (i >= j) ? __expf(Gs[i] - Gj) : 0.f;
                av[e] = (i > j) ? Bs[i] * akk[r] * dec : 0.f;
                ATT[i * 64 + j] = f2bf(aqk[r] * dec);
            }
            *(f32x4*)(At + j * 64 + i0) = av;
        }
    }
    HSYNC();
    {
#pragma unroll
        for (int i = 0; i < 5; ++i) { const int q = tid + 256 * i, row = q >> 4, c16 = q & 15; if (q < 67 * 16) *(uint4*)(Vraw + row * 256 + c16 * 16) = rv[i]; }
    }
    HSYNC();
    {
        float r[64];
        if (tid < 128) {
            const int ch = 2048 + h * 128 + tid;
            const float w0 = P.conv_w[ch * 4 + 0], w1 = P.conv_w[ch * 4 + 1], w2 = P.conv_w[ch * 4 + 2], w3 = P.conv_w[ch * 4 + 3];
            const bf16_t* vcol = (const bf16_t*)Vraw + tid;
            float xm3 = bf2f(vcol[0]), xm2 = bf2f(vcol[128]), xm1 = bf2f(vcol[256]);
#pragma unroll
            for (int i = 0; i < 64; ++i) {
                const float x0 = bf2f(vcol[(i + 3) * 128]);
                const float y = w0 * xm3 + w1 * xm2 + w2 * xm1 + w3 * x0;
                r[i] = Bs[i] * silu_f(y);
                xm3 = xm2; xm2 = xm1; xm1 = x0;
            }
        } else {
            const int dk = tid - 128, half = dk >> 6, kk = dk & 63;
            bf16_t* KDT = (bf16_t*)(P.ws + WS_KDT) + (size_t)u * 128 * 64 + dk * 64;
#pragma unroll
            for (int i8 = 0; i8 < 8; ++i8) {
                unsigned pk[4];
#pragma unroll
                for (int e2 = 0; e2 < 4; ++e2) {
                    float kd[2];
#pragma unroll
                    for (int e = 0; e < 2; ++e) {
                        const int i = i8 * 8 + e2 * 2 + e;
                        const float kv = bf2f(*(const bf16_t*)(Ks + half * 8192 + lds_off(i, kk >> 3) + (kk & 7) * 2));
                        r[i] = -Bs[i] * Es[i] * kv;
                        kd[e] = kv * Xs[i];
                    }
                    pk[e2] = pack2(kd[0], kd[1]);
                }
                *(uint4*)(KDT + i8 * 8) = make_uint4(pk[0], pk[1], pk[2], pk[3]);
            }
        }
#pragma unroll
        for (int j = 0; j < 63; ++j) {
            const float xj = r[j];
#pragma unroll
            for (int i4 = ((j + 1) & ~3); i4 < 64; i4 += 4) {
                const f32x4 a = *(const f32x4*)(At + j * 64 + i4);
                r[i4] -= a[0] * xj; r[i4 + 1] -= a[1] * xj; r[i4 + 2] -= a[2] * xj; r[i4 + 3] -= a[3] * xj;
            }
        }
        if (tid < 128) {
            bf16_t* U = (bf16_t*)(P.ws + WS_U) + (size_t)u * 64 * 128 + (tid >> 5) * 2048 + (tid & 31);
#pragma unroll
            for (int i = 0; i < 64; ++i) { const int tt = i >> 5, i5 = i & 31, rr = (i5 & 3) + 4 * (i5 >> 3), hh = (i5 >> 2) & 1; U[(tt * 16 + rr) * 64 + hh * 32] = f2bf(r[i]); }
        } else {
            bf16_t* W = (bf16_t*)(P.ws + WS_W) + (size_t)u * 64 * 128 + (tid - 128);
#pragma unroll
            for (int i = 0; i < 64; ++i) W[i * 128] = f2bf(r[i]);
        }
        if (tid == 0) ((float*)(P.ws + WS_EG))[u] = Es[63];
    }
}

__device__ __forceinline__ void r1_chunk(const Params& P, int u, unsigned char* smem) {
    const bf16_t* proj = (const bf16_t*)(P.ws + WS_PROJ);
    int tid_ = VTID; asm volatile("" : "+v"(tid_));
    const int tid = tid_, wave = tid >> 6, lane = tid & 63;
    const int b = u >> 9, h = (u >> 6) & 7, c = u & 63;
    const size_t tok0 = (size_t)b * SEQ + c * 64;
    unsigned char* RQ = smem;
    unsigned char* RK = smem + 8192;
    unsigned char* VT = smem + 16384;
    unsigned char* RKT = smem + 32768;
    const float l2g = log2f(1.f - exp2f(-5.f - (float)h));
    unsigned char* VR = smem + 40960;
    HSYNC();
    bf16_t* QGR = (bf16_t*)(P.ws + WS_QGR) + (size_t)u * 64 * 64;
    {
        uint4 rq[2], rk[2], rv[4];
#pragma unroll
        for (int i = 0; i < 2; ++i) { const int q = tid + 256 * i, row = q >> 3, ch = q & 7;
            rq[i] = *(const uint4*)(proj + (tok0 + row) * NPROJ + C_RQ + h * 64 + ch * 8); rk[i] = *(const uint4*)(proj + (tok0 + row) * NPROJ + C_RK + h * 64 + ch * 8); }
#pragma unroll
        for (int i = 0; i < 4; ++i) { const int q = tid + 256 * i, row = q >> 4, c16 = q & 15; rv[i] = *(const uint4*)(proj + (tok0 + row) * NPROJ + C_RV + h * 128 + c16 * 8); }
#pragma unroll
        for (int i = 0; i < 2; ++i) { const int q = tid + 256 * i, row = q >> 3, ch = q & 7; *(uint4*)(RQ + lds_off(row, ch)) = rq[i]; *(uint4*)(RK + lds_off(row, ch)) = rk[i]; }
#pragma unroll
        for (int i = 0; i < 4; ++i) { const int q = tid + 256 * i, row = q >> 4, c16 = q & 15; *(uint4*)(VR + row * 256 + c16 * 16) = rv[i]; }
    }
    HSYNC();
    const float2* cs = (const float2*)(P.ws + WS_CS) + tok0 * 32;
    float2 cs8[8];
#pragma unroll
    for (int it = 0; it < 8; ++it) cs8[it] = cs[tid + 256 * it];
#pragma unroll
    for (int it = 0; it < 8; ++it) {
        const int e = tid + 256 * it, tok = e >> 5, i = e & 31;
        const float cs_ = cs8[it].x, sn = cs8[it].y;
        bf16_t* q1p = (bf16_t*)(RQ + lds_off(tok, i >> 3) + (i & 7) * 2); bf16_t* q2p = (bf16_t*)(RQ + lds_off(tok, (32 + i) >> 3) + (i & 7) * 2);
        bf16_t* k1p = (bf16_t*)(RK + lds_off(tok, i >> 3) + (i & 7) * 2); bf16_t* k2p = (bf16_t*)(RK + lds_off(tok, (32 + i) >> 3) + (i & 7) * 2);
        const float q1 = bf2f(*q1p), q2 = bf2f(*q2p), k1 = bf2f(*k1p) * 0.125f, k2 = bf2f(*k2p) * 0.125f;
        const float qa = q1 * cs_ - q2 * sn, qb = q1 * sn + q2 * cs_, ka = k1 * cs_ - k2 * sn, kb = k1 * sn + k2 * cs_;
        const float xi = exp2f(l2g * (float)(tok + 1)), zeta = exp2f(l2g * (float)(63 - tok));
        *q1p = f2bf(qa); *q2p = f2bf(qb); *k1p = f2bf(ka); *k2p = f2bf(kb);
        lds_st_bf16(RKT, i, tok, ka * zeta); lds_st_bf16(RKT, 32 + i, tok, kb * zeta);
        QGR[tok * 64 + i] = f2bf(qa * xi); QGR[tok * 64 + 32 + i] = f2bf(qb * xi);
    }
#pragma unroll 4
    for (int it = 0; it < 16; ++it) {
        const int e = tid + 256 * it, tok = e >> 6, dp = e & 63;
        const unsigned pr = *(const unsigned*)(VR + tok * 256 + dp * 4);
        *(bf16_t*)(VT + lds_off(dp * 2, tok >> 3) + (tok & 7) * 2) = (bf16_t)(pr & 0xffff);
        *(bf16_t*)(VT + lds_off(dp * 2 + 1, tok >> 3) + (tok & 7) * 2) = (bf16_t)(pr >> 16);
    }
    HSYNC();
    {
        bf16_t* VNTR = (bf16_t*)(P.ws + WS_VNTR) + (size_t)u * 128 * 64;
#pragma unroll
        for (int it = 0; it < 4; ++it) { const int q = tid + 256 * it, row = q >> 3, ch = q & 7; *(uint4*)(VNTR + row * 64 + ch * 8) = *(const uint4*)(VT + lds_off(row, ch)); }
    }
    {
        const int wr = wave >> 1, wc = wave & 1;
        f32x16 acc;
#pragma unroll
        for (int r = 0; r < 16; ++r) acc[r] = 0.f;
        if (!(wr == 0 && wc == 1)) {
#pragma unroll
            for (int ks = 0; ks < 4; ++ks) acc = __builtin_amdgcn_mfma_f32_32x32x16_bf16(frag_ld(RQ, wr * 32 + (lane & 31), ks, lane), frag_ld(RK, wc * 32 + (lane & 31), ks, lane), acc, 0, 0, 0);
        }
        const int j = wc * 32 + (lane & 31);
        bf16_t* ATTR = (bf16_t*)(P.ws + WS_ATTR) + (size_t)u * 64 * 64;
#pragma unroll
        for (int r = 0; r < 16; ++r) {
            const int i = wr * 32 + (r & 3) + 8 * (r >> 2) + 4 * (lane >> 5);
            const float dec = (i >= j) ? exp2f(l2g * (float)(i - j)) : 0.f;
            ATTR[i * 64 + j] = f2bf(acc[r] * dec);
        }
    }
    {
        f32x16 acc[2];
#pragma unroll
        for (int j = 0; j < 2; ++j)
#pragma unroll
            for (int r = 0; r < 16; ++r) acc[j][r] = 0.f;
#pragma unroll
        for (int ks = 0; ks < 4; ++ks) {
            const bf16x8 fa = frag_ld(VT, wave * 32 + (lane & 31), ks, lane);
#pragma unroll
            for (int j = 0; j < 2; ++j) acc[j] = __builtin_amdgcn_mfma_f32_32x32x16_bf16(fa, frag_ld(RKT, j * 32 + (lane & 31), ks, lane), acc[j], 0, 0, 0);
        }
        float* KVT = (float*)(P.ws + WS_KVT) + (size_t)u * 128 * 64;
#pragma unroll
        for (int j = 0; j < 2; ++j)
#pragma unroll
            for (int r = 0; r < 16; ++r) { const int dv = wave * 32 + (r & 3) + 8 * (r >> 2) + 4 * (lane >> 5); KVT[dv * 64 + j * 32 + (lane & 31)] = acc[j][r]; }
    }
}

__device__ __forceinline__ void phase_chunk1(const Params& P, int bid, int nb, unsigned char* smem, int mode = 0) {
    for (int u0 = bid; u0 < 2048; u0 += nb) { const int u = (bid & 1) ? ((u0 + 1024) & 2047) : u0; if (u < 1024) { if (mode != 2) d1_chunk(P, u, smem); } else if (mode != 1) r1_chunk(P, u - 1024, smem); }
}

__device__ __forceinline__ void d2_scan(const Params& P, int unit, unsigned char* rsmem) {
    const int tid = fresh_tid(), wave = tid >> 6, lane = tid & 63;
    const int bh = (unit & 7) + 8 * (unit >> 5), slice = (unit >> 3) & 3;
    const size_t cb = (size_t)bh * 64;
    const bf16_t* Wg = (const bf16_t*)(P.ws + WS_W); const bf16_t* KDg = (const bf16_t*)(P.ws + WS_KDT);
    const bf16_t* Ug = (const bf16_t*)(P.ws + WS_U); const float* EGg = (const float*)(P.ws + WS_EG);
    bf16_t* SCg = (bf16_t*)(P.ws + WS_SC); bf16_t* VNg = (bf16_t*)(P.ws + WS_VNT);
    unsigned char* Simg = rsmem;
    unsigned char* VNimg = rsmem + 8192;
    unsigned char* BUF = rsmem + 12288;
    const bool vn_wave = wave < 2, s_wave = wave < 4;
    const int hf = wave & 1, dt = wave & 3;
    f32x16 S0;
#pragma unroll
    for (int r = 0; r < 16; ++r) S0[r] = 0.f;
    uint4 w0a, w0b, k0a, k0b, w1a, w1b, k1a, k1b;
    bf16_t un0[16], un1[16];
#define D2_LOAD(SET, uu) { const bf16_t* wp = Wg + (uu) * 8192 + tid * 8; const bf16_t* kp = KDg + (uu) * 8192 + tid * 8; \
        w##SET##a = *(const uint4*)(wp); w##SET##b = *(const uint4*)(wp + 4096); k##SET##a = *(const uint4*)(kp); k##SET##b = *(const uint4*)(kp + 4096); \
        { const bf16_t* up = Ug + (uu) * 8192 + slice * 2048 + hf * 1024 + lane; _Pragma("unroll") for (int r = 0; r < 16; ++r) un##SET[r] = up[r * 64]; } }
#define D2_ST1(i, vw, vk, bufp) { const int q = tid + 512 * (i); { const int row = q >> 4, c16 = q & 15; *(uint4*)((bufp) + (c16 >> 3) * 8192 + lds_off(row, c16 & 7)) = (vw); } \
        { const int row = q >> 3, ch = q & 7; *(uint4*)((bufp) + 16384 + lds_off(row, ch)) = (vk); } }
#define D2_STORE(SET, par) { unsigned char* bufp = BUF + (par) * 32768; D2_ST1(0, w##SET##a, k##SET##a, bufp) D2_ST1(1, w##SET##b, k##SET##b, bufp) }
    const int egl = __float_as_int(EGg[cb + lane]);
    __syncthreads();
    if (s_wave) {
#pragma unroll
        for (int i = 0; i < 2; ++i) *(uint4*)(Simg + dt * 2048 + (lane + 64 * i) * 16) = make_uint4(0u, 0u, 0u, 0u);
#pragma unroll
        for (int i = 0; i < 2; ++i) *(uint4*)(SCg + cb * 16384 + slice * 4096 + dt * 1024 + (lane + 64 * i) * 8) = make_uint4(0u, 0u, 0u, 0u);
    }
    for (int r = 0; r < 16; ++r) { un0[r] = 0; un1[r] = 0; }
    D2_LOAD(0, cb)
    D2_STORE(0, 0)
    bf16_t unc[16];
#pragma unroll
    for (int r = 0; r < 16; ++r) unc[r] = un0[r];
    D2_LOAD(1, cb + 1)
    D2_LOAD(0, cb + 2)
    __syncthreads();
#define D2_STEP(c, UN) { const size_t u = cb + (c); const unsigned char* Wt = BUF + ((c) & 1) * 32768; const unsigned char* KDt = Wt + 16384; \
        if (vn_wave) { \
            f32x16 vn; _Pragma("unroll") for (int r = 0; r < 16; ++r) vn[r] = bf2f(UN[r]); \
            _Pragma("unroll") for (int half = 0; half < 2; ++half) _Pragma("unroll") for (int ks = 0; ks < 4; ++ks) \
                vn = __builtin_amdgcn_mfma_f32_32x32x16_bf16(frag_ld(Wt + half * 8192, hf * 32 + (lane & 31), ks, lane), frag_ld(Simg + half * 4096, lane & 31, ks, lane), vn, 0, 0, 0); \
            _Pragma("unroll") for (int g4 = 0; g4 < 4; ++g4) { const int r0 = g4 * 4; \
                const uint2 pkd = make_uint2(pack2(vn[r0], vn[r0 + 1]), pack2(vn[r0 + 2], vn[r0 + 3])); \
                const int tok = hf * 32 + 8 * g4 + 4 * (lane >> 5); \
                *(uint2*)(VNimg + lds_off(lane & 31, tok >> 3) + (tok & 7) * 2) = pkd; \
                *(uint2*)(VNg + u * 8192 + ((((slice * 2 + hf) * 4 + g4) * 64 + lane) * 4)) = pkd; } } \
        __syncthreads(); \
        if (s_wave) { \
            bf16_t* scdst = ((c) + 1 < 64) ? SCg + (u + 1) * 16384 : (bf16_t*)(P.ws + WS_DUMMY);        \
            const float eg = __int_as_float(__builtin_amdgcn_readlane(egl, (c))); \
            _Pragma("unroll") for (int r = 0; r < 16; ++r) S0[r] *= eg; \
            _Pragma("unroll") for (int ks = 0; ks < 4; ++ks) \
                S0 = __builtin_amdgcn_mfma_f32_32x32x16_bf16(frag_ld(KDt, dt * 32 + (lane & 31), ks, lane), frag_ld(VNimg, lane & 31, ks, lane), S0, 0, 0, 0); \
            _Pragma("unroll") for (int g4 = 0; g4 < 4; ++g4) { const int r0 = g4 * 4; const int kk = (dt & 1) * 32 + 8 * g4 + 4 * (lane >> 5); \
                const uint2 p0 = make_uint2(pack2(S0[r0], S0[r0 + 1]), pack2(S0[r0 + 2], S0[r0 + 3])); \
                *(uint2*)(Simg + (dt >> 1) * 4096 + lds_off(lane & 31, kk >> 3) + (kk & 7) * 2) = p0; \
                *(uint2*)(scdst + ((((slice * 4 + dt) * 4 + g4) * 64 + lane) * 4)) = p0; } } }
    for (int c = 0; c < 64; c += 2) {
        D2_STORE(1, 1)
        bf16_t unn[16];
#pragma unroll
        for (int r = 0; r < 16; ++r) unn[r] = un1[r];
        D2_LOAD(1, cb + (c + 3 < 64 ? c + 3 : 63))
        D2_STEP(c, unc)
        __syncthreads();
        D2_STORE(0, 0)
#pragma unroll
        for (int r = 0; r < 16; ++r) unc[r] = un0[r];
        D2_LOAD(0, cb + (c + 4 < 64 ? c + 4 : 63))
        D2_STEP(c + 1, unn)
        __syncthreads();
    }
}

__device__ __forceinline__ void r2_scan(const Params& P, int vb, int nvb) {
    const float* KVT = (const float*)(P.ws + WS_KVT); bf16_t* STR = (bf16_t*)(P.ws + WS_STR);
    int tid_ = VTID; asm volatile("" : "+v"(tid_));
    for (int idx = vb * 256 + tid_; idx < 16 * 8192; idx += nvb * 256) {
        const int bh = idx >> 13, e = idx & 8191, h = bh & 7;
        const float cd = exp2f(64.f * log2f(1.f - exp2f(-5.f - (float)h)));
        float S = 0.f;
#pragma unroll 8
        for (int c = 0; c < 64; ++c) {
            const size_t o = ((size_t)bh * 64 + c) * 8192 + e;
            STR[o] = f2bf(S);
            S = cd * S + KVT[o];
        }
    }
}

__device__ __forceinline__ void phase_econv(const Params& P, int bid, int nb, unsigned char* smem);
__device__ __forceinline__ void phase_scan(const Params& P, int bid, int nb, unsigned char* smem, int rbid, int rnb, unsigned char* rsmem, int mode = 0) {
    if (rbid < 64) { if (mode != 2) d2_scan(P, rbid, rsmem); }
    else if (mode != 1) {
        if (rnb != 256) phase_ple(P, rbid - 64, rnb - 64, rsmem);
        r2_scan(P, bid - 128, nb - 128);
        phase_econv(P, bid - 128, nb - 128, smem);
    }
}

template <int K1, bool RET>
__device__ __forceinline__ void chunk_out(const Params& P, int u, unsigned char* smem) {
    int tid_ = VTID; asm volatile("" : "+v"(tid_));
    const int tid = tid_, wave = tid >> 6, lane = tid & 63, wr = wave >> 1, wc = wave & 1;
    const int b = u >> 9, h = (u >> 6) & 7, c = u & 63;
    const size_t tok0 = (size_t)b * SEQ + c * 64;
    const bf16_t* A1 = RET ? (const bf16_t*)(P.ws + WS_QGR) + (size_t)u * 64 * 64 : (const bf16_t*)(P.ws + WS_QG) + (size_t)u * 64 * 128;
    const bf16_t* B1 = RET ? (const bf16_t*)(P.ws + WS_STR) + (size_t)u * 128 * 64 : (const bf16_t*)(P.ws + WS_SC) + (size_t)u * 128 * 128;
    const bf16_t* A2 = RET ? (const bf16_t*)(P.ws + WS_ATTR) + (size_t)u * 64 * 64 : (const bf16_t*)(P.ws + WS_ATT) + (size_t)u * 64 * 64;
    const bf16_t* B2 = RET ? (const bf16_t*)(P.ws + WS_VNTR) + (size_t)u * 128 * 64 : (const bf16_t*)(P.ws + WS_VNT) + (size_t)u * 128 * 64;
    float* red = (float*)(smem + 49152);
    f32x16 acc[2];
#pragma unroll
    for (int j = 0; j < 2; ++j)
#pragma unroll
        for (int r = 0; r < 16; ++r) acc[j][r] = 0.f;
    constexpr int NK1 = K1 / 64, NKT = NK1 + 1;
    uint4 A0_0, A0_1, A1_0, A1_1, A2_0, A2_1;
    uint4 B0_0, B0_1, B0_2, B0_3, B1_0, B1_1, B1_2, B1_3, B2_0, B2_1, B2_2, B2_3;
#define CO_LOAD(kt) { const bf16_t* Ap = ((kt) < NK1) ? A1 + (kt) * 64 : A2; const int lda = ((kt) < NK1) ? K1 : 64; const bf16_t* Bp = ((kt) < NK1) ? B1 + (kt) * 64 : B2; \
        { const int q = tid, row = q >> 3, ch = q & 7; A##kt##_0 = *(const uint4*)(Ap + row * lda + ch * 8); } \
        { const int q = tid + 256, row = q >> 3, ch = q & 7; A##kt##_1 = *(const uint4*)(Ap + row * lda + ch * 8); } \
        if (RET) { \
            { const int q = tid, row = q >> 3, ch = q & 7; B##kt##_0 = *(const uint4*)(Bp + row * lda + ch * 8); } \
            { const int q = tid + 256, row = q >> 3, ch = q & 7; B##kt##_1 = *(const uint4*)(Bp + row * lda + ch * 8); } \
            { const int q = tid + 512, row = q >> 3, ch = q & 7; B##kt##_2 = *(const uint4*)(Bp + row * lda + ch * 8); } \
            { const int q = tid + 768, row = q >> 3, ch = q & 7; B##kt##_3 = *(const uint4*)(Bp + row * lda + ch * 8); } \
        } else { \
            const bf16_t* src = ((kt) < NK1) ? B1 : B2; \
            CO_PIECE(kt, 0, pa) CO_PIECE(kt, 1, pb) B##kt##_0 = make_uint4(pa.x, pa.y, pb.x, pb.y); \
            CO_PIECE(kt, 2, pc) CO_PIECE(kt, 3, pd) B##kt##_1 = make_uint4(pc.x, pc.y, pd.x, pd.y); \
            CO_PIECE(kt, 4, pe) CO_PIECE(kt, 5, pf) B##kt##_2 = make_uint4(pe.x, pe.y, pf.x, pf.y); \
            CO_PIECE(kt, 6, pg) CO_PIECE(kt, 7, ph) B##kt##_3 = make_uint4(pg.x, pg.y, ph.x, ph.y); } }
#define CO_PIECE(kt, i, name) uint2 name; { const int q = tid + 256 * (i), ln = q & 63, g4 = (q >> 6) & 3, dd = (q >> 8) & 1, w = q >> 9; \
        const size_t piece = ((kt) < NK1) ? (size_t)(((w * 4 + 2 * (kt) + dd) * 4 + g4) * 64 + ln) : (size_t)(((w * 2 + dd) * 4 + g4) * 64 + ln); \
        name = *(const uint2*)(src + piece * 4); }
    CO_LOAD(0) CO_LOAD(1)
    if (NKT == 3) { CO_LOAD(2) }
    const bf16_t* proj = (const bf16_t*)(P.ws + WS_PROJ);
    unsigned gz[2][16];
#pragma unroll
    for (int r = 0; r < 16; ++r) {
        const size_t t = tok0 + wr * 32 + (r & 3) + 8 * (r >> 2) + 4 * (lane >> 5);
#pragma unroll
        for (int j = 0; j < 2; ++j) gz[j][r] = proj[t * NPROJ + (RET ? C_RG : C_Z) + h * 128 + wc * 64 + j * 32 + (lane & 31)];
    }
#define CO_PUT(i, val) { const int q = tid + 256 * (i), ln = q & 63, g4 = (q >> 6) & 3, dd = (q >> 8) & 1, w = q >> 9; const int kk = dd * 32 + 8 * g4 + 4 * (ln >> 5); \
        *(uint2*)(Bs_ + lds_off(w * 32 + (ln & 31), kk >> 3) + (kk & 7) * 2) = (val); }
#define CO_STAGE(kt, buf) { unsigned char* As_ = smem + (buf) * 24576; unsigned char* Bs_ = As_ + 8192; \
        { const int q = tid, row = q >> 3, ch = q & 7; *(uint4*)(As_ + lds_off(row, ch)) = A##kt##_0; } \
        { const int q = tid + 256, row = q >> 3, ch = q & 7; *(uint4*)(As_ + lds_off(row, ch)) = A##kt##_1; } \
        if (RET) { \
            { const int q = tid, row = q >> 3, ch = q & 7; *(uint4*)(Bs_ + lds_off(row, ch)) = B##kt##_0; } \
            { const int q = tid + 256, row = q >> 3, ch = q & 7; *(uint4*)(Bs_ + lds_off(row, ch)) = B##kt##_1; } \
            { const int q = tid + 512, row = q >> 3, ch = q & 7; *(uint4*)(Bs_ + lds_off(row, ch)) = B##kt##_2; } \
            { const int q = tid + 768, row = q >> 3, ch = q & 7; *(uint4*)(Bs_ + lds_off(row, ch)) = B##kt##_3; } \
        } else { \
            CO_PUT(0, make_uint2(B##kt##_0.x, B##kt##_0.y)) CO_PUT(1, make_uint2(B##kt##_0.z, B##kt##_0.w)) \
            CO_PUT(2, make_uint2(B##kt##_1.x, B##kt##_1.y)) CO_PUT(3, make_uint2(B##kt##_1.z, B##kt##_1.w)) \
            CO_PUT(4, make_uint2(B##kt##_2.x, B##kt##_2.y)) CO_PUT(5, make_uint2(B##kt##_2.z, B##kt##_2.w)) \
            CO_PUT(6, make_uint2(B##kt##_3.x, B##kt##_3.y)) CO_PUT(7, make_uint2(B##kt##_3.z, B##kt##_3.w)) } }
#define CO_MMA(buf) { const unsigned char* As_ = smem + (buf) * 24576; const unsigned char* Bs_ = As_ + 8192; \
        _Pragma("unroll") for (int ks = 0; ks < 4; ++ks) { const bf16x8 fa = frag_ld(As_, wr * 32 + (lane & 31), ks, lane); \
            _Pragma("unroll") for (int j = 0; j < 2; ++j) acc[j] = __builtin_amdgcn_mfma_f32_32x32x16_bf16(fa, frag_ld(Bs_, wc * 64 + j * 32 + (lane & 31), ks, lane), acc[j], 0, 0, 0); } }
    HSYNC();
    CO_STAGE(0, 0) CO_STAGE(1, 1)
    HSYNC();
    CO_MMA(0) CO_MMA(1)
    if (NKT == 3) {
        HSYNC();
        CO_STAGE(2, 0)
        HSYNC();
        CO_MMA(0)
    }
#pragma unroll
    for (int r = 0; r < 16; ++r) {
        float s1 = acc[0][r] + acc[1][r], s2 = acc[0][r] * acc[0][r] + acc[1][r] * acc[1][r];
#pragma unroll
        for (int o = 16; o >= 1; o >>= 1) { s1 += __shfl_xor(s1, o); s2 += __shfl_xor(s2, o); }
        if ((lane & 31) == 0) { const int row = wr * 32 + (r & 3) + 8 * (r >> 2) + 4 * (lane >> 5); red[(row * 2 + wc) * 2] = s1; red[(row * 2 + wc) * 2 + 1] = s2; }
    }
    HSYNC();
    bf16_t* mixed = (bf16_t*)(P.ws + WS_MIXED);
#pragma unroll
    for (int r = 0; r < 16; ++r) {
        const int row = wr * 32 + (r & 3) + 8 * (r >> 2) + 4 * (lane >> 5);
        const float s1 = red[row * 4] + red[row * 4 + 2], s2 = red[row * 4 + 1] + red[row * 4 + 3];
        const size_t t = tok0 + row;
#pragma unroll
        for (int j = 0; j < 2; ++j) {
            const int dv = wc * 64 + j * 32 + (lane & 31);
            float y;
            if (!RET) {
                const float rs = rsqrtf(s2 * (1.f / 128.f) + EPS);
                y = acc[j][r] * rs * P.dn_norm[dv] * silu_f(bf2f((bf16_t)gz[j][r]));
                mixed[t * D + h * 128 + dv] = f2bf(y);
            } else {
                const float mu = s1 * (1.f / 128.f);
                const float var = fmaxf(s2 * (1.f / 128.f) - mu * mu, 0.f);
                const float rs = rsqrtf(var + EPS);
                y = ((acc[j][r] - mu) * rs * P.ret_gn_w[h * 128 + dv] + P.ret_gn_b[h * 128 + dv]) * silu_f(bf2f((bf16_t)gz[j][r]));
                mixed[t * D + 1024 + h * 128 + dv] = f2bf(y);
            }
        }
    }
}

__device__ __forceinline__ void phase_chunk3(const Params& P, int bid, int nb, unsigned char* smem) {
    for (int u0 = bid; u0 < 2048; u0 += nb) { const int u = (bid & 1) ? ((u0 + 1024) & 2047) : u0; if (u < 1024) chunk_out<128, false>(P, u, smem); else chunk_out<64, true>(P, u - 1024, smem); }
}

__device__ __forceinline__ void ins16(float (&l)[16], float x) {
#pragma unroll
    for (int i = 0; i < 16; ++i) { const float hi = fmaxf(l[i], x); x = fminf(l[i], x); l[i] = hi; }
}
__device__ __forceinline__ void ins16x2(float (&l)[16], float xa, float xb) {
#pragma unroll
    for (int i = 0; i < 16; ++i) {
        const float h1 = fmaxf(l[i], xa); xa = fminf(l[i], xa);
        const float h2 = fmaxf(h1, xb); xb = fminf(h1, xb);
        l[i] = h2;
    }
}
__device__ __forceinline__ void phase_route(const Params& P, int bid, int nb, unsigned char* smem) {
    int* idx = (int*)(P.ws + WS_IDX); float* gates = (float*)(P.ws + WS_GATES);
    const bf16_t* Q = (const bf16_t*)(P.ws + WS_Q); const bf16_t* KEYS = (const bf16_t*)(P.ws + WS_KEYS);
    int tid_ = VTID; asm volatile("" : "+v"(tid_));
    const int tid = tid_, wave = tid >> 6, lane = tid & 63, fr = lane & 15, fq = lane >> 4;
    float* tile = (float*)smem;
    unsigned* L = (unsigned*)(smem + 256 * 33 * 4);
    const float NEG = -3.0e38f;
    for (int u = bid; u < 512; u += nb) {
        const size_t R0 = (size_t)u * 256;
        const size_t t0 = (size_t)u * 16;
        bf16x8 af[4][4];
#pragma unroll
        for (int j = 0; j < 4; ++j)
#pragma unroll
            for (int ks = 0; ks < 4; ++ks) af[j][ks] = *(const bf16x8*)(Q + (t0 + fr) * D + (4 * wave + j) * 128 + ks * 32 + fq * 8);
        float l[16];
#pragma unroll
        for (int i = 0; i < 16; ++i) l[i] = NEG;
        bf16x8 bq[2][2][4];
#define ROUTE_LOADB(chh, j0) _Pragma("unroll") for (int j = 0; j < 2; ++j) _Pragma("unroll") for (int nt = 0; nt < 2; ++nt) _Pragma("unroll") for (int ks = 0; ks < 4; ++ks) \
            bq[j][nt][ks] = *(const bf16x8*)(KEYS + (size_t)((4 * wave + (j0) + j) * 128 + (chh) * 32 + nt * 16 + fr) * 128 + ks * 32 + fq * 8);
#define ROUTE_MMA(j0) _Pragma("unroll") for (int j = 0; j < 2; ++j) _Pragma("unroll") for (int nt = 0; nt < 2; ++nt) { \
            f32x4 acc = {0.f, 0.f, 0.f, 0.f}; \
            _Pragma("unroll") for (int ks = 0; ks < 4; ++ks) acc = __builtin_amdgcn_mfma_f32_16x16x32_bf16(af[(j0) + j][ks], bq[j][nt][ks], acc, 0, 0, 0); \
            _Pragma("unroll") for (int jj = 0; jj < 4; ++jj) tile[((fq * 4 + jj) * 16 + 4 * wave + (j0) + j) * 33 + nt * 16 + fr] = acc[jj]; }
        ROUTE_LOADB(0, 0)
        for (int ch = 0; ch < 4; ++ch) {
            HSYNC();
            ROUTE_MMA(0)
            ROUTE_LOADB(ch, 2)
            ROUTE_MMA(2)
            if (ch < 3) { ROUTE_LOADB(ch + 1, 0) }
            HSYNC();
#pragma unroll
            for (int j = 0; j < 32; j += 2) {
                const float xa = __uint_as_float((__float_as_uint(tile[tid * 33 + j]) & ~0x7Fu) | (unsigned)(ch * 32 + j));
                const float xb = __uint_as_float((__float_as_uint(tile[tid * 33 + j + 1]) & ~0x7Fu) | (unsigned)(ch * 32 + j + 1));
                ins16x2(l, xa, xb);
            }
        }
#pragma unroll
        for (int i = 0; i < 16; ++i) L[tid * 16 + i] = __float_as_uint(l[i]);
        HSYNC();
        const int pe = tid & ~1, po = tid | 1;
        float s1[16], s2[16];
#pragma unroll
        for (int i = 0; i < 16; ++i) { s1[i] = __uint_as_float(L[pe * 16 + i]); s2[i] = __uint_as_float(L[po * 16 + i]); }
        float m[16];
#pragma unroll
        for (int i = 0; i < 16; ++i) m[i] = NEG;
#pragma unroll
        for (int i = 0; i < 16; ++i)
#pragma unroll
            for (int j = 0; j < 16; ++j)
                if ((i + 1) * (j + 1) <= 16) ins16(m, __uint_as_float((__float_as_uint(s1[i] + s2[j]) & ~0xFFu) | (unsigned)(i * 16 + j)));
        float e[16], sum = 0.f;
#pragma unroll
        for (int r = 0; r < 16; ++r) { e[r] = __expf(m[r] - m[0]); sum += e[r]; }
        const float inv = 1.f / sum;
        const int par = tid & 1;
        const size_t ob = ((R0 + tid) >> 1) * 16 + par * 8;
#pragma unroll
        for (int r = 0; r < 8; ++r) {
            float k_lo = m[r], k_hi = m[r + 8], e_lo = e[r], e_hi = e[r + 8];
            asm volatile("" : "+v"(k_lo), "+v"(k_hi), "+v"(e_lo), "+v"(e_hi));
            const float key = par ? k_hi : k_lo;
            const float ev = par ? e_hi : e_lo;
            const unsigned cand = __float_as_uint(key) & 0xFFu;
            const unsigned i1 = L[pe * 16 + (cand >> 4)] & 0x7Fu, i2 = L[po * 16 + (cand & 15)] & 0x7Fu;
            idx[ob + r] = (int)(i1 * 128 + i2);
            gates[ob + r] = ev * inv;
        }
    }
}

typedef float f32x2 __attribute__((ext_vector_type(2)));
typedef float v32f __attribute__((ext_vector_type(32)));
typedef float v16f __attribute__((ext_vector_type(16)));
typedef unsigned v6u __attribute__((ext_vector_type(6)));
constexpr int EROW = 1536;
__device__ __forceinline__ void fp6_calibrate(int (&sig)[32]) {
    v16f tlo, thi;
#pragma unroll
    for (int i = 0; i < 16; ++i) { tlo[i] = (i < 8) ? 0.125f * i : 1.f + 0.125f * (i - 8); thi[i] = (i < 8) ? 2.f + 0.25f * i : 4.f + 0.5f * (i - 8); }
    asm volatile("" : "+v"(tlo), "+v"(thi));
    const v6u tw = __builtin_amdgcn_cvt_scalef32_2xpk16_fp6_f32(tlo, thi, 1.0f);
    const v32f tr = __builtin_amdgcn_cvt_scalef32_pk32_f32_fp6(tw, 1.0f);
#pragma unroll
    for (int j = 0; j < 32; ++j) {
        const float v = tr[j];
        const int k = v < 2.f ? (int)(v * 8.f + 0.5f) : (v < 4.f ? 16 + (int)((v - 2.f) * 4.f + 0.5f) : 24 + (int)((v - 4.f) * 2.f + 0.5f));
        sig[j] = __builtin_amdgcn_readfirstlane(k) & 31;
    }
}
__device__ __forceinline__ void phase_econv(const Params& P, int bid, int nb, unsigned char* smem) {
    int tid_ = VTID; asm volatile("" : "+v"(tid_));
    const int wave = tid_ >> 6, lane = tid_ & 63;
    float* scales = (float*)(P.ws + WS_ESC);
    bool fp4_natural;
    { float ta = 1.0f, tb = 2.0f; asm volatile("" : "+v"(ta), "+v"(tb));
      const unsigned tw = __builtin_amdgcn_cvt_scalef32_pk_fp4_f32(0u, ta, tb, 1.0f, 0);
      const f32x2 tr = __builtin_amdgcn_cvt_scalef32_pk_f32_fp4(tw, 1.0f, 0);
      fp4_natural = __builtin_amdgcn_readfirstlane(tr[0] == 1.0f ? 1 : 0) != 0; }
    for (int r = bid * 4 + wave; r < 32768; r += nb * 4) {
        const bool isv = r >= 16384;
        const float* src = (isv ? P.expert_v : P.expert_u) + (size_t)(r & 16383) * D + lane * 32;
        f32x4 v[8]; float am = 0.f;
#pragma unroll
        for (int i = 0; i < 8; ++i) { v[i] = *(const f32x4*)(src + i * 4); am = fmaxf(am, fmaxf(fmaxf(fabsf(v[i][0]), fabsf(v[i][1])), fmaxf(fabsf(v[i][2]), fabsf(v[i][3])))); }
        am = wave_max(am);
        {
            unsigned char* dst = (isv ? P.ws + WS_EV4 + (size_t)(r - 16384) * 1024 : P.ws + WS_EU8 + (size_t)r * 1024) + lane * 16;
            const float sc = am > 0.f ? 6.0f / (0.8f * am) : 1.f;
            unsigned w[4] = {0u, 0u, 0u, 0u};
#define FP4_PK(i, bs) { const float a = v[(i) >> 1][((i) & 1) * 2] * sc, b = v[(i) >> 1][((i) & 1) * 2 + 1] * sc; \
                w[(i) >> 2] = __builtin_amdgcn_cvt_scalef32_pk_fp4_f32(w[(i) >> 2], fp4_natural ? a : b, fp4_natural ? b : a, 1.0f, bs); }
            FP4_PK(0, 0) FP4_PK(1, 1) FP4_PK(2, 2) FP4_PK(3, 3) FP4_PK(4, 0) FP4_PK(5, 1) FP4_PK(6, 2) FP4_PK(7, 3)
            FP4_PK(8, 0) FP4_PK(9, 1) FP4_PK(10, 2) FP4_PK(11, 3) FP4_PK(12, 0) FP4_PK(13, 1) FP4_PK(14, 2) FP4_PK(15, 3)
            *(uint4*)dst = make_uint4(w[0], w[1], w[2], w[3]);
            if (lane == 0) scales[r] = am > 0.f ? (0.8f * am) * (1.f / 6.0f) : 1.f;
        }
    }
}

__device__ __forceinline__ float gelu_f(float d) { return 0.5f * d * (1.f + erff(d * 0.70710678118654752f)); }

template <bool DRY>
__device__ __forceinline__ void phase_peer(const Params& P, int bid, int nb, int unit_lo = 0, int unit_hi = 512, int unit_step = 0) {
    const bf16_t* hn = (const bf16_t*)(P.ws + WS_HN); const int* idx = (const int*)(P.ws + WS_IDX); const float* gates = (const float*)(P.ws + WS_GATES);
    bf16_t* H = (bf16_t*)(P.ws + WS_H);
    const unsigned char* EU = P.ws + WS_EU8; const unsigned char* EV = P.ws + WS_EV4; const float* SC = (const float*)(P.ws + WS_ESC);
    const int wave = VTID >> 6, lane = VTID & 63;
    if (unit_step == 0) { unit_lo = bid; unit_step = nb; }
    for (int uu = unit_lo; uu < unit_hi; uu += unit_step)
    for (int tk = 0; tk < 4; ++tk) {
        const int t = uu * 16 + wave * 4 + tk;
        v32f acc; float xr[32];
#pragma unroll
        for (int q = 0; q < 4; ++q) {
            const uint4 v = *(const uint4*)(hn + (size_t)t * D + lane * 32 + q * 8);
            const unsigned ww[4] = {v.x, v.y, v.z, v.w};
#pragma unroll
            for (int j = 0; j < 4; ++j) { xr[q * 8 + 2 * j] = __uint_as_float(ww[j] << 16); xr[q * 8 + 2 * j + 1] = __uint_as_float(ww[j] & 0xffff0000u); }
        }
#pragma unroll
        for (int i = 0; i < 32; ++i) acc[i] = 0.f;
        const float rs_t = rsqrtf(((const float*)(P.ws + WS_RSS))[t] * (1.f / 2048.f) + EPS);
        const int   my_i0 = idx[(size_t)t * 128 + lane],   my_i1 = idx[(size_t)t * 128 + 64 + lane];
        const float my_g0 = gates[(size_t)t * 128 + lane], my_g1 = gates[(size_t)t * 128 + 64 + lane];
        uint4 U0, U1, U2, U3, U4, U5, U6, U7;
        uint4 V0, V1, V2, V3, V4, V5, V6, V7;
#define PEER_E(k) ((k) < 64 ? __builtin_amdgcn_readlane(my_i0, (k)) : __builtin_amdgcn_readlane(my_i1, (k) - 64))
#define PEER_LDU(j, kk) { const unsigned o_ = (unsigned)PEER_E(kk) * 1024u + lane16; U##j = *(const uint4*)(EU + o_); }
#define PEER_LDV(j, kk) { const unsigned o_ = (unsigned)PEER_E(kk) * 1024u + lane16; V##j = *(const uint4*)(EV + o_); }
#define PEER_DOT(j, dst) { const unsigned uw[4] = {U##j.x, U##j.y, U##j.z, U##j.w}; float d = 0.f; \
        _Pragma("unroll") for (int q = 0; q < 4; ++q) { \
            const f32x2 f0 = __builtin_amdgcn_cvt_scalef32_pk_f32_fp4(uw[q], 1.0f, 0), f1 = __builtin_amdgcn_cvt_scalef32_pk_f32_fp4(uw[q], 1.0f, 1), \
                        f2 = __builtin_amdgcn_cvt_scalef32_pk_f32_fp4(uw[q], 1.0f, 2), f3 = __builtin_amdgcn_cvt_scalef32_pk_f32_fp4(uw[q], 1.0f, 3); \
            d += f0[0] * xr[q * 8] + f0[1] * xr[q * 8 + 1] + f1[0] * xr[q * 8 + 2] + f1[1] * xr[q * 8 + 3]; \
            d += f2[0] * xr[q * 8 + 4] + f2[1] * xr[q * 8 + 5] + f3[0] * xr[q * 8 + 6] + f3[1] * xr[q * 8 + 7]; } \
        dst = d; __builtin_amdgcn_sched_barrier(0); }
#define PEER_AXPY(j, aj) { const unsigned vw[4] = {V##j.x, V##j.y, V##j.z, V##j.w}; \
        _Pragma("unroll") for (int q = 0; q < 4; ++q) { \
            const f32x2 f0 = __builtin_amdgcn_cvt_scalef32_pk_f32_fp4(vw[q], 1.0f, 0), f1 = __builtin_amdgcn_cvt_scalef32_pk_f32_fp4(vw[q], 1.0f, 1), \
                        f2 = __builtin_amdgcn_cvt_scalef32_pk_f32_fp4(vw[q], 1.0f, 2), f3 = __builtin_amdgcn_cvt_scalef32_pk_f32_fp4(vw[q], 1.0f, 3); \
            acc[q * 8] += (aj) * f0[0]; acc[q * 8 + 1] += (aj) * f0[1]; acc[q * 8 + 2] += (aj) * f1[0]; acc[q * 8 + 3] += (aj) * f1[1]; \
            acc[q * 8 + 4] += (aj) * f2[0]; acc[q * 8 + 5] += (aj) * f2[1]; acc[q * 8 + 6] += (aj) * f3[0]; acc[q * 8 + 7] += (aj) * f3[1]; } __builtin_amdgcn_sched_barrier(0); }
        const unsigned lane16 = (unsigned)lane * 16u;
        PEER_LDU(0, 0) PEER_LDU(1, 1) PEER_LDU(2, 2) PEER_LDU(3, 3) PEER_LDU(4, 4) PEER_LDU(5, 5) PEER_LDU(6, 6) PEER_LDU(7, 7)
        PEER_LDV(0, 0) PEER_LDV(1, 1) PEER_LDV(2, 2) PEER_LDV(3, 3) PEER_LDV(4, 4) PEER_LDV(5, 5) PEER_LDV(6, 6) PEER_LDV(7, 7)
        const bool b5 = (lane & 32) != 0, b4 = (lane & 16) != 0, b3 = (lane & 8) != 0;
        for (int k0 = 0; k0 < 128; k0 += 8) {
            const bool more = k0 + 8 < 128;
            float p0, p1, p2, p3, p4, p5, p6, p7;
            PEER_DOT(0, p0)
            PEER_DOT(1, p1)
            PEER_DOT(2, p2)
            PEER_DOT(3, p3)
            PEER_DOT(4, p4)
            PEER_DOT(5, p5)
            PEER_DOT(6, p6)
            PEER_DOT(7, p7)
            const float q0 = (b5 ? p4 : p0) + __shfl_xor(b5 ? p0 : p4, 32), q1 = (b5 ? p5 : p1) + __shfl_xor(b5 ? p1 : p5, 32);
            const float q2 = (b5 ? p6 : p2) + __shfl_xor(b5 ? p2 : p6, 32), q3 = (b5 ? p7 : p3) + __shfl_xor(b5 ? p3 : p7, 32);
            const float r0 = (b4 ? q2 : q0) + __shfl_xor(b4 ? q0 : q2, 16), r1 = (b4 ? q3 : q1) + __shfl_xor(b4 ? q1 : q3, 16);
            float dt = (b3 ? r1 : r0) + __shfl_xor(b3 ? r0 : r1, 8);
            dt += __shfl_xor(dt, 4); dt += __shfl_xor(dt, 2); dt += __shfl_xor(dt, 1);
            const int src_lane = (k0 & 63) + (lane >> 3);
            const int e_l = __shfl(k0 < 64 ? my_i0 : my_i1, src_lane);
            const float g_l = __shfl(k0 < 64 ? my_g0 : my_g1, src_lane);
            const float pre = dt * SC[e_l] * rs_t;
            const int a_l = __float_as_int(gelu_f(pre) * g_l * SC[16384 + e_l]);
            { const float a0 = __int_as_float(__builtin_amdgcn_readlane(a_l, 0));  PEER_AXPY(0, a0) if (more) { PEER_LDV(0, k0 + 8) PEER_LDU(0, k0 + 8) } }
            { const float a1 = __int_as_float(__builtin_amdgcn_readlane(a_l, 8));  PEER_AXPY(1, a1) if (more) { PEER_LDV(1, k0 + 9) PEER_LDU(1, k0 + 9) } }
            { const float a2 = __int_as_float(__builtin_amdgcn_readlane(a_l, 16)); PEER_AXPY(2, a2) if (more) { PEER_LDV(2, k0 + 10) PEER_LDU(2, k0 + 10) } }
            { const float a3 = __int_as_float(__builtin_amdgcn_readlane(a_l, 24)); PEER_AXPY(3, a3) if (more) { PEER_LDV(3, k0 + 11) PEER_LDU(3, k0 + 11) } }
            { const float a4 = __int_as_float(__builtin_amdgcn_readlane(a_l, 32)); PEER_AXPY(4, a4) if (more) { PEER_LDV(4, k0 + 12) PEER_LDU(4, k0 + 12) } }
            { const float a5 = __int_as_float(__builtin_amdgcn_readlane(a_l, 40)); PEER_AXPY(5, a5) if (more) { PEER_LDV(5, k0 + 13) PEER_LDU(5, k0 + 13) } }
            { const float a6 = __int_as_float(__builtin_amdgcn_readlane(a_l, 48)); PEER_AXPY(6, a6) if (more) { PEER_LDV(6, k0 + 14) PEER_LDU(6, k0 + 14) } }
            { const float a7 = __int_as_float(__builtin_amdgcn_readlane(a_l, 56)); PEER_AXPY(7, a7) if (more) { PEER_LDV(7, k0 + 15) PEER_LDU(7, k0 + 15) } }
        }
        if (DRY) {
#pragma unroll
            for (int i = 0; i < 32; ++i) asm volatile("" :: "v"(acc[i]));
            continue;
        }
        float ss = 0.f;
#pragma unroll
        for (int q = 0; q < 4; ++q) {
            uint4* hp = (uint4*)(H + (size_t)t * D + lane * 32 + q * 8);
            const uint4 hv = *hp; const unsigned hw[4] = {hv.x, hv.y, hv.z, hv.w}; unsigned ow[4];
#pragma unroll
            for (int j = 0; j < 4; ++j) {
                const float a = __uint_as_float(hw[j] << 16) + acc[q * 8 + 2 * j], b = __uint_as_float(hw[j] & 0xffff0000u) + acc[q * 8 + 2 * j + 1];
                acc[q * 8 + 2 * j] = a; acc[q * 8 + 2 * j + 1] = b; ss += a * a + b * b; ow[j] = pack2(a, b);
            }
            *hp = make_uint4(ow[0], ow[1], ow[2], ow[3]);
        }
        ss = wave_sum(ss);
        const float rs = rsqrtf(ss * (1.f / 2048.f) + EPS);
        bf16_t* hn3 = (bf16_t*)(P.ws + WS_HN) + (size_t)t * D + lane * 32;
#pragma unroll
        for (int q = 0; q < 4; ++q) {
            unsigned w[4];
#pragma unroll
            for (int j = 0; j < 4; ++j) { const int col = lane * 32 + q * 8 + 2 * j;
                w[j] = pack2(acc[q * 8 + 2 * j] * rs * P.norm_ple[col], acc[q * 8 + 2 * j + 1] * rs * P.norm_ple[col + 1]); }
            *(uint4*)(hn3 + q * 8) = make_uint4(w[0], w[1], w[2], w[3]);
        }
    }
}

enum { PH_PREP = 0, PH_GEMM1, PH_CHUNK1, PH_SCAN, PH_CHUNK3, PH_GEMM2, PH_GEMM3, PH_ROUTE, PH_PEER, PH_GEMM4, PH_FINAL, PH_COUNT };

#define XB_TMO      128
#define XB_XCNT(j)  (256  + 64 * (j))
#define XB_XSUB(j)  (1280 + 64 * (j))
#define XB_XGEN(j)  (2304 + 64 * (j))
#define XB_TOP      3328
#define XB_TOPGEN   3392
#define XCD_BAR_WORDS 3456
#define XB_SPIN_CAP (1u << 20)
#define LAS __attribute__((address_space(3)))
__device__ __forceinline__ unsigned xb_ld(unsigned* p)              { return __hip_atomic_load(p, __ATOMIC_RELAXED, __HIP_MEMORY_SCOPE_AGENT); }
__device__ __forceinline__ unsigned xb_add(unsigned* p, unsigned v) { return __hip_atomic_fetch_add(p, v, __ATOMIC_RELAXED, __HIP_MEMORY_SCOPE_AGENT); }
__device__ __forceinline__ unsigned xb_xcc_id() { return (unsigned)__builtin_amdgcn_s_getreg((3 << 11) | 20) & 0xFu; }
#define XB_SPIN(cond, bar) do { unsigned _sp = 0; while (cond) { __builtin_amdgcn_s_sleep(1); \
    if ((++_sp & 255u) == 0u) { if (xb_ld(&(bar)[XB_TMO])) break; if (_sp > XB_SPIN_CAP) { atomicAdd(&(bar)[XB_TMO], 1u); break; } } } } while (0)
struct XcdBarrier { unsigned* bar; unsigned x; volatile LAS unsigned* st; };
__device__ __forceinline__ XcdBarrier xcd_barrier_post(unsigned* bar, volatile LAS unsigned* st) {
    XcdBarrier b; b.bar = bar; b.x = xb_xcc_id(); b.st = st;
    if (threadIdx.x == 0) (void)xb_add(&bar[XB_XCNT(b.x)], 1u);
    return b;
}
__device__ __forceinline__ void xcd_barrier_complete(unsigned* bar, unsigned x, unsigned& nloc, unsigned& nx) {
    const unsigned G = gridDim.x * gridDim.y * gridDim.z;
    unsigned sum, cnt, mine, sp = 0u;
    for (;;) {
        sum = 0u; cnt = 0u; mine = 0u;
#pragma unroll
        for (unsigned j = 0; j < 16; ++j) { const unsigned c = xb_ld(&bar[XB_XCNT(j)]); sum += c; cnt += (c > 0u) ? 1u : 0u; mine = (j == x) ? c : mine; }
        if (sum == G) break;
        __builtin_amdgcn_s_sleep(1);
        if ((++sp & 255u) == 0u) { if (xb_ld(&bar[XB_TMO])) break; if (sp > XB_SPIN_CAP) { atomicAdd(&bar[XB_TMO], 1u); break; } }
    }
    nloc = mine > 0u ? mine : 1u; nx = cnt > 0u ? cnt : 1u;
}
__device__ __forceinline__ void xcd_barrier(const XcdBarrier& b) {
    asm volatile("s_waitcnt vmcnt(0)" ::: "memory");
    __syncthreads();
    if (threadIdx.x == 0) {
        unsigned* bar = b.bar;
        __builtin_amdgcn_s_waitcnt(0);
        unsigned nloc = b.st[0], nx = b.st[1];
        if (nloc == 0u) { xcd_barrier_complete(bar, b.x, nloc, nx); b.st[0] = nloc; b.st[1] = nx; }
        const unsigned old = xb_add(&bar[XB_XSUB(b.x)], 1u);
        const unsigned gen = old / nloc;
        if (old + 1u == (gen + 1u) * nloc) {
            __builtin_amdgcn_fence(__ATOMIC_RELEASE, "agent");
            asm volatile("s_waitcnt vmcnt(0)" ::: "memory");
            const unsigned og = xb_add(&bar[XB_TOP], 1u);
            const unsigned tg = og / nx;
            if (og + 1u == (tg + 1u) * nx) xb_add(&bar[XB_TOPGEN], 1u);
            else XB_SPIN(xb_ld(&bar[XB_TOPGEN]) == tg, bar);
            __builtin_amdgcn_fence(__ATOMIC_ACQUIRE, "agent");
            xb_add(&bar[XB_XGEN(b.x)], 1u);
            asm volatile("s_waitcnt vmcnt(0)" ::: "memory");
        } else {
            XB_SPIN(xb_ld(&bar[XB_XGEN(b.x)]) == gen, bar);
            __builtin_amdgcn_fence(__ATOMIC_ACQUIRE, "agent");
            asm volatile("s_waitcnt vmcnt(0)" ::: "memory");
        }
    }
    __syncthreads();
}

__device__ __forceinline__ void run_phase(const Params& P, int ph, int bid, int nb, unsigned char* smem, int rbid, int rnb, unsigned char* rsmem) {
    switch (ph) {
        case PH_PREP:   phase_prep(P, bid, nb, smem); break;
        case PH_GEMM1:  phase_gemm1(P, rbid, rnb, rsmem); break;
        case PH_CHUNK1: phase_chunk1(P, bid, nb, smem); break;
        case PH_SCAN:   phase_scan(P, bid, nb, smem, rbid, rnb, rsmem); break;
        case PH_CHUNK1 + 100: phase_chunk1(P, bid, nb, smem, 1); break;
        case PH_CHUNK1 + 200: phase_chunk1(P, bid, nb, smem, 2); break;
        case PH_SCAN + 100: phase_scan(P, bid, nb, smem, rbid, rnb, rsmem, 1); break;
        case PH_SCAN + 200: phase_scan(P, bid, nb, smem, rbid, rnb, rsmem, 2); break;
        case PH_CHUNK3: phase_chunk3(P, bid, nb, smem); break;
        case PH_GEMM2:  phase_gemm2(P, rbid, rnb, rsmem); break;
        case PH_GEMM3:  phase_gemm3(P, rbid, rnb, rsmem); break;
        case PH_ROUTE:
                        for (int u = bid; u < 512; u += nb) {
                            phase_route(P, u, 512, smem);
                            asm volatile("s_waitcnt vmcnt(0)" ::: "memory"); HSYNC();
                            phase_peer<false>(P, bid, nb, u, u + 1, 1);
                        }
                        break;
        case PH_PEER:   break;
        case PH_PEER + 100: phase_peer<true>(P, bid, nb); break;
        case PH_GEMM4:  phase_gemm4(P, rbid, rnb, rsmem); break;
        case PH_FINAL:  phase_final(P, bid, nb); break;
    }
}

#ifndef PROBE_A
#define PROBE_A -1
#endif
#ifndef PROBE_B
#define PROBE_B -1
#endif
constexpr int LDS_BYTES = 131072 + 16 + 256 + 16 + 128;

__global__ void __launch_bounds__(512, 2) fwd_kernel(Params P, int ph_lo, int ph_hi) {
    extern __shared__ __attribute__((aligned(16))) unsigned char rsmem[];
    const int rbid = blockIdx.x, rnb = gridDim.x;
    const int half = __builtin_amdgcn_readfirstlane((int)(threadIdx.x >> 8));
    const int bid = rbid * 2 + half, nb = rnb * 2;
    unsigned char* smem = rsmem + half * 65536;
    volatile LAS unsigned* st = (volatile LAS unsigned*)(rsmem + 131072);
    if (threadIdx.x == 0) { st[0] = 0u; st[1] = 0u; *(volatile LAS unsigned*)(rsmem + 131072 + 288) = 0u; *(volatile LAS unsigned*)(rsmem + 131072 + 288 + 64) = 0u; }
    __syncthreads();
    XcdBarrier xb = xcd_barrier_post((unsigned*)(P.ws + WS_BAR), st);
#if PROBE_A >= 0
    unsigned long long* tstamp = (unsigned long long*)(rsmem + 131072 + 16);
    xcd_barrier(xb);
    if (threadIdx.x == 0) tstamp[0] = __builtin_amdgcn_s_memrealtime();
#define RUN(ph) if (ph_lo <= (ph) && (ph) < ph_hi) { run_phase(P, (ph), bid, nb, smem, rbid, rnb, rsmem); xcd_barrier(xb); if (threadIdx.x == 0) tstamp[(ph) + 1] = __builtin_amdgcn_s_memrealtime(); }
#else
#ifndef SCAN_PROBE
#define SCAN_PROBE 0
#endif
#ifndef REPEAT_PH
#define REPEAT_PH -1
#endif
#define RUN(ph) if (ph_lo <= (ph) && (ph) < ph_hi) { if ((ph) == REPEAT_PH && (ph) == PH_PEER) { run_phase(P, PH_PEER + 100, bid, nb, smem, rbid, rnb, rsmem); xcd_barrier(xb); } run_phase(P, (ph), bid, nb, smem, rbid, rnb, rsmem); if ((ph) == REPEAT_PH && (ph) != PH_PEER) { xcd_barrier(xb); run_phase(P, ((ph) == PH_SCAN || (ph) == PH_CHUNK1) ? (ph) + SCAN_PROBE : (ph), bid, nb, smem, rbid, rnb, rsmem); } if ((ph) + 1 < ph_hi) xcd_barrier(xb); }
#endif
    RUN(PH_PREP) RUN(PH_GEMM1) RUN(PH_CHUNK1) RUN(PH_SCAN) RUN(PH_CHUNK3) RUN(PH_GEMM2) RUN(PH_GEMM3) RUN(PH_ROUTE)
    RUN(PH_GEMM4) RUN(PH_FINAL)
#if PROBE_A >= 0
    __syncthreads();
    if (rbid == 0) {
        const float da = (float)(tstamp[PROBE_A + 1] - tstamp[PROBE_A]) * 0.01f;
        if (threadIdx.x == 0) P.out[0] = da;
#if PROBE_B >= 0
        const float db = (float)(tstamp[PROBE_B + 1] - tstamp[PROBE_B]) * 0.01f * (1.f / 16.f);
        for (int i = threadIdx.x; i < 65536; i += 512) P.out[65536 + i] = db;
#endif
    }
#endif
}

extern "C" void kernel_launch(void* const* d_in, const int* in_sizes, int n_in, void* d_out, int out_size, void* d_ws, size_t ws_size, hipStream_t stream) {
    static int grid = 0;
    if (grid == 0) {
        if (n_in != 21 || out_size != T * D || ws_size < WS_END) { fprintf(stderr, "kernel_launch: unexpected shapes: n_in %d out %d ws %zu (need %zu)\n", n_in, out_size, ws_size, (size_t)WS_END); grid = -1; return; }
        if (hipFuncSetAttribute((const void*)fwd_kernel, hipFuncAttributeMaxDynamicSharedMemorySize, LDS_BYTES) != hipSuccess) { fprintf(stderr, "kernel_launch: hipFuncSetAttribute failed\n"); grid = -1; return; }
        int dev = 0, cus = 0, per_cu = 0;
        hipGetDevice(&dev); hipDeviceGetAttribute(&cus, hipDeviceAttributeMultiprocessorCount, dev);
        if (hipOccupancyMaxActiveBlocksPerMultiprocessor(&per_cu, (const void*)fwd_kernel, 512, LDS_BYTES) != hipSuccess || per_cu < 1) { fprintf(stderr, "kernel_launch: occupancy query failed (%d)\n", per_cu); grid = -1; return; }
        if (per_cu > 1) per_cu = 1;
        grid = cus * per_cu;
        fprintf(stderr, "kernel_launch: grid %d (%d CUs x %d)\n", grid, cus, per_cu);
    }
    if (grid < 0) return;
    Params P{};
    P.x = (const float*)d_in[0]; P.p = (const float*)d_in[1]; P.positions = (const int*)d_in[2]; P.norm_mix = (const float*)d_in[3]; P.w_in = (const float*)d_in[4];
    P.conv_w = (const float*)d_in[5]; P.a_log = (const float*)d_in[6]; P.dt_bias = (const float*)d_in[7]; P.dn_norm = (const float*)d_in[8]; P.ret_gn_w = (const float*)d_in[9];
    P.ret_gn_b = (const float*)d_in[10]; P.w_out = (const float*)d_in[11]; P.norm_ffn = (const float*)d_in[12]; P.w_pq = (const float*)d_in[13]; P.sub_keys = (const float*)d_in[14];
    P.expert_u = (const float*)d_in[15]; P.expert_v = (const float*)d_in[16]; P.norm_ple = (const float*)d_in[17]; P.w_ple_gate = (const float*)d_in[18]; P.w_ple_proj = (const float*)d_in[19];
    P.norm_final = (const float*)d_in[20]; P.out = (float*)d_out; P.ws = (unsigned char*)d_ws;
    (void)hipMemsetAsync((unsigned char*)d_ws + WS_BAR, 0, XCD_BAR_WORDS * 4, stream);
    int lo = 0, hi = PH_COUNT;
    void* args[] = {&P, &lo, &hi};
    hipError_t e = hipLaunchCooperativeKernel((const void*)fwd_kernel, dim3(grid), dim3(512), args, LDS_BYTES, stream);
    if (e != hipSuccess) fprintf(stderr, "kernel_launch: cooperative launch failed: %s (grid %d)\n", hipGetErrorString(e), grid);
}
```

```cpp
#include <hip/hip_runtime.h>
#include <cstdio>
#include <cstdint>

typedef unsigned short bf16_t;
typedef short bf16x8 __attribute__((ext_vector_type(8)));
typedef float f32x16 __attribute__((ext_vector_type(16)));
typedef float f32x4 __attribute__((ext_vector_type(4)));
__device__ __forceinline__ int fresh_tid() { int t = (int)threadIdx.x; asm volatile("" : "+v"(t)); return t; }
#define VTID (fresh_tid() & 255)

constexpr int T = 8192, D = 2048, SEQ = 4096;
constexpr int NPROJ = 7424;
constexpr int C_Z = 3072, C_RQ = 4096, C_RK = 4608, C_RV = 5120, C_RG = 6144, C_A = 7168, C_B = 7176;
constexpr int IN_COLS = 7184;
constexpr float EPS = 1e-6f;

constexpr size_t WS_HN    = 0;
constexpr size_t WS_KVT   = WS_HN;
constexpr size_t WS_WTIN  = WS_HN + (size_t)T * D * 2;
constexpr size_t WS_STR   = WS_WTIN;
constexpr size_t WS_ATTR  = WS_STR + (size_t)1024 * 128 * 64 * 2;
constexpr size_t WS_WTOUT = WS_WTIN + (size_t)NPROJ * D * 2;
constexpr size_t WS_WTPQ  = WS_WTOUT + (size_t)D * D * 2;
constexpr size_t WS_WTG   = WS_WTPQ + (size_t)D * D * 2;
constexpr size_t WS_WTPP  = WS_WTG + (size_t)D * D * 2;
constexpr size_t WS_KEYS  = WS_WTPP + (size_t)D * 256 * 2;
constexpr size_t WS_PBF   = WS_KEYS + (size_t)16 * 128 * 128 * 2;
constexpr size_t WS_PROJ  = WS_PBF + (size_t)T * 256 * 2;
constexpr size_t WS_Q     = WS_PROJ;
constexpr size_t WS_SCORES= WS_PROJ + (size_t)T * D * 2;
constexpr size_t WS_MIXED = WS_PROJ + (size_t)T * NPROJ * 2;
constexpr size_t WS_H     = WS_MIXED + (size_t)T * D * 2;
constexpr size_t WS_IDX   = WS_H + (size_t)T * D * 4;
constexpr size_t WS_GATES = WS_IDX + (size_t)T * 128 * 4;
constexpr size_t WS_U     = WS_GATES + (size_t)T * 128 * 4;
constexpr size_t WS_W     = WS_U + (size_t)1024 * 64 * 128 * 4;
constexpr size_t WS_KDT   = WS_W + (size_t)1024 * 64 * 128 * 2;
constexpr size_t WS_QG    = WS_KDT + (size_t)1024 * 128 * 64 * 2;
constexpr size_t WS_ATT   = WS_QG + (size_t)1024 * 64 * 128 * 2;
constexpr size_t WS_QGR   = WS_ATT + (size_t)1024 * 64 * 64 * 2;
constexpr size_t WS_EU8   = WS_QGR + (size_t)1024 * 64 * 64 * 2;
constexpr size_t WS_EV4   = WS_EU8 + (size_t)16384 * 2048;
constexpr size_t WS_ESC   = WS_EV4 + (size_t)16384 * 2048;
constexpr size_t WS_EG    = WS_ESC + (size_t)2 * 16384 * 4;
constexpr size_t WS_RSS   = WS_EG + 4096;
constexpr size_t WS_BAR   = WS_RSS + (size_t)T * 4;
constexpr size_t WS_CS    = WS_BAR + 16384;
constexpr size_t WS_DUMMY = WS_CS + (size_t)T * 32 * 8;
constexpr size_t WS_END   = WS_DUMMY + 32768;
constexpr size_t WS_VNT   = WS_H;
constexpr size_t WS_SC    = WS_VNT + (size_t)1024 * 128 * 64 * 2;
constexpr size_t WS_VNTR  = WS_SC + (size_t)1024 * 128 * 128 * 2;
static_assert(WS_VNTR + (size_t)1024 * 128 * 64 * 2 == WS_H + (size_t)T * D * 4, "chunk buffers must fit the H region");

struct Params {
    const float *x, *p; const int* positions;
    const float *norm_mix, *w_in, *conv_w, *a_log, *dt_bias, *dn_norm, *ret_gn_w, *ret_gn_b, *w_out, *norm_ffn, *w_pq, *sub_keys,
                *expert_u, *expert_v, *norm_ple, *w_ple_gate, *w_ple_proj, *norm_final;
    float* out; unsigned char* ws;
};

typedef __bf16 bf16v2_t __attribute__((ext_vector_type(2)));
typedef float f32v2_t __attribute__((ext_vector_type(2)));
__device__ __forceinline__ bf16_t f2bf(float f) { return __builtin_bit_cast(bf16_t, (__bf16)f); }
__device__ __forceinline__ float bf2f(bf16_t h) { return __uint_as_float(((unsigned)h) << 16); }
__device__ __forceinline__ unsigned pack2(float a, float b) { const f32v2_t v = {a, b}; return __builtin_bit_cast(unsigned, __builtin_convertvector(v, bf16v2_t)); }
__device__ __forceinline__ float wave_sum(float v) {
#pragma unroll
    for (int o = 32; o >= 1; o >>= 1) v += __shfl_xor(v, o);
    return v;
}
__device__ __forceinline__ float wave_max(float v) {
#pragma unroll
    for (int o = 32; o >= 1; o >>= 1) v = fmaxf(v, __shfl_xor(v, o));
    return v;
}
__device__ __forceinline__ float silu_f(float x) { return x * __builtin_amdgcn_rcpf(1.f + __expf(-x)); }
__device__ __forceinline__ float sigmoid_f(float x) { return __builtin_amdgcn_rcpf(1.f + __expf(-x)); }

#define LASP __attribute__((address_space(3)))
__device__ __forceinline__ void half_sync(const unsigned char* smem) {
    asm volatile("s_waitcnt lgkmcnt(0)" ::: "memory");
    const unsigned half = (((unsigned)(size_t)smem) >> 16) & 1u;
    LASP unsigned* cnt = (LASP unsigned*)(size_t)(131072u + 288u + 64u * half);
    unsigned old = 0u;
    if ((threadIdx.x & 63u) == 0u) old = __hip_atomic_fetch_add(cnt, 1u, __ATOMIC_RELAXED, __HIP_MEMORY_SCOPE_WORKGROUP);
    old = (unsigned)__builtin_amdgcn_readfirstlane((int)old);
    const unsigned tgt = (old / 4u + 1u) * 4u;
    while (__hip_atomic_load(cnt, __ATOMIC_RELAXED, __HIP_MEMORY_SCOPE_WORKGROUP) < tgt) __builtin_amdgcn_s_sleep(1);
    asm volatile("" ::: "memory");
}
#define HSYNC() half_sync(smem)

template <bool MAPIN>
__device__ __forceinline__ void transpose_tile(const float* __restrict__ W, int ldw, int K, bf16_t* __restrict__ Wt, int kt, int nt, float* tile  ) {
    const int tid = VTID;
    half_sync((const unsigned char*)tile);
#pragma unroll
    for (int i = 0; i < 4; ++i) {
        const int idx = tid + 256 * i, kr = idx >> 4, c4 = idx & 15;
        const int n = nt * 64 + c4 * 4;
        int c = n; bool valid = true;
        if (MAPIN) { if (n < 4096) c = n; else if (n < 7168) c = n + 16; else if (n < 7184) c = n - 3072; else valid = false; }
        f32x4 v = {0.f, 0.f, 0.f, 0.f};
        if (valid) v = *(const f32x4*)(W + (size_t)(kt * 64 + kr) * ldw + c);
        float* d = tile + kr * 65 + c4 * 4;
        d[0] = v[0]; d[1] = v[1]; d[2] = v[2]; d[3] = v[3];
    }
    half_sync((const unsigned char*)tile);
#pragma unroll
    for (int i = 0; i < 2; ++i) {
        const int ch = tid + 256 * i, n = ch >> 3, kc = ch & 7;
        unsigned w[4];
#pragma unroll
        for (int j = 0; j < 4; ++j) w[j] = pack2(tile[(kc * 8 + 2 * j) * 65 + n], tile[(kc * 8 + 2 * j + 1) * 65 + n]);
        uint4 o = make_uint4(w[0], w[1], w[2], w[3]);
        *(uint4*)(Wt + (size_t)(nt * 64 + n) * K + kt * 64 + kc * 8) = o;
    }
}

template <bool OUT_BF16>
__device__ __forceinline__ void rmsnorm_row(const float* __restrict__ in, const float* __restrict__ w, void* __restrict__ out, int lane) {
    f32x4 v[8]; float ss = 0.f;
#pragma unroll
    for (int i = 0; i < 8; ++i) { v[i] = *(const f32x4*)(in + (i * 64 + lane) * 4); ss += v[i][0] * v[i][0] + v[i][1] * v[i][1] + v[i][2] * v[i][2] + v[i][3] * v[i][3]; }
    ss = wave_sum(ss);
    const float r = rsqrtf(ss * (1.f / 2048.f) + EPS);
#pragma unroll
    for (int i = 0; i < 8; ++i) {
        const f32x4 g = *(const f32x4*)(w + (i * 64 + lane) * 4);
        const float a = v[i][0] * r * g[0], b = v[i][1] * r * g[1], c = v[i][2] * r * g[2], d = v[i][3] * r * g[3];
        if (OUT_BF16) { uint2 o = make_uint2(pack2(a, b), pack2(c, d)); *(uint2*)((bf16_t*)out + (i * 64 + lane) * 4) = o; }
        else { f32x4 o = {a, b, c, d}; *(f32x4*)((float*)out + (i * 64 + lane) * 4) = o; }
    }
}

__device__ __forceinline__ void phase_prep(const Params& P, int bid, int nb, unsigned char* smem) {
    float* tile = (float*)smem;
    const int tid = VTID;
    const int n_in = 32 * 116, n_sq = 32 * 32, n_pp = 4 * 32;
    const int n_tr = n_in + 3 * n_sq + n_pp;
    struct TrDesc { const float* W; bf16_t* Wt; int ldw, K, kt, nt, mapin; };
    auto tr_desc = [&](int u) {
        TrDesc d;
        if (u < n_in) { d.W = P.w_in; d.Wt = (bf16_t*)(P.ws + WS_WTIN); d.ldw = IN_COLS; d.K = D; d.kt = u % 32; d.nt = u / 32; d.mapin = 1; }
        else if (u < n_in + n_sq) { const int v = u - n_in; d.W = P.w_out; d.Wt = (bf16_t*)(P.ws + WS_WTOUT); d.ldw = D; d.K = D; d.kt = v % 32; d.nt = v / 32; d.mapin = 0; }
        else if (u < n_in + 2 * n_sq) { const int v = u - n_in - n_sq; d.W = P.w_pq; d.Wt = (bf16_t*)(P.ws + WS_WTPQ); d.ldw = D; d.K = D; d.kt = v % 32; d.nt = v / 32; d.mapin = 0; }
        else if (u < n_in + 3 * n_sq) { const int v = u - n_in - 2 * n_sq; d.W = P.w_ple_gate; d.Wt = (bf16_t*)(P.ws + WS_WTG); d.ldw = D; d.K = D; d.kt = v % 32; d.nt = v / 32; d.mapin = 0; }
        else { const int v = u - n_in - 3 * n_sq; d.W = P.w_ple_proj; d.Wt = (bf16_t*)(P.ws + WS_WTPP); d.ldw = D; d.K = 256; d.kt = v % 4; d.nt = v / 4; d.mapin = 0; }
        return d;
    };
    f32x4 tv0, tv1, tv2, tv3;
#define TR_LOAD1(d, i, dst) { const int idx = tid + 256 * (i), kr = idx >> 4, c4 = idx & 15; const int n = (d).nt * 64 + c4 * 4; int c = n; bool valid = true; \
        if ((d).mapin) { if (n < 4096) c = n; else if (n < 7168) c = n + 16; else if (n < 7184) c = n - 3072; else valid = false; } \
        dst = (f32x4){0.f, 0.f, 0.f, 0.f}; if (valid) dst = *(const f32x4*)((d).W + (size_t)((d).kt * 64 + kr) * (d).ldw + c); }
#define TR_LOAD(d) { TR_LOAD1(d, 0, tv0) TR_LOAD1(d, 1, tv1) TR_LOAD1(d, 2, tv2) TR_LOAD1(d, 3, tv3) }
#define TR_PUT(i, src) { const int idx = tid + 256 * (i), kr = idx >> 4, c4 = idx & 15; float* dd = tile + kr * 65 + c4 * 4; dd[0] = src[0]; dd[1] = src[1]; dd[2] = src[2]; dd[3] = src[3]; }
    if (bid < n_tr) { const TrDesc d0 = tr_desc(bid); TR_LOAD(d0) }
    for (int u = bid; u < n_tr; u += nb) {
        const TrDesc cur = tr_desc(u);
        half_sync((const unsigned char*)tile);
        TR_PUT(0, tv0) TR_PUT(1, tv1) TR_PUT(2, tv2) TR_PUT(3, tv3)
        if (u + nb < n_tr) { const TrDesc nx = tr_desc(u + nb); TR_LOAD(nx) }
        half_sync((const unsigned char*)tile);
#pragma unroll
        for (int i = 0; i < 2; ++i) {
            const int ch = tid + 256 * i, n = ch >> 3, kc = ch & 7;
            unsigned w[4];
#pragma unroll
            for (int j = 0; j < 4; ++j) w[j] = pack2(tile[(kc * 8 + 2 * j) * 65 + n], tile[(kc * 8 + 2 * j + 1) * 65 + n]);
            *(uint4*)(cur.Wt + (size_t)(cur.nt * 64 + n) * cur.K + cur.kt * 64 + kc * 8) = make_uint4(w[0], w[1], w[2], w[3]);
        }
    }
    {
        bf16_t* keys = (bf16_t*)(P.ws + WS_KEYS); bf16_t* pbf = (bf16_t*)(P.ws + WS_PBF);
        const int n4a = 262144 / 4, n4b = T * 256 / 4;
        for (int i = bid * 256 + tid; i < n4a + n4b; i += nb * 256) {
            const bool a = i < n4a; const int j = a ? i : i - n4a;
            const f32x4 v = *(const f32x4*)((a ? P.sub_keys : P.p) + (size_t)j * 4);
            *(uint2*)((a ? keys : pbf) + (size_t)j * 4) = make_uint2(pack2(v[0], v[1]), pack2(v[2], v[3]));
        }
    }
    { float* rss = (float*)(P.ws + WS_RSS); for (int i = bid * 256 + tid; i < T; i += nb * 256) rss[i] = 0.f; }
    {
        float2* cs = (float2*)(P.ws + WS_CS);
        for (int e = bid * 256 + tid; e < T * 32; e += nb * 256) {
            const int t = e >> 5, i = e & 31;
            const float ang = (float)P.positions[t] * powf(10000.f, -(float)i / 32.f);
            float sn, c0; sincosf(ang, &sn, &c0);
            cs[e] = make_float2(c0, sn);
        }
    }
    {
        const int wave = tid >> 6, lane = tid & 63;
        bf16_t* hn = (bf16_t*)(P.ws + WS_HN);
        for (int r = bid * 4 + wave; r < T; r += nb * 4) rmsnorm_row<true>(P.x + (size_t)r * D, P.norm_mix, hn + (size_t)r * D, lane);
    }
}

__device__ __forceinline__ int lds_off(int row, int ch) { return row * 128 + ((ch ^ ((row >> 1) & 7)) << 4); }

__device__ __forceinline__ void gemm_mainloop(const bf16_t* __restrict__ A, int lda, const bf16_t* __restrict__ Bt, int ldb, int K,
                                              f32x16 (&acc)[2][2], unsigned char* smem) {
    const int tid = VTID, wave = tid >> 6, lane = tid & 63, wr = wave >> 1, wc = wave & 1;
    const int nk = K / 64;
    uint4 ra[4], rb[4];
    __syncthreads();
#pragma unroll
    for (int i = 0; i < 4; ++i) { const int c = tid + 256 * i, row = c >> 3, ch = c & 7;
        ra[i] = *(const uint4*)(A + (size_t)row * lda + ch * 8); rb[i] = *(const uint4*)(Bt + (size_t)row * ldb + ch * 8); }
#pragma unroll
    for (int i = 0; i < 4; ++i) { const int c = tid + 256 * i, row = c >> 3, ch = c & 7;
        *(uint4*)(smem + lds_off(row, ch)) = ra[i]; *(uint4*)(smem + 16384 + lds_off(row, ch)) = rb[i]; }
    __syncthreads();
    for (int kt = 0; kt < nk; ++kt) {
        unsigned char* cur = smem + (kt & 1) * 32768;
        unsigned char* nxt = smem + ((kt + 1) & 1) * 32768;
        const bool more = kt + 1 < nk;
        if (more) {
#pragma unroll
            for (int i = 0; i < 4; ++i) { const int c = tid + 256 * i, row = c >> 3, ch = c & 7;
                ra[i] = *(const uint4*)(A + (size_t)row * lda + (kt + 1) * 64 + ch * 8); rb[i] = *(const uint4*)(Bt + (size_t)row * ldb + (kt + 1) * 64 + ch * 8); }
        }
#pragma unroll
        for (int ks = 0; ks < 4; ++ks) {
            bf16x8 af[2], bfr[2];
#pragma unroll
            for (int i = 0; i < 2; ++i) { const int row = wr * 64 + i * 32 + (lane & 31); af[i] = *(const bf16x8*)(cur + lds_off(row, ks * 2 + (lane >> 5))); }
#pragma unroll
            for (int j = 0; j < 2; ++j) { const int row = wc * 64 + j * 32 + (lane & 31); bfr[j] = *(const bf16x8*)(cur + 16384 + lds_off(row, ks * 2 + (lane >> 5))); }
#pragma unroll
            for (int i = 0; i < 2; ++i)
#pragma unroll
                for (int j = 0; j < 2; ++j) acc[i][j] = __builtin_amdgcn_mfma_f32_32x32x16_bf16(af[i], bfr[j], acc[i][j], 0, 0, 0);
        }
        if (more) {
#pragma unroll
            for (int i = 0; i < 4; ++i) { const int c = tid + 256 * i, row = c >> 3, ch = c & 7;
                *(uint4*)(nxt + lds_off(row, ch)) = ra[i]; *(uint4*)(nxt + 16384 + lds_off(row, ch)) = rb[i]; }
        }
        __syncthreads();
    }
}
#define ACC_FOREACH(body)                                                                                   \
    { const int _tid = VTID, _wave = _tid >> 6, _lane = _tid & 63, _wr = _wave >> 1, _wc = _wave & 1; \
      _Pragma("unroll") for (int i = 0; i < 2; ++i) _Pragma("unroll") for (int j = 0; j < 2; ++j)          \
      _Pragma("unroll") for (int r = 0; r < 16; ++r) {                                                     \
          const int row = _wr * 64 + i * 32 + (r & 3) + 8 * (r >> 2) + 4 * (_lane >> 5);                   \
          const int col = _wc * 64 + j * 32 + (_lane & 31); body } }

__device__ __forceinline__ void zero_acc(f32x16 (&acc)[2][2]) {
#pragma unroll
    for (int i = 0; i < 2; ++i)
#pragma unroll
        for (int j = 0; j < 2; ++j)
#pragma unroll
            for (int r = 0; r < 16; ++r) acc[i][j][r] = 0.f;
}

__device__ __forceinline__ void phase_scores(const Params& P, int bid, int nb, unsigned char* smem) {
    const bf16_t* A = (const bf16_t*)(P.ws + WS_Q); const bf16_t* Bt = (const bf16_t*)(P.ws + WS_KEYS); float* C = (float*)(P.ws + WS_SCORES);
    const int nmt = T / 128, nnt = 16;
    for (int t = bid; t < nmt * nnt; t += nb) {
        const int mt = t % nmt, nt = t / nmt;
        f32x16 acc[2][2]; zero_acc(acc);
        gemm_mainloop(A + (size_t)mt * 128 * D + nt * 128, D, Bt + (size_t)nt * 128 * 128, 128, 128, acc, smem);
        ACC_FOREACH({ C[(size_t)(mt * 128 + row) * D + nt * 128 + col] = acc[i][j][r]; })
    }
}
__device__ __forceinline__ int g2_lds_byte(int r, int c) { const int st = (r >> 4) * 2 + (c >> 5), ob = (r & 15) * 64 + (c & 31) * 2; return st * 1024 + (ob ^ (((ob >> 9) & 1) << 5)); }
__device__ __forceinline__ void g2_stage_rc(int b, int& R, int& C) { const int st = b >> 10, sb = b & 1023, swz = sb ^ (((sb >> 9) & 1) << 5); R = (st >> 1) * 16 + (swz >> 6); C = (st & 1) * 32 + ((swz & 63) >> 1); }
__device__ __forceinline__ void g2_zero(f32x4 (&acc)[8][4]) {
#pragma unroll
    for (int m = 0; m < 8; ++m)
#pragma unroll
        for (int n = 0; n < 4; ++n) acc[m][n] = (f32x4){0.f, 0.f, 0.f, 0.f};
}
__device__ __forceinline__ void g2_mainloop(const bf16_t* __restrict__ Ab, int lda, const bf16_t* __restrict__ Bb, int ldb, int K, f32x4 (&acc)[8][4], unsigned char* shm) {
    const int tid = fresh_tid(), wid = tid >> 6, lane = tid & 63, wr = wid >> 2, wc = wid & 3, fr = lane & 15, fq = lane >> 4;
    int sR[4], sC[4];
#pragma unroll
    for (int i = 0; i < 4; ++i) g2_stage_rc(wid * 1024 + i * 8192 + lane * 16, sR[i], sC[i]);
#define G2_STAGE(buf, kt) { _Pragma("unroll") for (int i = 0; i < 4; ++i) { \
        __builtin_amdgcn_global_load_lds((const unsigned*)(Ab + (size_t)sR[i] * lda + (kt) * 64 + sC[i]), (unsigned*)(shm + (buf) * 65536 + wid * 1024 + i * 8192), 16, 0, 0); \
        __builtin_amdgcn_global_load_lds((const unsigned*)(Bb + (size_t)sR[i] * ldb + (kt) * 64 + sC[i]), (unsigned*)(shm + (buf) * 65536 + 32768 + wid * 1024 + i * 8192), 16, 0, 0); } }
    const int nt = K / 64;
    __syncthreads();
    G2_STAGE(0, 0)
    asm volatile("s_waitcnt vmcnt(0)" ::: "memory");
    __syncthreads();
    for (int t = 0; t < nt; ++t) {
        const int cur = t & 1;
        if (t + 1 < nt) G2_STAGE(cur ^ 1, t + 1)
        const unsigned char* SA = shm + cur * 65536; const unsigned char* SB = SA + 32768;
#pragma unroll
        for (int ks = 0; ks < 2; ++ks) {
            bf16x8 At[8], Bf[4];
#pragma unroll
            for (int m = 0; m < 8; ++m) At[m] = *(const bf16x8*)(SA + g2_lds_byte(wr * 128 + m * 16 + fr, ks * 32 + fq * 8));
#pragma unroll
            for (int n = 0; n < 4; ++n) Bf[n] = *(const bf16x8*)(SB + g2_lds_byte(wc * 64 + n * 16 + fr, ks * 32 + fq * 8));
#pragma unroll
            for (int m = 0; m < 8; ++m)
#pragma unroll
                for (int n = 0; n < 4; ++n) acc[m][n] = __builtin_amdgcn_mfma_f32_16x16x32_bf16(At[m], Bf[n], acc[m][n], 0, 0, 0);
            __builtin_amdgcn_sched_barrier(0);
        }
        asm volatile("s_waitcnt vmcnt(0)" ::: "memory");
        __syncthreads();
    }
}
#define G2_FOREACH(body)                                                                                       \
    { const int _tid = fresh_tid(), _wid = _tid >> 6, _lane = _tid & 63, _wr = _wid >> 2, _wc = _wid & 3, _fr = _lane & 15, _fq = _lane >> 4; \
      _Pragma("unroll") for (int m = 0; m < 8; ++m) _Pragma("unroll") for (int n = 0; n < 4; ++n)             \
      _Pragma("unroll") for (int j = 0; j < 4; ++j) {                                                         \
          const int row = _wr * 128 + m * 16 + _fq * 4 + j; const int col = _wc * 64 + n * 16 + _fr; const float val = acc[m][n][j]; body } }
#define G8_HT (128 * 64)
__device__ __forceinline__ void g8_mainloop(const bf16_t* __restrict__ A, const bf16_t* __restrict__ Bt, int K, int brow, int bcol, f32x4 (&acc)[2][2][4][2], unsigned char* shmb) {
    bf16_t* shm = (bf16_t*)shmb;
    const int tid = fresh_tid();
    const int wid = tid >> 6, lane = tid & 63, wr = wid >> 2, wc = wid & 3, fr = lane & 15, fq = lane >> 4;
#define G8_SA(b, h) (shm + ((b) * 2 + (h)) * G8_HT)
#define G8_SB(b, h) (shm + (4 + (b) * 2 + (h)) * G8_HT)
#define G8_STAGE(Pp, BASE, br, kt) do { const long _g = (long)(br) * K + (long)(kt) * 64; \
    _Pragma("unroll") for (int _i = 0; _i < 2; ++_i) { const int _b = tid * 16 + _i * 8192; int _r, _c; g2_stage_rc(_b, _r, _c); \
      __builtin_amdgcn_global_load_lds((const unsigned*)(BASE + _g + (long)_r * K + _c), (unsigned*)((char*)(Pp) + _b), 16, 0, 0); } } while (0)
#define G8_LDA(dst, b, h) _Pragma("unroll") for (int m = 0; m < 4; ++m) _Pragma("unroll") for (int k = 0; k < 2; ++k) \
    dst[m][k] = *reinterpret_cast<const bf16x8*>((const char*)G8_SA(b, h) + g2_lds_byte(wr * 64 + m * 16 + fr, k * 32 + fq * 8))
#define G8_LDB(dst, b, h) _Pragma("unroll") for (int n = 0; n < 2; ++n) _Pragma("unroll") for (int k = 0; k < 2; ++k) \
    dst[n][k] = *reinterpret_cast<const bf16x8*>((const char*)G8_SB(b, h) + g2_lds_byte(wc * 32 + n * 16 + fr, k * 32 + fq * 8))
#define G8_MMA(ai, bj, At_, Bt_) do { __builtin_amdgcn_s_setprio(1); \
    _Pragma("unroll") for (int m = 0; m < 4; ++m) _Pragma("unroll") for (int n = 0; n < 2; ++n) _Pragma("unroll") for (int k = 0; k < 2; ++k) \
      acc[ai][bj][m][n] = __builtin_amdgcn_mfma_f32_16x16x32_bf16(At_[m][k], Bt_[n][k], acc[ai][bj][m][n], 0, 0, 0); \
    __builtin_amdgcn_s_setprio(0); } while (0)
#define G8_WAIT_V(n) asm volatile("s_waitcnt vmcnt(" #n ")" ::: "memory")
#define G8_WAIT_L(n) asm volatile("s_waitcnt lgkmcnt(" #n ")" ::: "memory")
#define G8_BAR __builtin_amdgcn_s_barrier()
#define G8_SCHED __builtin_amdgcn_sched_barrier(0)
    bf16x8 At[4][2], B0[2][2], B1[2][2];
    const int nt = K / 64;
    __syncthreads();
    G8_STAGE(G8_SB(0, 0), Bt, bcol, 0); G8_STAGE(G8_SA(0, 0), A, brow, 0);
    G8_STAGE(G8_SB(0, 1), Bt, bcol + 128, 0); G8_STAGE(G8_SA(0, 1), A, brow + 128, 0);
    if (wr == 1) G8_BAR;
    G8_WAIT_V(4); G8_BAR;
    G8_STAGE(G8_SB(1, 0), Bt, bcol, 1); G8_STAGE(G8_SA(1, 0), A, brow, 1); G8_STAGE(G8_SB(1, 1), Bt, bcol + 128, 1);
    G8_WAIT_V(6); G8_BAR;
    for (int t = 0; t < nt - 2; t += 2) {
        G8_LDB(B0, 0, 0); G8_SCHED; G8_LDA(At, 0, 0); G8_STAGE(G8_SA(1, 1), A, brow + 128, t + 1);
        G8_WAIT_L(8); G8_BAR; G8_WAIT_L(0); G8_MMA(0, 0, At, B0); G8_BAR; G8_SCHED;
        G8_LDB(B1, 0, 1); G8_STAGE(G8_SB(0, 0), Bt, bcol, t + 2);
        G8_BAR; G8_WAIT_L(0); G8_MMA(0, 1, At, B1); G8_BAR;
        G8_LDA(At, 0, 1); G8_STAGE(G8_SA(0, 0), A, brow, t + 2);
        G8_BAR; G8_WAIT_L(0); G8_MMA(1, 0, At, B0); G8_BAR; G8_SCHED;
        G8_STAGE(G8_SB(0, 1), Bt, bcol + 128, t + 2);
        G8_WAIT_V(6); G8_BAR; G8_MMA(1, 1, At, B1); G8_BAR;
        G8_LDB(B0, 1, 0); G8_SCHED; G8_LDA(At, 1, 0); G8_STAGE(G8_SA(0, 1), A, brow + 128, t + 2);
        G8_WAIT_L(8); G8_BAR; G8_WAIT_L(0); G8_MMA(0, 0, At, B0); G8_BAR; G8_SCHED;
        G8_LDB(B1, 1, 1); G8_STAGE(G8_SB(1, 0), Bt, bcol, t + 3);
        G8_BAR; G8_WAIT_L(0); G8_MMA(0, 1, At, B1); G8_BAR;
        G8_LDA(At, 1, 1); G8_STAGE(G8_SA(1, 0), A, brow, t + 3);
        G8_BAR; G8_WAIT_L(0); G8_MMA(1, 0, At, B0); G8_BAR; G8_SCHED;
        G8_STAGE(G8_SB(1, 1), Bt, bcol + 128, t + 3);
        G8_WAIT_V(6); G8_BAR; G8_MMA(1, 1, At, B1); G8_BAR;
    }
    { G8_LDB(B0, 0, 0); G8_LDA(At, 0, 0); G8_STAGE(G8_SA(1, 1), A, brow + 128, nt - 1);
      G8_BAR; G8_WAIT_L(0); G8_MMA(0, 0, At, B0); G8_BAR;
      G8_LDB(B1, 0, 1); G8_BAR; G8_WAIT_L(0); G8_MMA(0, 1, At, B1); G8_BAR;
      G8_LDA(At, 0, 1); G8_WAIT_V(4); G8_BAR; G8_WAIT_L(0); G8_MMA(1, 0, At, B0); G8_MMA(1, 1, At, B1); G8_BAR; }
    { G8_LDB(B0, 1, 0); G8_LDA(At, 1, 0); G8_WAIT_V(2); G8_BAR; G8_WAIT_L(0); G8_MMA(0, 0, At, B0); G8_BAR;
      G8_LDB(B1, 1, 1); G8_WAIT_V(0); G8_BAR; G8_WAIT_L(0); G8_MMA(0, 1, At, B1); G8_BAR;
      G8_LDA(At, 1, 1); G8_BAR; G8_WAIT_L(0); G8_MMA(1, 0, At, B0); G8_MMA(1, 1, At, B1); G8_BAR; }
    if (wr == 0) G8_BAR;
}
__device__ __forceinline__ void g8_zero(f32x4 (&acc)[2][2][4][2]) {
#pragma unroll
    for (int a = 0; a < 2; ++a)
#pragma unroll
        for (int b = 0; b < 2; ++b)
#pragma unroll
            for (int m = 0; m < 4; ++m)
#pragma unroll
                for (int n = 0; n < 2; ++n) acc[a][b][m][n] = (f32x4){0.f, 0.f, 0.f, 0.f};
}
#define G8_FOREACH(body)                                                                                       \
    { const int _tid = fresh_tid(), _wid = _tid >> 6, _lane = _tid & 63, _wr = _wid >> 2, _wc = _wid & 3, _fr = _lane & 15, _fq = _lane >> 4; \
      _Pragma("unroll") for (int ai = 0; ai < 2; ++ai) _Pragma("unroll") for (int bj = 0; bj < 2; ++bj)       \
      _Pragma("unroll") for (int m = 0; m < 4; ++m) _Pragma("unroll") for (int n = 0; n < 2; ++n)             \
      _Pragma("unroll") for (int j = 0; j < 4; ++j) {                                                         \
          const int row = ai * 128 + _wr * 64 + m * 16 + _fq * 4 + j; const int col = bj * 128 + _wc * 32 + n * 16 + _fr; const float val = acc[ai][bj][m][n][j]; body } }

__device__ __forceinline__ bool g2_tile(int bid, int nb, int it, int nM, int nN, int& pm, int& pn) {
    if (nb == 256 && nM == 32) { const int xcd = bid & 7, jj = bid >> 3; pm = 4 * xcd + (jj & 3); pn = 8 * it + (jj >> 2); return pn < nN; }
    const int t = bid + it * nb; pm = t % nM; pn = t / nM; return t < nM * nN;
}

__device__ __forceinline__ void phase_ple(const Params& P, int bid, int nb, unsigned char* smem) {
    const bf16_t* A = (const bf16_t*)(P.ws + WS_PBF); const bf16_t* Bt = (const bf16_t*)(P.ws + WS_WTPP); bf16_t* C = (bf16_t*)P.out;
    for (int t = bid; t < 256; t += nb) {
        const int pm = t & 31, pn = t >> 5;
        f32x4 acc[8][4]; g2_zero(acc);
        g2_mainloop(A + (size_t)pm * 256 * 256, 256, Bt + (size_t)pn * 256 * 256, 256, 256, acc, smem);
        G2_FOREACH({ C[(size_t)(pm * 256 + row) * D + pn * 256 + col] = f2bf(val); })
    }
}
__device__ __forceinline__ void phase_gemm1(const Params& P, int bid, int nb, unsigned char* smem) {
    const bf16_t* A = (const bf16_t*)(P.ws + WS_HN); const bf16_t* Bt = (const bf16_t*)(P.ws + WS_WTIN); bf16_t* C = (bf16_t*)(P.ws + WS_PROJ);
    int pm, pn;
    for (int it = 0; g2_tile(bid, nb, it, T / 256, NPROJ / 256, pm, pn); ++it) {
        f32x4 acc[2][2][4][2]; g8_zero(acc);
        g8_mainloop(A, Bt, D, pm * 256, pn * 256, acc, smem);
        G8_FOREACH({ C[(size_t)(pm * 256 + row) * NPROJ + pn * 256 + col] = f2bf(val); })
    }
    if (nb == 256 && bid >= 160) phase_ple(P, bid - 160, 96, smem);
}
__device__ __forceinline__ void phase_gemm2(const Params& P, int bid, int nb, unsigned char* smem) {
    const bf16_t* A = (const bf16_t*)(P.ws + WS_MIXED); const bf16_t* Bt = (const bf16_t*)(P.ws + WS_WTOUT); bf16_t* H = (bf16_t*)(P.ws + WS_H);
    bf16_t* HW = (bf16_t*)(P.ws + WS_HN); float* rss = (float*)(P.ws + WS_RSS);
    int pm, pn;
    for (int it = 0; g2_tile(bid, nb, it, T / 256, D / 256, pm, pn); ++it) {
        f32x4 acc[2][2][4][2]; g8_zero(acc);
        g8_mainloop(A, Bt, D, pm * 256, pn * 256, acc, smem);
        const int tid = fresh_tid(), wid = tid >> 6, lane = tid & 63, wr = wid >> 2, wc = wid & 3, fr = lane & 15, fq = lane >> 4;
#pragma unroll
        for (int ai = 0; ai < 2; ++ai)
#pragma unroll
            for (int m = 0; m < 4; ++m)
#pragma unroll
                for (int j = 0; j < 4; ++j) {
                    const int row = pm * 256 + ai * 128 + wr * 64 + m * 16 + fq * 4 + j;
                    float ss = 0.f;
#pragma unroll
                    for (int bj = 0; bj < 2; ++bj)
#pragma unroll
                        for (int n = 0; n < 2; ++n) {
                            const int col = pn * 256 + bj * 128 + wc * 32 + n * 16 + fr;
                            const size_t o = (size_t)row * D + col;
                            const float v = P.x[o] + acc[ai][bj][m][n][j];
                            H[o] = f2bf(v); HW[o] = f2bf(v * P.norm_ffn[col]); ss += v * v;
                        }
                    ss += __shfl_xor(ss, 1); ss += __shfl_xor(ss, 2); ss += __shfl_xor(ss, 4); ss += __shfl_xor(ss, 8);
                    if (fr == 0) atomicAdd(rss + row, ss);
                }
    }
}
__device__ __forceinline__ void phase_gemm3(const Params& P, int bid, int nb, unsigned char* smem) {
    const bf16_t* A = (const bf16_t*)(P.ws + WS_HN); const bf16_t* Bt = (const bf16_t*)(P.ws + WS_WTPQ); bf16_t* C = (bf16_t*)(P.ws + WS_Q);
    int pm, pn;
    for (int it = 0; g2_tile(bid, nb, it, T / 256, D / 256, pm, pn); ++it) {
        f32x4 acc[2][2][4][2]; g8_zero(acc);
        g8_mainloop(A, Bt, D, pm * 256, pn * 256, acc, smem);
        const float* rss = (const float*)(P.ws + WS_RSS);
        G8_FOREACH({ const float rs = rsqrtf(rss[pm * 256 + row] * (1.f / 2048.f) + EPS); C[(size_t)(pm * 256 + row) * D + pn * 256 + col] = f2bf(val * rs); })
    }
}
__device__ __forceinline__ void phase_gemm4(const Params& P, int bid, int nb, unsigned char* smem) {
    const bf16_t* A = (const bf16_t*)(P.ws + WS_HN); const bf16_t* Bt = (const bf16_t*)(P.ws + WS_WTG);
    const bf16_t* ple = (const bf16_t*)P.out; bf16_t* H = (bf16_t*)(P.ws + WS_H);
    int pm, pn;
    for (int it = 0; g2_tile(bid, nb, it, T / 256, D / 256, pm, pn); ++it) {
        f32x4 acc[2][2][4][2]; g8_zero(acc);
        g8_mainloop(A, Bt, D, pm * 256, pn * 256, acc, smem);
        G8_FOREACH({ const size_t o = (size_t)(pm * 256 + row) * D + pn * 256 + col; H[o] = f2bf(bf2f(H[o]) + sigmoid_f(val) * bf2f(ple[o])); })
    }
}

template <bool OUT_BF16>
__device__ __forceinline__ void phase_rownorm(const float* in, const float* w, void* out, int bid, int nb) {
    const int wave = VTID >> 6, lane = VTID & 63;
    for (int r = bid * 4 + wave; r < T; r += nb * 4) {
        if (OUT_BF16) rmsnorm_row<true>(in + (size_t)r * D, w, (bf16_t*)out + (size_t)r * D, lane);
        else rmsnorm_row<false>(in + (size_t)r * D, w, (float*)out + (size_t)r * D, lane);
    }
}

__device__ __forceinline__ void phase_final(const Params& P, int bid, int nb) {
    const bf16_t* H = (const bf16_t*)(P.ws + WS_H);
    const int wave = VTID >> 6, lane = VTID & 63;
    for (int r = bid * 4 + wave; r < T; r += nb * 4) {
        float v[32]; float ss = 0.f;
#pragma unroll
        for (int i = 0; i < 4; ++i) {
            const uint4 hv = *(const uint4*)(H + (size_t)r * D + (i * 64 + lane) * 8); const unsigned hw[4] = {hv.x, hv.y, hv.z, hv.w};
#pragma unroll
            for (int j = 0; j < 4; ++j) { v[i * 8 + 2 * j] = __uint_as_float(hw[j] << 16); v[i * 8 + 2 * j + 1] = __uint_as_float(hw[j] & 0xffff0000u); ss += v[i * 8 + 2 * j] * v[i * 8 + 2 * j] + v[i * 8 + 2 * j + 1] * v[i * 8 + 2 * j + 1]; }
        }
        ss = wave_sum(ss);
        const float rs = rsqrtf(ss * (1.f / 2048.f) + EPS);
#pragma unroll
        for (int i = 0; i < 4; ++i)
#pragma unroll
            for (int q = 0; q < 2; ++q) {
                const int col = (i * 64 + lane) * 8 + q * 4;
                const f32x4 g = *(const f32x4*)(P.norm_final + col);
                f32x4 o = {v[i * 8 + q * 4] * rs * g[0], v[i * 8 + q * 4 + 1] * rs * g[1], v[i * 8 + q * 4 + 2] * rs * g[2], v[i * 8 + q * 4 + 3] * rs * g[3]};
                *(f32x4*)(P.out + (size_t)r * D + col) = o;
            }
    }
}

__device__ __forceinline__ bf16x8 frag_ld(const unsigned char* tile, int row, int ks, int lane) { return *(const bf16x8*)(tile + lds_off(row, ks * 2 + (lane >> 5))); }
__device__ __forceinline__ void lds_st_bf16(unsigned char* tile, int row, int k, float v) { *(bf16_t*)(tile + lds_off(row, k >> 3) + (k & 7) * 2) = f2bf(v); }

__device__ __forceinline__ void d1_chunk(const Params& P, int u, unsigned char* smem) {
    const bf16_t* proj = (const bf16_t*)(P.ws + WS_PROJ);
    int tid_ = VTID; asm volatile("" : "+v"(tid_));
    const int tid = tid_, wave = tid >> 6, lane = tid & 63;
    const int b = u >> 9, h = (u >> 6) & 7, c = u & 63;
    const size_t tok0 = (size_t)b * SEQ + c * 64;
    unsigned char* Ks = smem;
    unsigned char* Qs = smem + 16384;
    unsigned char* Vraw = smem + 16384;
    float* At = (float*)(smem + 34816);
    float* Gs = (float*)(smem + 51200);
    float* Bs = Gs + 64;
    float* Es = Gs + 128;
    float* Xs = Gs + 192;
    HSYNC();
    if (wave == 0) {
        const size_t t = tok0 + lane;
        const float a = bf2f(proj[t * NPROJ + C_A + h]), bb = bf2f(proj[t * NPROJ + C_B + h]);
        const float xs = a + P.dt_bias[h];
        const float sp = xs > 20.f ? xs : log1pf(expf(xs));
        float g = -expf(P.a_log[h]) * sp;
#pragma unroll
        for (int o = 1; o < 64; o <<= 1) { const float n = __shfl_up(g, o); if (lane >= o) g += n; }
        Gs[lane] = g; Bs[lane] = 1.f / (1.f + expf(-bb));
        Es[lane] = __expf(g); Xs[lane] = __expf(__shfl(g, 63) - g);
    }
    bf16_t* QG = (bf16_t*)(P.ws + WS_QG) + (size_t)u * 64 * 128;
    unsigned char* RAW = smem + 32768;
    uint4 rq[5], rk[5], rv[5];
#pragma unroll
    for (int i = 0; i < 5; ++i) {
        const int q = tid + 256 * i, row = q >> 4, c16 = q & 15;
        rq[i] = make_uint4(0u, 0u, 0u, 0u); rk[i] = rq[i]; rv[i] = rq[i];
        if (q < 67 * 16 && (c > 0 || row >= 3)) {
            const bf16_t* src = proj + (tok0 + row - 3) * NPROJ + h * 128 + c16 * 8;
            rq[i] = *(const uint4*)(src); rk[i] = *(const uint4*)(src + 1024); rv[i] = *(const uint4*)(src + 2048);
        }
    }
#pragma unroll
    for (int isk = 0; isk < 2; ++isk) {
        const int chb = (isk ? 1024 : 0) + h * 128;
#pragma unroll
        for (int i = 0; i < 5; ++i) { const int q = tid + 256 * i, row = q >> 4, c16 = q & 15; if (q < 67 * 16) *(uint4*)(RAW + row * 256 + c16 * 16) = isk ? rk[i] : rq[i]; }
        const int ch0 = chb + lane * 2;
        const f32x4 cw0 = *(const f32x4*)(P.conv_w + ch0 * 4), cw1 = *(const f32x4*)(P.conv_w + ch0 * 4 + 4);
        HSYNC();
        float y0[16], y1[16], ss[16];
#pragma unroll
        for (int j = 0; j < 16; ++j) {
            const int tok = wave + 4 * j;
            float a0 = 0.f, a1 = 0.f;
#pragma unroll
            for (int t4 = 0; t4 < 4; ++t4) {
                const unsigned pr = *(const unsigned*)(RAW + (tok + t4) * 256 + lane * 4);
                a0 += bf2f((bf16_t)(pr & 0xffff)) * cw0[t4];
                a1 += bf2f((bf16_t)(pr >> 16)) * cw1[t4];
            }
            y0[j] = silu_f(a0); y1[j] = silu_f(a1); ss[j] = y0[j] * y0[j] + y1[j] * y1[j];
        }
        const bool b5 = (lane & 32) != 0, b4 = (lane & 16) != 0, b3 = (lane & 8) != 0, b2 = (lane & 4) != 0;
        float q8[8], q4[4], q2[2];
#pragma unroll
        for (int j = 0; j < 8; ++j) q8[j] = (b5 ? ss[j + 8] : ss[j]) + __shfl_xor(b5 ? ss[j] : ss[j + 8], 32);
#pragma unroll
        for (int j = 0; j < 4; ++j) q4[j] = (b4 ? q8[j + 4] : q8[j]) + __shfl_xor(b4 ? q8[j] : q8[j + 4], 16);
#pragma unroll
        for (int j = 0; j < 2; ++j) q2[j] = (b3 ? q4[j + 2] : q4[j]) + __shfl_xor(b3 ? q4[j] : q4[j + 2], 8);
        float st = (b2 ? q2[1] : q2[0]) + __shfl_xor(b2 ? q2[0] : q2[1], 4);
        st += __shfl_xor(st, 2); st += __shfl_xor(st, 1);
        float rl = rsqrtf(st + EPS); if (!isk) rl *= 0.08838834764831845f;
        const int rli = __float_as_int(rl);
#pragma unroll
        for (int j = 0; j < 16; ++j) {
            const int tok = wave + 4 * j;
            const float r = __int_as_float(__builtin_amdgcn_readlane(rli, 4 * j));
            const float z0 = y0[j] * r, z1 = y1[j] * r;
            const int k = lane * 2, half = k >> 6, kk = k & 63;
            *(unsigned*)((isk ? Ks : Qs) + half * 8192 + lds_off(tok, kk >> 3) + (kk & 7) * 2) = pack2(z0, z1);
            if (!isk) { const float eg = Es[tok]; *(unsigned*)(QG + tok * 128 + k) = pack2(z0 * eg, z1 * eg); }
        }
        HSYNC();
    }
    {
        const int wr = wave >> 1, wc = wave & 1;
        f32x16 akk, aqk;
#pragma unroll
        for (int r = 0; r < 16; ++r) { akk[r] = 0.f; aqk[r] = 0.f; }
        if (!(wr == 0 && wc == 1)) {
#pragma unroll
            for (int half = 0; half < 2; ++half)
#pragma unroll
                for (int ks = 0; ks < 4; ++ks) {
                    const bf16x8 fk = frag_ld(Ks + half * 8192, wr * 32 + (lane & 31), ks, lane);
                    const bf16x8 fq = frag_ld(Qs + half * 8192, wr * 32 + (lane & 31), ks, lane);
                    const bf16x8 fb = frag_ld(Ks + half * 8192, wc * 32 + (lane & 31), ks, lane);
                    akk = __builtin_amdgcn_mfma_f32_32x32x16_bf16(fk, fb, akk, 0, 0, 0);
                    aqk = __builtin_amdgcn_mfma_f32_32x32x16_bf16(fq, fb, aqk, 0, 0, 0);
                }
        }
        const int j = wc * 32 + (lane & 31); const float Gj = Gs[j];
        bf16_t* ATT = (bf16_t*)(P.ws + WS_ATT) + (size_t)u * 64 * 64;
#pragma unroll
        for (int g4 = 0; g4 < 4; ++g4) {
            const int i0 = wr * 32 + 8 * g4 + 4 * (lane >> 5);
            f32x4 av;
#pragma unroll
            for (int e = 0; e < 4; ++e) {
                const int i = i0 + e, r = g4 * 4 + e;
                const float dec = (i >= j) ? __expf(Gs[i] - Gj) : 0.f;
                av[e] = (i > j) ? Bs[i] * akk[r] * dec : 0.f;
                ATT[i * 64 + j] = f2bf(aqk[r] * dec);
            }
            *(f32x4*)(At + j * 64 + i0) = av;
        }
    }
    HSYNC();
    {
#pragma unroll
        for (int i = 0; i < 5; ++i) { const int q = tid + 256 * i, row = q >> 4, c16 = q & 15; if (q < 67 * 16) *(uint4*)(Vraw + row * 256 + c16 * 16) = rv[i]; }
    }
    HSYNC();
    {
        float r[64];
        if (tid < 128) {
            const int ch = 2048 + h * 128 + tid;
            const float w0 = P.conv_w[ch * 4 + 0], w1 = P.conv_w[ch * 4 + 1], w2 = P.conv_w[ch * 4 + 2], w3 = P.conv_w[ch * 4 + 3];
            const bf16_t* vcol = (const bf16_t*)Vraw + tid;
            float xm3 = bf2f(vcol[0]), xm2 = bf2f(vcol[128]), xm1 = bf2f(vcol[256]);
#pragma unroll
            for (int i = 0; i < 64; ++i) {
                const float x0 = bf2f(vcol[(i + 3) * 128]);
                const float y = w0 * xm3 + w1 * xm2 + w2 * xm1 + w3 * x0;
                r[i] = Bs[i] * silu_f(y);
                xm3 = xm2; xm2 = xm1; xm1 = x0;
            }
        } else {
            const int dk = tid - 128, half = dk >> 6, kk = dk & 63;
            bf16_t* KDT = (bf16_t*)(P.ws + WS_KDT) + (size_t)u * 128 * 64 + dk * 64;
#pragma unroll
            for (int i8 = 0; i8 < 8; ++i8) {
                unsigned pk[4];
#pragma unroll
                for (int e2 = 0; e2 < 4; ++e2) {
                    float kd[2];
#pragma unroll
                    for (int e = 0; e < 2; ++e) {
                        const int i = i8 * 8 + e2 * 2 + e;
                        const float kv = bf2f(*(const bf16_t*)(Ks + half * 8192 + lds_off(i, kk >> 3) + (kk & 7) * 2));
                        r[i] = -Bs[i] * Es[i] * kv;
                        kd[e] = kv * Xs[i];
                    }
                    pk[e2] = pack2(kd[0], kd[1]);
                }
                *(uint4*)(KDT + i8 * 8) = make_uint4(pk[0], pk[1], pk[2], pk[3]);
            }
        }
#pragma unroll
        for (int j = 0; j < 63; ++j) {
            const float xj = r[j];
#pragma unroll
            for (int i4 = ((j + 1) & ~3); i4 < 64; i4 += 4) {
                const f32x4 a = *(const f32x4*)(At + j * 64 + i4);
                r[i4] -= a[0] * xj; r[i4 + 1] -= a[1] * xj; r[i4 + 2] -= a[2] * xj; r[i4 + 3] -= a[3] * xj;
            }
        }
        if (tid < 128) {
            bf16_t* U = (bf16_t*)(P.ws + WS_U) + (size_t)u * 64 * 128 + (tid >> 5) * 2048 + (tid & 31);
#pragma unroll
            for (int i = 0; i < 64; ++i) { const int tt = i >> 5, i5 = i & 31, rr = (i5 & 3) + 4 * (i5 >> 3), hh = (i5 >> 2) & 1; U[(tt * 16 + rr) * 64 + hh * 32] = f2bf(r[i]); }
        } else {
            bf16_t* W = (bf16_t*)(P.ws + WS_W) + (size_t)u * 64 * 128 + (tid - 128);
#pragma unroll
            for (int i = 0; i < 64; ++i) W[i * 128] = f2bf(r[i]);
        }
        if (tid == 0) ((float*)(P.ws + WS_EG))[u] = Es[63];
    }
}

__device__ __forceinline__ void r1_chunk(const Params& P, int u, unsigned char* smem) {
    const bf16_t* proj = (const bf16_t*)(P.ws + WS_PROJ);
    int tid_ = VTID; asm volatile("" : "+v"(tid_));
    const int tid = tid_, wave = tid >> 6, lane = tid & 63;
    const int b = u >> 9, h = (u >> 6) & 7, c = u & 63;
    const size_t tok0 = (size_t)b * SEQ + c * 64;
    unsigned char* RQ = smem;
    unsigned char* RK = smem + 8192;
    unsigned char* VT = smem + 16384;
    unsigned char* RKT = smem + 32768;
    const float l2g = log2f(1.f - exp2f(-5.f - (float)h));
    unsigned char* VR = smem + 40960;
    HSYNC();
    bf16_t* QGR = (bf16_t*)(P.ws + WS_QGR) + (size_t)u * 64 * 64;
    {
        uint4 rq[2], rk[2], rv[4];
#pragma unroll
        for (int i = 0; i < 2; ++i) { const int q = tid + 256 * i, row = q >> 3, ch = q & 7;
            rq[i] = *(const uint4*)(proj + (tok0 + row) * NPROJ + C_RQ + h * 64 + ch * 8); rk[i] = *(const uint4*)(proj + (tok0 + row) * NPROJ + C_RK + h * 64 + ch * 8); }
#pragma unroll
        for (int i = 0; i < 4; ++i) { const int q = tid + 256 * i, row = q >> 4, c16 = q & 15; rv[i] = *(const uint4*)(proj + (tok0 + row) * NPROJ + C_RV + h * 128 + c16 * 8); }
#pragma unroll
        for (int i = 0; i < 2; ++i) { const int q = tid + 256 * i, row = q >> 3, ch = q & 7; *(uint4*)(RQ + lds_off(row, ch)) = rq[i]; *(uint4*)(RK + lds_off(row, ch)) = rk[i]; }
#pragma unroll
        for (int i = 0; i < 4; ++i) { const int q = tid + 256 * i, row = q >> 4, c16 = q & 15; *(uint4*)(VR + row * 256 + c16 * 16) = rv[i]; }
    }
    HSYNC();
    const float2* cs = (const float2*)(P.ws + WS_CS) + tok0 * 32;
    float2 cs8[8];
#pragma unroll
    for (int it = 0; it < 8; ++it) cs8[it] = cs[tid + 256 * it];
#pragma unroll
    for (int it = 0; it < 8; ++it) {
        const int e = tid + 256 * it, tok = e >> 5, i = e & 31;
        const float cs_ = cs8[it].x, sn = cs8[it].y;
        bf16_t* q1p = (bf16_t*)(RQ + lds_off(tok, i >> 3) + (i & 7) * 2); bf16_t* q2p = (bf16_t*)(RQ + lds_off(tok, (32 + i) >> 3) + (i & 7) * 2);
        bf16_t* k1p = (bf16_t*)(RK + lds_off(tok, i >> 3) + (i & 7) * 2); bf16_t* k2p = (bf16_t*)(RK + lds_off(tok, (32 + i) >> 3) + (i & 7) * 2);
        const float q1 = bf2f(*q1p), q2 = bf2f(*q2p), k1 = bf2f(*k1p) * 0.125f, k2 = bf2f(*k2p) * 0.125f;
        const float qa = q1 * cs_ - q2 * sn, qb = q1 * sn + q2 * cs_, ka = k1 * cs_ - k2 * sn, kb = k1 * sn + k2 * cs_;
        const float xi = exp2f(l2g * (float)(tok + 1)), zeta = exp2f(l2g * (float)(63 - tok));
        *q1p = f2bf(qa); *q2p = f2bf(qb); *k1p = f2bf(ka); *k2p = f2bf(kb);
        lds_st_bf16(RKT, i, tok, ka * zeta); lds_st_bf16(RKT, 32 + i, tok, kb * zeta);
        QGR[tok * 64 + i] = f2bf(qa * xi); QGR[tok * 64 + 32 + i] = f2bf(qb * xi);
    }
#pragma unroll 4
    for (int it = 0; it < 16; ++it) {
        const int e = tid + 256 * it, tok = e >> 6, dp = e & 63;
        const unsigned pr = *(const unsigned*)(VR + tok * 256 + dp * 4);
        *(bf16_t*)(VT + lds_off(dp * 2, tok >> 3) + (tok & 7) * 2) = (bf16_t)(pr & 0xffff);
        *(bf16_t*)(VT + lds_off(dp * 2 + 1, tok >> 3) + (tok & 7) * 2) = (bf16_t)(pr >> 16);
    }
    HSYNC();
    {
        bf16_t* VNTR = (bf16_t*)(P.ws + WS_VNTR) + (size_t)u * 128 * 64;
#pragma unroll
        for (int it = 0; it < 4; ++it) { const int q = tid + 256 * it, row = q >> 3, ch = q & 7; *(uint4*)(VNTR + row * 64 + ch * 8) = *(const uint4*)(VT + lds_off(row, ch)); }
    }
    {
        const int wr = wave >> 1, wc = wave & 1;
        f32x16 acc;
#pragma unroll
        for (int r = 0; r < 16; ++r) acc[r] = 0.f;
        if (!(wr == 0 && wc == 1)) {
#pragma unroll
            for (int ks = 0; ks < 4; ++ks) acc = __builtin_amdgcn_mfma_f32_32x32x16_bf16(frag_ld(RQ, wr * 32 + (lane & 31), ks, lane), frag_ld(RK, wc * 32 + (lane & 31), ks, lane), acc, 0, 0, 0);
        }
        const int j = wc * 32 + (lane & 31);
        bf16_t* ATTR = (bf16_t*)(P.ws + WS_ATTR) + (size_t)u * 64 * 64;
#pragma unroll
        for (int r = 0; r < 16; ++r) {
            const int i = wr * 32 + (r & 3) + 8 * (r >> 2) + 4 * (lane >> 5);
            const float dec = (i >= j) ? exp2f(l2g * (float)(i - j)) : 0.f;
            ATTR[i * 64 + j] = f2bf(acc[r] * dec);
        }
    }
    {
        f32x16 acc[2];
#pragma unroll
        for (int j = 0; j < 2; ++j)
#pragma unroll
            for (int r = 0; r < 16; ++r) acc[j][r] = 0.f;
#pragma unroll
        for (int ks = 0; ks < 4; ++ks) {
            const bf16x8 fa = frag_ld(VT, wave * 32 + (lane & 31), ks, lane);
#pragma unroll
            for (int j = 0; j < 2; ++j) acc[j] = __builtin_amdgcn_mfma_f32_32x32x16_bf16(fa, frag_ld(RKT, j * 32 + (lane & 31), ks, lane), acc[j], 0, 0, 0);
        }
        float* KVT = (float*)(P.ws + WS_KVT) + (size_t)u * 128 * 64;
#pragma unroll
        for (int j = 0; j < 2; ++j)
#pragma unroll
            for (int r = 0; r < 16; ++r) { const int dv = wave * 32 + (r & 3) + 8 * (r >> 2) + 4 * (lane >> 5); KVT[dv * 64 + j * 32 + (lane & 31)] = acc[j][r]; }
    }
}

__device__ __forceinline__ void phase_chunk1(const Params& P, int bid, int nb, unsigned char* smem, int mode = 0) {
    for (int u0 = bid; u0 < 2048; u0 += nb) { const int u = (bid & 1) ? ((u0 + 1024) & 2047) : u0; if (u < 1024) { if (mode != 2) d1_chunk(P, u, smem); } else if (mode != 1) r1_chunk(P, u - 1024, smem); }
}

__device__ __forceinline__ void d2_scan(const Params& P, int unit, unsigned char* rsmem) {
    const int tid = fresh_tid(), wave = tid >> 6, lane = tid & 63;
    const int bh = (unit & 7) + 8 * (unit >> 5), slice = (unit >> 3) & 3;
    const size_t cb = (size_t)bh * 64;
    const bf16_t* Wg = (const bf16_t*)(P.ws + WS_W); const bf16_t* KDg = (const bf16_t*)(P.ws + WS_KDT);
    const bf16_t* Ug = (const bf16_t*)(P.ws + WS_U); const float* EGg = (const float*)(P.ws + WS_EG);
    bf16_t* SCg = (bf16_t*)(P.ws + WS_SC); bf16_t* VNg = (bf16_t*)(P.ws + WS_VNT);
    unsigned char* Simg = rsmem;
    unsigned char* VNimg = rsmem + 8192;
    unsigned char* BUF = rsmem + 12288;
    const bool vn_wave = wave < 2, s_wave = wave < 4;
    const int hf = wave & 1, dt = wave & 3;
    f32x16 S0;
#pragma unroll
    for (int r = 0; r < 16; ++r) S0[r] = 0.f;
    uint4 w0a, w0b, k0a, k0b, w1a, w1b, k1a, k1b;
    bf16_t un0[16], un1[16];
#define D2_LOAD(SET, uu) { const bf16_t* wp = Wg + (uu) * 8192 + tid * 8; const bf16_t* kp = KDg + (uu) * 8192 + tid * 8; \
        w##SET##a = *(const uint4*)(wp); w##SET##b = *(const uint4*)(wp + 4096); k##SET##a = *(const uint4*)(kp); k##SET##b = *(const uint4*)(kp + 4096); \
        { const bf16_t* up = Ug + (uu) * 8192 + slice * 2048 + hf * 1024 + lane; _Pragma("unroll") for (int r = 0; r < 16; ++r) un##SET[r] = up[r * 64]; } }
#define D2_ST1(i, vw, vk, bufp) { const int q = tid + 512 * (i); { const int row = q >> 4, c16 = q & 15; *(uint4*)((bufp) + (c16 >> 3) * 8192 + lds_off(row, c16 & 7)) = (vw); } \
        { const int row = q >> 3, ch = q & 7; *(uint4*)((bufp) + 16384 + lds_off(row, ch)) = (vk); } }
#define D2_STORE(SET, par) { unsigned char* bufp = BUF + (par) * 32768; D2_ST1(0, w##SET##a, k##SET##a, bufp) D2_ST1(1, w##SET##b, k##SET##b, bufp) }
    const int egl = __float_as_int(EGg[cb + lane]);
    __syncthreads();
    if (s_wave) {
#pragma unroll
        for (int i = 0; i < 2; ++i) *(uint4*)(Simg + dt * 2048 + (lane + 64 * i) * 16) = make_uint4(0u, 0u, 0u, 0u);
#pragma unroll
        for (int i = 0; i < 2; ++i) *(uint4*)(SCg + cb * 16384 + slice * 4096 + dt * 1024 + (lane + 64 * i) * 8) = make_uint4(0u, 0u, 0u, 0u);
    }
    for (int r = 0; r < 16; ++r) { un0[r] = 0; un1[r] = 0; }
    D2_LOAD(0, cb)
    D2_STORE(0, 0)
    bf16_t unc[16];
#pragma unroll
    for (int r = 0; r < 16; ++r) unc[r] = un0[r];
    D2_LOAD(1, cb + 1)
    D2_LOAD(0, cb + 2)
    __syncthreads();
#define D2_STEP(c, UN) { const size_t u = cb + (c); const unsigned char* Wt = BUF + ((c) & 1) * 32768; const unsigned char* KDt = Wt + 16384; \
        if (vn_wave) { \
            f32x16 vn; _Pragma("unroll") for (int r = 0; r < 16; ++r) vn[r] = bf2f(UN[r]); \
            _Pragma("unroll") for (int half = 0; half < 2; ++half) _Pragma("unroll") for (int ks = 0; ks < 4; ++ks) \
                vn = __builtin_amdgcn_mfma_f32_32x32x16_bf16(frag_ld(Wt + half * 8192, hf * 32 + (lane & 31), ks, lane), frag_ld(Simg + half * 4096, lane & 31, ks, lane), vn, 0, 0, 0); \
            _Pragma("unroll") for (int g4 = 0; g4 < 4; ++g4) { const int r0 = g4 * 4; \
                const uint2 pkd = make_uint2(pack2(vn[r0], vn[r0 + 1]), pack2(vn[r0 + 2], vn[r0 + 3])); \
                const int tok = hf * 32 + 8 * g4 + 4 * (lane >> 5); \
                *(uint2*)(VNimg + lds_off(lane & 31, tok >> 3) + (tok & 7) * 2) = pkd; \
                *(uint2*)(VNg + u * 8192 + ((((slice * 2 + hf) * 4 + g4) * 64 + lane) * 4)) = pkd; } } \
        __syncthreads(); \
        if (s_wave) { \
            bf16_t* scdst = ((c) + 1 < 64) ? SCg + (u + 1) * 16384 : (bf16_t*)(P.ws + WS_DUMMY);        \
            const float eg = __int_as_float(__builtin_amdgcn_readlane(egl, (c))); \
            _Pragma("unroll") for (int r = 0; r < 16; ++r) S0[r] *= eg; \
            _Pragma("unroll") for (int ks = 0; ks < 4; ++ks) \
                S0 = __builtin_amdgcn_mfma_f32_32x32x16_bf16(frag_ld(KDt, dt * 32 + (lane & 31), ks, lane), frag_ld(VNimg, lane & 31, ks, lane), S0, 0, 0, 0); \
            _Pragma("unroll") for (int g4 = 0; g4 < 4; ++g4) { const int r0 = g4 * 4; const int kk = (dt & 1) * 32 + 8 * g4 + 4 * (lane >> 5); \
                const uint2 p0 = make_uint2(pack2(S0[r0], S0[r0 + 1]), pack2(S0[r0 + 2], S0[r0 + 3])); \
                *(uint2*)(Simg + (dt >> 1) * 4096 + lds_off(lane & 31, kk >> 3) + (kk & 7) * 2) = p0; \
                *(uint2*)(scdst + ((((slice * 4 + dt) * 4 + g4) * 64 + lane) * 4)) = p0; } } }
    for (int c = 0; c < 64; c += 2) {
        D2_STORE(1, 1)
        bf16_t unn[16];
#pragma unroll
        for (int r = 0; r < 16; ++r) unn[r] = un1[r];
        D2_LOAD(1, cb + (c + 3 < 64 ? c + 3 : 63))
        D2_STEP(c, unc)
        __syncthreads();
        D2_STORE(0, 0)
#pragma unroll
        for (int r = 0; r < 16; ++r) unc[r] = un0[r];
        D2_LOAD(0, cb + (c + 4 < 64 ? c + 4 : 63))
        D2_STEP(c + 1, unn)
        __syncthreads();
    }
}

__device__ __forceinline__ void r2_scan(const Params& P, int vb, int nvb) {
    const float* KVT = (const float*)(P.ws + WS_KVT); bf16_t* STR = (bf16_t*)(P.ws + WS_STR);
    int tid_ = VTID; asm volatile("" : "+v"(tid_));
    for (int idx = vb * 256 + tid_; idx < 16 * 8192; idx += nvb * 256) {
        const int bh = idx >> 13, e = idx & 8191, h = bh & 7;
        const float cd = exp2f(64.f * log2f(1.f - exp2f(-5.f - (float)h)));
        float S = 0.f;
#pragma unroll 8
        for (int c = 0; c < 64; ++c) {
            const size_t o = ((size_t)bh * 64 + c) * 8192 + e;
            STR[o] = f2bf(S);
            S = cd * S + KVT[o];
        }
    }
}

__device__ __forceinline__ void phase_econv(const Params& P, int bid, int nb, unsigned char* smem);
__device__ __forceinline__ void phase_scan(const Params& P, int bid, int nb, unsigned char* smem, int rbid, int rnb, unsigned char* rsmem, int mode = 0) {
    if (rbid < 64) { if (mode != 2) d2_scan(P, rbid, rsmem); }
    else if (mode != 1) {
        if (rnb != 256) phase_ple(P, rbid - 64, rnb - 64, rsmem);
        r2_scan(P, bid - 128, nb - 128);
        phase_econv(P, bid - 128, nb - 128, smem);
    }
}

template <int K1, bool RET>
__device__ __forceinline__ void chunk_out(const Params& P, int u, unsigned char* smem) {
    int tid_ = VTID; asm volatile("" : "+v"(tid_));
    const int tid = tid_, wave = tid >> 6, lane = tid & 63, wr = wave >> 1, wc = wave & 1;
    const int b = u >> 9, h = (u >> 6) & 7, c = u & 63;
    const size_t tok0 = (size_t)b * SEQ + c * 64;
    const bf16_t* A1 = RET ? (const bf16_t*)(P.ws + WS_QGR) + (size_t)u * 64 * 64 : (const bf16_t*)(P.ws + WS_QG) + (size_t)u * 64 * 128;
    const bf16_t* B1 = RET ? (const bf16_t*)(P.ws + WS_STR) + (size_t)u * 128 * 64 : (const bf16_t*)(P.ws + WS_SC) + (size_t)u * 128 * 128;
    const bf16_t* A2 = RET ? (const bf16_t*)(P.ws + WS_ATTR) + (size_t)u * 64 * 64 : (const bf16_t*)(P.ws + WS_ATT) + (size_t)u * 64 * 64;
    const bf16_t* B2 = RET ? (const bf16_t*)(P.ws + WS_VNTR) + (size_t)u * 128 * 64 : (const bf16_t*)(P.ws + WS_VNT) + (size_t)u * 128 * 64;
    float* red = (float*)(smem + 49152);
    f32x16 acc[2];
#pragma unroll
    for (int j = 0; j < 2; ++j)
#pragma unroll
        for (int r = 0; r < 16; ++r) acc[j][r] = 0.f;
    constexpr int NK1 = K1 / 64, NKT = NK1 + 1;
    uint4 A0_0, A0_1, A1_0, A1_1, A2_0, A2_1;
    uint4 B0_0, B0_1, B0_2, B0_3, B1_0, B1_1, B1_2, B1_3, B2_0, B2_1, B2_2, B2_3;
#define CO_LOAD(kt) { const bf16_t* Ap = ((kt) < NK1) ? A1 + (kt) * 64 : A2; const int lda = ((kt) < NK1) ? K1 : 64; const bf16_t* Bp = ((kt) < NK1) ? B1 + (kt) * 64 : B2; \
        { const int q = tid, row = q >> 3, ch = q & 7; A##kt##_0 = *(const uint4*)(Ap + row * lda + ch * 8); } \
        { const int q = tid + 256, row = q >> 3, ch = q & 7; A##kt##_1 = *(const uint4*)(Ap + row * lda + ch * 8); } \
        if (RET) { \
            { const int q = tid, row = q >> 3, ch = q & 7; B##kt##_0 = *(const uint4*)(Bp + row * lda + ch * 8); } \
            { const int q = tid + 256, row = q >> 3, ch = q & 7; B##kt##_1 = *(const uint4*)(Bp + row * lda + ch * 8); } \
            { const int q = tid + 512, row = q >> 3, ch = q & 7; B##kt##_2 = *(const uint4*)(Bp + row * lda + ch * 8); } \
            { const int q = tid + 768, row = q >> 3, ch = q & 7; B##kt##_3 = *(const uint4*)(Bp + row * lda + ch * 8); } \
        } else { \
            const bf16_t* src = ((kt) < NK1) ? B1 : B2; \
            CO_PIECE(kt, 0, pa) CO_PIECE(kt, 1, pb) B##kt##_0 = make_uint4(pa.x, pa.y, pb.x, pb.y); \
            CO_PIECE(kt, 2, pc) CO_PIECE(kt, 3, pd) B##kt##_1 = make_uint4(pc.x, pc.y, pd.x, pd.y); \
            CO_PIECE(kt, 4, pe) CO_PIECE(kt, 5, pf) B##kt##_2 = make_uint4(pe.x, pe.y, pf.x, pf.y); \
            CO_PIECE(kt, 6, pg) CO_PIECE(kt, 7, ph) B##kt##_3 = make_uint4(pg.x, pg.y, ph.x, ph.y); } }
#define CO_PIECE(kt, i, name) uint2 name; { const int q = tid + 256 * (i), ln = q & 63, g4 = (q >> 6) & 3, dd = (q >> 8) & 1, w = q >> 9; \
        const size_t piece = ((kt) < NK1) ? (size_t)(((w * 4 + 2 * (kt) + dd) * 4 + g4) * 64 + ln) : (size_t)(((w * 2 + dd) * 4 + g4) * 64 + ln); \
        name = *(const uint2*)(src + piece * 4); }
    CO_LOAD(0) CO_LOAD(1)
    if (NKT == 3) { CO_LOAD(2) }
    const bf16_t* proj = (const bf16_t*)(P.ws + WS_PROJ);
    unsigned gz[2][16];
#pragma unroll
    for (int r = 0; r < 16; ++r) {
        const size_t t = tok0 + wr * 32 + (r & 3) + 8 * (r >> 2) + 4 * (lane >> 5);
#pragma unroll
        for (int j = 0; j < 2; ++j) gz[j][r] = proj[t * NPROJ + (RET ? C_RG : C_Z) + h * 128 + wc * 64 + j * 32 + (lane & 31)];
    }
#define CO_PUT(i, val) { const int q = tid + 256 * (i), ln = q & 63, g4 = (q >> 6) & 3, dd = (q >> 8) & 1, w = q >> 9; const int kk = dd * 32 + 8 * g4 + 4 * (ln >> 5); \
        *(uint2*)(Bs_ + lds_off(w * 32 + (ln & 31), kk >> 3) + (kk & 7) * 2) = (val); }
#define CO_STAGE(kt, buf) { unsigned char* As_ = smem + (buf) * 24576; unsigned char* Bs_ = As_ + 8192; \
        { const int q = tid, row = q >> 3, ch = q & 7; *(uint4*)(As_ + lds_off(row, ch)) = A##kt##_0; } \
        { const int q = tid + 256, row = q >> 3, ch = q & 7; *(uint4*)(As_ + lds_off(row, ch)) = A##kt##_1; } \
        if (RET) { \
            { const int q = tid, row = q >> 3, ch = q & 7; *(uint4*)(Bs_ + lds_off(row, ch)) = B##kt##_0; } \
            { const int q = tid + 256, row = q >> 3, ch = q & 7; *(uint4*)(Bs_ + lds_off(row, ch)) = B##kt##_1; } \
            { const int q = tid + 512, row = q >> 3, ch = q & 7; *(uint4*)(Bs_ + lds_off(row, ch)) = B##kt##_2; } \
            { const int q = tid + 768, row = q >> 3, ch = q & 7; *(uint4*)(Bs_ + lds_off(row, ch)) = B##kt##_3; } \
        } else { \
            CO_PUT(0, make_uint2(B##kt##_0.x, B##kt##_0.y)) CO_PUT(1, make_uint2(B##kt##_0.z, B##kt##_0.w)) \
            CO_PUT(2, make_uint2(B##kt##_1.x, B##kt##_1.y)) CO_PUT(3, make_uint2(B##kt##_1.z, B##kt##_1.w)) \
            CO_PUT(4, make_uint2(B##kt##_2.x, B##kt##_2.y)) CO_PUT(5, make_uint2(B##kt##_2.z, B##kt##_2.w)) \
            CO_PUT(6, make_uint2(B##kt##_3.x, B##kt##_3.y)) CO_PUT(7, make_uint2(B##kt##_3.z, B##kt##_3.w)) } }
#define CO_MMA(buf) { const unsigned char* As_ = smem + (buf) * 24576; const unsigned char* Bs_ = As_ + 8192; \
        _Pragma("unroll") for (int ks = 0; ks < 4; ++ks) { const bf16x8 fa = frag_ld(As_, wr * 32 + (lane & 31), ks, lane); \
            _Pragma("unroll") for (int j = 0; j < 2; ++j) acc[j] = __builtin_amdgcn_mfma_f32_32x32x16_bf16(fa, frag_ld(Bs_, wc * 64 + j * 32 + (lane & 31), ks, lane), acc[j], 0, 0, 0); } }
    HSYNC();
    CO_STAGE(0, 0) CO_STAGE(1, 1)
    HSYNC();
    CO_MMA(0) CO_MMA(1)
    if (NKT == 3) {
        HSYNC();
        CO_STAGE(2, 0)
        HSYNC();
        CO_MMA(0)
    }
#pragma unroll
    for (int r = 0; r < 16; ++r) {
        float s1 = acc[0][r] + acc[1][r], s2 = acc[0][r] * acc[0][r] + acc[1][r] * acc[1][r];
#pragma unroll
        for (int o = 16; o >= 1; o >>= 1) { s1 += __shfl_xor(s1, o); s2 += __shfl_xor(s2, o); }
        if ((lane & 31) == 0) { const int row = wr * 32 + (r & 3) + 8 * (r >> 2) + 4 * (lane >> 5); red[(row * 2 + wc) * 2] = s1; red[(row * 2 + wc) * 2 + 1] = s2; }
    }
    HSYNC();
    bf16_t* mixed = (bf16_t*)(P.ws + WS_MIXED);
#pragma unroll
    for (int r = 0; r < 16; ++r) {
        const int row = wr * 32 + (r & 3) + 8 * (r >> 2) + 4 * (lane >> 5);
        const float s1 = red[row * 4] + red[row * 4 + 2], s2 = red[row * 4 + 1] + red[row * 4 + 3];
        const size_t t = tok0 + row;
#pragma unroll
        for (int j = 0; j < 2; ++j) {
            const int dv = wc * 64 + j * 32 + (lane & 31);
            float y;
            if (!RET) {
                const float rs = rsqrtf(s2 * (1.f / 128.f) + EPS);
                y = acc[j][r] * rs * P.dn_norm[dv] * silu_f(bf2f((bf16_t)gz[j][r]));
                mixed[t * D + h * 128 + dv] = f2bf(y);
            } else {
                const float mu = s1 * (1.f / 128.f);
                const float var = fmaxf(s2 * (1.f / 128.f) - mu * mu, 0.f);
                const float rs = rsqrtf(var + EPS);
                y = ((acc[j][r] - mu) * rs * P.ret_gn_w[h * 128 + dv] + P.ret_gn_b[h * 128 + dv]) * silu_f(bf2f((bf16_t)gz[j][r]));
                mixed[t * D + 1024 + h * 128 + dv] = f2bf(y);
            }
        }
    }
}

__device__ __forceinline__ void phase_chunk3(const Params& P, int bid, int nb, unsigned char* smem) {
    for (int u0 = bid; u0 < 2048; u0 += nb) { const int u = (bid & 1) ? ((u0 + 1024) & 2047) : u0; if (u < 1024) chunk_out<128, false>(P, u, smem); else chunk_out<64, true>(P, u - 1024, smem); }
}

__device__ __forceinline__ void ins16(float (&l)[16], float x) {
#pragma unroll
    for (int i = 0; i < 16; ++i) { const float hi = fmaxf(l[i], x); x = fminf(l[i], x); l[i] = hi; }
}
__device__ __forceinline__ void ins16x2(float (&l)[16], float xa, float xb) {
#pragma unroll
    for (int i = 0; i < 16; ++i) {
        const float h1 = fmaxf(l[i], xa); xa = fminf(l[i], xa);
        const float h2 = fmaxf(h1, xb); xb = fminf(h1, xb);
        l[i] = h2;
    }
}
__device__ __forceinline__ void phase_route(const Params& P, int bid, int nb, unsigned char* smem) {
    int* idx = (int*)(P.ws + WS_IDX); float* gates = (float*)(P.ws + WS_GATES);
    const bf16_t* Q = (const bf16_t*)(P.ws + WS_Q); const bf16_t* KEYS = (const bf16_t*)(P.ws + WS_KEYS);
    int tid_ = VTID; asm volatile("" : "+v"(tid_));
    const int tid = tid_, wave = tid >> 6, lane = tid & 63, fr = lane & 15, fq = lane >> 4;
    float* tile = (float*)smem;
    unsigned* L = (unsigned*)(smem + 256 * 33 * 4);
    const float NEG = -3.0e38f;
    for (int u = bid; u < 512; u += nb) {
        const size_t R0 = (size_t)u * 256;
        const size_t t0 = (size_t)u * 16;
        bf16x8 af[4][4];
#pragma unroll
        for (int j = 0; j < 4; ++j)
#pragma unroll
            for (int ks = 0; ks < 4; ++ks) af[j][ks] = *(const bf16x8*)(Q + (t0 + fr) * D + (4 * wave + j) * 128 + ks * 32 + fq * 8);
        float l[16];
#pragma unroll
        for (int i = 0; i < 16; ++i) l[i] = NEG;
        bf16x8 bq[2][2][4];
#define ROUTE_LOADB(chh, j0) _Pragma("unroll") for (int j = 0; j < 2; ++j) _Pragma("unroll") for (int nt = 0; nt < 2; ++nt) _Pragma("unroll") for (int ks = 0; ks < 4; ++ks) \
            bq[j][nt][ks] = *(const bf16x8*)(KEYS + (size_t)((4 * wave + (j0) + j) * 128 + (chh) * 32 + nt * 16 + fr) * 128 + ks * 32 + fq * 8);
#define ROUTE_MMA(j0) _Pragma("unroll") for (int j = 0; j < 2; ++j) _Pragma("unroll") for (int nt = 0; nt < 2; ++nt) { \
            f32x4 acc = {0.f, 0.f, 0.f, 0.f}; \
            _Pragma("unroll") for (int ks = 0; ks < 4; ++ks) acc = __builtin_amdgcn_mfma_f32_16x16x32_bf16(af[(j0) + j][ks], bq[j][nt][ks], acc, 0, 0, 0); \
            _Pragma("unroll") for (int jj = 0; jj < 4; ++jj) tile[((fq * 4 + jj) * 16 + 4 * wave + (j0) + j) * 33 + nt * 16 + fr] = acc[jj]; }
        ROUTE_LOADB(0, 0)
        for (int ch = 0; ch < 4; ++ch) {
            HSYNC();
            ROUTE_MMA(0)
            ROUTE_LOADB(ch, 2)
            ROUTE_MMA(2)
            if (ch < 3) { ROUTE_LOADB(ch + 1, 0) }
            HSYNC();
#pragma unroll
            for (int j = 0; j < 32; j += 2) {
                const float xa = __uint_as_float((__float_as_uint(tile[tid * 33 + j]) & ~0x7Fu) | (unsigned)(ch * 32 + j));
                const float xb = __uint_as_float((__float_as_uint(tile[tid * 33 + j + 1]) & ~0x7Fu) | (unsigned)(ch * 32 + j + 1));
                ins16x2(l, xa, xb);
            }
        }
#pragma unroll
        for (int i = 0; i < 16; ++i) L[tid * 16 + i] = __float_as_uint(l[i]);
        HSYNC();
        const int pe = tid & ~1, po = tid | 1;
        float s1[16], s2[16];
#pragma unroll
        for (int i = 0; i < 16; ++i) { s1[i] = __uint_as_float(L[pe * 16 + i]); s2[i] = __uint_as_float(L[po * 16 + i]); }
        float m[16];
#pragma unroll
        for (int i = 0; i < 16; ++i) m[i] = NEG;
#pragma unroll
        for (int i = 0; i < 16; ++i)
#pragma unroll
            for (int j = 0; j < 16; ++j)
                if ((i + 1) * (j + 1) <= 16) ins16(m, __uint_as_float((__float_as_uint(s1[i] + s2[j]) & ~0xFFu) | (unsigned)(i * 16 + j)));
        float e[16], sum = 0.f;
#pragma unroll
        for (int r = 0; r < 16; ++r) { e[r] = __expf(m[r] - m[0]); sum += e[r]; }
        const float inv = 1.f / sum;
        const int par = tid & 1;
        const size_t ob = ((R0 + tid) >> 1) * 16 + par * 8;
#pragma unroll
        for (int r = 0; r < 8; ++r) {
            float k_lo = m[r], k_hi = m[r + 8], e_lo = e[r], e_hi = e[r + 8];
            asm volatile("" : "+v"(k_lo), "+v"(k_hi), "+v"(e_lo), "+v"(e_hi));
            const float key = par ? k_hi : k_lo;
            const float ev = par ? e_hi : e_lo;
            const unsigned cand = __float_as_uint(key) & 0xFFu;
            const unsigned i1 = L[pe * 16 + (cand >> 4)] & 0x7Fu, i2 = L[po * 16 + (cand & 15)] & 0x7Fu;
            idx[ob + r] = (int)(i1 * 128 + i2);
            gates[ob + r] = ev * inv;
        }
    }
}

typedef float f32x2 __attribute__((ext_vector_type(2)));
typedef float v32f __attribute__((ext_vector_type(32)));
typedef float v16f __attribute__((ext_vector_type(16)));
typedef unsigned v6u __attribute__((ext_vector_type(6)));
constexpr int EROW = 1536;
__device__ __forceinline__ void fp6_calibrate(int (&sig)[32]) {
    v16f tlo, thi;
#pragma unroll
    for (int i = 0; i < 16; ++i) { tlo[i] = (i < 8) ? 0.125f * i : 1.f + 0.125f * (i - 8); thi[i] = (i < 8) ? 2.f + 0.25f * i : 4.f + 0.5f * (i - 8); }
    asm volatile("" : "+v"(tlo), "+v"(thi));
    const v6u tw = __builtin_amdgcn_cvt_scalef32_2xpk16_fp6_f32(tlo, thi, 1.0f);
    const v32f tr = __builtin_amdgcn_cvt_scalef32_pk32_f32_fp6(tw, 1.0f);
#pragma unroll
    for (int j = 0; j < 32; ++j) {
        const float v = tr[j];
        const int k = v < 2.f ? (int)(v * 8.f + 0.5f) : (v < 4.f ? 16 + (int)((v - 2.f) * 4.f + 0.5f) : 24 + (int)((v - 4.f) * 2.f + 0.5f));
        sig[j] = __builtin_amdgcn_readfirstlane(k) & 31;
    }
}
__device__ __forceinline__ void phase_econv(const Params& P, int bid, int nb, unsigned char* smem) {
    int tid_ = VTID; asm volatile("" : "+v"(tid_));
    const int wave = tid_ >> 6, lane = tid_ & 63;
    float* scales = (float*)(P.ws + WS_ESC);
    bool fp4_natural;
    { float ta = 1.0f, tb = 2.0f; asm volatile("" : "+v"(ta), "+v"(tb));
      const unsigned tw = __builtin_amdgcn_cvt_scalef32_pk_fp4_f32(0u, ta, tb, 1.0f, 0);
      const f32x2 tr = __builtin_amdgcn_cvt_scalef32_pk_f32_fp4(tw, 1.0f, 0);
      fp4_natural = __builtin_amdgcn_readfirstlane(tr[0] == 1.0f ? 1 : 0) != 0; }
    for (int r = bid * 4 + wave; r < 32768; r += nb * 4) {
        const bool isv = r >= 16384;
        const float* src = (isv ? P.expert_v : P.expert_u) + (size_t)(r & 16383) * D + lane * 32;
        f32x4 v[8]; float am = 0.f;
#pragma unroll
        for (int i = 0; i < 8; ++i) { v[i] = *(const f32x4*)(src + i * 4); am = fmaxf(am, fmaxf(fmaxf(fabsf(v[i][0]), fabsf(v[i][1])), fmaxf(fabsf(v[i][2]), fabsf(v[i][3])))); }
        am = wave_max(am);
        {
            unsigned char* dst = (isv ? P.ws + WS_EV4 + (size_t)(r - 16384) * 1024 : P.ws + WS_EU8 + (size_t)r * 1024) + lane * 16;
            const float sc = am > 0.f ? 6.0f / (0.8f * am) : 1.f;
            unsigned w[4] = {0u, 0u, 0u, 0u};
#define FP4_PK(i, bs) { const float a = v[(i) >> 1][((i) & 1) * 2] * sc, b = v[(i) >> 1][((i) & 1) * 2 + 1] * sc; \
                w[(i) >> 2] = __builtin_amdgcn_cvt_scalef32_pk_fp4_f32(w[(i) >> 2], fp4_natural ? a : b, fp4_natural ? b : a, 1.0f, bs); }
            FP4_PK(0, 0) FP4_PK(1, 1) FP4_PK(2, 2) FP4_PK(3, 3) FP4_PK(4, 0) FP4_PK(5, 1) FP4_PK(6, 2) FP4_PK(7, 3)
            FP4_PK(8, 0) FP4_PK(9, 1) FP4_PK(10, 2) FP4_PK(11, 3) FP4_PK(12, 0) FP4_PK(13, 1) FP4_PK(14, 2) FP4_PK(15, 3)
            *(uint4*)dst = make_uint4(w[0], w[1], w[2], w[3]);
            if (lane == 0) scales[r] = am > 0.f ? (0.8f * am) * (1.f / 6.0f) : 1.f;
        }
    }
}

__device__ __forceinline__ float gelu_f(float d) { return 0.5f * d * (1.f + erff(d * 0.70710678118654752f)); }

template <bool DRY>
__device__ __forceinline__ void phase_peer(const Params& P, int bid, int nb, int unit_lo = 0, int unit_hi = 512, int unit_step = 0) {
    const bf16_t* hn = (const bf16_t*)(P.ws + WS_HN); const int* idx = (const int*)(P.ws + WS_IDX); const float* gates = (const float*)(P.ws + WS_GATES);
    bf16_t* H = (bf16_t*)(P.ws + WS_H);
    const unsigned char* EU = P.ws + WS_EU8; const unsigned char* EV = P.ws + WS_EV4; const float* SC = (const float*)(P.ws + WS_ESC);
    const int wave = VTID >> 6, lane = VTID & 63;
    if (unit_step == 0) { unit_lo = bid; unit_step = nb; }
    for (int uu = unit_lo; uu < unit_hi; uu += unit_step)
    for (int tk = 0; tk < 4; ++tk) {
        const int t = uu * 16 + wave * 4 + tk;
        v32f acc; float xr[32];
#pragma unroll
        for (int q = 0; q < 4; ++q) {
            const uint4 v = *(const uint4*)(hn + (size_t)t * D + lane * 32 + q * 8);
            const unsigned ww[4] = {v.x, v.y, v.z, v.w};
#pragma unroll
            for (int j = 0; j < 4; ++j) { xr[q * 8 + 2 * j] = __uint_as_float(ww[j] << 16); xr[q * 8 + 2 * j + 1] = __uint_as_float(ww[j] & 0xffff0000u); }
        }
#pragma unroll
        for (int i = 0; i < 32; ++i) acc[i] = 0.f;
        const float rs_t = rsqrtf(((const float*)(P.ws + WS_RSS))[t] * (1.f / 2048.f) + EPS);
        const int   my_i0 = idx[(size_t)t * 128 + lane],   my_i1 = idx[(size_t)t * 128 + 64 + lane];
        const float my_g0 = gates[(size_t)t * 128 + lane], my_g1 = gates[(size_t)t * 128 + 64 + lane];
        uint4 U0, U1, U2, U3, U4, U5, U6, U7;
        uint4 V0, V1, V2, V3, V4, V5, V6, V7;
#define PEER_E(k) ((k) < 64 ? __builtin_amdgcn_readlane(my_i0, (k)) : __builtin_amdgcn_readlane(my_i1, (k) - 64))
#define PEER_LDU(j, kk) { const unsigned o_ = (unsigned)PEER_E(kk) * 1024u + lane16; U##j = *(const uint4*)(EU + o_); }
#define PEER_LDV(j, kk) { const unsigned o_ = (unsigned)PEER_E(kk) * 1024u + lane16; V##j = *(const uint4*)(EV + o_); }
#define PEER_DOT(j, dst) { const unsigned uw[4] = {U##j.x, U##j.y, U##j.z, U##j.w}; float d = 0.f; \
        _Pragma("unroll") for (int q = 0; q < 4; ++q) { \
            const f32x2 f0 = __builtin_amdgcn_cvt_scalef32_pk_f32_fp4(uw[q], 1.0f, 0), f1 = __builtin_amdgcn_cvt_scalef32_pk_f32_fp4(uw[q], 1.0f, 1), \
                        f2 = __builtin_amdgcn_cvt_scalef32_pk_f32_fp4(uw[q], 1.0f, 2), f3 = __builtin_amdgcn_cvt_scalef32_pk_f32_fp4(uw[q], 1.0f, 3); \
            d += f0[0] * xr[q * 8] + f0[1] * xr[q * 8 + 1] + f1[0] * xr[q * 8 + 2] + f1[1] * xr[q * 8 + 3]; \
            d += f2[0] * xr[q * 8 + 4] + f2[1] * xr[q * 8 + 5] + f3[0] * xr[q * 8 + 6] + f3[1] * xr[q * 8 + 7]; } \
        dst = d; __builtin_amdgcn_sched_barrier(0); }
#define PEER_AXPY(j, aj) { const unsigned vw[4] = {V##j.x, V##j.y, V##j.z, V##j.w}; \
        _Pragma("unroll") for (int q = 0; q < 4; ++q) { \
            const f32x2 f0 = __builtin_amdgcn_cvt_scalef32_pk_f32_fp4(vw[q], 1.0f, 0), f1 = __builtin_amdgcn_cvt_scalef32_pk_f32_fp4(vw[q], 1.0f, 1), \
                        f2 = __builtin_amdgcn_cvt_scalef32_pk_f32_fp4(vw[q], 1.0f, 2), f3 = __builtin_amdgcn_cvt_scalef32_pk_f32_fp4(vw[q], 1.0f, 3); \
            acc[q * 8] += (aj) * f0[0]; acc[q * 8 + 1] += (aj) * f0[1]; acc[q * 8 + 2] += (aj) * f1[0]; acc[q * 8 + 3] += (aj) * f1[1]; \
            acc[q * 8 + 4] += (aj) * f2[0]; acc[q * 8 + 5] += (aj) * f2[1]; acc[q * 8 + 6] += (aj) * f3[0]; acc[q * 8 + 7] += (aj) * f3[1]; } __builtin_amdgcn_sched_barrier(0); }
        const unsigned lane16 = (unsigned)lane * 16u;
        PEER_LDU(0, 0) PEER_LDU(1, 1) PEER_LDU(2, 2) PEER_LDU(3, 3) PEER_LDU(4, 4) PEER_LDU(5, 5) PEER_LDU(6, 6) PEER_LDU(7, 7)
        PEER_LDV(0, 0) PEER_LDV(1, 1) PEER_LDV(2, 2) PEER_LDV(3, 3) PEER_LDV(4, 4) PEER_LDV(5, 5) PEER_LDV(6, 6) PEER_LDV(7, 7)
        const bool b5 = (lane & 32) != 0, b4 = (lane & 16) != 0, b3 = (lane & 8) != 0;
        for (int k0 = 0; k0 < 128; k0 += 8) {
            const bool more = k0 + 8 < 128;
            float p0, p1, p2, p3, p4, p5, p6, p7;
            PEER_DOT(0, p0)
            PEER_DOT(1, p1)
            PEER_DOT(2, p2)
            PEER_DOT(3, p3)
            PEER_DOT(4, p4)
            PEER_DOT(5, p5)
            PEER_DOT(6, p6)
            PEER_DOT(7, p7)
            const float q0 = (b5 ? p4 : p0) + __shfl_xor(b5 ? p0 : p4, 32), q1 = (b5 ? p5 : p1) + __shfl_xor(b5 ? p1 : p5, 32);
            const float q2 = (b5 ? p6 : p2) + __shfl_xor(b5 ? p2 : p6, 32), q3 = (b5 ? p7 : p3) + __shfl_xor(b5 ? p3 : p7, 32);
            const float r0 = (b4 ? q2 : q0) + __shfl_xor(b4 ? q0 : q2, 16), r1 = (b4 ? q3 : q1) + __shfl_xor(b4 ? q1 : q3, 16);
            float dt = (b3 ? r1 : r0) + __shfl_xor(b3 ? r0 : r1, 8);
            dt += __shfl_xor(dt, 4); dt += __shfl_xor(dt, 2); dt += __shfl_xor(dt, 1);
            const int src_lane = (k0 & 63) + (lane >> 3);
            const int e_l = __shfl(k0 < 64 ? my_i0 : my_i1, src_lane);
            const float g_l = __shfl(k0 < 64 ? my_g0 : my_g1, src_lane);
            const float pre = dt * SC[e_l] * rs_t;
            const int a_l = __float_as_int(gelu_f(pre) * g_l * SC[16384 + e_l]);
            { const float a0 = __int_as_float(__builtin_amdgcn_readlane(a_l, 0));  PEER_AXPY(0, a0) if (more) { PEER_LDV(0, k0 + 8) PEER_LDU(0, k0 + 8) } }
            { const float a1 = __int_as_float(__builtin_amdgcn_readlane(a_l, 8));  PEER_AXPY(1, a1) if (more) { PEER_LDV(1, k0 + 9) PEER_LDU(1, k0 + 9) } }
            { const float a2 = __int_as_float(__builtin_amdgcn_readlane(a_l, 16)); PEER_AXPY(2, a2) if (more) { PEER_LDV(2, k0 + 10) PEER_LDU(2, k0 + 10) } }
            { const float a3 = __int_as_float(__builtin_amdgcn_readlane(a_l, 24)); PEER_AXPY(3, a3) if (more) { PEER_LDV(3, k0 + 11) PEER_LDU(3, k0 + 11) } }
            { const float a4 = __int_as_float(__builtin_amdgcn_readlane(a_l, 32)); PEER_AXPY(4, a4) if (more) { PEER_LDV(4, k0 + 12) PEER_LDU(4, k0 + 12) } }
            { const float a5 = __int_as_float(__builtin_amdgcn_readlane(a_l, 40)); PEER_AXPY(5, a5) if (more) { PEER_LDV(5, k0 + 13) PEER_LDU(5, k0 + 13) } }
            { const float a6 = __int_as_float(__builtin_amdgcn_readlane(a_l, 48)); PEER_AXPY(6, a6) if (more) { PEER_LDV(6, k0 + 14) PEER_LDU(6, k0 + 14) } }
            { const float a7 = __int_as_float(__builtin_amdgcn_readlane(a_l, 56)); PEER_AXPY(7, a7) if (more) { PEER_LDV(7, k0 + 15) PEER_LDU(7, k0 + 15) } }
        }
        if (DRY) {
#pragma unroll
            for (int i = 0; i < 32; ++i) asm volatile("" :: "v"(acc[i]));
            continue;
        }
        float ss = 0.f;
#pragma unroll
        for (int q = 0; q < 4; ++q) {
            uint4* hp = (uint4*)(H + (size_t)t * D + lane * 32 + q * 8);
            const uint4 hv = *hp; const unsigned hw[4] = {hv.x, hv.y, hv.z, hv.w}; unsigned ow[4];
#pragma unroll
            for (int j = 0; j < 4; ++j) {
                const float a = __uint_as_float(hw[j] << 16) + acc[q * 8 + 2 * j], b = __uint_as_float(hw[j] & 0xffff0000u) + acc[q * 8 + 2 * j + 1];
                acc[q * 8 + 2 * j] = a; acc[q * 8 + 2 * j + 1] = b; ss += a * a + b * b; ow[j] = pack2(a, b);
            }
            *hp = make_uint4(ow[0], ow[1], ow[2], ow[3]);
        }
        ss = wave_sum(ss);
        const float rs = rsqrtf(ss * (1.f / 2048.f) + EPS);
        bf16_t* hn3 = (bf16_t*)(P.ws + WS_HN) + (size_t)t * D + lane * 32;
#pragma unroll
        for (int q = 0; q < 4; ++q) {
            unsigned w[4];
#pragma unroll
            for (int j = 0; j < 4; ++j) { const int col = lane * 32 + q * 8 + 2 * j;
                w[j] = pack2(acc[q * 8 + 2 * j] * rs * P.norm_ple[col], acc[q * 8 + 2 * j + 1] * rs * P.norm_ple[col + 1]); }
            *(uint4*)(hn3 + q * 8) = make_uint4(w[0], w[1], w[2], w[3]);
        }
    }
}

enum { PH_PREP = 0, PH_GEMM1, PH_CHUNK1, PH_SCAN, PH_CHUNK3, PH_GEMM2, PH_GEMM3, PH_ROUTE, PH_PEER, PH_GEMM4, PH_FINAL, PH_COUNT };

#define XB_TMO      128
#define XB_XCNT(j)  (256  + 64 * (j))
#define XB_XSUB(j)  (1280 + 64 * (j))
#define XB_XGEN(j)  (2304 + 64 * (j))
#define XB_TOP      3328
#define XB_TOPGEN   3392
#define XCD_BAR_WORDS 3456
#define XB_SPIN_CAP (1u << 20)
#define LAS __attribute__((address_space(3)))
__device__ __forceinline__ unsigned xb_ld(unsigned* p)              { return __hip_atomic_load(p, __ATOMIC_RELAXED, __HIP_MEMORY_SCOPE_AGENT); }
__device__ __forceinline__ unsigned xb_add(unsigned* p, unsigned v) { return __hip_atomic_fetch_add(p, v, __ATOMIC_RELAXED, __HIP_MEMORY_SCOPE_AGENT); }
__device__ __forceinline__ unsigned xb_xcc_id() { return (unsigned)__builtin_amdgcn_s_getreg((3 << 11) | 20) & 0xFu; }
#define XB_SPIN(cond, bar) do { unsigned _sp = 0; while (cond) { __builtin_amdgcn_s_sleep(1); \
    if ((++_sp & 255u) == 0u) { if (xb_ld(&(bar)[XB_TMO])) break; if (_sp > XB_SPIN_CAP) { atomicAdd(&(bar)[XB_TMO], 1u); break; } } } } while (0)
struct XcdBarrier { unsigned* bar; unsigned x; volatile LAS unsigned* st; };
__device__ __forceinline__ XcdBarrier xcd_barrier_post(unsigned* bar, volatile LAS unsigned* st) {
    XcdBarrier b; b.bar = bar; b.x = xb_xcc_id(); b.st = st;
    if (threadIdx.x == 0) (void)xb_add(&bar[XB_XCNT(b.x)], 1u);
    return b;
}
__device__ __forceinline__ void xcd_barrier_complete(unsigned* bar, unsigned x, unsigned& nloc, unsigned& nx) {
    const unsigned G = gridDim.x * gridDim.y * gridDim.z;
    unsigned sum, cnt, mine, sp = 0u;
    for (;;) {
        sum = 0u; cnt = 0u; mine = 0u;
#pragma unroll
        for (unsigned j = 0; j < 16; ++j) { const unsigned c = xb_ld(&bar[XB_XCNT(j)]); sum += c; cnt += (c > 0u) ? 1u : 0u; mine = (j == x) ? c : mine; }
        if (sum == G) break;
        __builtin_amdgcn_s_sleep(1);
        if ((++sp & 255u) == 0u) { if (xb_ld(&bar[XB_TMO])) break; if (sp > XB_SPIN_CAP) { atomicAdd(&bar[XB_TMO], 1u); break; } }
    }
    nloc = mine > 0u ? mine : 1u; nx = cnt > 0u ? cnt : 1u;
}
__device__ __forceinline__ void xcd_barrier(const XcdBarrier& b) {
    asm volatile("s_waitcnt vmcnt(0)" ::: "memory");
    __syncthreads();
    if (threadIdx.x == 0) {
        unsigned* bar = b.bar;
        __builtin_amdgcn_s_waitcnt(0);
        unsigned nloc = b.st[0], nx = b.st[1];
        if (nloc == 0u) { xcd_barrier_complete(bar, b.x, nloc, nx); b.st[0] = nloc; b.st[1] = nx; }
        const unsigned old = xb_add(&bar[XB_XSUB(b.x)], 1u);
        const unsigned gen = old / nloc;
        if (old + 1u == (gen + 1u) * nloc) {
            __builtin_amdgcn_fence(__ATOMIC_RELEASE, "agent");
            asm volatile("s_waitcnt vmcnt(0)" ::: "memory");
            const unsigned og = xb_add(&bar[XB_TOP], 1u);
            const unsigned tg = og / nx;
            if (og + 1u == (tg + 1u) * nx) xb_add(&bar[XB_TOPGEN], 1u);
            else XB_SPIN(xb_ld(&bar[XB_TOPGEN]) == tg, bar);
            __builtin_amdgcn_fence(__ATOMIC_ACQUIRE, "agent");
            xb_add(&bar[XB_XGEN(b.x)], 1u);
            asm volatile("s_waitcnt vmcnt(0)" ::: "memory");
        } else {
            XB_SPIN(xb_ld(&bar[XB_XGEN(b.x)]) == gen, bar);
            __builtin_amdgcn_fence(__ATOMIC_ACQUIRE, "agent");
            asm volatile("s_waitcnt vmcnt(0)" ::: "memory");
        }
    }
    __syncthreads();
}

__device__ __forceinline__ void run_phase(const Params& P, int ph, int bid, int nb, unsigned char* smem, int rbid, int rnb, unsigned char* rsmem) {
    switch (ph) {
        case PH_PREP:   phase_prep(P, bid, nb, smem); break;
        case PH_GEMM1:  phase_gemm1(P, rbid, rnb, rsmem); break;
        case PH_CHUNK1: phase_chunk1(P, bid, nb, smem); break;
        case PH_SCAN:   phase_scan(P, bid, nb, smem, rbid, rnb, rsmem); break;
        case PH_CHUNK1 + 100: phase_chunk1(P, bid, nb, smem, 1); break;
        case PH_CHUNK1 + 200: phase_chunk1(P, bid, nb, smem, 2); break;
        case PH_SCAN + 100: phase_scan(P, bid, nb, smem, rbid, rnb, rsmem, 1); break;
        case PH_SCAN + 200: phase_scan(P, bid, nb, smem, rbid, rnb, rsmem, 2); break;
        case PH_CHUNK3: phase_chunk3(P, bid, nb, smem); break;
        case PH_GEMM2:  phase_gemm2(P, rbid, rnb, rsmem); break;
        case PH_GEMM3:  phase_gemm3(P, rbid, rnb, rsmem); break;
        case PH_ROUTE:
                        for (int u = bid; u < 512; u += nb) {
                            phase_route(P, u, 512, smem);
                            asm volatile("s_waitcnt vmcnt(0)" ::: "memory"); HSYNC();
                            phase_peer<false>(P, bid, nb, u, u + 1, 1);
                        }
                        break;
        case PH_PEER:   break;
        case PH_PEER + 100: phase_peer<true>(P, bid, nb); break;
        case PH_GEMM4:  phase_gemm4(P, rbid, rnb, rsmem); break;
        case PH_FINAL:  phase_final(P, bid, nb); break;
    }
}

#ifndef PROBE_A
#define PROBE_A -1
#endif
#ifndef PROBE_B
#define PROBE_B -1
#endif
constexpr int LDS_BYTES = 131072 + 16 + 256 + 16 + 128;

__global__ void __launch_bounds__(512, 2) fwd_kernel(Params P, int ph_lo, int ph_hi) {
    extern __shared__ __attribute__((aligned(16))) unsigned char rsmem[];
    const int rbid = blockIdx.x, rnb = gridDim.x;
    const int half = __builtin_amdgcn_readfirstlane((int)(threadIdx.x >> 8));
    const int bid = rbid * 2 + half, nb = rnb * 2;
    unsigned char* smem = rsmem + half * 65536;
    volatile LAS unsigned* st = (volatile LAS unsigned*)(rsmem + 131072);
    if (threadIdx.x == 0) { st[0] = 0u; st[1] = 0u; *(volatile LAS unsigned*)(rsmem + 131072 + 288) = 0u; *(volatile LAS unsigned*)(rsmem + 131072 + 288 + 64) = 0u; }
    __syncthreads();
    XcdBarrier xb = xcd_barrier_post((unsigned*)(P.ws + WS_BAR), st);
#if PROBE_A >= 0
    unsigned long long* tstamp = (unsigned long long*)(rsmem + 131072 + 16);
    xcd_barrier(xb);
    if (threadIdx.x == 0) tstamp[0] = __builtin_amdgcn_s_memrealtime();
#define RUN(ph) if (ph_lo <= (ph) && (ph) < ph_hi) { run_phase(P, (ph), bid, nb, smem, rbid, rnb, rsmem); xcd_barrier(xb); if (threadIdx.x == 0) tstamp[(ph) + 1] = __builtin_amdgcn_s_memrealtime(); }
#else
#ifndef SCAN_PROBE
#define SCAN_PROBE 0
#endif
#ifndef REPEAT_PH
#define REPEAT_PH -1
#endif
#define RUN(ph) if (ph_lo <= (ph) && (ph) < ph_hi) { if ((ph) == REPEAT_PH && (ph) == PH_PEER) { run_phase(P, PH_PEER + 100, bid, nb, smem, rbid, rnb, rsmem); xcd_barrier(xb); } run_phase(P, (ph), bid, nb, smem, rbid, rnb, rsmem); if ((ph) == REPEAT_PH && (ph) != PH_PEER) { xcd_barrier(xb); run_phase(P, ((ph) == PH_SCAN || (ph) == PH_CHUNK1) ? (ph) + SCAN_PROBE : (ph), bid, nb, smem, rbid, rnb, rsmem); } if ((ph) + 1 < ph_hi) xcd_barrier(xb); }
#endif
    RUN(PH_PREP) RUN(PH_GEMM1) RUN(PH_CHUNK1) RUN(PH_SCAN) RUN(PH_CHUNK3) RUN(PH_GEMM2) RUN(PH_GEMM3) RUN(PH_ROUTE)
    RUN(PH_GEMM4) RUN(PH_FINAL)
#if PROBE_A >= 0
    __syncthreads();
    if (rbid == 0) {
        const float da = (float)(tstamp[PROBE_A + 1] - tstamp[PROBE_A]) * 0.01f;
        if (threadIdx.x == 0) P.out[0] = da;
#if PROBE_B >= 0
        const float db = (float)(tstamp[PROBE_B + 1] - tstamp[PROBE_B]) * 0.01f * (1.f / 16.f);
        for (int i = threadIdx.x; i < 65536; i += 512) P.out[65536 + i] = db;
#endif
    }
#endif
}

extern "C" void kernel_launch(void* const* d_in, const int* in_sizes, int n_in, void* d_out, int out_size, void* d_ws, size_t ws_size, hipStream_t stream) {
    static int grid = 0;
    if (grid == 0) {
        if (n_in != 21 || out_size != T * D || ws_size < WS_END) { fprintf(stderr, "kernel_launch: unexpected shapes: n_in %d out %d ws %zu (need %zu)\n", n_in, out_size, ws_size, (size_t)WS_END); grid = -1; return; }
        if (hipFuncSetAttribute((const void*)fwd_kernel, hipFuncAttributeMaxDynamicSharedMemorySize, LDS_BYTES) != hipSuccess) { fprintf(stderr, "kernel_launch: hipFuncSetAttribute failed\n"); grid = -1; return; }
        int dev = 0, cus = 0, per_cu = 0;
        hipGetDevice(&dev); hipDeviceGetAttribute(&cus, hipDeviceAttributeMultiprocessorCount, dev);
        if (hipOccupancyMaxActiveBlocksPerMultiprocessor(&per_cu, (const void*)fwd_kernel, 512, LDS_BYTES) != hipSuccess || per_cu < 1) { fprintf(stderr, "kernel_launch: occupancy query failed (%d)\n", per_cu); grid = -1; return; }
        if (per_cu > 1) per_cu = 1;
        grid = cus * per_cu;
        fprintf(stderr, "kernel_launch: grid %d (%d CUs x %d)\n", grid, cus, per_cu);
    }
    if (grid < 0) return;
    Params P{};
    P.x = (const float*)d_in[0]; P.p = (const float*)d_in[1]; P.positions = (const int*)d_in[2]; P.norm_mix = (const float*)d_in[3]; P.w_in = (const float*)d_in[4];
    P.conv_w = (const float*)d_in[5]; P.a_log = (const float*)d_in[6]; P.dt_bias = (const float*)d_in[7]; P.dn_norm = (const float*)d_in[8]; P.ret_gn_w = (const float*)d_in[9];
    P.ret_gn_b = (const float*)d_in[10]; P.w_out = (const float*)d_in[11]; P.norm_ffn = (const float*)d_in[12]; P.w_pq = (const float*)d_in[13]; P.sub_keys = (const float*)d_in[14];
    P.expert_u = (const float*)d_in[15]; P.expert_v = (const float*)d_in[16]; P.norm_ple = (const float*)d_in[17]; P.w_ple_gate = (const float*)d_in[18]; P.w_ple_proj = (const float*)d_in[19];
    P.norm_final = (const float*)d_in[20]; P.out = (float*)d_out; P.ws = (unsigned char*)d_ws;
    (void)hipMemsetAsync((unsigned char*)d_ws + WS_BAR, 0, XCD_BAR_WORDS * 4, stream);
    int lo = 0, hi = PH_COUNT;
    void* args[] = {&P, &lo, &hi};
    hipError_t e = hipLaunchCooperativeKernel((const void*)fwd_kernel, dim3(grid), dim3(512), args, LDS_BYTES, stream);
    if (e != hipSuccess) fprintf(stderr, "kernel_launch: cooperative launch failed: %s (grid %d)\n", hipGetErrorString(e), grid);
}
```

```cpp
#include <hip/hip_runtime.h>
#include <cstdio>
#include <cstdint>

typedef unsigned short bf16_t;
typedef short bf16x8 __attribute__((ext_vector_type(8)));
typedef float f32x16 __attribute__((ext_vector_type(16)));
typedef float f32x4 __attribute__((ext_vector_type(4)));
__device__ __forceinline__ int fresh_tid() { int t = (int)threadIdx.x; asm volatile("" : "+v"(t)); return t; }
#define VTID (fresh_tid() & 255)

constexpr int T = 8192, D = 2048, SEQ = 4096;
constexpr int NPROJ = 7424;
constexpr int C_Z = 3072, C_RQ = 4096, C_RK = 4608, C_RV = 5120, C_RG = 6144, C_A = 7168, C_B = 7176;
constexpr int IN_COLS = 7184;
constexpr float EPS = 1e-6f;

constexpr size_t WS_HN    = 0;
constexpr size_t WS_KVT   = WS_HN;
constexpr size_t WS_WTIN  = WS_HN + (size_t)T * D * 2;
constexpr size_t WS_STR   = WS_WTIN;
constexpr size_t WS_ATTR  = WS_STR + (size_t)1024 * 128 * 64 * 2;
constexpr size_t WS_WTOUT = WS_WTIN + (size_t)NPROJ * D * 2;
constexpr size_t WS_WTPQ  = WS_WTOUT + (size_t)D * D * 2;
constexpr size_t WS_WTG   = WS_WTPQ + (size_t)D * D * 2;
constexpr size_t WS_WTPP  = WS_WTG + (size_t)D * D * 2;
constexpr size_t WS_KEYS  = WS_WTPP + (size_t)D * 256 * 2;
constexpr size_t WS_PBF   = WS_KEYS + (size_t)16 * 128 * 128 * 2;
constexpr size_t WS_PROJ  = WS_PBF + (size_t)T * 256 * 2;
constexpr size_t WS_Q     = WS_PROJ;
constexpr size_t WS_SCORES= WS_PROJ + (size_t)T * D * 2;
constexpr size_t WS_MIXED = WS_PROJ + (size_t)T * NPROJ * 2;
constexpr size_t WS_H     = WS_MIXED + (size_t)T * D * 2;
constexpr size_t WS_IDX   = WS_H + (size_t)T * D * 4;
constexpr size_t WS_GATES = WS_IDX + (size_t)T * 128 * 4;
constexpr size_t WS_U     = WS_GATES + (size_t)T * 128 * 4;
constexpr size_t WS_W     = WS_U + (size_t)1024 * 64 * 128 * 4;
constexpr size_t WS_KDT   = WS_W + (size_t)1024 * 64 * 128 * 2;
constexpr size_t WS_QG    = WS_KDT + (size_t)1024 * 128 * 64 * 2;
constexpr size_t WS_ATT   = WS_QG + (size_t)1024 * 64 * 128 * 2;
constexpr size_t WS_QGR   = WS_ATT + (size_t)1024 * 64 * 64 * 2;
constexpr size_t WS_EU8   = WS_QGR + (size_t)1024 * 64 * 64 * 2;
constexpr size_t WS_EV4   = WS_EU8 + (size_t)16384 * 2048;
constexpr size_t WS_ESC   = WS_EV4 + (size_t)16384 * 2048;
constexpr size_t WS_EG    = WS_ESC + (size_t)2 * 16384 * 4;
constexpr size_t WS_RSS   = WS_EG + 4096;
constexpr size_t WS_BAR   = WS_RSS + (size_t)T * 4;
constexpr size_t WS_CS    = WS_BAR + 16384;
constexpr size_t WS_DUMMY = WS_CS + (size_t)T * 32 * 8;
constexpr size_t WS_END   = WS_DUMMY + 32768;
constexpr size_t WS_VNT   = WS_H;
constexpr size_t WS_SC    = WS_VNT + (size_t)1024 * 128 * 64 * 2;
constexpr size_t WS_VNTR  = WS_SC + (size_t)1024 * 128 * 128 * 2;
static_assert(WS_VNTR + (size_t)1024 * 128 * 64 * 2 == WS_H + (size_t)T * D * 4, "chunk buffers must fit the H region");

struct Params {
    const float *x, *p; const int* positions;
    const float *norm_mix, *w_in, *conv_w, *a_log, *dt_bias, *dn_norm, *ret_gn_w, *ret_gn_b, *w_out, *norm_ffn, *w_pq, *sub_keys,
                *expert_u, *expert_v, *norm_ple, *w_ple_gate, *w_ple_proj, *norm_final;
    float* out; unsigned char* ws;
};

typedef __bf16 bf16v2_t __attribute__((ext_vector_type(2)));
typedef float f32v2_t __attribute__((ext_vector_type(2)));
__device__ __forceinline__ bf16_t f2bf(float f) { return __builtin_bit_cast(bf16_t, (__bf16)f); }
__device__ __forceinline__ float bf2f(bf16_t h) { return __uint_as_float(((unsigned)h) << 16); }
__device__ __forceinline__ unsigned pack2(float a, float b) { const f32v2_t v = {a, b}; return __builtin_bit_cast(unsigned, __builtin_convertvector(v, bf16v2_t)); }
#define DPPF(v, ctrl) __int_as_float(__builtin_amdgcn_update_dpp(0, __float_as_int(v), (ctrl), 0xF, 0xF, false))
__device__ __forceinline__ float half_sum32(float v) {
    v += DPPF(v, 0x128); v += DPPF(v, 0x124); v += DPPF(v, 0x122); v += DPPF(v, 0x121);
    const auto r = __builtin_amdgcn_permlane16_swap(__float_as_uint(v), __float_as_uint(v), false, false);
    return __uint_as_float(r[0]) + __uint_as_float(r[1]);
}
__device__ __forceinline__ float wave_sum(float v) {
    v = half_sum32(v);
    const auto r = __builtin_amdgcn_permlane32_swap(__float_as_uint(v), __float_as_uint(v), false, false);
    return __uint_as_float(r[0]) + __uint_as_float(r[1]);
}
__device__ __forceinline__ float wave_max(float v) {
    v = fmaxf(v, DPPF(v, 0x128)); v = fmaxf(v, DPPF(v, 0x124)); v = fmaxf(v, DPPF(v, 0x122)); v = fmaxf(v, DPPF(v, 0x121));
    const auto r = __builtin_amdgcn_permlane16_swap(__float_as_uint(v), __float_as_uint(v), false, false);
    v = fmaxf(__uint_as_float(r[0]), __uint_as_float(r[1]));
    const auto r2 = __builtin_amdgcn_permlane32_swap(__float_as_uint(v), __float_as_uint(v), false, false);
    return fmaxf(__uint_as_float(r2[0]), __uint_as_float(r2[1]));
}
__device__ __forceinline__ float silu_f(float x) { return x * __builtin_amdgcn_rcpf(1.f + __expf(-x)); }
__device__ __forceinline__ float sigmoid_f(float x) { return __builtin_amdgcn_rcpf(1.f + __expf(-x)); }

#define LASP __attribute__((address_space(3)))
__device__ __forceinline__ void half_sync(const unsigned char* smem) {
    asm volatile("s_waitcnt lgkmcnt(0)" ::: "memory");
    const unsigned half = (((unsigned)(size_t)smem) >> 16) & 1u;
    LASP unsigned* cnt = (LASP unsigned*)(size_t)(131072u + 288u + 64u * half);
    unsigned old = 0u;
    if ((threadIdx.x & 63u) == 0u) old = __hip_atomic_fetch_add(cnt, 1u, __ATOMIC_RELAXED, __HIP_MEMORY_SCOPE_WORKGROUP);
    old = (unsigned)__builtin_amdgcn_readfirstlane((int)old);
    const unsigned tgt = (old / 4u + 1u) * 4u;
    while (__hip_atomic_load(cnt, __ATOMIC_RELAXED, __HIP_MEMORY_SCOPE_WORKGROUP) < tgt) __builtin_amdgcn_s_sleep(1);
    asm volatile("" ::: "memory");
}
#define HSYNC() half_sync(smem)

template <bool MAPIN>
__device__ __forceinline__ void transpose_tile(const float* __restrict__ W, int ldw, int K, bf16_t* __restrict__ Wt, int kt, int nt, float* tile  ) {
    const int tid = VTID;
    half_sync((const unsigned char*)tile);
#pragma unroll
    for (int i = 0; i < 4; ++i) {
        const int idx = tid + 256 * i, kr = idx >> 4, c4 = idx & 15;
        const int n = nt * 64 + c4 * 4;
        int c = n; bool valid = true;
        if (MAPIN) { if (n < 4096) c = n; else if (n < 7168) c = n + 16; else if (n < 7184) c = n - 3072; else valid = false; }
        f32x4 v = {0.f, 0.f, 0.f, 0.f};
        if (valid) v = *(const f32x4*)(W + (size_t)(kt * 64 + kr) * ldw + c);
        float* d = tile + kr * 65 + c4 * 4;
        d[0] = v[0]; d[1] = v[1]; d[2] = v[2]; d[3] = v[3];
    }
    half_sync((const unsigned char*)tile);
#pragma unroll
    for (int i = 0; i < 2; ++i) {
        const int ch = tid + 256 * i, n = ch >> 3, kc = ch & 7;
        unsigned w[4];
#pragma unroll
        for (int j = 0; j < 4; ++j) w[j] = pack2(tile[(kc * 8 + 2 * j) * 65 + n], tile[(kc * 8 + 2 * j + 1) * 65 + n]);
        uint4 o = make_uint4(w[0], w[1], w[2], w[3]);
        *(uint4*)(Wt + (size_t)(nt * 64 + n) * K + kt * 64 + kc * 8) = o;
    }
}

template <bool OUT_BF16>
__device__ __forceinline__ void rmsnorm_row(const float* __restrict__ in, const float* __restrict__ w, void* __restrict__ out, int lane) {
    f32x4 v[8]; float ss = 0.f;
#pragma unroll
    for (int i = 0; i < 8; ++i) { v[i] = *(const f32x4*)(in + (i * 64 + lane) * 4); ss += v[i][0] * v[i][0] + v[i][1] * v[i][1] + v[i][2] * v[i][2] + v[i][3] * v[i][3]; }
    ss = wave_sum(ss);
    const float r = rsqrtf(ss * (1.f / 2048.f) + EPS);
#pragma unroll
    for (int i = 0; i < 8; ++i) {
        const f32x4 g = *(const f32x4*)(w + (i * 64 + lane) * 4);
        const float a = v[i][0] * r * g[0], b = v[i][1] * r * g[1], c = v[i][2] * r * g[2], d = v[i][3] * r * g[3];
        if (OUT_BF16) { uint2 o = make_uint2(pack2(a, b), pack2(c, d)); *(uint2*)((bf16_t*)out + (i * 64 + lane) * 4) = o; }
        else { f32x4 o = {a, b, c, d}; *(f32x4*)((float*)out + (i * 64 + lane) * 4) = o; }
    }
}

__device__ __forceinline__ void phase_prep(const Params& P, int bid, int nb, unsigned char* smem) {
    float* tile = (float*)smem;
    const int tid = VTID;
    const int n_in = 32 * 116, n_sq = 32 * 32, n_pp = 4 * 32;
    const int n_tr = n_in + 3 * n_sq + n_pp;
    struct TrDesc { const float* W; bf16_t* Wt; int ldw, K, kt, nt, mapin; };
    auto tr_desc = [&](int u) {
        TrDesc d;
        if (u < n_in) { d.W = P.w_in; d.Wt = (bf16_t*)(P.ws + WS_WTIN); d.ldw = IN_COLS; d.K = D; d.kt = u % 32; d.nt = u / 32; d.mapin = 1; }
        else if (u < n_in + n_sq) { const int v = u - n_in; d.W = P.w_out; d.Wt = (bf16_t*)(P.ws + WS_WTOUT); d.ldw = D; d.K = D; d.kt = v % 32; d.nt = v / 32; d.mapin = 0; }
        else if (u < n_in + 2 * n_sq) { const int v = u - n_in - n_sq; d.W = P.w_pq; d.Wt = (bf16_t*)(P.ws + WS_WTPQ); d.ldw = D; d.K = D; d.kt = v % 32; d.nt = v / 32; d.mapin = 0; }
        else if (u < n_in + 3 * n_sq) { const int v = u - n_in - 2 * n_sq; d.W = P.w_ple_gate; d.Wt = (bf16_t*)(P.ws + WS_WTG); d.ldw = D; d.K = D; d.kt = v % 32; d.nt = v / 32; d.mapin = 0; }
        else { const int v = u - n_in - 3 * n_sq; d.W = P.w_ple_proj; d.Wt = (bf16_t*)(P.ws + WS_WTPP); d.ldw = D; d.K = 256; d.kt = v % 4; d.nt = v / 4; d.mapin = 0; }
        return d;
    };
    f32x4 tv0, tv1, tv2, tv3;
#define TR_LOAD1(d, i, dst) { const int idx = tid + 256 * (i), kr = idx >> 4, c4 = idx & 15; const int n = (d).nt * 64 + c4 * 4; int c = n; bool valid = true; \
        if ((d).mapin) { if (n < 4096) c = n; else if (n < 7168) c = n + 16; else if (n < 7184) c = n - 3072; else valid = false; } \
        dst = (f32x4){0.f, 0.f, 0.f, 0.f}; if (valid) dst = *(const f32x4*)((d).W + (size_t)((d).kt * 64 + kr) * (d).ldw + c); }
#define TR_LOAD(d) { TR_LOAD1(d, 0, tv0) TR_LOAD1(d, 1, tv1) TR_LOAD1(d, 2, tv2) TR_LOAD1(d, 3, tv3) }
#define TR_PUT(i, src) { const int idx = tid + 256 * (i), kr = idx >> 4, c4 = idx & 15; float* dd = tile + kr * 65 + c4 * 4; dd[0] = src[0]; dd[1] = src[1]; dd[2] = src[2]; dd[3] = src[3]; }
    if (bid < n_tr) { const TrDesc d0 = tr_desc(bid); TR_LOAD(d0) }
    for (int u = bid; u < n_tr; u += nb) {
        const TrDesc cur = tr_desc(u);
        half_sync((const unsigned char*)tile);
        TR_PUT(0, tv0) TR_PUT(1, tv1) TR_PUT(2, tv2) TR_PUT(3, tv3)
        if (u + nb < n_tr) { const TrDesc nx = tr_desc(u + nb); TR_LOAD(nx) }
        half_sync((const unsigned char*)tile);
#pragma unroll
        for (int i = 0; i < 2; ++i) {
            const int ch = tid + 256 * i, n = ch >> 3, kc = ch & 7;
            unsigned w[4];
#pragma unroll
            for (int j = 0; j < 4; ++j) w[j] = pack2(tile[(kc * 8 + 2 * j) * 65 + n], tile[(kc * 8 + 2 * j + 1) * 65 + n]);
            *(uint4*)(cur.Wt + (size_t)(cur.nt * 64 + n) * cur.K + cur.kt * 64 + kc * 8) = make_uint4(w[0], w[1], w[2], w[3]);
        }
    }
    {
        bf16_t* keys = (bf16_t*)(P.ws + WS_KEYS); bf16_t* pbf = (bf16_t*)(P.ws + WS_PBF);
        const int n4a = 262144 / 4, n4b = T * 256 / 4;
        for (int i = bid * 256 + tid; i < n4a + n4b; i += nb * 256) {
            const bool a = i < n4a; const int j = a ? i : i - n4a;
            const f32x4 v = *(const f32x4*)((a ? P.sub_keys : P.p) + (size_t)j * 4);
            *(uint2*)((a ? keys : pbf) + (size_t)j * 4) = make_uint2(pack2(v[0], v[1]), pack2(v[2], v[3]));
        }
    }
    { float* rss = (float*)(P.ws + WS_RSS); for (int i = bid * 256 + tid; i < T; i += nb * 256) rss[i] = 0.f; }
    {
        float2* cs = (float2*)(P.ws + WS_CS);
        for (int e = bid * 256 + tid; e < T * 32; e += nb * 256) {
            const int t = e >> 5, i = e & 31;
            const float ang = (float)P.positions[t] * powf(10000.f, -(float)i / 32.f);
            float sn, c0; sincosf(ang, &sn, &c0);
            cs[e] = make_float2(c0, sn);
        }
    }
    {
        const int wave = tid >> 6, lane = tid & 63;
        bf16_t* hn = (bf16_t*)(P.ws + WS_HN);
        for (int r = bid * 4 + wave; r < T; r += nb * 4) rmsnorm_row<true>(P.x + (size_t)r * D, P.norm_mix, hn + (size_t)r * D, lane);
    }
}

__device__ __forceinline__ int lds_off(int row, int ch) { return row * 128 + ((ch ^ ((row >> 1) & 7)) << 4); }

__device__ __forceinline__ void gemm_mainloop(const bf16_t* __restrict__ A, int lda, const bf16_t* __restrict__ Bt, int ldb, int K,
                                              f32x16 (&acc)[2][2], unsigned char* smem) {
    const int tid = VTID, wave = tid >> 6, lane = tid & 63, wr = wave >> 1, wc = wave & 1;
    const int nk = K / 64;
    uint4 ra[4], rb[4];
    __syncthreads();
#pragma unroll
    for (int i = 0; i < 4; ++i) { const int c = tid + 256 * i, row = c >> 3, ch = c & 7;
        ra[i] = *(const uint4*)(A + (size_t)row * lda + ch * 8); rb[i] = *(const uint4*)(Bt + (size_t)row * ldb + ch * 8); }
#pragma unroll
    for (int i = 0; i < 4; ++i) { const int c = tid + 256 * i, row = c >> 3, ch = c & 7;
        *(uint4*)(smem + lds_off(row, ch)) = ra[i]; *(uint4*)(smem + 16384 + lds_off(row, ch)) = rb[i]; }
    __syncthreads();
    for (int kt = 0; kt < nk; ++kt) {
        unsigned char* cur = smem + (kt & 1) * 32768;
        unsigned char* nxt = smem + ((kt + 1) & 1) * 32768;
        const bool more = kt + 1 < nk;
        if (more) {
#pragma unroll
            for (int i = 0; i < 4; ++i) { const int c = tid + 256 * i, row = c >> 3, ch = c & 7;
                ra[i] = *(const uint4*)(A + (size_t)row * lda + (kt + 1) * 64 + ch * 8); rb[i] = *(const uint4*)(Bt + (size_t)row * ldb + (kt + 1) * 64 + ch * 8); }
        }
#pragma unroll
        for (int ks = 0; ks < 4; ++ks) {
            bf16x8 af[2], bfr[2];
#pragma unroll
            for (int i = 0; i < 2; ++i) { const int row = wr * 64 + i * 32 + (lane & 31); af[i] = *(const bf16x8*)(cur + lds_off(row, ks * 2 + (lane >> 5))); }
#pragma unroll
            for (int j = 0; j < 2; ++j) { const int row = wc * 64 + j * 32 + (lane & 31); bfr[j] = *(const bf16x8*)(cur + 16384 + lds_off(row, ks * 2 + (lane >> 5))); }
#pragma unroll
            for (int i = 0; i < 2; ++i)
#pragma unroll
                for (int j = 0; j < 2; ++j) acc[i][j] = __builtin_amdgcn_mfma_f32_32x32x16_bf16(af[i], bfr[j], acc[i][j], 0, 0, 0);
        }
        if (more) {
#pragma unroll
            for (int i = 0; i < 4; ++i) { const int c = tid + 256 * i, row = c >> 3, ch = c & 7;
                *(uint4*)(nxt + lds_off(row, ch)) = ra[i]; *(uint4*)(nxt + 16384 + lds_off(row, ch)) = rb[i]; }
        }
        __syncthreads();
    }
}
#define ACC_FOREACH(body)                                                                                   \
    { const int _tid = VTID, _wave = _tid >> 6, _lane = _tid & 63, _wr = _wave >> 1, _wc = _wave & 1; \
      _Pragma("unroll") for (int i = 0; i < 2; ++i) _Pragma("unroll") for (int j = 0; j < 2; ++j)          \
      _Pragma("unroll") for (int r = 0; r < 16; ++r) {                                                     \
          const int row = _wr * 64 + i * 32 + (r & 3) + 8 * (r >> 2) + 4 * (_lane >> 5);                   \
          const int col = _wc * 64 + j * 32 + (_lane & 31); body } }

__device__ __forceinline__ void zero_acc(f32x16 (&acc)[2][2]) {
#pragma unroll
    for (int i = 0; i < 2; ++i)
#pragma unroll
        for (int j = 0; j < 2; ++j)
#pragma unroll
            for (int r = 0; r < 16; ++r) acc[i][j][r] = 0.f;
}

__device__ __forceinline__ void phase_scores(const Params& P, int bid, int nb, unsigned char* smem) {
    const bf16_t* A = (const bf16_t*)(P.ws + WS_Q); const bf16_t* Bt = (const bf16_t*)(P.ws + WS_KEYS); float* C = (float*)(P.ws + WS_SCORES);
    const int nmt = T / 128, nnt = 16;
    for (int t = bid; t < nmt * nnt; t += nb) {
        const int mt = t % nmt, nt = t / nmt;
        f32x16 acc[2][2]; zero_acc(acc);
        gemm_mainloop(A + (size_t)mt * 128 * D + nt * 128, D, Bt + (size_t)nt * 128 * 128, 128, 128, acc, smem);
        ACC_FOREACH({ C[(size_t)(mt * 128 + row) * D + nt * 128 + col] = acc[i][j][r]; })
    }
}
__device__ __forceinline__ int g2_lds_byte(int r, int c) { const int st = (r >> 4) * 2 + (c >> 5), ob = (r & 15) * 64 + (c & 31) * 2; return st * 1024 + (ob ^ (((ob >> 9) & 1) << 5)); }
__device__ __forceinline__ void g2_stage_rc(int b, int& R, int& C) { const int st = b >> 10, sb = b & 1023, swz = sb ^ (((sb >> 9) & 1) << 5); R = (st >> 1) * 16 + (swz >> 6); C = (st & 1) * 32 + ((swz & 63) >> 1); }
__device__ __forceinline__ void g2_zero(f32x4 (&acc)[8][4]) {
#pragma unroll
    for (int m = 0; m < 8; ++m)
#pragma unroll
        for (int n = 0; n < 4; ++n) acc[m][n] = (f32x4){0.f, 0.f, 0.f, 0.f};
}
__device__ __forceinline__ void g2_mainloop(const bf16_t* __restrict__ Ab, int lda, const bf16_t* __restrict__ Bb, int ldb, int K, f32x4 (&acc)[8][4], unsigned char* shm) {
    const int tid = fresh_tid(), wid = tid >> 6, lane = tid & 63, wr = wid >> 2, wc = wid & 3, fr = lane & 15, fq = lane >> 4;
    int sR[4], sC[4];
#pragma unroll
    for (int i = 0; i < 4; ++i) g2_stage_rc(wid * 1024 + i * 8192 + lane * 16, sR[i], sC[i]);
#define G2_STAGE(buf, kt) { _Pragma("unroll") for (int i = 0; i < 4; ++i) { \
        __builtin_amdgcn_global_load_lds((const unsigned*)(Ab + (size_t)sR[i] * lda + (kt) * 64 + sC[i]), (unsigned*)(shm + (buf) * 65536 + wid * 1024 + i * 8192), 16, 0, 0); \
        __builtin_amdgcn_global_load_lds((const unsigned*)(Bb + (size_t)sR[i] * ldb + (kt) * 64 + sC[i]), (unsigned*)(shm + (buf) * 65536 + 32768 + wid * 1024 + i * 8192), 16, 0, 0); } }
    const int nt = K / 64;
    __syncthreads();
    G2_STAGE(0, 0)
    asm volatile("s_waitcnt vmcnt(0)" ::: "memory");
    __syncthreads();
    for (int t = 0; t < nt; ++t) {
        const int cur = t & 1;
        if (t + 1 < nt) G2_STAGE(cur ^ 1, t + 1)
        const unsigned char* SA = shm + cur * 65536; const unsigned char* SB = SA + 32768;
#pragma unroll
        for (int ks = 0; ks < 2; ++ks) {
            bf16x8 At[8], Bf[4];
#pragma unroll
            for (int m = 0; m < 8; ++m) At[m] = *(const bf16x8*)(SA + g2_lds_byte(wr * 128 + m * 16 + fr, ks * 32 + fq * 8));
#pragma unroll
            for (int n = 0; n < 4; ++n) Bf[n] = *(const bf16x8*)(SB + g2_lds_byte(wc * 64 + n * 16 + fr, ks * 32 + fq * 8));
#pragma unroll
            for (int m = 0; m < 8; ++m)
#pragma unroll
                for (int n = 0; n < 4; ++n) acc[m][n] = __builtin_amdgcn_mfma_f32_16x16x32_bf16(At[m], Bf[n], acc[m][n], 0, 0, 0);
            __builtin_amdgcn_sched_barrier(0);
        }
        asm volatile("s_waitcnt vmcnt(0)" ::: "memory");
        __syncthreads();
    }
}
#define G2_FOREACH(body)                                                                                       \
    { const int _tid = fresh_tid(), _wid = _tid >> 6, _lane = _tid & 63, _wr = _wid >> 2, _wc = _wid & 3, _fr = _lane & 15, _fq = _lane >> 4; \
      _Pragma("unroll") for (int m = 0; m < 8; ++m) _Pragma("unroll") for (int n = 0; n < 4; ++n)             \
      _Pragma("unroll") for (int j = 0; j < 4; ++j) {                                                         \
          const int row = _wr * 128 + m * 16 + _fq * 4 + j; const int col = _wc * 64 + n * 16 + _fr; const float val = acc[m][n][j]; body } }
#define G8_HT (128 * 64)
__device__ __forceinline__ void g8_mainloop(const bf16_t* __restrict__ A, const bf16_t* __restrict__ Bt, int K, int brow, int bcol, f32x4 (&acc)[2][2][4][2], unsigned char* shmb) {
    bf16_t* shm = (bf16_t*)shmb;
    const int tid = fresh_tid();
    const int wid = tid >> 6, lane = tid & 63, wr = wid >> 2, wc = wid & 3, fr = lane & 15, fq = lane >> 4;
#define G8_SA(b, h) (shm + ((b) * 2 + (h)) * G8_HT)
#define G8_SB(b, h) (shm + (4 + (b) * 2 + (h)) * G8_HT)
#define G8_STAGE(Pp, BASE, br, kt) do { const long _g = (long)(br) * K + (long)(kt) * 64; \
    _Pragma("unroll") for (int _i = 0; _i < 2; ++_i) { const int _b = tid * 16 + _i * 8192; int _r, _c; g2_stage_rc(_b, _r, _c); \
      __builtin_amdgcn_global_load_lds((const unsigned*)(BASE + _g + (long)_r * K + _c), (unsigned*)((char*)(Pp) + _b), 16, 0, 0); } } while (0)
#define G8_LDA(dst, b, h) _Pragma("unroll") for (int m = 0; m < 4; ++m) _Pragma("unroll") for (int k = 0; k < 2; ++k) \
    dst[m][k] = *reinterpret_cast<const bf16x8*>((const char*)G8_SA(b, h) + g2_lds_byte(wr * 64 + m * 16 + fr, k * 32 + fq * 8))
#define G8_LDB(dst, b, h) _Pragma("unroll") for (int n = 0; n < 2; ++n) _Pragma("unroll") for (int k = 0; k < 2; ++k) \
    dst[n][k] = *reinterpret_cast<const bf16x8*>((const char*)G8_SB(b, h) + g2_lds_byte(wc * 32 + n * 16 + fr, k * 32 + fq * 8))
#define G8_MMA(ai, bj, At_, Bt_) do { __builtin_amdgcn_s_setprio(1); \
    _Pragma("unroll") for (int m = 0; m < 4; ++m) _Pragma("unroll") for (int n = 0; n < 2; ++n) _Pragma("unroll") for (int k = 0; k < 2; ++k) \
      acc[ai][bj][m][n] = __builtin_amdgcn_mfma_f32_16x16x32_bf16(At_[m][k], Bt_[n][k], acc[ai][bj][m][n], 0, 0, 0); \
    __builtin_amdgcn_s_setprio(0); } while (0)
#define G8_WAIT_V(n) asm volatile("s_waitcnt vmcnt(" #n ")" ::: "memory")
#define G8_WAIT_L(n) asm volatile("s_waitcnt lgkmcnt(" #n ")" ::: "memory")
#define G8_BAR __builtin_amdgcn_s_barrier()
#define G8_SCHED __builtin_amdgcn_sched_barrier(0)
    bf16x8 At[4][2], B0[2][2], B1[2][2];
    const int nt = K / 64;
    __syncthreads();
    G8_STAGE(G8_SB(0, 0), Bt, bcol, 0); G8_STAGE(G8_SA(0, 0), A, brow, 0);
    G8_STAGE(G8_SB(0, 1), Bt, bcol + 128, 0); G8_STAGE(G8_SA(0, 1), A, brow + 128, 0);
    if (wr == 1) G8_BAR;
    G8_WAIT_V(4); G8_BAR;
    G8_STAGE(G8_SB(1, 0), Bt, bcol, 1); G8_STAGE(G8_SA(1, 0), A, brow, 1); G8_STAGE(G8_SB(1, 1), Bt, bcol + 128, 1);
    G8_WAIT_V(6); G8_BAR;
    for (int t = 0; t < nt - 2; t += 2) {
        G8_LDB(B0, 0, 0); G8_SCHED; G8_LDA(At, 0, 0); G8_STAGE(G8_SA(1, 1), A, brow + 128, t + 1);
        G8_WAIT_L(8); G8_BAR; G8_WAIT_L(0); G8_MMA(0, 0, At, B0); G8_BAR; G8_SCHED;
        G8_LDB(B1, 0, 1); G8_STAGE(G8_SB(0, 0), Bt, bcol, t + 2);
        G8_BAR; G8_WAIT_L(0); G8_MMA(0, 1, At, B1); G8_BAR;
        G8_LDA(At, 0, 1); G8_STAGE(G8_SA(0, 0), A, brow, t + 2);
        G8_BAR; G8_WAIT_L(0); G8_MMA(1, 0, At, B0); G8_BAR; G8_SCHED;
        G8_STAGE(G8_SB(0, 1), Bt, bcol + 128, t + 2);
        G8_WAIT_V(6); G8_BAR; G8_MMA(1, 1, At, B1); G8_BAR;
        G8_LDB(B0, 1, 0); G8_SCHED; G8_LDA(At, 1, 0); G8_STAGE(G8_SA(0, 1), A, brow + 128, t + 2);
        G8_WAIT_L(8); G8_BAR; G8_WAIT_L(0); G8_MMA(0, 0, At, B0); G8_BAR; G8_SCHED;
        G8_LDB(B1, 1, 1); G8_STAGE(G8_SB(1, 0), Bt, bcol, t + 3);
        G8_BAR; G8_WAIT_L(0); G8_MMA(0, 1, At, B1); G8_BAR;
        G8_LDA(At, 1, 1); G8_STAGE(G8_SA(1, 0), A, brow, t + 3);
        G8_BAR; G8_WAIT_L(0); G8_MMA(1, 0, At, B0); G8_BAR; G8_SCHED;
        G8_STAGE(G8_SB(1, 1), Bt, bcol + 128, t + 3);
        G8_WAIT_V(6); G8_BAR; G8_MMA(1, 1, At, B1); G8_BAR;
    }
    { G8_LDB(B0, 0, 0); G8_LDA(At, 0, 0); G8_STAGE(G8_SA(1, 1), A, brow + 128, nt - 1);
      G8_BAR; G8_WAIT_L(0); G8_MMA(0, 0, At, B0); G8_BAR;
      G8_LDB(B1, 0, 1); G8_BAR; G8_WAIT_L(0); G8_MMA(0, 1, At, B1); G8_BAR;
      G8_LDA(At, 0, 1); G8_WAIT_V(4); G8_BAR; G8_WAIT_L(0); G8_MMA(1, 0, At, B0); G8_MMA(1, 1, At, B1); G8_BAR; }
    { G8_LDB(B0, 1, 0); G8_LDA(At, 1, 0); G8_WAIT_V(2); G8_BAR; G8_WAIT_L(0); G8_MMA(0, 0, At, B0); G8_BAR;
      G8_LDB(B1, 1, 1); G8_WAIT_V(0); G8_BAR; G8_WAIT_L(0); G8_MMA(0, 1, At, B1); G8_BAR;
      G8_LDA(At, 1, 1); G8_BAR; G8_WAIT_L(0); G8_MMA(1, 0, At, B0); G8_MMA(1, 1, At, B1); G8_BAR; }
    if (wr == 0) G8_BAR;
}
__device__ __forceinline__ void g8_zero(f32x4 (&acc)[2][2][4][2]) {
#pragma unroll
    for (int a = 0; a < 2; ++a)
#pragma unroll
        for (int b = 0; b < 2; ++b)
#pragma unroll
            for (int m = 0; m < 4; ++m)
#pragma unroll
                for (int n = 0; n < 2; ++n) acc[a][b][m][n] = (f32x4){0.f, 0.f, 0.f, 0.f};
}
#define G8_FOREACH(body)                                                                                       \
    { const int _tid = fresh_tid(), _wid = _tid >> 6, _lane = _tid & 63, _wr = _wid >> 2, _wc = _wid & 3, _fr = _lane & 15, _fq = _lane >> 4; \
      _Pragma("unroll") for (int ai = 0; ai < 2; ++ai) _Pragma("unroll") for (int bj = 0; bj < 2; ++bj)       \
      _Pragma("unroll") for (int m = 0; m < 4; ++m) _Pragma("unroll") for (int n = 0; n < 2; ++n)             \
      _Pragma("unroll") for (int j = 0; j < 4; ++j) {                                                         \
          const int row = ai * 128 + _wr * 64 + m * 16 + _fq * 4 + j; const int col = bj * 128 + _wc * 32 + n * 16 + _fr; const float val = acc[ai][bj][m][n][j]; body } }

__device__ __forceinline__ bool g2_tile(int bid, int nb, int it, int nM, int nN, int& pm, int& pn) {
    if (nb == 256 && nM == 32) { const int xcd = bid & 7, jj = bid >> 3; pm = 4 * xcd + (jj & 3); pn = 8 * it + (jj >> 2); return pn < nN; }
    const int t = bid + it * nb; pm = t % nM; pn = t / nM; return t < nM * nN;
}

__device__ __forceinline__ void phase_ple(const Params& P, int bid, int nb, unsigned char* smem) {
    const bf16_t* A = (const bf16_t*)(P.ws + WS_PBF); const bf16_t* Bt = (const bf16_t*)(P.ws + WS_WTPP); bf16_t* C = (bf16_t*)P.out;
    for (int t = bid; t < 256; t += nb) {
        const int pm = t & 31, pn = t >> 5;
        f32x4 acc[8][4]; g2_zero(acc);
        g2_mainloop(A + (size_t)pm * 256 * 256, 256, Bt + (size_t)pn * 256 * 256, 256, 256, acc, smem);
        G2_FOREACH({ C[(size_t)(pm * 256 + row) * D + pn * 256 + col] = f2bf(val); })
    }
}
__device__ __forceinline__ void phase_gemm1(const Params& P, int bid, int nb, unsigned char* smem) {
    const bf16_t* A = (const bf16_t*)(P.ws + WS_HN); const bf16_t* Bt = (const bf16_t*)(P.ws + WS_WTIN); bf16_t* C = (bf16_t*)(P.ws + WS_PROJ);
    int pm, pn;
    for (int it = 0; g2_tile(bid, nb, it, T / 256, NPROJ / 256, pm, pn); ++it) {
        f32x4 acc[2][2][4][2]; g8_zero(acc);
        g8_mainloop(A, Bt, D, pm * 256, pn * 256, acc, smem);
        G8_FOREACH({ C[(size_t)(pm * 256 + row) * NPROJ + pn * 256 + col] = f2bf(val); })
    }
    if (nb == 256 && bid >= 160) phase_ple(P, bid - 160, 96, smem);
}
__device__ __forceinline__ void phase_gemm2(const Params& P, int bid, int nb, unsigned char* smem) {
    const bf16_t* A = (const bf16_t*)(P.ws + WS_MIXED); const bf16_t* Bt = (const bf16_t*)(P.ws + WS_WTOUT); bf16_t* H = (bf16_t*)(P.ws + WS_H);
    bf16_t* HW = (bf16_t*)(P.ws + WS_HN); float* rss = (float*)(P.ws + WS_RSS);
    int pm, pn;
    for (int it = 0; g2_tile(bid, nb, it, T / 256, D / 256, pm, pn); ++it) {
        f32x4 acc[2][2][4][2]; g8_zero(acc);
        g8_mainloop(A, Bt, D, pm * 256, pn * 256, acc, smem);
        const int tid = fresh_tid(), wid = tid >> 6, lane = tid & 63, wr = wid >> 2, wc = wid & 3, fr = lane & 15, fq = lane >> 4;
#pragma unroll
        for (int ai = 0; ai < 2; ++ai)
#pragma unroll
            for (int m = 0; m < 4; ++m)
#pragma unroll
                for (int j = 0; j < 4; ++j) {
                    const int row = pm * 256 + ai * 128 + wr * 64 + m * 16 + fq * 4 + j;
                    float ss = 0.f;
#pragma unroll
                    for (int bj = 0; bj < 2; ++bj)
#pragma unroll
                        for (int n = 0; n < 2; ++n) {
                            const int col = pn * 256 + bj * 128 + wc * 32 + n * 16 + fr;
                            const size_t o = (size_t)row * D + col;
                            const float v = P.x[o] + acc[ai][bj][m][n][j];
                            H[o] = f2bf(v); HW[o] = f2bf(v * P.norm_ffn[col]); ss += v * v;
                        }
                    ss += DPPF(ss, 0x128); ss += DPPF(ss, 0x124); ss += DPPF(ss, 0x122); ss += DPPF(ss, 0x121);
                    if (fr == 0) atomicAdd(rss + row, ss);
                }
    }
}
__device__ __forceinline__ void phase_gemm3(const Params& P, int bid, int nb, unsigned char* smem) {
    const bf16_t* A = (const bf16_t*)(P.ws + WS_HN); const bf16_t* Bt = (const bf16_t*)(P.ws + WS_WTPQ); bf16_t* C = (bf16_t*)(P.ws + WS_Q);
    int pm, pn;
    for (int it = 0; g2_tile(bid, nb, it, T / 256, D / 256, pm, pn); ++it) {
        f32x4 acc[2][2][4][2]; g8_zero(acc);
        g8_mainloop(A, Bt, D, pm * 256, pn * 256, acc, smem);
        const float* rss = (const float*)(P.ws + WS_RSS);
        G8_FOREACH({ const float rs = rsqrtf(rss[pm * 256 + row] * (1.f / 2048.f) + EPS); C[(size_t)(pm * 256 + row) * D + pn * 256 + col] = f2bf(val * rs); })
    }
}
__device__ __forceinline__ void phase_gemm4(const Params& P, int bid, int nb, unsigned char* smem) {
    const bf16_t* A = (const bf16_t*)(P.ws + WS_HN); const bf16_t* Bt = (const bf16_t*)(P.ws + WS_WTG);
    const bf16_t* ple = (const bf16_t*)P.out; bf16_t* H = (bf16_t*)(P.ws + WS_H);
    int pm, pn;
    for (int it = 0; g2_tile(bid, nb, it, T / 256, D / 256, pm, pn); ++it) {
        f32x4 acc[2][2][4][2]; g8_zero(acc);
        g8_mainloop(A, Bt, D, pm * 256, pn * 256, acc, smem);
        G8_FOREACH({ const size_t o = (size_t)(pm * 256 + row) * D + pn * 256 + col; H[o] = f2bf(bf2f(H[o]) + sigmoid_f(val) * bf2f(ple[o])); })
    }
}

template <bool OUT_BF16>
__device__ __forceinline__ void phase_rownorm(const float* in, const float* w, void* out, int bid, int nb) {
    const int wave = VTID >> 6, lane = VTID & 63;
    for (int r = bid * 4 + wave; r < T; r += nb * 4) {
        if (OUT_BF16) rmsnorm_row<true>(in + (size_t)r * D, w, (bf16_t*)out + (size_t)r * D, lane);
        else rmsnorm_row<false>(in + (size_t)r * D, w, (float*)out + (size_t)r * D, lane);
    }
}

__device__ __forceinline__ void phase_final(const Params& P, int bid, int nb) {
    const bf16_t* H = (const bf16_t*)(P.ws + WS_H);
    const int wave = VTID >> 6, lane = VTID & 63;
    for (int r = bid * 4 + wave; r < T; r += nb * 4) {
        float v[32]; float ss = 0.f;
#pragma unroll
        for (int i = 0; i < 4; ++i) {
            const uint4 hv = *(const uint4*)(H + (size_t)r * D + (i * 64 + lane) * 8); const unsigned hw[4] = {hv.x, hv.y, hv.z, hv.w};
#pragma unroll
            for (int j = 0; j < 4; ++j) { v[i * 8 + 2 * j] = __uint_as_float(hw[j] << 16); v[i * 8 + 2 * j + 1] = __uint_as_float(hw[j] & 0xffff0000u); ss += v[i * 8 + 2 * j] * v[i * 8 + 2 * j] + v[i * 8 + 2 * j + 1] * v[i * 8 + 2 * j + 1]; }
        }
        ss = wave_sum(ss);
        const float rs = rsqrtf(ss * (1.f / 2048.f) + EPS);
#pragma unroll
        for (int i = 0; i < 4; ++i)
#pragma unroll
            for (int q = 0; q < 2; ++q) {
                const int col = (i * 64 + lane) * 8 + q * 4;
                const f32x4 g = *(const f32x4*)(P.norm_final + col);
                f32x4 o = {v[i * 8 + q * 4] * rs * g[0], v[i * 8 + q * 4 + 1] * rs * g[1], v[i * 8 + q * 4 + 2] * rs * g[2], v[i * 8 + q * 4 + 3] * rs * g[3]};
                *(f32x4*)(P.out + (size_t)r * D + col) = o;
            }
    }
}

__device__ __forceinline__ bf16x8 frag_ld(const unsigned char* tile, int row, int ks, int lane) { return *(const bf16x8*)(tile + lds_off(row, ks * 2 + (lane >> 5))); }
__device__ __forceinline__ void lds_st_bf16(unsigned char* tile, int row, int k, float v) { *(bf16_t*)(tile + lds_off(row, k >> 3) + (k & 7) * 2) = f2bf(v); }

__device__ __forceinline__ void d1_chunk(const Params& P, int u, unsigned char* smem) {
    const bf16_t* proj = (const bf16_t*)(P.ws + WS_PROJ);
    int tid_ = VTID; asm volatile("" : "+v"(tid_));
    const int tid = tid_, wave = tid >> 6, lane = tid & 63;
    const int b = u >> 9, h = (u >> 6) & 7, c = u & 63;
    const size_t tok0 = (size_t)b * SEQ + c * 64;
    unsigned char* Ks = smem;
    unsigned char* Qs = smem + 16384;
    unsigned char* Vraw = smem + 16384;
    float* At = (float*)(smem + 34816);
    float* Gs = (float*)(smem + 51200);
    float* Bs = Gs + 64;
    float* Es = Gs + 128;
    float* Xs = Gs + 192;
    HSYNC();
    if (wave == 0) {
        const size_t t = tok0 + lane;
        const float a = bf2f(proj[t * NPROJ + C_A + h]), bb = bf2f(proj[t * NPROJ + C_B + h]);
        const float xs = a + P.dt_bias[h];
        const float sp = xs > 20.f ? xs : log1pf(expf(xs));
        float g = -expf(P.a_log[h]) * sp;
#pragma unroll
        for (int o = 1; o < 64; o <<= 1) { const float n = __shfl_up(g, o); if (lane >= o) g += n; }
        Gs[lane] = g; Bs[lane] = 1.f / (1.f + expf(-bb));
        Es[lane] = __expf(g); Xs[lane] = __expf(__shfl(g, 63) - g);
    }
    bf16_t* QG = (bf16_t*)(P.ws + WS_QG) + (size_t)u * 64 * 128;
    unsigned char* RAW = smem + 32768;
    uint4 rq[5], rk[5], rv[5];
#pragma unroll
    for (int i = 0; i < 5; ++i) {
        const int q = tid + 256 * i, row = q >> 4, c16 = q & 15;
        rq[i] = make_uint4(0u, 0u, 0u, 0u); rk[i] = rq[i]; rv[i] = rq[i];
        if (q < 67 * 16 && (c > 0 || row >= 3)) {
            const bf16_t* src = proj + (tok0 + row - 3) * NPROJ + h * 128 + c16 * 8;
            rq[i] = *(const uint4*)(src); rk[i] = *(const uint4*)(src + 1024); rv[i] = *(const uint4*)(src + 2048);
        }
    }
#pragma unroll
    for (int isk = 0; isk < 2; ++isk) {
        const int chb = (isk ? 1024 : 0) + h * 128;
#pragma unroll
        for (int i = 0; i < 5; ++i) { const int q = tid + 256 * i, row = q >> 4, c16 = q & 15; if (q < 67 * 16) *(uint4*)(RAW + row * 256 + c16 * 16) = isk ? rk[i] : rq[i]; }
        const int ch0 = chb + lane * 2;
        const f32x4 cw0 = *(const f32x4*)(P.conv_w + ch0 * 4), cw1 = *(const f32x4*)(P.conv_w + ch0 * 4 + 4);
        HSYNC();
        float y0[16], y1[16], ss[16];
#pragma unroll
        for (int j = 0; j < 16; ++j) {
            const int tok = wave + 4 * j;
            float a0 = 0.f, a1 = 0.f;
#pragma unroll
            for (int t4 = 0; t4 < 4; ++t4) {
                const unsigned pr = *(const unsigned*)(RAW + (tok + t4) * 256 + lane * 4);
                a0 += bf2f((bf16_t)(pr & 0xffff)) * cw0[t4];
                a1 += bf2f((bf16_t)(pr >> 16)) * cw1[t4];
            }
            y0[j] = silu_f(a0); y1[j] = silu_f(a1); ss[j] = y0[j] * y0[j] + y1[j] * y1[j];
        }
        const bool b5 = (lane & 32) != 0, b4 = (lane & 16) != 0, b3 = (lane & 8) != 0, b2 = (lane & 4) != 0;
        float q8[8], q4[4], q2[2];
#pragma unroll
        for (int j = 0; j < 8; ++j) { const auto r_ = __builtin_amdgcn_permlane32_swap(__float_as_uint(ss[j]), __float_as_uint(ss[j + 8]), false, false); q8[j] = __uint_as_float(r_[0]) + __uint_as_float(r_[1]); }
#pragma unroll
        for (int j = 0; j < 4; ++j) { const auto r_ = __builtin_amdgcn_permlane16_swap(__float_as_uint(q8[j]), __float_as_uint(q8[j + 4]), false, false); q4[j] = __uint_as_float(r_[0]) + __uint_as_float(r_[1]); }
#pragma unroll
        for (int j = 0; j < 2; ++j) q2[j] = (b3 ? q4[j + 2] : q4[j]) + DPPF(b3 ? q4[j] : q4[j + 2], 0x128);
        float st = (b2 ? q2[1] : q2[0]) + __shfl_xor(b2 ? q2[0] : q2[1], 4);
        st += DPPF(st, 0x4E); st += DPPF(st, 0xB1);
        float rl = rsqrtf(st + EPS); if (!isk) rl *= 0.08838834764831845f;
        const int rli = __float_as_int(rl);
#pragma unroll
        for (int j = 0; j < 16; ++j) {
            const int tok = wave + 4 * j;
            const float r = __int_as_float(__builtin_amdgcn_readlane(rli, 4 * j));
            const float z0 = y0[j] * r, z1 = y1[j] * r;
            const int k = lane * 2, half = k >> 6, kk = k & 63;
            *(unsigned*)((isk ? Ks : Qs) + half * 8192 + lds_off(tok, kk >> 3) + (kk & 7) * 2) = pack2(z0, z1);
            if (!isk) { const float eg = Es[tok]; *(unsigned*)(QG + tok * 128 + k) = pack2(z0 * eg, z1 * eg); }
        }
        HSYNC();
    }
    {
        const int wr = wave >> 1, wc = wave & 1;
        f32x16 akk, aqk;
#pragma unroll
        for (int r = 0; r < 16; ++r) { akk[r] = 0.f; aqk[r] = 0.f; }
        if (!(wr == 0 && wc == 1)) {
#pragma unroll
            for (int half = 0; half < 2; ++half)
#pragma unroll
                for (int ks = 0; ks < 4; ++ks) {
                    const bf16x8 fk = frag_ld(Ks + half * 8192, wr * 32 + (lane & 31), ks, lane);
                    const bf16x8 fq = frag_ld(Qs + half * 8192, wr * 32 + (lane & 31), ks, lane);
                    const bf16x8 fb = frag_ld(Ks + half * 8192, wc * 32 + (lane & 31), ks, lane);
                    akk = __builtin_amdgcn_mfma_f32_32x32x16_bf16(fk, fb, akk, 0, 0, 0);
                    aqk = __builtin_amdgcn_mfma_f32_32x32x16_bf16(fq, fb, aqk, 0, 0, 0);
                }
        }
        const int j = wc * 32 + (lane & 31); const float Gj = Gs[j];
        bf16_t* ATT = (bf16_t*)(P.ws + WS_ATT) + (size_t)u * 64 * 64;
#pragma unroll
        for (int g4 = 0; g4 < 4; ++g4) {
            const int i0 = wr * 32 + 8 * g4 + 4 * (lane >> 5);
            f32x4 av;
#pragma unroll
            for (int e = 0; e < 4; ++e) {
                const int i = i0 + e, r = g4 * 4 + e;
                const float dec = (i >= j) ? __expf(Gs[i] - Gj) : 0.f;
                av[e] = (i > j) ? Bs[i] * akk[r] * dec : 0.f;
                ATT[i * 64 + j] = f2bf(aqk[r] * dec);
            }
            *(f32x4*)(At + j * 64 + i0) = av;
        }
    }
    HSYNC();
    {
#pragma unroll
        for (int i = 0; i < 5; ++i) { const int q = tid + 256 * i, row = q >> 4, c16 = q & 15; if (q < 67 * 16) *(uint4*)(Vraw + row * 256 + c16 * 16) = rv[i]; }
    }
    HSYNC();
    {
        float r[64];
        if (tid < 128) {
            const int ch = 2048 + h * 128 + tid;
            const float w0 = P.conv_w[ch * 4 + 0], w1 = P.conv_w[ch * 4 + 1], w2 = P.conv_w[ch * 4 + 2], w3 = P.conv_w[ch * 4 + 3];
            const bf16_t* vcol = (const bf16_t*)Vraw + tid;
            float xm3 = bf2f(vcol[0]), xm2 = bf2f(vcol[128]), xm1 = bf2f(vcol[256]);
#pragma unroll
            for (int i = 0; i < 64; ++i) {
                const float x0 = bf2f(vcol[(i + 3) * 128]);
                const float y = w0 * xm3 + w1 * xm2 + w2 * xm1 + w3 * x0;
                r[i] = Bs[i] * silu_f(y);
                xm3 = xm2; xm2 = xm1; xm1 = x0;
            }
        } else {
            const int dk = tid - 128, half = dk >> 6, kk = dk & 63;
            bf16_t* KDT = (bf16_t*)(P.ws + WS_KDT) + (size_t)u * 128 * 64 + dk * 64;
#pragma unroll
            for (int i8 = 0; i8 < 8; ++i8) {
                unsigned pk[4];
#pragma unroll
                for (int e2 = 0; e2 < 4; ++e2) {
                    float kd[2];
#pragma unroll
                    for (int e = 0; e < 2; ++e) {
                        const int i = i8 * 8 + e2 * 2 + e;
                        const float kv = bf2f(*(const bf16_t*)(Ks + half * 8192 + lds_off(i, kk >> 3) + (kk & 7) * 2));
                        r[i] = -Bs[i] * Es[i] * kv;
                        kd[e] = kv * Xs[i];
                    }
                    pk[e2] = pack2(kd[0], kd[1]);
                }
                *(uint4*)(KDT + i8 * 8) = make_uint4(pk[0], pk[1], pk[2], pk[3]);
            }
        }
#pragma unroll
        for (int j = 0; j < 63; ++j) {
            const float xj = r[j];
#pragma unroll
            for (int i4 = ((j + 1) & ~3); i4 < 64; i4 += 4) {
                const f32x4 a = *(const f32x4*)(At + j * 64 + i4);
                r[i4] -= a[0] * xj; r[i4 + 1] -= a[1] * xj; r[i4 + 2] -= a[2] * xj; r[i4 + 3] -= a[3] * xj;
            }
        }
        if (tid < 128) {
            bf16_t* U = (bf16_t*)(P.ws + WS_U) + (size_t)u * 64 * 128 + (tid >> 5) * 2048 + (tid & 31);
#pragma unroll
            for (int i = 0; i < 64; ++i) { const int tt = i >> 5, i5 = i & 31, rr = (i5 & 3) + 4 * (i5 >> 3), hh = (i5 >> 2) & 1; U[(tt * 16 + rr) * 64 + hh * 32] = f2bf(r[i]); }
        } else {
            bf16_t* W = (bf16_t*)(P.ws + WS_W) + (size_t)u * 64 * 128 + (tid - 128);
#pragma unroll
            for (int i = 0; i < 64; ++i) W[i * 128] = f2bf(r[i]);
        }
        if (tid == 0) ((float*)(P.ws + WS_EG))[u] = Es[63];
    }
}

__device__ __forceinline__ void r1_chunk(const Params& P, int u, unsigned char* smem) {
    const bf16_t* proj = (const bf16_t*)(P.ws + WS_PROJ);
    int tid_ = VTID; asm volatile("" : "+v"(tid_));
    const int tid = tid_, wave = tid >> 6, lane = tid & 63;
    const int b = u >> 9, h = (u >> 6) & 7, c = u & 63;
    const size_t tok0 = (size_t)b * SEQ + c * 64;
    unsigned char* RQ = smem;
    unsigned char* RK = smem + 8192;
    unsigned char* VT = smem + 16384;
    unsigned char* RKT = smem + 32768;
    const float l2g = log2f(1.f - exp2f(-5.f - (float)h));
    unsigned char* VR = smem + 40960;
    HSYNC();
    bf16_t* QGR = (bf16_t*)(P.ws + WS_QGR) + (size_t)u * 64 * 64;
    {
        uint4 rq[2], rk[2], rv[4];
#pragma unroll
        for (int i = 0; i < 2; ++i) { const int q = tid + 256 * i, row = q >> 3, ch = q & 7;
            rq[i] = *(const uint4*)(proj + (tok0 + row) * NPROJ + C_RQ + h * 64 + ch * 8); rk[i] = *(const uint4*)(proj + (tok0 + row) * NPROJ + C_RK + h * 64 + ch * 8); }
#pragma unroll
        for (int i = 0; i < 4; ++i) { const int q = tid + 256 * i, row = q >> 4, c16 = q & 15; rv[i] = *(const uint4*)(proj + (tok0 + row) * NPROJ + C_RV + h * 128 + c16 * 8); }
#pragma unroll
        for (int i = 0; i < 2; ++i) { const int q = tid + 256 * i, row = q >> 3, ch = q & 7; *(uint4*)(RQ + lds_off(row, ch)) = rq[i]; *(uint4*)(RK + lds_off(row, ch)) = rk[i]; }
#pragma unroll
        for (int i = 0; i < 4; ++i) { const int q = tid + 256 * i, row = q >> 4, c16 = q & 15; *(uint4*)(VR + row * 256 + c16 * 16) = rv[i]; }
    }
    HSYNC();
    const float2* cs = (const float2*)(P.ws + WS_CS) + tok0 * 32;
    float2 cs8[8];
#pragma unroll
    for (int it = 0; it < 8; ++it) cs8[it] = cs[tid + 256 * it];
#pragma unroll
    for (int it = 0; it < 8; ++it) {
        const int e = tid + 256 * it, tok = e >> 5, i = e & 31;
        const float cs_ = cs8[it].x, sn = cs8[it].y;
        bf16_t* q1p = (bf16_t*)(RQ + lds_off(tok, i >> 3) + (i & 7) * 2); bf16_t* q2p = (bf16_t*)(RQ + lds_off(tok, (32 + i) >> 3) + (i & 7) * 2);
        bf16_t* k1p = (bf16_t*)(RK + lds_off(tok, i >> 3) + (i & 7) * 2); bf16_t* k2p = (bf16_t*)(RK + lds_off(tok, (32 + i) >> 3) + (i & 7) * 2);
        const float q1 = bf2f(*q1p), q2 = bf2f(*q2p), k1 = bf2f(*k1p) * 0.125f, k2 = bf2f(*k2p) * 0.125f;
        const float qa = q1 * cs_ - q2 * sn, qb = q1 * sn + q2 * cs_, ka = k1 * cs_ - k2 * sn, kb = k1 * sn + k2 * cs_;
        const float xi = exp2f(l2g * (float)(tok + 1)), zeta = exp2f(l2g * (float)(63 - tok));
        *q1p = f2bf(qa); *q2p = f2bf(qb); *k1p = f2bf(ka); *k2p = f2bf(kb);
        lds_st_bf16(RKT, i, tok, ka * zeta); lds_st_bf16(RKT, 32 + i, tok, kb * zeta);
        QGR[tok * 64 + i] = f2bf(qa * xi); QGR[tok * 64 + 32 + i] = f2bf(qb * xi);
    }
#pragma unroll 4
    for (int it = 0; it < 16; ++it) {
        const int e = tid + 256 * it, tok = e >> 6, dp = e & 63;
        const unsigned pr = *(const unsigned*)(VR + tok * 256 + dp * 4);
        *(bf16_t*)(VT + lds_off(dp * 2, tok >> 3) + (tok & 7) * 2) = (bf16_t)(pr & 0xffff);
        *(bf16_t*)(VT + lds_off(dp * 2 + 1, tok >> 3) + (tok & 7) * 2) = (bf16_t)(pr >> 16);
    }
    HSYNC();
    {
        bf16_t* VNTR = (bf16_t*)(P.ws + WS_VNTR) + (size_t)u * 128 * 64;
#pragma unroll
        for (int it = 0; it < 4; ++it) { const int q = tid + 256 * it, row = q >> 3, ch = q & 7; *(uint4*)(VNTR + row * 64 + ch * 8) = *(const uint4*)(VT + lds_off(row, ch)); }
    }
    {
        const int wr = wave >> 1, wc = wave & 1;
        f32x16 acc;
#pragma unroll
        for (int r = 0; r < 16; ++r) acc[r] = 0.f;
        if (!(wr == 0 && wc == 1)) {
#pragma unroll
            for (int ks = 0; ks < 4; ++ks) acc = __builtin_amdgcn_mfma_f32_32x32x16_bf16(frag_ld(RQ, wr * 32 + (lane & 31), ks, lane), frag_ld(RK, wc * 32 + (lane & 31), ks, lane), acc, 0, 0, 0);
        }
        const int j = wc * 32 + (lane & 31);
        bf16_t* ATTR = (bf16_t*)(P.ws + WS_ATTR) + (size_t)u * 64 * 64;
#pragma unroll
        for (int r = 0; r < 16; ++r) {
            const int i = wr * 32 + (r & 3) + 8 * (r >> 2) + 4 * (lane >> 5);
            const float dec = (i >= j) ? exp2f(l2g * (float)(i - j)) : 0.f;
            ATTR[i * 64 + j] = f2bf(acc[r] * dec);
        }
    }
    {
        f32x16 acc[2];
#pragma unroll
        for (int j = 0; j < 2; ++j)
#pragma unroll
            for (int r = 0; r < 16; ++r) acc[j][r] = 0.f;
#pragma unroll
        for (int ks = 0; ks < 4; ++ks) {
            const bf16x8 fa = frag_ld(VT, wave * 32 + (lane & 31), ks, lane);
#pragma unroll
            for (int j = 0; j < 2; ++j) acc[j] = __builtin_amdgcn_mfma_f32_32x32x16_bf16(fa, frag_ld(RKT, j * 32 + (lane & 31), ks, lane), acc[j], 0, 0, 0);
        }
        float* KVT = (float*)(P.ws + WS_KVT) + (size_t)u * 128 * 64;
#pragma unroll
        for (int j = 0; j < 2; ++j)
#pragma unroll
            for (int r = 0; r < 16; ++r) { const int dv = wave * 32 + (r & 3) + 8 * (r >> 2) + 4 * (lane >> 5); KVT[dv * 64 + j * 32 + (lane & 31)] = acc[j][r]; }
    }
}

__device__ __forceinline__ void phase_chunk1(const Params& P, int bid, int nb, unsigned char* smem, int mode = 0) {
    for (int u0 = bid; u0 < 2048; u0 += nb) { const int u = (bid & 1) ? ((u0 + 1024) & 2047) : u0; if (u < 1024) { if (mode != 2) d1_chunk(P, u, smem); } else if (mode != 1) r1_chunk(P, u - 1024, smem); }
}

__device__ __forceinline__ void d2_scan(const Params& P, int unit, unsigned char* rsmem) {
    const int tid = fresh_tid(), wave = tid >> 6, lane = tid & 63;
    const int bh = (unit & 7) + 8 * (unit >> 5), slice = (unit >> 3) & 3;
    const size_t cb = (size_t)bh * 64;
    const bf16_t* Wg = (const bf16_t*)(P.ws + WS_W); const bf16_t* KDg = (const bf16_t*)(P.ws + WS_KDT);
    const bf16_t* Ug = (const bf16_t*)(P.ws + WS_U); const float* EGg = (const float*)(P.ws + WS_EG);
    bf16_t* SCg = (bf16_t*)(P.ws + WS_SC); bf16_t* VNg = (bf16_t*)(P.ws + WS_VNT);
    unsigned char* Simg = rsmem;
    unsigned char* VNimg = rsmem + 8192;
    unsigned char* BUF = rsmem + 12288;
    const bool vn_wave = wave < 2, s_wave = wave < 4;
    const int hf = wave & 1, dt = wave & 3;
    f32x16 S0;
#pragma unroll
    for (int r = 0; r < 16; ++r) S0[r] = 0.f;
    uint4 w0a, w0b, k0a, k0b, w1a, w1b, k1a, k1b;
    bf16_t un0[16], un1[16];
#define D2_LOAD(SET, uu) { const bf16_t* wp = Wg + (uu) * 8192 + tid * 8; const bf16_t* kp = KDg + (uu) * 8192 + tid * 8; \
        w##SET##a = *(const uint4*)(wp); w##SET##b = *(const uint4*)(wp + 4096); k##SET##a = *(const uint4*)(kp); k##SET##b = *(const uint4*)(kp + 4096); \
        { const bf16_t* up = Ug + (uu) * 8192 + slice * 2048 + hf * 1024 + lane; _Pragma("unroll") for (int r = 0; r < 16; ++r) un##SET[r] = up[r * 64]; } }
#define D2_ST1(i, vw, vk, bufp) { const int q = tid + 512 * (i); { const int row = q >> 4, c16 = q & 15; *(uint4*)((bufp) + (c16 >> 3) * 8192 + lds_off(row, c16 & 7)) = (vw); } \
        { const int row = q >> 3, ch = q & 7; *(uint4*)((bufp) + 16384 + lds_off(row, ch)) = (vk); } }
#define D2_STORE(SET, par) { unsigned char* bufp = BUF + (par) * 32768; D2_ST1(0, w##SET##a, k##SET##a, bufp) D2_ST1(1, w##SET##b, k##SET##b, bufp) }
    const int egl = __float_as_int(EGg[cb + lane]);
    __syncthreads();
    if (s_wave) {
#pragma unroll
        for (int i = 0; i < 2; ++i) *(uint4*)(Simg + dt * 2048 + (lane + 64 * i) * 16) = make_uint4(0u, 0u, 0u, 0u);
#pragma unroll
        for (int i = 0; i < 2; ++i) *(uint4*)(SCg + cb * 16384 + slice * 4096 + dt * 1024 + (lane + 64 * i) * 8) = make_uint4(0u, 0u, 0u, 0u);
    }
    for (int r = 0; r < 16; ++r) { un0[r] = 0; un1[r] = 0; }
    D2_LOAD(0, cb)
    D2_STORE(0, 0)
    bf16_t unc[16];
#pragma unroll
    for (int r = 0; r < 16; ++r) unc[r] = un0[r];
    D2_LOAD(1, cb + 1)
    D2_LOAD(0, cb + 2)
    __syncthreads();
#define D2_STEP(c, UN) { const size_t u = cb + (c); const unsigned char* Wt = BUF + ((c) & 1) * 32768; const unsigned char* KDt = Wt + 16384; \
        if (vn_wave) { \
            f32x16 vn; _Pragma("unroll") for (int r = 0; r < 16; ++r) vn[r] = bf2f(UN[r]); \
            _Pragma("unroll") for (int half = 0; half < 2; ++half) _Pragma("unroll") for (int ks = 0; ks < 4; ++ks) \
                vn = __builtin_amdgcn_mfma_f32_32x32x16_bf16(frag_ld(Wt + half * 8192, hf * 32 + (lane & 31), ks, lane), frag_ld(Simg + half * 4096, lane & 31, ks, lane), vn, 0, 0, 0); \
            _Pragma("unroll") for (int g4 = 0; g4 < 4; ++g4) { const int r0 = g4 * 4; \
                const uint2 pkd = make_uint2(pack2(vn[r0], vn[r0 + 1]), pack2(vn[r0 + 2], vn[r0 + 3])); \
                const int tok = hf * 32 + 8 * g4 + 4 * (lane >> 5); \
                *(uint2*)(VNimg + lds_off(lane & 31, tok >> 3) + (tok & 7) * 2) = pkd; \
                *(uint2*)(VNg + u * 8192 + ((((slice * 2 + hf) * 4 + g4) * 64 + lane) * 4)) = pkd; } } \
        __syncthreads(); \
        if (s_wave) { \
            bf16_t* scdst = ((c) + 1 < 64) ? SCg + (u + 1) * 16384 : (bf16_t*)(P.ws + WS_DUMMY);        \
            const float eg = __int_as_float(__builtin_amdgcn_readlane(egl, (c))); \
            _Pragma("unroll") for (int r = 0; r < 16; ++r) S0[r] *= eg; \
            _Pragma("unroll") for (int ks = 0; ks < 4; ++ks) \
                S0 = __builtin_amdgcn_mfma_f32_32x32x16_bf16(frag_ld(KDt, dt * 32 + (lane & 31), ks, lane), frag_ld(VNimg, lane & 31, ks, lane), S0, 0, 0, 0); \
            _Pragma("unroll") for (int g4 = 0; g4 < 4; ++g4) { const int r0 = g4 * 4; const int kk = (dt & 1) * 32 + 8 * g4 + 4 * (lane >> 5); \
                const uint2 p0 = make_uint2(pack2(S0[r0], S0[r0 + 1]), pack2(S0[r0 + 2], S0[r0 + 3])); \
                *(uint2*)(Simg + (dt >> 1) * 4096 + lds_off(lane & 31, kk >> 3) + (kk & 7) * 2) = p0; \
                *(uint2*)(scdst + ((((slice * 4 + dt) * 4 + g4) * 64 + lane) * 4)) = p0; } } }
    for (int c = 0; c < 64; c += 2) {
        D2_STORE(1, 1)
        bf16_t unn[16];
#pragma unroll
        for (int r = 0; r < 16; ++r) unn[r] = un1[r];
        D2_LOAD(1, cb + (c + 3 < 64 ? c + 3 : 63))
        D2_STEP(c, unc)
        __syncthreads();
        D2_STORE(0, 0)
#pragma unroll
        for (int r = 0; r < 16; ++r) unc[r] = un0[r];
        D2_LOAD(0, cb + (c + 4 < 64 ? c + 4 : 63))
        D2_STEP(c + 1, unn)
        __syncthreads();
    }
}

__device__ __forceinline__ void r2_scan(const Params& P, int vb, int nvb) {
    const float* KVT = (const float*)(P.ws + WS_KVT); bf16_t* STR = (bf16_t*)(P.ws + WS_STR);
    int tid_ = VTID; asm volatile("" : "+v"(tid_));
    for (int idx = vb * 256 + tid_; idx < 16 * 8192; idx += nvb * 256) {
        const int bh = idx >> 13, e = idx & 8191, h = bh & 7;
        const float cd = exp2f(64.f * log2f(1.f - exp2f(-5.f - (float)h)));
        float S = 0.f;
#pragma unroll 8
        for (int c = 0; c < 64; ++c) {
            const size_t o = ((size_t)bh * 64 + c) * 8192 + e;
            STR[o] = f2bf(S);
            S = cd * S + KVT[o];
        }
    }
}

__device__ __forceinline__ void phase_econv(const Params& P, int bid, int nb, unsigned char* smem);
__device__ __forceinline__ void phase_scan(const Params& P, int bid, int nb, unsigned char* smem, int rbid, int rnb, unsigned char* rsmem, int mode = 0) {
    if (rbid < 64) { if (mode != 2) d2_scan(P, rbid, rsmem); }
    else if (mode != 1) {
        if (rnb != 256) phase_ple(P, rbid - 64, rnb - 64, rsmem);
        r2_scan(P, bid - 128, nb - 128);
        phase_econv(P, bid - 128, nb - 128, smem);
    }
}

template <int K1, bool RET>
__device__ __forceinline__ void chunk_out(const Params& P, int u, unsigned char* smem) {
    int tid_ = VTID; asm volatile("" : "+v"(tid_));
    const int tid = tid_, wave = tid >> 6, lane = tid & 63, wr = wave >> 1, wc = wave & 1;
    const int b = u >> 9, h = (u >> 6) & 7, c = u & 63;
    const size_t tok0 = (size_t)b * SEQ + c * 64;
    const bf16_t* A1 = RET ? (const bf16_t*)(P.ws + WS_QGR) + (size_t)u * 64 * 64 : (const bf16_t*)(P.ws + WS_QG) + (size_t)u * 64 * 128;
    const bf16_t* B1 = RET ? (const bf16_t*)(P.ws + WS_STR) + (size_t)u * 128 * 64 : (const bf16_t*)(P.ws + WS_SC) + (size_t)u * 128 * 128;
    const bf16_t* A2 = RET ? (const bf16_t*)(P.ws + WS_ATTR) + (size_t)u * 64 * 64 : (const bf16_t*)(P.ws + WS_ATT) + (size_t)u * 64 * 64;
    const bf16_t* B2 = RET ? (const bf16_t*)(P.ws + WS_VNTR) + (size_t)u * 128 * 64 : (const bf16_t*)(P.ws + WS_VNT) + (size_t)u * 128 * 64;
    float* red = (float*)(smem + 49152);
    f32x16 acc[2];
#pragma unroll
    for (int j = 0; j < 2; ++j)
#pragma unroll
        for (int r = 0; r < 16; ++r) acc[j][r] = 0.f;
    constexpr int NK1 = K1 / 64, NKT = NK1 + 1;
    uint4 A0_0, A0_1, A1_0, A1_1, A2_0, A2_1;
    uint4 B0_0, B0_1, B0_2, B0_3, B1_0, B1_1, B1_2, B1_3, B2_0, B2_1, B2_2, B2_3;
#define CO_LOAD(kt) { const bf16_t* Ap = ((kt) < NK1) ? A1 + (kt) * 64 : A2; const int lda = ((kt) < NK1) ? K1 : 64; const bf16_t* Bp = ((kt) < NK1) ? B1 + (kt) * 64 : B2; \
        { const int q = tid, row = q >> 3, ch = q & 7; A##kt##_0 = *(const uint4*)(Ap + row * lda + ch * 8); } \
        { const int q = tid + 256, row = q >> 3, ch = q & 7; A##kt##_1 = *(const uint4*)(Ap + row * lda + ch * 8); } \
        if (RET) { \
            { const int q = tid, row = q >> 3, ch = q & 7; B##kt##_0 = *(const uint4*)(Bp + row * lda + ch * 8); } \
            { const int q = tid + 256, row = q >> 3, ch = q & 7; B##kt##_1 = *(const uint4*)(Bp + row * lda + ch * 8); } \
            { const int q = tid + 512, row = q >> 3, ch = q & 7; B##kt##_2 = *(const uint4*)(Bp + row * lda + ch * 8); } \
            { const int q = tid + 768, row = q >> 3, ch = q & 7; B##kt##_3 = *(const uint4*)(Bp + row * lda + ch * 8); } \
        } else { \
            const bf16_t* src = ((kt) < NK1) ? B1 : B2; \
            CO_PIECE(kt, 0, pa) CO_PIECE(kt, 1, pb) B##kt##_0 = make_uint4(pa.x, pa.y, pb.x, pb.y); \
            CO_PIECE(kt, 2, pc) CO_PIECE(kt, 3, pd) B##kt##_1 = make_uint4(pc.x, pc.y, pd.x, pd.y); \
            CO_PIECE(kt, 4, pe) CO_PIECE(kt, 5, pf) B##kt##_2 = make_uint4(pe.x, pe.y, pf.x, pf.y); \
            CO_PIECE(kt, 6, pg) CO_PIECE(kt, 7, ph) B##kt##_3 = make_uint4(pg.x, pg.y, ph.x, ph.y); } }
#define CO_PIECE(kt, i, name) uint2 name; { const int q = tid + 256 * (i), ln = q & 63, g4 = (q >> 6) & 3, dd = (q >> 8) & 1, w = q >> 9; \
        const size_t piece = ((kt) < NK1) ? (size_t)(((w * 4 + 2 * (kt) + dd) * 4 + g4) * 64 + ln) : (size_t)(((w * 2 + dd) * 4 + g4) * 64 + ln); \
        name = *(const uint2*)(src + piece * 4); }
    CO_LOAD(0) CO_LOAD(1)
    if (NKT == 3) { CO_LOAD(2) }
    const bf16_t* proj = (const bf16_t*)(P.ws + WS_PROJ);
    unsigned gz[2][16];
#pragma unroll
    for (int r = 0; r < 16; ++r) {
        const size_t t = tok0 + wr * 32 + (r & 3) + 8 * (r >> 2) + 4 * (lane >> 5);
#pragma unroll
        for (int j = 0; j < 2; ++j) gz[j][r] = proj[t * NPROJ + (RET ? C_RG : C_Z) + h * 128 + wc * 64 + j * 32 + (lane & 31)];
    }
#define CO_PUT(i, val) { const int q = tid + 256 * (i), ln = q & 63, g4 = (q >> 6) & 3, dd = (q >> 8) & 1, w = q >> 9; const int kk = dd * 32 + 8 * g4 + 4 * (ln >> 5); \
        *(uint2*)(Bs_ + lds_off(w * 32 + (ln & 31), kk >> 3) + (kk & 7) * 2) = (val); }
#define CO_STAGE(kt, buf) { unsigned char* As_ = smem + (buf) * 24576; unsigned char* Bs_ = As_ + 8192; \
        { const int q = tid, row = q >> 3, ch = q & 7; *(uint4*)(As_ + lds_off(row, ch)) = A##kt##_0; } \
        { const int q = tid + 256, row = q >> 3, ch = q & 7; *(uint4*)(As_ + lds_off(row, ch)) = A##kt##_1; } \
        if (RET) { \
            { const int q = tid, row = q >> 3, ch = q & 7; *(uint4*)(Bs_ + lds_off(row, ch)) = B##kt##_0; } \
            { const int q = tid + 256, row = q >> 3, ch = q & 7; *(uint4*)(Bs_ + lds_off(row, ch)) = B##kt##_1; } \
            { const int q = tid + 512, row = q >> 3, ch = q & 7; *(uint4*)(Bs_ + lds_off(row, ch)) = B##kt##_2; } \
            { const int q = tid + 768, row = q >> 3, ch = q & 7; *(uint4*)(Bs_ + lds_off(row, ch)) = B##kt##_3; } \
        } else { \
            CO_PUT(0, make_uint2(B##kt##_0.x, B##kt##_0.y)) CO_PUT(1, make_uint2(B##kt##_0.z, B##kt##_0.w)) \
            CO_PUT(2, make_uint2(B##kt##_1.x, B##kt##_1.y)) CO_PUT(3, make_uint2(B##kt##_1.z, B##kt##_1.w)) \
            CO_PUT(4, make_uint2(B##kt##_2.x, B##kt##_2.y)) CO_PUT(5, make_uint2(B##kt##_2.z, B##kt##_2.w)) \
            CO_PUT(6, make_uint2(B##kt##_3.x, B##kt##_3.y)) CO_PUT(7, make_uint2(B##kt##_3.z, B##kt##_3.w)) } }
#define CO_MMA(buf) { const unsigned char* As_ = smem + (buf) * 24576; const unsigned char* Bs_ = As_ + 8192; \
        _Pragma("unroll") for (int ks = 0; ks < 4; ++ks) { const bf16x8 fa = frag_ld(As_, wr * 32 + (lane & 31), ks, lane); \
            _Pragma("unroll") for (int j = 0; j < 2; ++j) acc[j] = __builtin_amdgcn_mfma_f32_32x32x16_bf16(fa, frag_ld(Bs_, wc * 64 + j * 32 + (lane & 31), ks, lane), acc[j], 0, 0, 0); } }
    HSYNC();
    CO_STAGE(0, 0) CO_STAGE(1, 1)
    HSYNC();
    CO_MMA(0) CO_MMA(1)
    if (NKT == 3) {
        HSYNC();
        CO_STAGE(2, 0)
        HSYNC();
        CO_MMA(0)
    }
#pragma unroll
    for (int r = 0; r < 16; ++r) {
        float s1 = acc[0][r] + acc[1][r], s2 = acc[0][r] * acc[0][r] + acc[1][r] * acc[1][r];
        s1 = half_sum32(s1); s2 = half_sum32(s2);
        if ((lane & 31) == 0) { const int row = wr * 32 + (r & 3) + 8 * (r >> 2) + 4 * (lane >> 5); red[(row * 2 + wc) * 2] = s1; red[(row * 2 + wc) * 2 + 1] = s2; }
    }
    HSYNC();
    bf16_t* mixed = (bf16_t*)(P.ws + WS_MIXED);
#pragma unroll
    for (int r = 0; r < 16; ++r) {
        const int row = wr * 32 + (r & 3) + 8 * (r >> 2) + 4 * (lane >> 5);
        const float s1 = red[row * 4] + red[row * 4 + 2], s2 = red[row * 4 + 1] + red[row * 4 + 3];
        const size_t t = tok0 + row;
#pragma unroll
        for (int j = 0; j < 2; ++j) {
            const int dv = wc * 64 + j * 32 + (lane & 31);
            float y;
            if (!RET) {
                const float rs = rsqrtf(s2 * (1.f / 128.f) + EPS);
                y = acc[j][r] * rs * P.dn_norm[dv] * silu_f(bf2f((bf16_t)gz[j][r]));
                mixed[t * D + h * 128 + dv] = f2bf(y);
            } else {
                const float mu = s1 * (1.f / 128.f);
                const float var = fmaxf(s2 * (1.f / 128.f) - mu * mu, 0.f);
                const float rs = rsqrtf(var + EPS);
                y = ((acc[j][r] - mu) * rs * P.ret_gn_w[h * 128 + dv] + P.ret_gn_b[h * 128 + dv]) * silu_f(bf2f((bf16_t)gz[j][r]));
                mixed[t * D + 1024 + h * 128 + dv] = f2bf(y);
            }
        }
    }
}

__device__ __forceinline__ void phase_chunk3(const Params& P, int bid, int nb, unsigned char* smem) {
    for (int u0 = bid; u0 < 2048; u0 += nb) { const int u = (bid & 1) ? ((u0 + 1024) & 2047) : u0; if (u < 1024) chunk_out<128, false>(P, u, smem); else chunk_out<64, true>(P, u - 1024, smem); }
}

__device__ __forceinline__ void ins16(float (&l)[16], float x) {
#pragma unroll
    for (int i = 0; i < 16; ++i) { const float hi = fmaxf(l[i], x); x = fminf(l[i], x); l[i] = hi; }
}
__device__ __forceinline__ void ins16x2(float (&l)[16], float xa, float xb) {
#pragma unroll
    for (int i = 0; i < 16; ++i) {
        const float h1 = fmaxf(l[i], xa); xa = fminf(l[i], xa);
        const float h2 = fmaxf(h1, xb); xb = fminf(h1, xb);
        l[i] = h2;
    }
}
__device__ __forceinline__ void phase_route(const Params& P, int bid, int nb, unsigned char* smem) {
    int* idx = (int*)(P.ws + WS_IDX); float* gates = (float*)(P.ws + WS_GATES);
    const bf16_t* Q = (const bf16_t*)(P.ws + WS_Q); const bf16_t* KEYS = (const bf16_t*)(P.ws + WS_KEYS);
    int tid_ = VTID; asm volatile("" : "+v"(tid_));
    const int tid = tid_, wave = tid >> 6, lane = tid & 63, fr = lane & 15, fq = lane >> 4;
    float* tile = (float*)smem;
    unsigned* L = (unsigned*)(smem + 256 * 33 * 4);
    const float NEG = -3.0e38f;
    for (int u = bid; u < 512; u += nb) {
        const size_t R0 = (size_t)u * 256;
        const size_t t0 = (size_t)u * 16;
        bf16x8 af[4][4];
#pragma unroll
        for (int j = 0; j < 4; ++j)
#pragma unroll
            for (int ks = 0; ks < 4; ++ks) af[j][ks] = *(const bf16x8*)(Q + (t0 + fr) * D + (4 * wave + j) * 128 + ks * 32 + fq * 8);
        float l[16];
#pragma unroll
        for (int i = 0; i < 16; ++i) l[i] = NEG;
        bf16x8 bq[2][2][4];
#define ROUTE_LOADB(chh, j0) _Pragma("unroll") for (int j = 0; j < 2; ++j) _Pragma("unroll") for (int nt = 0; nt < 2; ++nt) _Pragma("unroll") for (int ks = 0; ks < 4; ++ks) \
            bq[j][nt][ks] = *(const bf16x8*)(KEYS + (size_t)((4 * wave + (j0) + j) * 128 + (chh) * 32 + nt * 16 + fr) * 128 + ks * 32 + fq * 8);
#define ROUTE_MMA(j0) _Pragma("unroll") for (int j = 0; j < 2; ++j) _Pragma("unroll") for (int nt = 0; nt < 2; ++nt) { \
            f32x4 acc = {0.f, 0.f, 0.f, 0.f}; \
            _Pragma("unroll") for (int ks = 0; ks < 4; ++ks) acc = __builtin_amdgcn_mfma_f32_16x16x32_bf16(af[(j0) + j][ks], bq[j][nt][ks], acc, 0, 0, 0); \
            _Pragma("unroll") for (int jj = 0; jj < 4; ++jj) tile[((fq * 4 + jj) * 16 + 4 * wave + (j0) + j) * 33 + nt * 16 + fr] = acc[jj]; }
        ROUTE_LOADB(0, 0)
        for (int ch = 0; ch < 4; ++ch) {
            HSYNC();
            ROUTE_MMA(0)
            ROUTE_LOADB(ch, 2)
            ROUTE_MMA(2)
            if (ch < 3) { ROUTE_LOADB(ch + 1, 0) }
            HSYNC();
#pragma unroll
            for (int j = 0; j < 32; j += 2) {
                const float xa = __uint_as_float((__float_as_uint(tile[tid * 33 + j]) & ~0x7Fu) | (unsigned)(ch * 32 + j));
                const float xb = __uint_as_float((__float_as_uint(tile[tid * 33 + j + 1]) & ~0x7Fu) | (unsigned)(ch * 32 + j + 1));
                ins16x2(l, xa, xb);
            }
        }
#pragma unroll
        for (int i = 0; i < 16; ++i) L[tid * 16 + i] = __float_as_uint(l[i]);
        HSYNC();
        const int pe = tid & ~1, po = tid | 1;
        float s1[16], s2[16];
#pragma unroll
        for (int i = 0; i < 16; ++i) { s1[i] = __uint_as_float(L[pe * 16 + i]); s2[i] = __uint_as_float(L[po * 16 + i]); }
        float m[16];
#pragma unroll
        for (int i = 0; i < 16; ++i) m[i] = NEG;
#pragma unroll
        for (int i = 0; i < 16; ++i)
#pragma unroll
            for (int j = 0; j < 16; ++j)
                if ((i + 1) * (j + 1) <= 16) ins16(m, __uint_as_float((__float_as_uint(s1[i] + s2[j]) & ~0xFFu) | (unsigned)(i * 16 + j)));
        float e[16], sum = 0.f;
#pragma unroll
        for (int r = 0; r < 16; ++r) { e[r] = __expf(m[r] - m[0]); sum += e[r]; }
        const float inv = 1.f / sum;
        const int par = tid & 1;
        const size_t ob = ((R0 + tid) >> 1) * 16 + par * 8;
#pragma unroll
        for (int r = 0; r < 8; ++r) {
            float k_lo = m[r], k_hi = m[r + 8], e_lo = e[r], e_hi = e[r + 8];
            asm volatile("" : "+v"(k_lo), "+v"(k_hi), "+v"(e_lo), "+v"(e_hi));
            const float key = par ? k_hi : k_lo;
            const float ev = par ? e_hi : e_lo;
            const unsigned cand = __float_as_uint(key) & 0xFFu;
            const unsigned i1 = L[pe * 16 + (cand >> 4)] & 0x7Fu, i2 = L[po * 16 + (cand & 15)] & 0x7Fu;
            idx[ob + r] = (int)(i1 * 128 + i2);
            gates[ob + r] = ev * inv;
        }
    }
}

typedef float f32x2 __attribute__((ext_vector_type(2)));
typedef float v32f __attribute__((ext_vector_type(32)));
typedef float v16f __attribute__((ext_vector_type(16)));
typedef unsigned v6u __attribute__((ext_vector_type(6)));
constexpr int EROW = 1536;
__device__ __forceinline__ void fp6_calibrate(int (&sig)[32]) {
    v16f tlo, thi;
#pragma unroll
    for (int i = 0; i < 16; ++i) { tlo[i] = (i < 8) ? 0.125f * i : 1.f + 0.125f * (i - 8); thi[i] = (i < 8) ? 2.f + 0.25f * i : 4.f + 0.5f * (i - 8); }
    asm volatile("" : "+v"(tlo), "+v"(thi));
    const v6u tw = __builtin_amdgcn_cvt_scalef32_2xpk16_fp6_f32(tlo, thi, 1.0f);
    const v32f tr = __builtin_amdgcn_cvt_scalef32_pk32_f32_fp6(tw, 1.0f);
#pragma unroll
    for (int j = 0; j < 32; ++j) {
        const float v = tr[j];
        const int k = v < 2.f ? (int)(v * 8.f + 0.5f) : (v < 4.f ? 16 + (int)((v - 2.f) * 4.f + 0.5f) : 24 + (int)((v - 4.f) * 2.f + 0.5f));
        sig[j] = __builtin_amdgcn_readfirstlane(k) & 31;
    }
}
__device__ __forceinline__ void phase_econv(const Params& P, int bid, int nb, unsigned char* smem) {
    int tid_ = VTID; asm volatile("" : "+v"(tid_));
    const int wave = tid_ >> 6, lane = tid_ & 63;
    float* scales = (float*)(P.ws + WS_ESC);
    bool fp4_natural;
    { float ta = 1.0f, tb = 2.0f; asm volatile("" : "+v"(ta), "+v"(tb));
      const unsigned tw = __builtin_amdgcn_cvt_scalef32_pk_fp4_f32(0u, ta, tb, 1.0f, 0);
      const f32x2 tr = __builtin_amdgcn_cvt_scalef32_pk_f32_fp4(tw, 1.0f, 0);
      fp4_natural = __builtin_amdgcn_readfirstlane(tr[0] == 1.0f ? 1 : 0) != 0; }
    for (int r = bid * 4 + wave; r < 32768; r += nb * 4) {
        const bool isv = r >= 16384;
        const float* src = (isv ? P.expert_v : P.expert_u) + (size_t)(r & 16383) * D + lane * 32;
        f32x4 v[8]; float am = 0.f;
#pragma unroll
        for (int i = 0; i < 8; ++i) { v[i] = *(const f32x4*)(src + i * 4); am = fmaxf(am, fmaxf(fmaxf(fabsf(v[i][0]), fabsf(v[i][1])), fmaxf(fabsf(v[i][2]), fabsf(v[i][3])))); }
        am = wave_max(am);
        {
            unsigned char* dst = (isv ? P.ws + WS_EV4 + (size_t)(r - 16384) * 1024 : P.ws + WS_EU8 + (size_t)r * 1024) + lane * 16;
            const float sc = am > 0.f ? 6.0f / (0.8f * am) : 1.f;
            unsigned w[4] = {0u, 0u, 0u, 0u};
#define FP4_PK(i, bs) { const float a = v[(i) >> 1][((i) & 1) * 2] * sc, b = v[(i) >> 1][((i) & 1) * 2 + 1] * sc; \
                w[(i) >> 2] = __builtin_amdgcn_cvt_scalef32_pk_fp4_f32(w[(i) >> 2], fp4_natural ? a : b, fp4_natural ? b : a, 1.0f, bs); }
            FP4_PK(0, 0) FP4_PK(1, 1) FP4_PK(2, 2) FP4_PK(3, 3) FP4_PK(4, 0) FP4_PK(5, 1) FP4_PK(6, 2) FP4_PK(7, 3)
            FP4_PK(8, 0) FP4_PK(9, 1) FP4_PK(10, 2) FP4_PK(11, 3) FP4_PK(12, 0) FP4_PK(13, 1) FP4_PK(14, 2) FP4_PK(15, 3)
            *(uint4*)dst = make_uint4(w[0], w[1], w[2], w[3]);
            if (lane == 0) scales[r] = am > 0.f ? (0.8f * am) * (1.f / 6.0f) : 1.f;
        }
    }
}

__device__ __forceinline__ float gelu_f(float d) { return 0.5f * d * (1.f + erff(d * 0.70710678118654752f)); }

template <bool DRY>
__device__ __forceinline__ void phase_peer(const Params& P, int bid, int nb, int unit_lo = 0, int unit_hi = 512, int unit_step = 0) {
    const bf16_t* hn = (const bf16_t*)(P.ws + WS_HN); const int* idx = (const int*)(P.ws + WS_IDX); const float* gates = (const float*)(P.ws + WS_GATES);
    bf16_t* H = (bf16_t*)(P.ws + WS_H);
    const unsigned char* EU = P.ws + WS_EU8; const unsigned char* EV = P.ws + WS_EV4; const float* SC = (const float*)(P.ws + WS_ESC);
    const int wave = VTID >> 6, lane = VTID & 63;
    if (unit_step == 0) { unit_lo = bid; unit_step = nb; }
    for (int uu = unit_lo; uu < unit_hi; uu += unit_step)
    for (int tk = 0; tk < 4; ++tk) {
        const int t = uu * 16 + wave * 4 + tk;
        v32f acc; float xr[32];
#pragma unroll
        for (int q = 0; q < 4; ++q) {
            const uint4 v = *(const uint4*)(hn + (size_t)t * D + lane * 32 + q * 8);
            const unsigned ww[4] = {v.x, v.y, v.z, v.w};
#pragma unroll
            for (int j = 0; j < 4; ++j) { xr[q * 8 + 2 * j] = __uint_as_float(ww[j] << 16); xr[q * 8 + 2 * j + 1] = __uint_as_float(ww[j] & 0xffff0000u); }
        }
#pragma unroll
        for (int i = 0; i < 32; ++i) acc[i] = 0.f;
        const float rs_t = rsqrtf(((const float*)(P.ws + WS_RSS))[t] * (1.f / 2048.f) + EPS);
        const int   my_i0 = idx[(size_t)t * 128 + lane],   my_i1 = idx[(size_t)t * 128 + 64 + lane];
        const float my_g0 = gates[(size_t)t * 128 + lane], my_g1 = gates[(size_t)t * 128 + 64 + lane];
        uint4 U0, U1, U2, U3, U4, U5, U6, U7;
        uint4 V0, V1, V2, V3, V4, V5, V6, V7;
#define PEER_E(k) ((k) < 64 ? __builtin_amdgcn_readlane(my_i0, (k)) : __builtin_amdgcn_readlane(my_i1, (k) - 64))
#define PEER_LDU(j, kk) { const unsigned o_ = (unsigned)PEER_E(kk) * 1024u + lane16; U##j = *(const uint4*)(EU + o_); }
#define PEER_LDV(j, kk) { const unsigned o_ = (unsigned)PEER_E(kk) * 1024u + lane16; V##j = *(const uint4*)(EV + o_); }
#define PEER_DOT(j, dst) { const unsigned uw[4] = {U##j.x, U##j.y, U##j.z, U##j.w}; float d = 0.f; \
        _Pragma("unroll") for (int q = 0; q < 4; ++q) { \
            const f32x2 f0 = __builtin_amdgcn_cvt_scalef32_pk_f32_fp4(uw[q], 1.0f, 0), f1 = __builtin_amdgcn_cvt_scalef32_pk_f32_fp4(uw[q], 1.0f, 1), \
                        f2 = __builtin_amdgcn_cvt_scalef32_pk_f32_fp4(uw[q], 1.0f, 2), f3 = __builtin_amdgcn_cvt_scalef32_pk_f32_fp4(uw[q], 1.0f, 3); \
            d += f0[0] * xr[q * 8] + f0[1] * xr[q * 8 + 1] + f1[0] * xr[q * 8 + 2] + f1[1] * xr[q * 8 + 3]; \
            d += f2[0] * xr[q * 8 + 4] + f2[1] * xr[q * 8 + 5] + f3[0] * xr[q * 8 + 6] + f3[1] * xr[q * 8 + 7]; } \
        dst = d; __builtin_amdgcn_sched_barrier(0); }
#define PEER_AXPY(j, aj) { const unsigned vw[4] = {V##j.x, V##j.y, V##j.z, V##j.w}; \
        _Pragma("unroll") for (int q = 0; q < 4; ++q) { \
            const f32x2 f0 = __builtin_amdgcn_cvt_scalef32_pk_f32_fp4(vw[q], 1.0f, 0), f1 = __builtin_amdgcn_cvt_scalef32_pk_f32_fp4(vw[q], 1.0f, 1), \
                        f2 = __builtin_amdgcn_cvt_scalef32_pk_f32_fp4(vw[q], 1.0f, 2), f3 = __builtin_amdgcn_cvt_scalef32_pk_f32_fp4(vw[q], 1.0f, 3); \
            acc[q * 8] += (aj) * f0[0]; acc[q * 8 + 1] += (aj) * f0[1]; acc[q * 8 + 2] += (aj) * f1[0]; acc[q * 8 + 3] += (aj) * f1[1]; \
            acc[q * 8 + 4] += (aj) * f2[0]; acc[q * 8 + 5] += (aj) * f2[1]; acc[q * 8 + 6] += (aj) * f3[0]; acc[q * 8 + 7] += (aj) * f3[1]; } __builtin_amdgcn_sched_barrier(0); }
        const unsigned lane16 = (unsigned)lane * 16u;
        PEER_LDU(0, 0) PEER_LDU(1, 1) PEER_LDU(2, 2) PEER_LDU(3, 3) PEER_LDU(4, 4) PEER_LDU(5, 5) PEER_LDU(6, 6) PEER_LDU(7, 7)
        PEER_LDV(0, 0) PEER_LDV(1, 1) PEER_LDV(2, 2) PEER_LDV(3, 3) PEER_LDV(4, 4) PEER_LDV(5, 5) PEER_LDV(6, 6) PEER_LDV(7, 7)
        const bool b5 = (lane & 32) != 0, b4 = (lane & 16) != 0, b3 = (lane & 8) != 0;
        for (int k0 = 0; k0 < 128; k0 += 8) {
            const bool more = k0 + 8 < 128;
            const int src_lane = (k0 & 63) + (lane >> 3);
            const int e_l = __shfl(k0 < 64 ? my_i0 : my_i1, src_lane);
            const float g_l = __shfl(k0 < 64 ? my_g0 : my_g1, src_lane);
            const float su_l = SC[e_l], sv_l = SC[16384 + e_l];
            float p0, p1, p2, p3, p4, p5, p6, p7;
            PEER_DOT(0, p0)
            PEER_DOT(1, p1)
            PEER_DOT(2, p2)
            PEER_DOT(3, p3)
            PEER_DOT(4, p4)
            PEER_DOT(5, p5)
            PEER_DOT(6, p6)
            PEER_DOT(7, p7)
#define PEER_SW32(a, b, o) { const auto r_ = __builtin_amdgcn_permlane32_swap(__float_as_uint(a), __float_as_uint(b), false, false); o = __uint_as_float(r_[0]) + __uint_as_float(r_[1]); }
#define PEER_SW16(a, b, o) { const auto r_ = __builtin_amdgcn_permlane16_swap(__float_as_uint(a), __float_as_uint(b), false, false); o = __uint_as_float(r_[0]) + __uint_as_float(r_[1]); }
#define PEER_DPP(v, ctrl) __int_as_float(__builtin_amdgcn_update_dpp(0, __float_as_int(v), (ctrl), 0xF, 0xF, false))
            float q0, q1, q2, q3, r0, r1;
            PEER_SW32(p0, p4, q0) PEER_SW32(p1, p5, q1) PEER_SW32(p2, p6, q2) PEER_SW32(p3, p7, q3)
            PEER_SW16(q0, q2, r0) PEER_SW16(q1, q3, r1)
            const float keep = b3 ? r1 : r0, send = b3 ? r0 : r1;
            float dt = keep + PEER_DPP(send, 0x128);
            dt += PEER_DPP(dt, 0xB1); dt += PEER_DPP(dt, 0x4E); dt += PEER_DPP(dt, 0x141);
            const float pre = dt * su_l * rs_t;
            const int a_l = __float_as_int(gelu_f(pre) * g_l * sv_l);
            { const float a0 = __int_as_float(__builtin_amdgcn_readlane(a_l, 0));  PEER_AXPY(0, a0) if (more) { PEER_LDV(0, k0 + 8) PEER_LDU(0, k0 + 8) } }
            { const float a1 = __int_as_float(__builtin_amdgcn_readlane(a_l, 8));  PEER_AXPY(1, a1) if (more) { PEER_LDV(1, k0 + 9) PEER_LDU(1, k0 + 9) } }
            { const float a2 = __int_as_float(__builtin_amdgcn_readlane(a_l, 16)); PEER_AXPY(2, a2) if (more) { PEER_LDV(2, k0 + 10) PEER_LDU(2, k0 + 10) } }
            { const float a3 = __int_as_float(__builtin_amdgcn_readlane(a_l, 24)); PEER_AXPY(3, a3) if (more) { PEER_LDV(3, k0 + 11) PEER_LDU(3, k0 + 11) } }
            { const float a4 = __int_as_float(__builtin_amdgcn_readlane(a_l, 32)); PEER_AXPY(4, a4) if (more) { PEER_LDV(4, k0 + 12) PEER_LDU(4, k0 + 12) } }
            { const float a5 = __int_as_float(__builtin_amdgcn_readlane(a_l, 40)); PEER_AXPY(5, a5) if (more) { PEER_LDV(5, k0 + 13) PEER_LDU(5, k0 + 13) } }
            { const float a6 = __int_as_float(__builtin_amdgcn_readlane(a_l, 48)); PEER_AXPY(6, a6) if (more) { PEER_LDV(6, k0 + 14) PEER_LDU(6, k0 + 14) } }
            { const float a7 = __int_as_float(__builtin_amdgcn_readlane(a_l, 56)); PEER_AXPY(7, a7) if (more) { PEER_LDV(7, k0 + 15) PEER_LDU(7, k0 + 15) } }
        }
        if (DRY) {
#pragma unroll
            for (int i = 0; i < 32; ++i) asm volatile("" :: "v"(acc[i]));
            continue;
        }
        float ss = 0.f;
#pragma unroll
        for (int q = 0; q < 4; ++q) {
            uint4* hp = (uint4*)(H + (size_t)t * D + lane * 32 + q * 8);
            const uint4 hv = *hp; const unsigned hw[4] = {hv.x, hv.y, hv.z, hv.w}; unsigned ow[4];
#pragma unroll
            for (int j = 0; j < 4; ++j) {
                const float a = __uint_as_float(hw[j] << 16) + acc[q * 8 + 2 * j], b = __uint_as_float(hw[j] & 0xffff0000u) + acc[q * 8 + 2 * j + 1];
                acc[q * 8 + 2 * j] = a; acc[q * 8 + 2 * j + 1] = b; ss += a * a + b * b; ow[j] = pack2(a, b);
            }
            *hp = make_uint4(ow[0], ow[1], ow[2], ow[3]);
        }
        ss = wave_sum(ss);
        const float rs = rsqrtf(ss * (1.f / 2048.f) + EPS);
        bf16_t* hn3 = (bf16_t*)(P.ws + WS_HN) + (size_t)t * D + lane * 32;
#pragma unroll
        for (int q = 0; q < 4; ++q) {
            unsigned w[4];
#pragma unroll
            for (int j = 0; j < 4; ++j) { const int col = lane * 32 + q * 8 + 2 * j;
                w[j] = pack2(acc[q * 8 + 2 * j] * rs * P.norm_ple[col], acc[q * 8 + 2 * j + 1] * rs * P.norm_ple[col + 1]); }
            *(uint4*)(hn3 + q * 8) = make_uint4(w[0], w[1], w[2], w[3]);
        }
    }
}

enum { PH_PREP = 0, PH_GEMM1, PH_CHUNK1, PH_SCAN, PH_CHUNK3, PH_GEMM2, PH_GEMM3, PH_ROUTE, PH_PEER, PH_GEMM4, PH_FINAL, PH_COUNT };

#define XB_TMO      128
#define XB_XCNT(j)  (256  + 64 * (j))
#define XB_XSUB(j)  (1280 + 64 * (j))
#define XB_XGEN(j)  (2304 + 64 * (j))
#define XB_TOP      3328
#define XB_TOPGEN   3392
#define XCD_BAR_WORDS 3456
#define XB_SPIN_CAP (1u << 20)
#define LAS __attribute__((address_space(3)))
__device__ __forceinline__ unsigned xb_ld(unsigned* p)              { return __hip_atomic_load(p, __ATOMIC_RELAXED, __HIP_MEMORY_SCOPE_AGENT); }
__device__ __forceinline__ unsigned xb_add(unsigned* p, unsigned v) { return __hip_atomic_fetch_add(p, v, __ATOMIC_RELAXED, __HIP_MEMORY_SCOPE_AGENT); }
__device__ __forceinline__ unsigned xb_xcc_id() { return (unsigned)__builtin_amdgcn_s_getreg((3 << 11) | 20) & 0xFu; }
#define XB_SPIN(cond, bar) do { unsigned _sp = 0; while (cond) { __builtin_amdgcn_s_sleep(1); \
    if ((++_sp & 255u) == 0u) { if (xb_ld(&(bar)[XB_TMO])) break; if (_sp > XB_SPIN_CAP) { atomicAdd(&(bar)[XB_TMO], 1u); break; } } } } while (0)
struct XcdBarrier { unsigned* bar; unsigned x; volatile LAS unsigned* st; };
__device__ __forceinline__ XcdBarrier xcd_barrier_post(unsigned* bar, volatile LAS unsigned* st) {
    XcdBarrier b; b.bar = bar; b.x = xb_xcc_id(); b.st = st;
    if (threadIdx.x == 0) (void)xb_add(&bar[XB_XCNT(b.x)], 1u);
    return b;
}
__device__ __forceinline__ void xcd_barrier_complete(unsigned* bar, unsigned x, unsigned& nloc, unsigned& nx) {
    const unsigned G = gridDim.x * gridDim.y * gridDim.z;
    unsigned sum, cnt, mine, sp = 0u;
    for (;;) {
        sum = 0u; cnt = 0u; mine = 0u;
#pragma unroll
        for (unsigned j = 0; j < 16; ++j) { const unsigned c = xb_ld(&bar[XB_XCNT(j)]); sum += c; cnt += (c > 0u) ? 1u : 0u; mine = (j == x) ? c : mine; }
        if (sum == G) break;
        __builtin_amdgcn_s_sleep(1);
        if ((++sp & 255u) == 0u) { if (xb_ld(&bar[XB_TMO])) break; if (sp > XB_SPIN_CAP) { atomicAdd(&bar[XB_TMO], 1u); break; } }
    }
    nloc = mine > 0u ? mine : 1u; nx = cnt > 0u ? cnt : 1u;
}
__device__ __forceinline__ void xcd_barrier(const XcdBarrier& b) {
    asm volatile("s_waitcnt vmcnt(0)" ::: "memory");
    __syncthreads();
    if (threadIdx.x == 0) {
        unsigned* bar = b.bar;
        __builtin_amdgcn_s_waitcnt(0);
        unsigned nloc = b.st[0], nx = b.st[1];
        if (nloc == 0u) { xcd_barrier_complete(bar, b.x, nloc, nx); b.st[0] = nloc; b.st[1] = nx; }
        const unsigned old = xb_add(&bar[XB_XSUB(b.x)], 1u);
        const unsigned gen = old / nloc;
        if (old + 1u == (gen + 1u) * nloc) {
            __builtin_amdgcn_fence(__ATOMIC_RELEASE, "agent");
            asm volatile("s_waitcnt vmcnt(0)" ::: "memory");
            const unsigned og = xb_add(&bar[XB_TOP], 1u);
            const unsigned tg = og / nx;
            if (og + 1u == (tg + 1u) * nx) xb_add(&bar[XB_TOPGEN], 1u);
            else XB_SPIN(xb_ld(&bar[XB_TOPGEN]) == tg, bar);
            __builtin_amdgcn_fence(__ATOMIC_ACQUIRE, "agent");
            xb_add(&bar[XB_XGEN(b.x)], 1u);
            asm volatile("s_waitcnt vmcnt(0)" ::: "memory");
        } else {
            XB_SPIN(xb_ld(&bar[XB_XGEN(b.x)]) == gen, bar);
            __builtin_amdgcn_fence(__ATOMIC_ACQUIRE, "agent");
            asm volatile("s_waitcnt vmcnt(0)" ::: "memory");
        }
    }
    __syncthreads();
}

__device__ __forceinline__ void run_phase(const Params& P, int ph, int bid, int nb, unsigned char* smem, int rbid, int rnb, unsigned char* rsmem) {
    switch (ph) {
        case PH_PREP:   phase_prep(P, bid, nb, smem); break;
        case PH_GEMM1:  phase_gemm1(P, rbid, rnb, rsmem); break;
        case PH_CHUNK1: phase_chunk1(P, bid, nb, smem); break;
        case PH_SCAN:   phase_scan(P, bid, nb, smem, rbid, rnb, rsmem); break;
        case PH_CHUNK1 + 100: phase_chunk1(P, bid, nb, smem, 1); break;
        case PH_CHUNK1 + 200: phase_chunk1(P, bid, nb, smem, 2); break;
        case PH_SCAN + 100: phase_scan(P, bid, nb, smem, rbid, rnb, rsmem, 1); break;
        case PH_SCAN + 200: phase_scan(P, bid, nb, smem, rbid, rnb, rsmem, 2); break;
        case PH_CHUNK3: phase_chunk3(P, bid, nb, smem); break;
        case PH_GEMM2:  phase_gemm2(P, rbid, rnb, rsmem); break;
        case PH_GEMM3:  phase_gemm3(P, rbid, rnb, rsmem); break;
        case PH_ROUTE:
                        for (int u = bid; u < 512; u += nb) {
                            phase_route(P, u, 512, smem);
                            asm volatile("s_waitcnt vmcnt(0)" ::: "memory"); HSYNC();
                            phase_peer<false>(P, bid, nb, u, u + 1, 1);
                        }
                        break;
        case PH_PEER:   break;
        case PH_PEER + 100: phase_peer<true>(P, bid, nb); break;
        case PH_GEMM4:  phase_gemm4(P, rbid, rnb, rsmem); break;
        case PH_FINAL:  phase_final(P, bid, nb); break;
    }
}

#ifndef PROBE_A
#define PROBE_A -1
#endif
#ifndef PROBE_B
#define PROBE_B -1
#endif
constexpr int LDS_BYTES = 131072 + 16 + 256 + 16 + 128;

__global__ void __launch_bounds__(512, 2) fwd_kernel(Params P, int ph_lo, int ph_hi) {
    extern __shared__ __attribute__((aligned(16))) unsigned char rsmem[];
    const int rbid = blockIdx.x, rnb = gridDim.x;
    const int half = __builtin_amdgcn_readfirstlane((int)(threadIdx.x >> 8));
    const int bid = rbid * 2 + half, nb = rnb * 2;
    unsigned char* smem = rsmem + half * 65536;
    volatile LAS unsigned* st = (volatile LAS unsigned*)(rsmem + 131072);
    if (threadIdx.x == 0) { st[0] = 0u; st[1] = 0u; *(volatile LAS unsigned*)(rsmem + 131072 + 288) = 0u; *(volatile LAS unsigned*)(rsmem + 131072 + 288 + 64) = 0u; }
    __syncthreads();
    XcdBarrier xb = xcd_barrier_post((unsigned*)(P.ws + WS_BAR), st);
#if PROBE_A >= 0
    unsigned long long* tstamp = (unsigned long long*)(rsmem + 131072 + 16);
    xcd_barrier(xb);
    if (threadIdx.x == 0) tstamp[0] = __builtin_amdgcn_s_memrealtime();
#define RUN(ph) if (ph_lo <= (ph) && (ph) < ph_hi) { run_phase(P, (ph), bid, nb, smem, rbid, rnb, rsmem); xcd_barrier(xb); if (threadIdx.x == 0) tstamp[(ph) + 1] = __builtin_amdgcn_s_memrealtime(); }
#else
#ifndef SCAN_PROBE
#define SCAN_PROBE 0
#endif
#ifndef REPEAT_PH
#define REPEAT_PH -1
#endif
#define RUN(ph) if (ph_lo <= (ph) && (ph) < ph_hi) { if ((ph) == REPEAT_PH && (ph) == PH_PEER) { run_phase(P, PH_PEER + 100, bid, nb, smem, rbid, rnb, rsmem); xcd_barrier(xb); } run_phase(P, (ph), bid, nb, smem, rbid, rnb, rsmem); if ((ph) == REPEAT_PH && (ph) != PH_PEER) { xcd_barrier(xb); run_phase(P, ((ph) == PH_SCAN || (ph) == PH_CHUNK1) ? (ph) + SCAN_PROBE : (ph), bid, nb, smem, rbid, rnb, rsmem); } if ((ph) + 1 < ph_hi) xcd_barrier(xb); }
#endif
    RUN(PH_PREP) RUN(PH_GEMM1) RUN(PH_CHUNK1) RUN(PH_SCAN) RUN(PH_CHUNK3) RUN(PH_GEMM2) RUN(PH_GEMM3) RUN(PH_ROUTE)
    RUN(PH_GEMM4) RUN(PH_FINAL)
#if PROBE_A >= 0
    __syncthreads();
    if (rbid == 0) {
        const float da = (float)(tstamp[PROBE_A + 1] - tstamp[PROBE_A]) * 0.01f;
        if (threadIdx.x == 0) P.out[0] = da;
#if PROBE_B >= 0
        const float db = (float)(tstamp[PROBE_B + 1] - tstamp[PROBE_B]) * 0.01f * (1.f / 16.f);
        for (int i = threadIdx.x; i < 65536; i += 512) P.out[65536 + i] = db;
#endif
    }
#endif
}

extern "C" void kernel_launch(void* const* d_in, const int* in_sizes, int n_in, void* d_out, int out_size, void* d_ws, size_t ws_size, hipStream_t stream) {
    static int grid = 0;
    if (grid == 0) {
        if (n_in != 21 || out_size != T * D || ws_size < WS_END) { fprintf(stderr, "kernel_launch: unexpected shapes: n_in %d out %d ws %zu (need %zu)\n", n_in, out_size, ws_size, (size_t)WS_END); grid = -1; return; }
        if (hipFuncSetAttribute((const void*)fwd_kernel, hipFuncAttributeMaxDynamicSharedMemorySize, LDS_BYTES) != hipSuccess) { fprintf(stderr, "kernel_launch: hipFuncSetAttribute failed\n"); grid = -1; return; }
        int dev = 0, cus = 0, per_cu = 0;
        hipGetDevice(&dev); hipDeviceGetAttribute(&cus, hipDeviceAttributeMultiprocessorCount, dev);
        if (hipOccupancyMaxActiveBlocksPerMultiprocessor(&per_cu, (const void*)fwd_kernel, 512, LDS_BYTES) != hipSuccess || per_cu < 1) { fprintf(stderr, "kernel_launch: occupancy query failed (%d)\n", per_cu); grid = -1; return; }
        if (per_cu > 1) per_cu = 1;
        grid = cus * per_cu;
        fprintf(stderr, "kernel_launch: grid %d (%d CUs x %d)\n", grid, cus, per_cu);
    }
    if (grid < 0) return;
    Params P{};
    P.x = (const float*)d_in[0]; P.p = (const float*)d_in[1]; P.positions = (const int*)d_in[2]; P.norm_mix = (const float*)d_in[3]; P.w_in = (const float*)d_in[4];
    P.conv_w = (const float*)d_in[5]; P.a_log = (const float*)d_in[6]; P.dt_bias = (const float*)d_in[7]; P.dn_norm = (const float*)d_in[8]; P.ret_gn_w = (const float*)d_in[9];
    P.ret_gn_b = (const float*)d_in[10]; P.w_out = (const float*)d_in[11]; P.norm_ffn = (const float*)d_in[12]; P.w_pq = (const float*)d_in[13]; P.sub_keys = (const float*)d_in[14];
    P.expert_u = (const float*)d_in[15]; P.expert_v = (const float*)d_in[16]; P.norm_ple = (const float*)d_in[17]; P.w_ple_gate = (const float*)d_in[18]; P.w_ple_proj = (const float*)d_in[19];
    P.norm_final = (const float*)d_in[20]; P.out = (float*)d_out; P.ws = (unsigned char*)d_ws;
    (void)hipMemsetAsync((unsigned char*)d_ws + WS_BAR, 0, XCD_BAR_WORDS * 4, stream);
    int lo = 0, hi = PH_COUNT;
    void* args[] = {&P, &lo, &hi};
    hipError_t e = hipLaunchCooperativeKernel((const void*)fwd_kernel, dim3(grid), dim3(512), args, LDS_BYTES, stream);
    if (e != hipSuccess) fprintf(stderr, "kernel_launch: cooperative launch failed: %s (grid %d)\n", hipGetErrorString(e), grid);
}
```

```cpp
#include <hip/hip_runtime.h>
#include <cstdio>
#include <cstdint>

typedef unsigned short bf16_t;
typedef short bf16x8 __attribute__((ext_vector_type(8)));
typedef float f32x16 __attribute__((ext_vector_type(16)));
typedef float f32x4 __attribute__((ext_vector_type(4)));
__device__ __forceinline__ int fresh_tid() { int t = (int)threadIdx.x; asm volatile("" : "+v"(t)); return t; }
#define VTID (fresh_tid() & 255)

constexpr int T = 8192, D = 2048, SEQ = 4096;
constexpr int NPROJ = 7424;
constexpr int C_Z = 3072, C_RQ = 4096, C_RK = 4608, C_RV = 5120, C_RG = 6144, C_A = 7168, C_B = 7176;
constexpr int IN_COLS = 7184;
constexpr float EPS = 1e-6f;

constexpr size_t WS_HN    = 0;
constexpr size_t WS_KVT   = WS_HN;
constexpr size_t WS_WTIN  = WS_HN + (size_t)T * D * 2;
constexpr size_t WS_STR   = WS_WTIN;
constexpr size_t WS_ATTR  = WS_STR + (size_t)1024 * 128 * 64 * 2;
constexpr size_t WS_WTOUT = WS_WTIN + (size_t)NPROJ * D * 2;
constexpr size_t WS_WTPQ  = WS_WTOUT + (size_t)D * D * 2;
constexpr size_t WS_WTG   = WS_WTPQ + (size_t)D * D * 2;
constexpr size_t WS_WTPP  = WS_WTG + (size_t)D * D * 2;
constexpr size_t WS_KEYS  = WS_WTPP + (size_t)D * 256 * 2;
constexpr size_t WS_PBF   = WS_KEYS + (size_t)16 * 128 * 128 * 2;
constexpr size_t WS_PROJ  = WS_PBF + (size_t)T * 256 * 2;
constexpr size_t WS_Q     = WS_PROJ;
constexpr size_t WS_SCORES= WS_PROJ + (size_t)T * D * 2;
constexpr size_t WS_MIXED = WS_PROJ + (size_t)T * NPROJ * 2;
constexpr size_t WS_H     = WS_MIXED + (size_t)T * D * 2;
constexpr size_t WS_IDX   = WS_H + (size_t)T * D * 4;
constexpr size_t WS_GATES = WS_IDX + (size_t)T * 128 * 4;
constexpr size_t WS_U     = WS_GATES + (size_t)T * 128 * 4;
constexpr size_t WS_W     = WS_U + (size_t)1024 * 64 * 128 * 4;
constexpr size_t WS_KDT   = WS_W + (size_t)1024 * 64 * 128 * 2;
constexpr size_t WS_QG    = WS_KDT + (size_t)1024 * 128 * 64 * 2;
constexpr size_t WS_ATT   = WS_QG + (size_t)1024 * 64 * 128 * 2;
constexpr size_t WS_QGR   = WS_ATT + (size_t)1024 * 64 * 64 * 2;
constexpr size_t WS_EU8   = WS_QGR + (size_t)1024 * 64 * 64 * 2;
constexpr size_t WS_EV4   = WS_EU8 + (size_t)16384 * 2048;
constexpr size_t WS_ESC   = WS_EV4 + (size_t)16384 * 2048;
constexpr size_t WS_EG    = WS_ESC + (size_t)2 * 16384 * 4;
constexpr size_t WS_RSS   = WS_EG + 4096;
constexpr size_t WS_BAR   = WS_RSS + (size_t)T * 4;
constexpr size_t WS_CS    = WS_BAR + 16384;
constexpr size_t WS_DUMMY = WS_CS + (size_t)T * 32 * 8;
constexpr size_t WS_END   = WS_DUMMY + 32768;
constexpr size_t WS_VNT   = WS_H;
constexpr size_t WS_SC    = WS_VNT + (size_t)1024 * 128 * 64 * 2;
constexpr size_t WS_VNTR  = WS_SC + (size_t)1024 * 128 * 128 * 2;
static_assert(WS_VNTR + (size_t)1024 * 128 * 64 * 2 == WS_H + (size_t)T * D * 4, "chunk buffers must fit the H region");

struct Params {
    const float *x, *p; const int* positions;
    const float *norm_mix, *w_in, *conv_w, *a_log, *dt_bias, *dn_norm, *ret_gn_w, *ret_gn_b, *w_out, *norm_ffn, *w_pq, *sub_keys,
                *expert_u, *expert_v, *norm_ple, *w_ple_gate, *w_ple_proj, *norm_final;
    float* out; unsigned char* ws;
};

typedef __bf16 bf16v2_t __attribute__((ext_vector_type(2)));
typedef float f32v2_t __attribute__((ext_vector_type(2)));
__device__ __forceinline__ bf16_t f2bf(float f) { return __builtin_bit_cast(bf16_t, (__bf16)f); }
__device__ __forceinline__ float bf2f(bf16_t h) { return __uint_as_float(((unsigned)h) << 16); }
__device__ __forceinline__ unsigned pack2(float a, float b) { const f32v2_t v = {a, b}; return __builtin_bit_cast(unsigned, __builtin_convertvector(v, bf16v2_t)); }
#define DPPF(v, ctrl) __int_as_float(__builtin_amdgcn_update_dpp(0, __float_as_int(v), (ctrl), 0xF, 0xF, false))
__device__ __forceinline__ float half_sum32(float v) {
    v += DPPF(v, 0x128); v += DPPF(v, 0x124); v += DPPF(v, 0x122); v += DPPF(v, 0x121);
    const auto r = __builtin_amdgcn_permlane16_swap(__float_as_uint(v), __float_as_uint(v), false, false);
    return __uint_as_float(r[0]) + __uint_as_float(r[1]);
}
__device__ __forceinline__ float wave_sum(float v) {
    v = half_sum32(v);
    const auto r = __builtin_amdgcn_permlane32_swap(__float_as_uint(v), __float_as_uint(v), false, false);
    return __uint_as_float(r[0]) + __uint_as_float(r[1]);
}
__device__ __forceinline__ float wave_max(float v) {
    v = fmaxf(v, DPPF(v, 0x128)); v = fmaxf(v, DPPF(v, 0x124)); v = fmaxf(v, DPPF(v, 0x122)); v = fmaxf(v, DPPF(v, 0x121));
    const auto r = __builtin_amdgcn_permlane16_swap(__float_as_uint(v), __float_as_uint(v), false, false);
    v = fmaxf(__uint_as_float(r[0]), __uint_as_float(r[1]));
    const auto r2 = __builtin_amdgcn_permlane32_swap(__float_as_uint(v), __float_as_uint(v), false, false);
    return fmaxf(__uint_as_float(r2[0]), __uint_as_float(r2[1]));
}
__device__ __forceinline__ float silu_f(float x) { return x * __builtin_amdgcn_rcpf(1.f + __expf(-x)); }
__device__ __forceinline__ float sigmoid_f(float x) { return __builtin_amdgcn_rcpf(1.f + __expf(-x)); }

#define LASP __attribute__((address_space(3)))
__device__ __forceinline__ void half_sync(const unsigned char* smem) {
    asm volatile("s_waitcnt lgkmcnt(0)" ::: "memory");
    const unsigned half = (((unsigned)(size_t)smem) >> 16) & 1u;
    LASP unsigned* cnt = (LASP unsigned*)(size_t)(131072u + 288u + 64u * half);
    unsigned old = 0u;
    if ((threadIdx.x & 63u) == 0u) old = __hip_atomic_fetch_add(cnt, 1u, __ATOMIC_RELAXED, __HIP_MEMORY_SCOPE_WORKGROUP);
    old = (unsigned)__builtin_amdgcn_readfirstlane((int)old);
    const unsigned tgt = (old / 4u + 1u) * 4u;
    while (__hip_atomic_load(cnt, __ATOMIC_RELAXED, __HIP_MEMORY_SCOPE_WORKGROUP) < tgt) __builtin_amdgcn_s_sleep(1);
    asm volatile("" ::: "memory");
}
#define HSYNC() half_sync(smem)

template <bool MAPIN>
__device__ __forceinline__ void transpose_tile(const float* __restrict__ W, int ldw, int K, bf16_t* __restrict__ Wt, int kt, int nt, float* tile  ) {
    const int tid = VTID;
    half_sync((const unsigned char*)tile);
#pragma unroll
    for (int i = 0; i < 4; ++i) {
        const int idx = tid + 256 * i, kr = idx >> 4, c4 = idx & 15;
        const int n = nt * 64 + c4 * 4;
        int c = n; bool valid = true;
        if (MAPIN) { if (n < 4096) c = n; else if (n < 7168) c = n + 16; else if (n < 7184) c = n - 3072; else valid = false; }
        f32x4 v = {0.f, 0.f, 0.f, 0.f};
        if (valid) v = *(const f32x4*)(W + (size_t)(kt * 64 + kr) * ldw + c);
        float* d = tile + kr * 65 + c4 * 4;
        d[0] = v[0]; d[1] = v[1]; d[2] = v[2]; d[3] = v[3];
    }
    half_sync((const unsigned char*)tile);
#pragma unroll
    for (int i = 0; i < 2; ++i) {
        const int ch = tid + 256 * i, n = ch >> 3, kc = ch & 7;
        unsigned w[4];
#pragma unroll
        for (int j = 0; j < 4; ++j) w[j] = pack2(tile[(kc * 8 + 2 * j) * 65 + n], tile[(kc * 8 + 2 * j + 1) * 65 + n]);
        uint4 o = make_uint4(w[0], w[1], w[2], w[3]);
        *(uint4*)(Wt + (size_t)(nt * 64 + n) * K + kt * 64 + kc * 8) = o;
    }
}

template <bool OUT_BF16>
__device__ __forceinline__ void rmsnorm_row(const float* __restrict__ in, const float* __restrict__ w, void* __restrict__ out, int lane) {
    f32x4 v[8]; float ss = 0.f;
#pragma unroll
    for (int i = 0; i < 8; ++i) { v[i] = *(const f32x4*)(in + (i * 64 + lane) * 4); ss += v[i][0] * v[i][0] + v[i][1] * v[i][1] + v[i][2] * v[i][2] + v[i][3] * v[i][3]; }
    ss = wave_sum(ss);
    const float r = rsqrtf(ss * (1.f / 2048.f) + EPS);
#pragma unroll
    for (int i = 0; i < 8; ++i) {
        const f32x4 g = *(const f32x4*)(w + (i * 64 + lane) * 4);
        const float a = v[i][0] * r * g[0], b = v[i][1] * r * g[1], c = v[i][2] * r * g[2], d = v[i][3] * r * g[3];
        if (OUT_BF16) { uint2 o = make_uint2(pack2(a, b), pack2(c, d)); *(uint2*)((bf16_t*)out + (i * 64 + lane) * 4) = o; }
        else { f32x4 o = {a, b, c, d}; *(f32x4*)((float*)out + (i * 64 + lane) * 4) = o; }
    }
}

__device__ __forceinline__ void phase_prep(const Params& P, int bid, int nb, unsigned char* smem) {
    float* tile = (float*)smem;
    const int tid = VTID;
    const int n_in = 32 * 116, n_sq = 32 * 32, n_pp = 4 * 32;
    const int n_tr = n_in + 3 * n_sq + n_pp;
    struct TrDesc { const float* W; bf16_t* Wt; int ldw, K, kt, nt, mapin; };
    auto tr_desc = [&](int u) {
        TrDesc d;
        if (u < n_in) { d.W = P.w_in; d.Wt = (bf16_t*)(P.ws + WS_WTIN); d.ldw = IN_COLS; d.K = D; d.kt = u % 32; d.nt = u / 32; d.mapin = 1; }
        else if (u < n_in + n_sq) { const int v = u - n_in; d.W = P.w_out; d.Wt = (bf16_t*)(P.ws + WS_WTOUT); d.ldw = D; d.K = D; d.kt = v % 32; d.nt = v / 32; d.mapin = 0; }
        else if (u < n_in + 2 * n_sq) { const int v = u - n_in - n_sq; d.W = P.w_pq; d.Wt = (bf16_t*)(P.ws + WS_WTPQ); d.ldw = D; d.K = D; d.kt = v % 32; d.nt = v / 32; d.mapin = 0; }
        else if (u < n_in + 3 * n_sq) { const int v = u - n_in - 2 * n_sq; d.W = P.w_ple_gate; d.Wt = (bf16_t*)(P.ws + WS_WTG); d.ldw = D; d.K = D; d.kt = v % 32; d.nt = v / 32; d.mapin = 0; }
        else { const int v = u - n_in - 3 * n_sq; d.W = P.w_ple_proj; d.Wt = (bf16_t*)(P.ws + WS_WTPP); d.ldw = D; d.K = 256; d.kt = v % 4; d.nt = v / 4; d.mapin = 0; }
        return d;
    };
    f32x4 tv0, tv1, tv2, tv3;
#define TR_LOAD1(d, i, dst) { const int idx = tid + 256 * (i), kr = idx >> 4, c4 = idx & 15; const int n = (d).nt * 64 + c4 * 4; int c = n; bool valid = true; \
        if ((d).mapin) { if (n < 4096) c = n; else if (n < 7168) c = n + 16; else if (n < 7184) c = n - 3072; else valid = false; } \
        dst = (f32x4){0.f, 0.f, 0.f, 0.f}; if (valid) dst = *(const f32x4*)((d).W + (size_t)((d).kt * 64 + kr) * (d).ldw + c); }
#define TR_LOAD(d) { TR_LOAD1(d, 0, tv0) TR_LOAD1(d, 1, tv1) TR_LOAD1(d, 2, tv2) TR_LOAD1(d, 3, tv3) }
#define TR_PUT(i, src) { const int idx = tid + 256 * (i), kr = idx >> 4, c4 = idx & 15; float* dd = tile + kr * 65 + c4 * 4; dd[0] = src[0]; dd[1] = src[1]; dd[2] = src[2]; dd[3] = src[3]; }
    if (bid < n_tr) { const TrDesc d0 = tr_desc(bid); TR_LOAD(d0) }
    for (int u = bid; u < n_tr; u += nb) {
        const TrDesc cur = tr_desc(u);
        half_sync((const unsigned char*)tile);
        TR_PUT(0, tv0) TR_PUT(1, tv1) TR_PUT(2, tv2) TR_PUT(3, tv3)
        if (u + nb < n_tr) { const TrDesc nx = tr_desc(u + nb); TR_LOAD(nx) }
        half_sync((const unsigned char*)tile);
#pragma unroll
        for (int i = 0; i < 2; ++i) {
            const int ch = tid + 256 * i, n = ch >> 3, kc = ch & 7;
            unsigned w[4];
#pragma unroll
            for (int j = 0; j < 4; ++j) w[j] = pack2(tile[(kc * 8 + 2 * j) * 65 + n], tile[(kc * 8 + 2 * j + 1) * 65 + n]);
            *(uint4*)(cur.Wt + (size_t)(cur.nt * 64 + n) * cur.K + cur.kt * 64 + kc * 8) = make_uint4(w[0], w[1], w[2], w[3]);
        }
    }
    {
        bf16_t* keys = (bf16_t*)(P.ws + WS_KEYS); bf16_t* pbf = (bf16_t*)(P.ws + WS_PBF);
        const int n4a = 262144 / 4, n4b = T * 256 / 4;
        for (int i = bid * 256 + tid; i < n4a + n4b; i += nb * 256) {
            const bool a = i < n4a; const int j = a ? i : i - n4a;
            const f32x4 v = *(const f32x4*)((a ? P.sub_keys : P.p) + (size_t)j * 4);
            *(uint2*)((a ? keys : pbf) + (size_t)j * 4) = make_uint2(pack2(v[0], v[1]), pack2(v[2], v[3]));
        }
    }
    { float* rss = (float*)(P.ws + WS_RSS); for (int i = bid * 256 + tid; i < T; i += nb * 256) rss[i] = 0.f; }
    {
        float2* cs = (float2*)(P.ws + WS_CS);
        for (int e = bid * 256 + tid; e < T * 32; e += nb * 256) {
            const int t = e >> 5, i = e & 31;
            const float ang = (float)P.positions[t] * powf(10000.f, -(float)i / 32.f);
            float sn, c0; sincosf(ang, &sn, &c0);
            cs[e] = make_float2(c0, sn);
        }
    }
    {
        const int wave = tid >> 6, lane = tid & 63;
        bf16_t* hn = (bf16_t*)(P.ws + WS_HN);
        for (int r = bid * 4 + wave; r < T; r += nb * 4) rmsnorm_row<true>(P.x + (size_t)r * D, P.norm_mix, hn + (size_t)r * D, lane);
    }
}

__device__ __forceinline__ int lds_off(int row, int ch) { return row * 128 + ((ch ^ ((row >> 1) & 7)) << 4); }

__device__ __forceinline__ void gemm_mainloop(const bf16_t* __restrict__ A, int lda, const bf16_t* __restrict__ Bt, int ldb, int K,
                                              f32x16 (&acc)[2][2], unsigned char* smem) {
    const int tid = VTID, wave = tid >> 6, lane = tid & 63, wr = wave >> 1, wc = wave & 1;
    const int nk = K / 64;
    uint4 ra[4], rb[4];
    __syncthreads();
#pragma unroll
    for (int i = 0; i < 4; ++i) { const int c = tid + 256 * i, row = c >> 3, ch = c & 7;
        ra[i] = *(const uint4*)(A + (size_t)row * lda + ch * 8); rb[i] = *(const uint4*)(Bt + (size_t)row * ldb + ch * 8); }
#pragma unroll
    for (int i = 0; i < 4; ++i) { const int c = tid + 256 * i, row = c >> 3, ch = c & 7;
        *(uint4*)(smem + lds_off(row, ch)) = ra[i]; *(uint4*)(smem + 16384 + lds_off(row, ch)) = rb[i]; }
    __syncthreads();
    for (int kt = 0; kt < nk; ++kt) {
        unsigned char* cur = smem + (kt & 1) * 32768;
        unsigned char* nxt = smem + ((kt + 1) & 1) * 32768;
        const bool more = kt + 1 < nk;
        if (more) {
#pragma unroll
            for (int i = 0; i < 4; ++i) { const int c = tid + 256 * i, row = c >> 3, ch = c & 7;
                ra[i] = *(const uint4*)(A + (size_t)row * lda + (kt + 1) * 64 + ch * 8); rb[i] = *(const uint4*)(Bt + (size_t)row * ldb + (kt + 1) * 64 + ch * 8); }
        }
#pragma unroll
        for (int ks = 0; ks < 4; ++ks) {
            bf16x8 af[2], bfr[2];
#pragma unroll
            for (int i = 0; i < 2; ++i) { const int row = wr * 64 + i * 32 + (lane & 31); af[i] = *(const bf16x8*)(cur + lds_off(row, ks * 2 + (lane >> 5))); }
#pragma unroll
            for (int j = 0; j < 2; ++j) { const int row = wc * 64 + j * 32 + (lane & 31); bfr[j] = *(const bf16x8*)(cur + 16384 + lds_off(row, ks * 2 + (lane >> 5))); }
#pragma unroll
            for (int i = 0; i < 2; ++i)
#pragma unroll
                for (int j = 0; j < 2; ++j) acc[i][j] = __builtin_amdgcn_mfma_f32_32x32x16_bf16(af[i], bfr[j], acc[i][j], 0, 0, 0);
        }
        if (more) {
#pragma unroll
            for (int i = 0; i < 4; ++i) { const int c = tid + 256 * i, row = c >> 3, ch = c & 7;
                *(uint4*)(nxt + lds_off(row, ch)) = ra[i]; *(uint4*)(nxt + 16384 + lds_off(row, ch)) = rb[i]; }
        }
        __syncthreads();
    }
}
#define ACC_FOREACH(body)                                                                                   \
    { const int _tid = VTID, _wave = _tid >> 6, _lane = _tid & 63, _wr = _wave >> 1, _wc = _wave & 1; \
      _Pragma("unroll") for (int i = 0; i < 2; ++i) _Pragma("unroll") for (int j = 0; j < 2; ++j)          \
      _Pragma("unroll") for (int r = 0; r < 16; ++r) {                                                     \
          const int row = _wr * 64 + i * 32 + (r & 3) + 8 * (r >> 2) + 4 * (_lane >> 5);                   \
          const int col = _wc * 64 + j * 32 + (_lane & 31); body } }

__device__ __forceinline__ void zero_acc(f32x16 (&acc)[2][2]) {
#pragma unroll
    for (int i = 0; i < 2; ++i)
#pragma unroll
        for (int j = 0; j < 2; ++j)
#pragma unroll
            for (int r = 0; r < 16; ++r) acc[i][j][r] = 0.f;
}

__device__ __forceinline__ void phase_scores(const Params& P, int bid, int nb, unsigned char* smem) {
    const bf16_t* A = (const bf16_t*)(P.ws + WS_Q); const bf16_t* Bt = (const bf16_t*)(P.ws + WS_KEYS); float* C = (float*)(P.ws + WS_SCORES);
    const int nmt = T / 128, nnt = 16;
    for (int t = bid; t < nmt * nnt; t += nb) {
        const int mt = t % nmt, nt = t / nmt;
        f32x16 acc[2][2]; zero_acc(acc);
        gemm_mainloop(A + (size_t)mt * 128 * D + nt * 128, D, Bt + (size_t)nt * 128 * 128, 128, 128, acc, smem);
        ACC_FOREACH({ C[(size_t)(mt * 128 + row) * D + nt * 128 + col] = acc[i][j][r]; })
    }
}
__device__ __forceinline__ int g2_lds_byte(int r, int c) { const int st = (r >> 4) * 2 + (c >> 5), ob = (r & 15) * 64 + (c & 31) * 2; return st * 1024 + (ob ^ (((ob >> 9) & 1) << 5)); }
__device__ __forceinline__ void g2_stage_rc(int b, int& R, int& C) { const int st = b >> 10, sb = b & 1023, swz = sb ^ (((sb >> 9) & 1) << 5); R = (st >> 1) * 16 + (swz >> 6); C = (st & 1) * 32 + ((swz & 63) >> 1); }
__device__ __forceinline__ void g2_zero(f32x4 (&acc)[8][4]) {
#pragma unroll
    for (int m = 0; m < 8; ++m)
#pragma unroll
        for (int n = 0; n < 4; ++n) acc[m][n] = (f32x4){0.f, 0.f, 0.f, 0.f};
}
__device__ __forceinline__ void g2_mainloop(const bf16_t* __restrict__ Ab, int lda, const bf16_t* __restrict__ Bb, int ldb, int K, f32x4 (&acc)[8][4], unsigned char* shm) {
    const int tid = fresh_tid(), wid = tid >> 6, lane = tid & 63, wr = wid >> 2, wc = wid & 3, fr = lane & 15, fq = lane >> 4;
    int sR[4], sC[4];
#pragma unroll
    for (int i = 0; i < 4; ++i) g2_stage_rc(wid * 1024 + i * 8192 + lane * 16, sR[i], sC[i]);
#define G2_STAGE(buf, kt) { _Pragma("unroll") for (int i = 0; i < 4; ++i) { \
        __builtin_amdgcn_global_load_lds((const unsigned*)(Ab + (size_t)sR[i] * lda + (kt) * 64 + sC[i]), (unsigned*)(shm + (buf) * 65536 + wid * 1024 + i * 8192), 16, 0, 0); \
        __builtin_amdgcn_global_load_lds((const unsigned*)(Bb + (size_t)sR[i] * ldb + (kt) * 64 + sC[i]), (unsigned*)(shm + (buf) * 65536 + 32768 + wid * 1024 + i * 8192), 16, 0, 0); } }
    const int nt = K / 64;
    __syncthreads();
    G2_STAGE(0, 0)
    asm volatile("s_waitcnt vmcnt(0)" ::: "memory");
    __syncthreads();
    for (int t = 0; t < nt; ++t) {
        const int cur = t & 1;
        if (t + 1 < nt) G2_STAGE(cur ^ 1, t + 1)
        const unsigned char* SA = shm + cur * 65536; const unsigned char* SB = SA + 32768;
#pragma unroll
        for (int ks = 0; ks < 2; ++ks) {
            bf16x8 At[8], Bf[4];
#pragma unroll
            for (int m = 0; m < 8; ++m) At[m] = *(const bf16x8*)(SA + g2_lds_byte(wr * 128 + m * 16 + fr, ks * 32 + fq * 8));
#pragma unroll
            for (int n = 0; n < 4; ++n) Bf[n] = *(const bf16x8*)(SB + g2_lds_byte(wc * 64 + n * 16 + fr, ks * 32 + fq * 8));
#pragma unroll
            for (int m = 0; m < 8; ++m)
#pragma unroll
                for (int n = 0; n < 4; ++n) acc[m][n] = __builtin_amdgcn_mfma_f32_16x16x32_bf16(At[m], Bf[n], acc[m][n], 0, 0, 0);
            __builtin_amdgcn_sched_barrier(0);
        }
        asm volatile("s_waitcnt vmcnt(0)" ::: "memory");
        __syncthreads();
    }
}
#define G2_FOREACH(body)                                                                                       \
    { const int _tid = fresh_tid(), _wid = _tid >> 6, _lane = _tid & 63, _wr = _wid >> 2, _wc = _wid & 3, _fr = _lane & 15, _fq = _lane >> 4; \
      _Pragma("unroll") for (int m = 0; m < 8; ++m) _Pragma("unroll") for (int n = 0; n < 4; ++n)             \
      _Pragma("unroll") for (int j = 0; j < 4; ++j) {                                                         \
          const int row = _wr * 128 + m * 16 + _fq * 4 + j; const int col = _wc * 64 + n * 16 + _fr; const float val = acc[m][n][j]; body } }
#define G8_HT (128 * 64)
__device__ __forceinline__ void g8_mainloop(const bf16_t* __restrict__ A, const bf16_t* __restrict__ Bt, int K, int brow, int bcol, f32x4 (&acc)[2][2][4][2], unsigned char* shmb) {
    bf16_t* shm = (bf16_t*)shmb;
    const int tid = fresh_tid();
    const int wid = tid >> 6, lane = tid & 63, wr = wid >> 2, wc = wid & 3, fr = lane & 15, fq = lane >> 4;
#define G8_SA(b, h) (shm + ((b) * 2 + (h)) * G8_HT)
#define G8_SB(b, h) (shm + (4 + (b) * 2 + (h)) * G8_HT)
#define G8_STAGE(Pp, BASE, br, kt) do { const long _g = (long)(br) * K + (long)(kt) * 64; \
    _Pragma("unroll") for (int _i = 0; _i < 2; ++_i) { const int _b = tid * 16 + _i * 8192; int _r, _c; g2_stage_rc(_b, _r, _c); \
      __builtin_amdgcn_global_load_lds((const unsigned*)(BASE + _g + (long)_r * K + _c), (unsigned*)((char*)(Pp) + _b), 16, 0, 0); } } while (0)
#define G8_LDA(dst, b, h) _Pragma("unroll") for (int m = 0; m < 4; ++m) _Pragma("unroll") for (int k = 0; k < 2; ++k) \
    dst[m][k] = *reinterpret_cast<const bf16x8*>((const char*)G8_SA(b, h) + g2_lds_byte(wr * 64 + m * 16 + fr, k * 32 + fq * 8))
#define G8_LDB(dst, b, h) _Pragma("unroll") for (int n = 0; n < 2; ++n) _Pragma("unroll") for (int k = 0; k < 2; ++k) \
    dst[n][k] = *reinterpret_cast<const bf16x8*>((const char*)G8_SB(b, h) + g2_lds_byte(wc * 32 + n * 16 + fr, k * 32 + fq * 8))
#define G8_MMA(ai, bj, At_, Bt_) do { __builtin_amdgcn_s_setprio(1); \
    _Pragma("unroll") for (int m = 0; m < 4; ++m) _Pragma("unroll") for (int n = 0; n < 2; ++n) _Pragma("unroll") for (int k = 0; k < 2; ++k) \
      acc[ai][bj][m][n] = __builtin_amdgcn_mfma_f32_16x16x32_bf16(At_[m][k], Bt_[n][k], acc[ai][bj][m][n], 0, 0, 0); \
    __builtin_amdgcn_s_setprio(0); } while (0)
#define G8_WAIT_V(n) asm volatile("s_waitcnt vmcnt(" #n ")" ::: "memory")
#define G8_WAIT_L(n) asm volatile("s_waitcnt lgkmcnt(" #n ")" ::: "memory")
#define G8_BAR __builtin_amdgcn_s_barrier()
#define G8_SCHED __builtin_amdgcn_sched_barrier(0)
    bf16x8 At[4][2], B0[2][2], B1[2][2];
    const int nt = K / 64;
    __syncthreads();
    G8_STAGE(G8_SB(0, 0), Bt, bcol, 0); G8_STAGE(G8_SA(0, 0), A, brow, 0);
    G8_STAGE(G8_SB(0, 1), Bt, bcol + 128, 0); G8_STAGE(G8_SA(0, 1), A, brow + 128, 0);
    if (wr == 1) G8_BAR;
    G8_WAIT_V(4); G8_BAR;
    G8_STAGE(G8_SB(1, 0), Bt, bcol, 1); G8_STAGE(G8_SA(1, 0), A, brow, 1); G8_STAGE(G8_SB(1, 1), Bt, bcol + 128, 1);
    G8_WAIT_V(6); G8_BAR;
    for (int t = 0; t < nt - 2; t += 2) {
        G8_LDB(B0, 0, 0); G8_SCHED; G8_LDA(At, 0, 0); G8_STAGE(G8_SA(1, 1), A, brow + 128, t + 1);
        G8_WAIT_L(8); G8_BAR; G8_WAIT_L(0); G8_MMA(0, 0, At, B0); G8_BAR; G8_SCHED;
        G8_LDB(B1, 0, 1); G8_STAGE(G8_SB(0, 0), Bt, bcol, t + 2);
        G8_BAR; G8_WAIT_L(0); G8_MMA(0, 1, At, B1); G8_BAR;
        G8_LDA(At, 0, 1); G8_STAGE(G8_SA(0, 0), A, brow, t + 2);
        G8_BAR; G8_WAIT_L(0); G8_MMA(1, 0, At, B0); G8_BAR; G8_SCHED;
        G8_STAGE(G8_SB(0, 1), Bt, bcol + 128, t + 2);
        G8_WAIT_V(6); G8_BAR; G8_MMA(1, 1, At, B1); G8_BAR;
        G8_LDB(B0, 1, 0); G8_SCHED; G8_LDA(At, 1, 0); G8_STAGE(G8_SA(0, 1), A, brow + 128, t + 2);
        G8_WAIT_L(8); G8_BAR; G8_WAIT_L(0); G8_MMA(0, 0, At, B0); G8_BAR; G8_SCHED;
        G8_LDB(B1, 1, 1); G8_STAGE(G8_SB(1, 0), Bt, bcol, t + 3);
        G8_BAR; G8_WAIT_L(0); G8_MMA(0, 1, At, B1); G8_BAR;
        G8_LDA(At, 1, 1); G8_STAGE(G8_SA(1, 0), A, brow, t + 3);
        G8_BAR; G8_WAIT_L(0); G8_MMA(1, 0, At, B0); G8_BAR; G8_SCHED;
        G8_STAGE(G8_SB(1, 1), Bt, bcol + 128, t + 3);
        G8_WAIT_V(6); G8_BAR; G8_MMA(1, 1, At, B1); G8_BAR;
    }
    { G8_LDB(B0, 0, 0); G8_LDA(At, 0, 0); G8_STAGE(G8_SA(1, 1), A, brow + 128, nt - 1);
      G8_BAR; G8_WAIT_L(0); G8_MMA(0, 0, At, B0); G8_BAR;
      G8_LDB(B1, 0, 1); G8_BAR; G8_WAIT_L(0); G8_MMA(0, 1, At, B1); G8_BAR;
      G8_LDA(At, 0, 1); G8_WAIT_V(4); G8_BAR; G8_WAIT_L(0); G8_MMA(1, 0, At, B0); G8_MMA(1, 1, At, B1); G8_BAR; }
    { G8_LDB(B0, 1, 0); G8_LDA(At, 1, 0); G8_WAIT_V(2); G8_BAR; G8_WAIT_L(0); G8_MMA(0, 0, At, B0); G8_BAR;
      G8_LDB(B1, 1, 1); G8_WAIT_V(0); G8_BAR; G8_WAIT_L(0); G8_MMA(0, 1, At, B1); G8_BAR;
      G8_LDA(At, 1, 1); G8_BAR; G8_WAIT_L(0); G8_MMA(1, 0, At, B0); G8_MMA(1, 1, At, B1); G8_BAR; }
    if (wr == 0) G8_BAR;
}
__device__ __forceinline__ void g8_zero(f32x4 (&acc)[2][2][4][2]) {
#pragma unroll
    for (int a = 0; a < 2; ++a)
#pragma unroll
        for (int b = 0; b < 2; ++b)
#pragma unroll
            for (int m = 0; m < 4; ++m)
#pragma unroll
                for (int n = 0; n < 2; ++n) acc[a][b][m][n] = (f32x4){0.f, 0.f, 0.f, 0.f};
}
#define G8_FOREACH(body)                                                                                       \
    { const int _tid = fresh_tid(), _wid = _tid >> 6, _lane = _tid & 63, _wr = _wid >> 2, _wc = _wid & 3, _fr = _lane & 15, _fq = _lane >> 4; \
      _Pragma("unroll") for (int ai = 0; ai < 2; ++ai) _Pragma("unroll") for (int bj = 0; bj < 2; ++bj)       \
      _Pragma("unroll") for (int m = 0; m < 4; ++m) _Pragma("unroll") for (int n = 0; n < 2; ++n)             \
      _Pragma("unroll") for (int j = 0; j < 4; ++j) {                                                         \
          const int row = ai * 128 + _wr * 64 + m * 16 + _fq * 4 + j; const int col = bj * 128 + _wc * 32 + n * 16 + _fr; const float val = acc[ai][bj][m][n][j]; body } }

__device__ __forceinline__ bool g2_tile(int bid, int nb, int it, int nM, int nN, int& pm, int& pn) {
    if (nb == 256 && nM == 32) { const int xcd = bid & 7, jj = bid >> 3; pm = 4 * xcd + (jj & 3); pn = 8 * it + (jj >> 2); return pn < nN; }
    const int t = bid + it * nb; pm = t % nM; pn = t / nM; return t < nM * nN;
}

__device__ __forceinline__ void phase_ple(const Params& P, int bid, int nb, unsigned char* smem) {
    const bf16_t* A = (const bf16_t*)(P.ws + WS_PBF); const bf16_t* Bt = (const bf16_t*)(P.ws + WS_WTPP); bf16_t* C = (bf16_t*)P.out;
    for (int t = bid; t < 256; t += nb) {
        const int pm = t & 31, pn = t >> 5;
        f32x4 acc[8][4]; g2_zero(acc);
        g2_mainloop(A + (size_t)pm * 256 * 256, 256, Bt + (size_t)pn * 256 * 256, 256, 256, acc, smem);
        G2_FOREACH({ C[(size_t)(pm * 256 + row) * D + pn * 256 + col] = f2bf(val); })
    }
}
__device__ __forceinline__ void phase_gemm1(const Params& P, int bid, int nb, unsigned char* smem) {
    const bf16_t* A = (const bf16_t*)(P.ws + WS_HN); const bf16_t* Bt = (const bf16_t*)(P.ws + WS_WTIN); bf16_t* C = (bf16_t*)(P.ws + WS_PROJ);
    int pm, pn;
    for (int it = 0; g2_tile(bid, nb, it, T / 256, NPROJ / 256, pm, pn); ++it) {
        f32x4 acc[2][2][4][2]; g8_zero(acc);
        g8_mainloop(A, Bt, D, pm * 256, pn * 256, acc, smem);
        G8_FOREACH({ C[(size_t)(pm * 256 + row) * NPROJ + pn * 256 + col] = f2bf(val); })
    }
    if (nb == 256 && bid >= 160) phase_ple(P, bid - 160, 96, smem);
}
__device__ __forceinline__ void phase_gemm2(const Params& P, int bid, int nb, unsigned char* smem) {
    const bf16_t* A = (const bf16_t*)(P.ws + WS_MIXED); const bf16_t* Bt = (const bf16_t*)(P.ws + WS_WTOUT); bf16_t* H = (bf16_t*)(P.ws + WS_H);
    bf16_t* HW = (bf16_t*)(P.ws + WS_HN); float* rss = (float*)(P.ws + WS_RSS);
    int pm, pn;
    for (int it = 0; g2_tile(bid, nb, it, T / 256, D / 256, pm, pn); ++it) {
        f32x4 acc[2][2][4][2]; g8_zero(acc);
        g8_mainloop(A, Bt, D, pm * 256, pn * 256, acc, smem);
        const int tid = fresh_tid(), wid = tid >> 6, lane = tid & 63, wr = wid >> 2, wc = wid & 3, fr = lane & 15, fq = lane >> 4;
#pragma unroll
        for (int ai = 0; ai < 2; ++ai)
#pragma unroll
            for (int m = 0; m < 4; ++m)
#pragma unroll
                for (int j = 0; j < 4; ++j) {
                    const int row = pm * 256 + ai * 128 + wr * 64 + m * 16 + fq * 4 + j;
                    float ss = 0.f;
#pragma unroll
                    for (int bj = 0; bj < 2; ++bj)
#pragma unroll
                        for (int n = 0; n < 2; ++n) {
                            const int col = pn * 256 + bj * 128 + wc * 32 + n * 16 + fr;
                            const size_t o = (size_t)row * D + col;
                            const float v = P.x[o] + acc[ai][bj][m][n][j];
                            H[o] = f2bf(v); HW[o] = f2bf(v * P.norm_ffn[col]); ss += v * v;
                        }
                    ss += DPPF(ss, 0x128); ss += DPPF(ss, 0x124); ss += DPPF(ss, 0x122); ss += DPPF(ss, 0x121);
                    if (fr == 0) atomicAdd(rss + row, ss);
                }
    }
}
__device__ __forceinline__ void phase_gemm3(const Params& P, int bid, int nb, unsigned char* smem) {
    const bf16_t* A = (const bf16_t*)(P.ws + WS_HN); const bf16_t* Bt = (const bf16_t*)(P.ws + WS_WTPQ); bf16_t* C = (bf16_t*)(P.ws + WS_Q);
    int pm, pn;
    for (int it = 0; g2_tile(bid, nb, it, T / 256, D / 256, pm, pn); ++it) {
        f32x4 acc[2][2][4][2]; g8_zero(acc);
        g8_mainloop(A, Bt, D, pm * 256, pn * 256, acc, smem);
        const float* rss = (const float*)(P.ws + WS_RSS);
        G8_FOREACH({ const float rs = rsqrtf(rss[pm * 256 + row] * (1.f / 2048.f) + EPS); C[(size_t)(pm * 256 + row) * D + pn * 256 + col] = f2bf(val * rs); })
    }
}
__device__ __forceinline__ void phase_gemm4(const Params& P, int bid, int nb, unsigned char* smem) {
    const bf16_t* A = (const bf16_t*)(P.ws + WS_HN); const bf16_t* Bt = (const bf16_t*)(P.ws + WS_WTG);
    const bf16_t* ple = (const bf16_t*)P.out; bf16_t* H = (bf16_t*)(P.ws + WS_H);
    int pm, pn;
    for (int it = 0; g2_tile(bid, nb, it, T / 256, D / 256, pm, pn); ++it) {
        f32x4 acc[2][2][4][2]; g8_zero(acc);
        g8_mainloop(A, Bt, D, pm * 256, pn * 256, acc, smem);
        G8_FOREACH({ const size_t o = (size_t)(pm * 256 + row) * D + pn * 256 + col; H[o] = f2bf(bf2f(H[o]) + sigmoid_f(val) * bf2f(ple[o])); })
    }
}

template <bool OUT_BF16>
__device__ __forceinline__ void phase_rownorm(const float* in, const float* w, void* out, int bid, int nb) {
    const int wave = VTID >> 6, lane = VTID & 63;
    for (int r = bid * 4 + wave; r < T; r += nb * 4) {
        if (OUT_BF16) rmsnorm_row<true>(in + (size_t)r * D, w, (bf16_t*)out + (size_t)r * D, lane);
        else rmsnorm_row<false>(in + (size_t)r * D, w, (float*)out + (size_t)r * D, lane);
    }
}

__device__ __forceinline__ void phase_final(const Params& P, int bid, int nb) {
    const bf16_t* H = (const bf16_t*)(P.ws + WS_H);
    const int wave = VTID >> 6, lane = VTID & 63;
    for (int r = bid * 4 + wave; r < T; r += nb * 4) {
        float v[32]; float ss = 0.f;
#pragma unroll
        for (int i = 0; i < 4; ++i) {
            const uint4 hv = *(const uint4*)(H + (size_t)r * D + (i * 64 + lane) * 8); const unsigned hw[4] = {hv.x, hv.y, hv.z, hv.w};
#pragma unroll
            for (int j = 0; j < 4; ++j) { v[i * 8 + 2 * j] = __uint_as_float(hw[j] << 16); v[i * 8 + 2 * j + 1] = __uint_as_float(hw[j] & 0xffff0000u); ss += v[i * 8 + 2 * j] * v[i * 8 + 2 * j] + v[i * 8 + 2 * j + 1] * v[i * 8 + 2 * j + 1]; }
        }
        ss = wave_sum(ss);
        const float rs = rsqrtf(ss * (1.f / 2048.f) + EPS);
#pragma unroll
        for (int i = 0; i < 4; ++i)
#pragma unroll
            for (int q = 0; q < 2; ++q) {
                const int col = (i * 64 + lane) * 8 + q * 4;
                const f32x4 g = *(const f32x4*)(P.norm_final + col);
                f32x4 o = {v[i * 8 + q * 4] * rs * g[0], v[i * 8 + q * 4 + 1] * rs * g[1], v[i * 8 + q * 4 + 2] * rs * g[2], v[i * 8 + q * 4 + 3] * rs * g[3]};
                *(f32x4*)(P.out + (size_t)r * D + col) = o;
            }
    }
}

__device__ __forceinline__ bf16x8 frag_ld(const unsigned char* tile, int row, int ks, int lane) { return *(const bf16x8*)(tile + lds_off(row, ks * 2 + (lane >> 5))); }
__device__ __forceinline__ void lds_st_bf16(unsigned char* tile, int row, int k, float v) { *(bf16_t*)(tile + lds_off(row, k >> 3) + (k & 7) * 2) = f2bf(v); }

__device__ __forceinline__ void d1_chunk(const Params& P, int u, unsigned char* smem) {
    const bf16_t* proj = (const bf16_t*)(P.ws + WS_PROJ);
    int tid_ = VTID; asm volatile("" : "+v"(tid_));
    const int tid = tid_, wave = tid >> 6, lane = tid & 63;
    const int b = u >> 9, h = (u >> 6) & 7, c = u & 63;
    const size_t tok0 = (size_t)b * SEQ + c * 64;
    unsigned char* Ks = smem;
    unsigned char* Qs = smem + 16384;
    unsigned char* Vraw = smem + 16384;
    float* At = (float*)(smem + 34816);
    float* Gs = (float*)(smem + 51200);
    float* Bs = Gs + 64;
    float* Es = Gs + 128;
    float* Xs = Gs + 192;
    HSYNC();
    if (wave == 0) {
        const size_t t = tok0 + lane;
        const float a = bf2f(proj[t * NPROJ + C_A + h]), bb = bf2f(proj[t * NPROJ + C_B + h]);
        const float xs = a + P.dt_bias[h];
        const float sp = xs > 20.f ? xs : log1pf(expf(xs));
        float g = -expf(P.a_log[h]) * sp;
#pragma unroll
        for (int o = 1; o < 64; o <<= 1) { const float n = __shfl_up(g, o); if (lane >= o) g += n; }
        Gs[lane] = g; Bs[lane] = 1.f / (1.f + expf(-bb));
        Es[lane] = __expf(g); Xs[lane] = __expf(__shfl(g, 63) - g);
    }
    bf16_t* QG = (bf16_t*)(P.ws + WS_QG) + (size_t)u * 64 * 128;
    unsigned char* RAW = smem + 32768;
    uint4 rq[5], rk[5], rv[5];
#pragma unroll
    for (int i = 0; i < 5; ++i) {
        const int q = tid + 256 * i, row = q >> 4, c16 = q & 15;
        rq[i] = make_uint4(0u, 0u, 0u, 0u); rk[i] = rq[i]; rv[i] = rq[i];
        if (q < 67 * 16 && (c > 0 || row >= 3)) {
            const bf16_t* src = proj + (tok0 + row - 3) * NPROJ + h * 128 + c16 * 8;
            rq[i] = *(const uint4*)(src); rk[i] = *(const uint4*)(src + 1024); rv[i] = *(const uint4*)(src + 2048);
        }
    }
#pragma unroll
    for (int isk = 0; isk < 2; ++isk) {
        const int chb = (isk ? 1024 : 0) + h * 128;
#pragma unroll
        for (int i = 0; i < 5; ++i) { const int q = tid + 256 * i, row = q >> 4, c16 = q & 15; if (q < 67 * 16) *(uint4*)(RAW + row * 256 + c16 * 16) = isk ? rk[i] : rq[i]; }
        const int ch0 = chb + lane * 2;
        const f32x4 cw0 = *(const f32x4*)(P.conv_w + ch0 * 4), cw1 = *(const f32x4*)(P.conv_w + ch0 * 4 + 4);
        HSYNC();
        float y0[16], y1[16], ss[16];
#pragma unroll
        for (int j = 0; j < 16; ++j) {
            const int tok = wave + 4 * j;
            float a0 = 0.f, a1 = 0.f;
#pragma unroll
            for (int t4 = 0; t4 < 4; ++t4) {
                const unsigned pr = *(const unsigned*)(RAW + (tok + t4) * 256 + lane * 4);
                a0 += bf2f((bf16_t)(pr & 0xffff)) * cw0[t4];
                a1 += bf2f((bf16_t)(pr >> 16)) * cw1[t4];
            }
            y0[j] = silu_f(a0); y1[j] = silu_f(a1); ss[j] = y0[j] * y0[j] + y1[j] * y1[j];
        }
        const bool b5 = (lane & 32) != 0, b4 = (lane & 16) != 0, b3 = (lane & 8) != 0, b2 = (lane & 4) != 0;
        float q8[8], q4[4], q2[2];
#pragma unroll
        for (int j = 0; j < 8; ++j) { const auto r_ = __builtin_amdgcn_permlane32_swap(__float_as_uint(ss[j]), __float_as_uint(ss[j + 8]), false, false); q8[j] = __uint_as_float(r_[0]) + __uint_as_float(r_[1]); }
#pragma unroll
        for (int j = 0; j < 4; ++j) { const auto r_ = __builtin_amdgcn_permlane16_swap(__float_as_uint(q8[j]), __float_as_uint(q8[j + 4]), false, false); q4[j] = __uint_as_float(r_[0]) + __uint_as_float(r_[1]); }
#pragma unroll
        for (int j = 0; j < 2; ++j) q2[j] = (b3 ? q4[j + 2] : q4[j]) + DPPF(b3 ? q4[j] : q4[j + 2], 0x128);
        float st = (b2 ? q2[1] : q2[0]) + __shfl_xor(b2 ? q2[0] : q2[1], 4);
        st += DPPF(st, 0x4E); st += DPPF(st, 0xB1);
        float rl = rsqrtf(st + EPS); if (!isk) rl *= 0.08838834764831845f;
        const int rli = __float_as_int(rl);
#pragma unroll
        for (int j = 0; j < 16; ++j) {
            const int tok = wave + 4 * j;
            const float r = __int_as_float(__builtin_amdgcn_readlane(rli, 4 * j));
            const float z0 = y0[j] * r, z1 = y1[j] * r;
            const int k = lane * 2, half = k >> 6, kk = k & 63;
            *(unsigned*)((isk ? Ks : Qs) + half * 8192 + lds_off(tok, kk >> 3) + (kk & 7) * 2) = pack2(z0, z1);
            if (!isk) { const float eg = Es[tok]; *(unsigned*)(QG + tok * 128 + k) = pack2(z0 * eg, z1 * eg); }
        }
        HSYNC();
    }
    {
        const int wr = wave >> 1, wc = wave & 1;
        f32x16 akk, aqk;
#pragma unroll
        for (int r = 0; r < 16; ++r) { akk[r] = 0.f; aqk[r] = 0.f; }
        if (!(wr == 0 && wc == 1)) {
#pragma unroll
            for (int half = 0; half < 2; ++half)
#pragma unroll
                for (int ks = 0; ks < 4; ++ks) {
                    const bf16x8 fk = frag_ld(Ks + half * 8192, wr * 32 + (lane & 31), ks, lane);
                    const bf16x8 fq = frag_ld(Qs + half * 8192, wr * 32 + (lane & 31), ks, lane);
                    const bf16x8 fb = frag_ld(Ks + half * 8192, wc * 32 + (lane & 31), ks, lane);
                    akk = __builtin_amdgcn_mfma_f32_32x32x16_bf16(fk, fb, akk, 0, 0, 0);
                    aqk = __builtin_amdgcn_mfma_f32_32x32x16_bf16(fq, fb, aqk, 0, 0, 0);
                }
        }
        const int j = wc * 32 + (lane & 31); const float Gj = Gs[j];
        bf16_t* ATT = (bf16_t*)(P.ws + WS_ATT) + (size_t)u * 64 * 64;
#pragma unroll
        for (int g4 = 0; g4 < 4; ++g4) {
            const int i0 = wr * 32 + 8 * g4 + 4 * (lane >> 5);
            f32x4 av;
#pragma unroll
            for (int e = 0; e < 4; ++e) {
                const int i = i0 + e, r = g4 * 4 + e;
                const float dec = (i >= j) ? __expf(Gs[i] - Gj) : 0.f;
                av[e] = (i > j) ? Bs[i] * akk[r] * dec : 0.f;
                ATT[i * 64 + j] = f2bf(aqk[r] * dec);
            }
            *(f32x4*)(At + j * 64 + i0) = av;
        }
    }
    HSYNC();
    {
#pragma unroll
        for (int i = 0; i < 5; ++i) { const int q = tid + 256 * i, row = q >> 4, c16 = q & 15; if (q < 67 * 16) *(uint4*)(Vraw + row * 256 + c16 * 16) = rv[i]; }
    }
    HSYNC();
    {
        float r[64];
        if (tid < 128) {
            const int ch = 2048 + h * 128 + tid;
            const float w0 = P.conv_w[ch * 4 + 0], w1 = P.conv_w[ch * 4 + 1], w2 = P.conv_w[ch * 4 + 2], w3 = P.conv_w[ch * 4 + 3];
            const bf16_t* vcol = (const bf16_t*)Vraw + tid;
            float xm3 = bf2f(vcol[0]), xm2 = bf2f(vcol[128]), xm1 = bf2f(vcol[256]);
#pragma unroll
            for (int i = 0; i < 64; ++i) {
                const float x0 = bf2f(vcol[(i + 3) * 128]);
                const float y = w0 * xm3 + w1 * xm2 + w2 * xm1 + w3 * x0;
                r[i] = Bs[i] * silu_f(y);
                xm3 = xm2; xm2 = xm1; xm1 = x0;
            }
        } else {
            const int dk = tid - 128, half = dk >> 6, kk = dk & 63;
            bf16_t* KDT = (bf16_t*)(P.ws + WS_KDT) + (size_t)u * 128 * 64 + dk * 64;
#pragma unroll
            for (int i8 = 0; i8 < 8; ++i8) {
                unsigned pk[4];
#pragma unroll
                for (int e2 = 0; e2 < 4; ++e2) {
                    float kd[2];
#pragma unroll
                    for (int e = 0; e < 2; ++e) {
                        const int i = i8 * 8 + e2 * 2 + e;
                        const float kv = bf2f(*(const bf16_t*)(Ks + half * 8192 + lds_off(i, kk >> 3) + (kk & 7) * 2));
                        r[i] = -Bs[i] * Es[i] * kv;
                        kd[e] = kv * Xs[i];
                    }
                    pk[e2] = pack2(kd[0], kd[1]);
                }
                *(uint4*)(KDT + i8 * 8) = make_uint4(pk[0], pk[1], pk[2], pk[3]);
            }
        }
#pragma unroll
        for (int j = 0; j < 63; ++j) {
            const float xj = r[j];
#pragma unroll
            for (int i4 = ((j + 1) & ~3); i4 < 64; i4 += 4) {
                const f32x4 a = *(const f32x4*)(At + j * 64 + i4);
                r[i4] -= a[0] * xj; r[i4 + 1] -= a[1] * xj; r[i4 + 2] -= a[2] * xj; r[i4 + 3] -= a[3] * xj;
            }
        }
        if (tid < 128) {
            bf16_t* U = (bf16_t*)(P.ws + WS_U) + (size_t)u * 64 * 128 + (tid >> 5) * 2048 + (tid & 31);
#pragma unroll
            for (int i = 0; i < 64; ++i) { const int tt = i >> 5, i5 = i & 31, rr = (i5 & 3) + 4 * (i5 >> 3), hh = (i5 >> 2) & 1; U[(tt * 16 + rr) * 64 + hh * 32] = f2bf(r[i]); }
        } else {
            bf16_t* W = (bf16_t*)(P.ws + WS_W) + (size_t)u * 64 * 128 + (tid - 128);
#pragma unroll
            for (int i = 0; i < 64; ++i) W[i * 128] = f2bf(r[i]);
        }
        if (tid == 0) ((float*)(P.ws + WS_EG))[u] = Es[63];
    }
}

__device__ __forceinline__ void r1_chunk(const Params& P, int u, unsigned char* smem) {
    const bf16_t* proj = (const bf16_t*)(P.ws + WS_PROJ);
    int tid_ = VTID; asm volatile("" : "+v"(tid_));
    const int tid = tid_, wave = tid >> 6, lane = tid & 63;
    const int b = u >> 9, h = (u >> 6) & 7, c = u & 63;
    const size_t tok0 = (size_t)b * SEQ + c * 64;
    unsigned char* RQ = smem;
    unsigned char* RK = smem + 8192;
    unsigned char* VT = smem + 16384;
    unsigned char* RKT = smem + 32768;
    const float l2g = log2f(1.f - exp2f(-5.f - (float)h));
    unsigned char* VR = smem + 40960;
    HSYNC();
    bf16_t* QGR = (bf16_t*)(P.ws + WS_QGR) + (size_t)u * 64 * 64;
    {
        uint4 rq[2], rk[2], rv[4];
#pragma unroll
        for (int i = 0; i < 2; ++i) { const int q = tid + 256 * i, row = q >> 3, ch = q & 7;
            rq[i] = *(const uint4*)(proj + (tok0 + row) * NPROJ + C_RQ + h * 64 + ch * 8); rk[i] = *(const uint4*)(proj + (tok0 + row) * NPROJ + C_RK + h * 64 + ch * 8); }
#pragma unroll
        for (int i = 0; i < 4; ++i) { const int q = tid + 256 * i, row = q >> 4, c16 = q & 15; rv[i] = *(const uint4*)(proj + (tok0 + row) * NPROJ + C_RV + h * 128 + c16 * 8); }
#pragma unroll
        for (int i = 0; i < 2; ++i) { const int q = tid + 256 * i, row = q >> 3, ch = q & 7; *(uint4*)(RQ + lds_off(row, ch)) = rq[i]; *(uint4*)(RK + lds_off(row, ch)) = rk[i]; }
#pragma unroll
        for (int i = 0; i < 4; ++i) { const int q = tid + 256 * i, row = q >> 4, c16 = q & 15; *(uint4*)(VR + row * 256 + c16 * 16) = rv[i]; }
    }
    HSYNC();
    const float2* cs = (const float2*)(P.ws + WS_CS) + tok0 * 32;
    float2 cs8[8];
#pragma unroll
    for (int it = 0; it < 8; ++it) cs8[it] = cs[tid + 256 * it];
#pragma unroll
    for (int it = 0; it < 8; ++it) {
        const int e = tid + 256 * it, tok = e >> 5, i = e & 31;
        const float cs_ = cs8[it].x, sn = cs8[it].y;
        bf16_t* q1p = (bf16_t*)(RQ + lds_off(tok, i >> 3) + (i & 7) * 2); bf16_t* q2p = (bf16_t*)(RQ + lds_off(tok, (32 + i) >> 3) + (i & 7) * 2);
        bf16_t* k1p = (bf16_t*)(RK + lds_off(tok, i >> 3) + (i & 7) * 2); bf16_t* k2p = (bf16_t*)(RK + lds_off(tok, (32 + i) >> 3) + (i & 7) * 2);
        const float q1 = bf2f(*q1p), q2 = bf2f(*q2p), k1 = bf2f(*k1p) * 0.125f, k2 = bf2f(*k2p) * 0.125f;
        const float qa = q1 * cs_ - q2 * sn, qb = q1 * sn + q2 * cs_, ka = k1 * cs_ - k2 * sn, kb = k1 * sn + k2 * cs_;
        const float xi = exp2f(l2g * (float)(tok + 1)), zeta = exp2f(l2g * (float)(63 - tok));
        *q1p = f2bf(qa); *q2p = f2bf(qb); *k1p = f2bf(ka); *k2p = f2bf(kb);
        lds_st_bf16(RKT, i, tok, ka * zeta); lds_st_bf16(RKT, 32 + i, tok, kb * zeta);
        QGR[tok * 64 + i] = f2bf(qa * xi); QGR[tok * 64 + 32 + i] = f2bf(qb * xi);
    }
#pragma unroll 4
    for (int it = 0; it < 16; ++it) {
        const int e = tid + 256 * it, tok = e >> 6, dp = e & 63;
        const unsigned pr = *(const unsigned*)(VR + tok * 256 + dp * 4);
        *(bf16_t*)(VT + lds_off(dp * 2, tok >> 3) + (tok & 7) * 2) = (bf16_t)(pr & 0xffff);
        *(bf16_t*)(VT + lds_off(dp * 2 + 1, tok >> 3) + (tok & 7) * 2) = (bf16_t)(pr >> 16);
    }
    HSYNC();
    {
        bf16_t* VNTR = (bf16_t*)(P.ws + WS_VNTR) + (size_t)u * 128 * 64;
#pragma unroll
        for (int it = 0; it < 4; ++it) { const int q = tid + 256 * it, row = q >> 3, ch = q & 7; *(uint4*)(VNTR + row * 64 + ch * 8) = *(const uint4*)(VT + lds_off(row, ch)); }
    }
    {
        const int wr = wave >> 1, wc = wave & 1;
        f32x16 acc;
#pragma unroll
        for (int r = 0; r < 16; ++r) acc[r] = 0.f;
        if (!(wr == 0 && wc == 1)) {
#pragma unroll
            for (int ks = 0; ks < 4; ++ks) acc = __builtin_amdgcn_mfma_f32_32x32x16_bf16(frag_ld(RQ, wr * 32 + (lane & 31), ks, lane), frag_ld(RK, wc * 32 + (lane & 31), ks, lane), acc, 0, 0, 0);
        }
        const int j = wc * 32 + (lane & 31);
        bf16_t* ATTR = (bf16_t*)(P.ws + WS_ATTR) + (size_t)u * 64 * 64;
#pragma unroll
        for (int r = 0; r < 16; ++r) {
            const int i = wr * 32 + (r & 3) + 8 * (r >> 2) + 4 * (lane >> 5);
            const float dec = (i >= j) ? exp2f(l2g * (float)(i - j)) : 0.f;
            ATTR[i * 64 + j] = f2bf(acc[r] * dec);
        }
    }
    {
        f32x16 acc[2];
#pragma unroll
        for (int j = 0; j < 2; ++j)
#pragma unroll
            for (int r = 0; r < 16; ++r) acc[j][r] = 0.f;
#pragma unroll
        for (int ks = 0; ks < 4; ++ks) {
            const bf16x8 fa = frag_ld(VT, wave * 32 + (lane & 31), ks, lane);
#pragma unroll
            for (int j = 0; j < 2; ++j) acc[j] = __builtin_amdgcn_mfma_f32_32x32x16_bf16(fa, frag_ld(RKT, j * 32 + (lane & 31), ks, lane), acc[j], 0, 0, 0);
        }
        float* KVT = (float*)(P.ws + WS_KVT) + (size_t)u * 128 * 64;
#pragma unroll
        for (int j = 0; j < 2; ++j)
#pragma unroll
            for (int r = 0; r < 16; ++r) { const int dv = wave * 32 + (r & 3) + 8 * (r >> 2) + 4 * (lane >> 5); KVT[dv * 64 + j * 32 + (lane & 31)] = acc[j][r]; }
    }
}

__device__ __forceinline__ void phase_chunk1(const Params& P, int bid, int nb, unsigned char* smem, int mode = 0) {
    for (int u0 = bid; u0 < 2048; u0 += nb) { const int u = (bid & 1) ? ((u0 + 1024) & 2047) : u0; if (u < 1024) { if (mode != 2) d1_chunk(P, u, smem); } else if (mode != 1) r1_chunk(P, u - 1024, smem); }
}

__device__ __forceinline__ void d2_scan(const Params& P, int unit, unsigned char* rsmem) {
    const int tid = fresh_tid(), wave = tid >> 6, lane = tid & 63;
    const int bh = (unit & 7) + 8 * (unit >> 5), slice = (unit >> 3) & 3;
    const size_t cb = (size_t)bh * 64;
    const bf16_t* Wg = (const bf16_t*)(P.ws + WS_W); const bf16_t* KDg = (const bf16_t*)(P.ws + WS_KDT);
    const bf16_t* Ug = (const bf16_t*)(P.ws + WS_U); const float* EGg = (const float*)(P.ws + WS_EG);
    bf16_t* SCg = (bf16_t*)(P.ws + WS_SC); bf16_t* VNg = (bf16_t*)(P.ws + WS_VNT);
    unsigned char* Simg = rsmem;
    unsigned char* VNimg = rsmem + 8192;
    unsigned char* BUF = rsmem + 12288;
    const bool vn_wave = wave < 2, s_wave = wave < 4;
    const int hf = wave & 1, dt = wave & 3;
    f32x16 S0;
#pragma unroll
    for (int r = 0; r < 16; ++r) S0[r] = 0.f;
    uint4 w0a, w0b, k0a, k0b, w1a, w1b, k1a, k1b;
    bf16_t un0[16], un1[16];
#define D2_LOAD(SET, uu) { const bf16_t* wp = Wg + (uu) * 8192 + tid * 8; const bf16_t* kp = KDg + (uu) * 8192 + tid * 8; \
        w##SET##a = *(const uint4*)(wp); w##SET##b = *(const uint4*)(wp + 4096); k##SET##a = *(const uint4*)(kp); k##SET##b = *(const uint4*)(kp + 4096); \
        { const bf16_t* up = Ug + (uu) * 8192 + slice * 2048 + hf * 1024 + lane; _Pragma("unroll") for (int r = 0; r < 16; ++r) un##SET[r] = up[r * 64]; } }
#define D2_ST1(i, vw, vk, bufp) { const int q = tid + 512 * (i); { const int row = q >> 4, c16 = q & 15; *(uint4*)((bufp) + (c16 >> 3) * 8192 + lds_off(row, c16 & 7)) = (vw); } \
        { const int row = q >> 3, ch = q & 7; *(uint4*)((bufp) + 16384 + lds_off(row, ch)) = (vk); } }
#define D2_STORE(SET, par) { unsigned char* bufp = BUF + (par) * 32768; D2_ST1(0, w##SET##a, k##SET##a, bufp) D2_ST1(1, w##SET##b, k##SET##b, bufp) }
    const int egl = __float_as_int(EGg[cb + lane]);
    __syncthreads();
    if (s_wave) {
#pragma unroll
        for (int i = 0; i < 2; ++i) *(uint4*)(Simg + dt * 2048 + (lane + 64 * i) * 16) = make_uint4(0u, 0u, 0u, 0u);
#pragma unroll
        for (int i = 0; i < 2; ++i) *(uint4*)(SCg + cb * 16384 + slice * 4096 + dt * 1024 + (lane + 64 * i) * 8) = make_uint4(0u, 0u, 0u, 0u);
    }
    for (int r = 0; r < 16; ++r) { un0[r] = 0; un1[r] = 0; }
    D2_LOAD(0, cb)
    D2_STORE(0, 0)
    bf16_t unc[16];
#pragma unroll
    for (int r = 0; r < 16; ++r) unc[r] = un0[r];
    D2_LOAD(1, cb + 1)
    D2_LOAD(0, cb + 2)
    __syncthreads();
#define D2_STEP(c, UN) { const size_t u = cb + (c); const unsigned char* Wt = BUF + ((c) & 1) * 32768; const unsigned char* KDt = Wt + 16384; \
        if (vn_wave) { \
            f32x16 vn; _Pragma("unroll") for (int r = 0; r < 16; ++r) vn[r] = bf2f(UN[r]); \
            _Pragma("unroll") for (int half = 0; half < 2; ++half) _Pragma("unroll") for (int ks = 0; ks < 4; ++ks) \
                vn = __builtin_amdgcn_mfma_f32_32x32x16_bf16(frag_ld(Wt + half * 8192, hf * 32 + (lane & 31), ks, lane), frag_ld(Simg + half * 4096, lane & 31, ks, lane), vn, 0, 0, 0); \
            _Pragma("unroll") for (int g4 = 0; g4 < 4; ++g4) { const int r0 = g4 * 4; \
                const uint2 pkd = make_uint2(pack2(vn[r0], vn[r0 + 1]), pack2(vn[r0 + 2], vn[r0 + 3])); \
                const int tok = hf * 32 + 8 * g4 + 4 * (lane >> 5); \
                *(uint2*)(VNimg + lds_off(lane & 31, tok >> 3) + (tok & 7) * 2) = pkd; \
                *(uint2*)(VNg + u * 8192 + ((((slice * 2 + hf) * 4 + g4) * 64 + lane) * 4)) = pkd; } } \
        __syncthreads(); \
        if (s_wave) { \
            bf16_t* scdst = ((c) + 1 < 64) ? SCg + (u + 1) * 16384 : (bf16_t*)(P.ws + WS_DUMMY);        \
            const float eg = __int_as_float(__builtin_amdgcn_readlane(egl, (c))); \
            _Pragma("unroll") for (int r = 0; r < 16; ++r) S0[r] *= eg; \
            _Pragma("unroll") for (int ks = 0; ks < 4; ++ks) \
                S0 = __builtin_amdgcn_mfma_f32_32x32x16_bf16(frag_ld(KDt, dt * 32 + (lane & 31), ks, lane), frag_ld(VNimg, lane & 31, ks, lane), S0, 0, 0, 0); \
            _Pragma("unroll") for (int g4 = 0; g4 < 4; ++g4) { const int r0 = g4 * 4; const int kk = (dt & 1) * 32 + 8 * g4 + 4 * (lane >> 5); \
                const uint2 p0 = make_uint2(pack2(S0[r0], S0[r0 + 1]), pack2(S0[r0 + 2], S0[r0 + 3])); \
                *(uint2*)(Simg + (dt >> 1) * 4096 + lds_off(lane & 31, kk >> 3) + (kk & 7) * 2) = p0; \
                *(uint2*)(scdst + ((((slice * 4 + dt) * 4 + g4) * 64 + lane) * 4)) = p0; } } }
    for (int c = 0; c < 64; c += 2) {
        D2_STORE(1, 1)
        bf16_t unn[16];
#pragma unroll
        for (int r = 0; r < 16; ++r) unn[r] = un1[r];
        D2_LOAD(1, cb + (c + 3 < 64 ? c + 3 : 63))
        D2_STEP(c, unc)
        __syncthreads();
        D2_STORE(0, 0)
#pragma unroll
        for (int r = 0; r < 16; ++r) unc[r] = un0[r];
        D2_LOAD(0, cb + (c + 4 < 64 ? c + 4 : 63))
        D2_STEP(c + 1, unn)
        __syncthreads();
    }
}

__device__ __forceinline__ void r2_scan(const Params& P, int vb, int nvb) {
    const float* KVT = (const float*)(P.ws + WS_KVT); bf16_t* STR = (bf16_t*)(P.ws + WS_STR);
    int tid_ = VTID; asm volatile("" : "+v"(tid_));
    for (int idx = vb * 256 + tid_; idx < 16 * 8192; idx += nvb * 256) {
        const int bh = idx >> 13, e = idx & 8191, h = bh & 7;
        const float cd = exp2f(64.f * log2f(1.f - exp2f(-5.f - (float)h)));
        float S = 0.f;
#pragma unroll 8
        for (int c = 0; c < 64; ++c) {
            const size_t o = ((size_t)bh * 64 + c) * 8192 + e;
            STR[o] = f2bf(S);
            S = cd * S + KVT[o];
        }
    }
}

__device__ __forceinline__ void phase_econv(const Params& P, int bid, int nb, unsigned char* smem);
__device__ __forceinline__ void phase_scan(const Params& P, int bid, int nb, unsigned char* smem, int rbid, int rnb, unsigned char* rsmem, int mode = 0) {
    if (rbid < 64) { if (mode != 2) d2_scan(P, rbid, rsmem); }
    else if (mode != 1) {
        if (rnb != 256) phase_ple(P, rbid - 64, rnb - 64, rsmem);
        r2_scan(P, bid - 128, nb - 128);
        phase_econv(P, bid - 128, nb - 128, smem);
    }
}

template <int K1, bool RET>
__device__ __forceinline__ void chunk_out(const Params& P, int u, unsigned char* smem) {
    int tid_ = VTID; asm volatile("" : "+v"(tid_));
    const int tid = tid_, wave = tid >> 6, lane = tid & 63, wr = wave >> 1, wc = wave & 1;
    const int b = u >> 9, h = (u >> 6) & 7, c = u & 63;
    const size_t tok0 = (size_t)b * SEQ + c * 64;
    const bf16_t* A1 = RET ? (const bf16_t*)(P.ws + WS_QGR) + (size_t)u * 64 * 64 : (const bf16_t*)(P.ws + WS_QG) + (size_t)u * 64 * 128;
    const bf16_t* B1 = RET ? (const bf16_t*)(P.ws + WS_STR) + (size_t)u * 128 * 64 : (const bf16_t*)(P.ws + WS_SC) + (size_t)u * 128 * 128;
    const bf16_t* A2 = RET ? (const bf16_t*)(P.ws + WS_ATTR) + (size_t)u * 64 * 64 : (const bf16_t*)(P.ws + WS_ATT) + (size_t)u * 64 * 64;
    const bf16_t* B2 = RET ? (const bf16_t*)(P.ws + WS_VNTR) + (size_t)u * 128 * 64 : (const bf16_t*)(P.ws + WS_VNT) + (size_t)u * 128 * 64;
    float* red = (float*)(smem + 49152);
    f32x16 acc[2];
#pragma unroll
    for (int j = 0; j < 2; ++j)
#pragma unroll
        for (int r = 0; r < 16; ++r) acc[j][r] = 0.f;
    constexpr int NK1 = K1 / 64, NKT = NK1 + 1;
    uint4 A0_0, A0_1, A1_0, A1_1, A2_0, A2_1;
    uint4 B0_0, B0_1, B0_2, B0_3, B1_0, B1_1, B1_2, B1_3, B2_0, B2_1, B2_2, B2_3;
#define CO_LOAD(kt) { const bf16_t* Ap = ((kt) < NK1) ? A1 + (kt) * 64 : A2; const int lda = ((kt) < NK1) ? K1 : 64; const bf16_t* Bp = ((kt) < NK1) ? B1 + (kt) * 64 : B2; \
        { const int q = tid, row = q >> 3, ch = q & 7; A##kt##_0 = *(const uint4*)(Ap + row * lda + ch * 8); } \
        { const int q = tid + 256, row = q >> 3, ch = q & 7; A##kt##_1 = *(const uint4*)(Ap + row * lda + ch * 8); } \
        if (RET) { \
            { const int q = tid, row = q >> 3, ch = q & 7; B##kt##_0 = *(const uint4*)(Bp + row * lda + ch * 8); } \
            { const int q = tid + 256, row = q >> 3, ch = q & 7; B##kt##_1 = *(const uint4*)(Bp + row * lda + ch * 8); } \
            { const int q = tid + 512, row = q >> 3, ch = q & 7; B##kt##_2 = *(const uint4*)(Bp + row * lda + ch * 8); } \
            { const int q = tid + 768, row = q >> 3, ch = q & 7; B##kt##_3 = *(const uint4*)(Bp + row * lda + ch * 8); } \
        } else { \
            const bf16_t* src = ((kt) < NK1) ? B1 : B2; \
            CO_PIECE(kt, 0, pa) CO_PIECE(kt, 1, pb) B##kt##_0 = make_uint4(pa.x, pa.y, pb.x, pb.y); \
            CO_PIECE(kt, 2, pc) CO_PIECE(kt, 3, pd) B##kt##_1 = make_uint4(pc.x, pc.y, pd.x, pd.y); \
            CO_PIECE(kt, 4, pe) CO_PIECE(kt, 5, pf) B##kt##_2 = make_uint4(pe.x, pe.y, pf.x, pf.y); \
            CO_PIECE(kt, 6, pg) CO_PIECE(kt, 7, ph) B##kt##_3 = make_uint4(pg.x, pg.y, ph.x, ph.y); } }
#define CO_PIECE(kt, i, name) uint2 name; { const int q = tid + 256 * (i), ln = q & 63, g4 = (q >> 6) & 3, dd = (q >> 8) & 1, w = q >> 9; \
        const size_t piece = ((kt) < NK1) ? (size_t)(((w * 4 + 2 * (kt) + dd) * 4 + g4) * 64 + ln) : (size_t)(((w * 2 + dd) * 4 + g4) * 64 + ln); \
        name = *(const uint2*)(src + piece * 4); }
    CO_LOAD(0) CO_LOAD(1)
    if (NKT == 3) { CO_LOAD(2) }
    const bf16_t* proj = (const bf16_t*)(P.ws + WS_PROJ);
    unsigned gz[2][16];
#pragma unroll
    for (int r = 0; r < 16; ++r) {
        const size_t t = tok0 + wr * 32 + (r & 3) + 8 * (r >> 2) + 4 * (lane >> 5);
#pragma unroll
        for (int j = 0; j < 2; ++j) gz[j][r] = proj[t * NPROJ + (RET ? C_RG : C_Z) + h * 128 + wc * 64 + j * 32 + (lane & 31)];
    }
#define CO_PUT(i, val) { const int q = tid + 256 * (i), ln = q & 63, g4 = (q >> 6) & 3, dd = (q >> 8) & 1, w = q >> 9; const int kk = dd * 32 + 8 * g4 + 4 * (ln >> 5); \
        *(uint2*)(Bs_ + lds_off(w * 32 + (ln & 31), kk >> 3) + (kk & 7) * 2) = (val); }
#define CO_STAGE(kt, buf) { unsigned char* As_ = smem + (buf) * 24576; unsigned char* Bs_ = As_ + 8192; \
        { const int q = tid, row = q >> 3, ch = q & 7; *(uint4*)(As_ + lds_off(row, ch)) = A##kt##_0; } \
        { const int q = tid + 256, row = q >> 3, ch = q & 7; *(uint4*)(As_ + lds_off(row, ch)) = A##kt##_1; } \
        if (RET) { \
            { const int q = tid, row = q >> 3, ch = q & 7; *(uint4*)(Bs_ + lds_off(row, ch)) = B##kt##_0; } \
            { const int q = tid + 256, row = q >> 3, ch = q & 7; *(uint4*)(Bs_ + lds_off(row, ch)) = B##kt##_1; } \
            { const int q = tid + 512, row = q >> 3, ch = q & 7; *(uint4*)(Bs_ + lds_off(row, ch)) = B##kt##_2; } \
            { const int q = tid + 768, row = q >> 3, ch = q & 7; *(uint4*)(Bs_ + lds_off(row, ch)) = B##kt##_3; } \
        } else { \
            CO_PUT(0, make_uint2(B##kt##_0.x, B##kt##_0.y)) CO_PUT(1, make_uint2(B##kt##_0.z, B##kt##_0.w)) \
            CO_PUT(2, make_uint2(B##kt##_1.x, B##kt##_1.y)) CO_PUT(3, make_uint2(B##kt##_1.z, B##kt##_1.w)) \
            CO_PUT(4, make_uint2(B##kt##_2.x, B##kt##_2.y)) CO_PUT(5, make_uint2(B##kt##_2.z, B##kt##_2.w)) \
            CO_PUT(6, make_uint2(B##kt##_3.x, B##kt##_3.y)) CO_PUT(7, make_uint2(B##kt##_3.z, B##kt##_3.w)) } }
#define CO_MMA(buf) { const unsigned char* As_ = smem + (buf) * 24576; const unsigned char* Bs_ = As_ + 8192; \
        _Pragma("unroll") for (int ks = 0; ks < 4; ++ks) { const bf16x8 fa = frag_ld(As_, wr * 32 + (lane & 31), ks, lane); \
            _Pragma("unroll") for (int j = 0; j < 2; ++j) acc[j] = __builtin_amdgcn_mfma_f32_32x32x16_bf16(fa, frag_ld(Bs_, wc * 64 + j * 32 + (lane & 31), ks, lane), acc[j], 0, 0, 0); } }
    HSYNC();
    CO_STAGE(0, 0) CO_STAGE(1, 1)
    HSYNC();
    CO_MMA(0) CO_MMA(1)
    if (NKT == 3) {
        HSYNC();
        CO_STAGE(2, 0)
        HSYNC();
        CO_MMA(0)
    }
#pragma unroll
    for (int r = 0; r < 16; ++r) {
        float s1 = acc[0][r] + acc[1][r], s2 = acc[0][r] * acc[0][r] + acc[1][r] * acc[1][r];
        s1 = half_sum32(s1); s2 = half_sum32(s2);
        if ((lane & 31) == 0) { const int row = wr * 32 + (r & 3) + 8 * (r >> 2) + 4 * (lane >> 5); red[(row * 2 + wc) * 2] = s1; red[(row * 2 + wc) * 2 + 1] = s2; }
    }
    HSYNC();
    bf16_t* mixed = (bf16_t*)(P.ws + WS_MIXED);
#pragma unroll
    for (int r = 0; r < 16; ++r) {
        const int row = wr * 32 + (r & 3) + 8 * (r >> 2) + 4 * (lane >> 5);
        const float s1 = red[row * 4] + red[row * 4 + 2], s2 = red[row * 4 + 1] + red[row * 4 + 3];
        const size_t t = tok0 + row;
#pragma unroll
        for (int j = 0; j < 2; ++j) {
            const int dv = wc * 64 + j * 32 + (lane & 31);
            float y;
            if (!RET) {
                const float rs = rsqrtf(s2 * (1.f / 128.f) + EPS);
                y = acc[j][r] * rs * P.dn_norm[dv] * silu_f(bf2f((bf16_t)gz[j][r]));
                mixed[t * D + h * 128 + dv] = f2bf(y);
            } else {
                const float mu = s1 * (1.f / 128.f);
                const float var = fmaxf(s2 * (1.f / 128.f) - mu * mu, 0.f);
                const float rs = rsqrtf(var + EPS);
                y = ((acc[j][r] - mu) * rs * P.ret_gn_w[h * 128 + dv] + P.ret_gn_b[h * 128 + dv]) * silu_f(bf2f((bf16_t)gz[j][r]));
                mixed[t * D + 1024 + h * 128 + dv] = f2bf(y);
            }
        }
    }
}

__device__ __forceinline__ void phase_chunk3(const Params& P, int bid, int nb, unsigned char* smem) {
    for (int u0 = bid; u0 < 2048; u0 += nb) { const int u = (bid & 1) ? ((u0 + 1024) & 2047) : u0; if (u < 1024) chunk_out<128, false>(P, u, smem); else chunk_out<64, true>(P, u - 1024, smem); }
}

__device__ __forceinline__ void ins16(float (&l)[16], float x) {
#pragma unroll
    for (int i = 0; i < 16; ++i) { const float hi = fmaxf(l[i], x); x = fminf(l[i], x); l[i] = hi; }
}
__device__ __forceinline__ void ins16x2(float (&l)[16], float xa, float xb) {
#pragma unroll
    for (int i = 0; i < 16; ++i) {
        const float h1 = fmaxf(l[i], xa); xa = fminf(l[i], xa);
        const float h2 = fmaxf(h1, xb); xb = fminf(h1, xb);
        l[i] = h2;
    }
}
__device__ __forceinline__ void phase_route(const Params& P, int bid, int nb, unsigned char* smem) {
    int* idx = (int*)(P.ws + WS_IDX); float* gates = (float*)(P.ws + WS_GATES);
    const bf16_t* Q = (const bf16_t*)(P.ws + WS_Q); const bf16_t* KEYS = (const bf16_t*)(P.ws + WS_KEYS);
    int tid_ = VTID; asm volatile("" : "+v"(tid_));
    const int tid = tid_, wave = tid >> 6, lane = tid & 63, fr = lane & 15, fq = lane >> 4;
    float* tile = (float*)smem;
    unsigned* L = (unsigned*)(smem + 256 * 33 * 4);
    const float NEG = -3.0e38f;
    for (int u = bid; u < 512; u += nb) {
        const size_t R0 = (size_t)u * 256;
        const size_t t0 = (size_t)u * 16;
        bf16x8 af[4][4];
#pragma unroll
        for (int j = 0; j < 4; ++j)
#pragma unroll
            for (int ks = 0; ks < 4; ++ks) af[j][ks] = *(const bf16x8*)(Q + (t0 + fr) * D + (4 * wave + j) * 128 + ks * 32 + fq * 8);
        float l[16];
#pragma unroll
        for (int i = 0; i < 16; ++i) l[i] = NEG;
        bf16x8 bq[2][2][4];
#define ROUTE_LOADB(chh, j0) _Pragma("unroll") for (int j = 0; j < 2; ++j) _Pragma("unroll") for (int nt = 0; nt < 2; ++nt) _Pragma("unroll") for (int ks = 0; ks < 4; ++ks) \
            bq[j][nt][ks] = *(const bf16x8*)(KEYS + (size_t)((4 * wave + (j0) + j) * 128 + (chh) * 32 + nt * 16 + fr) * 128 + ks * 32 + fq * 8);
#define ROUTE_MMA(j0) _Pragma("unroll") for (int j = 0; j < 2; ++j) _Pragma("unroll") for (int nt = 0; nt < 2; ++nt) { \
            f32x4 acc = {0.f, 0.f, 0.f, 0.f}; \
            _Pragma("unroll") for (int ks = 0; ks < 4; ++ks) acc = __builtin_amdgcn_mfma_f32_16x16x32_bf16(af[(j0) + j][ks], bq[j][nt][ks], acc, 0, 0, 0); \
            _Pragma("unroll") for (int jj = 0; jj < 4; ++jj) tile[((fq * 4 + jj) * 16 + 4 * wave + (j0) + j) * 33 + nt * 16 + fr] = acc[jj]; }
        ROUTE_LOADB(0, 0)
        for (int ch = 0; ch < 4; ++ch) {
            HSYNC();
            ROUTE_MMA(0)
            ROUTE_LOADB(ch, 2)
            ROUTE_MMA(2)
            if (ch < 3) { ROUTE_LOADB(ch + 1, 0) }
            HSYNC();
#pragma unroll
            for (int j = 0; j < 32; j += 2) {
                const float xa = __uint_as_float((__float_as_uint(tile[tid * 33 + j]) & ~0x7Fu) | (unsigned)(ch * 32 + j));
                const float xb = __uint_as_float((__float_as_uint(tile[tid * 33 + j + 1]) & ~0x7Fu) | (unsigned)(ch * 32 + j + 1));
                ins16x2(l, xa, xb);
            }
        }
#pragma unroll
        for (int i = 0; i < 16; ++i) L[tid * 16 + i] = __float_as_uint(l[i]);
        HSYNC();
        const int pe = tid & ~1, po = tid | 1;
        float s1[16], s2[16];
#pragma unroll
        for (int i = 0; i < 16; ++i) { s1[i] = __uint_as_float(L[pe * 16 + i]); s2[i] = __uint_as_float(L[po * 16 + i]); }
        float m[16];
#pragma unroll
        for (int i = 0; i < 16; ++i) m[i] = NEG;
#pragma unroll
        for (int i = 0; i < 16; ++i)
#pragma unroll
            for (int j = 0; j < 16; ++j)
                if ((i + 1) * (j + 1) <= 16) ins16(m, __uint_as_float((__float_as_uint(s1[i] + s2[j]) & ~0xFFu) | (unsigned)(i * 16 + j)));
        float e[16], sum = 0.f;
#pragma unroll
        for (int r = 0; r < 16; ++r) { e[r] = __expf(m[r] - m[0]); sum += e[r]; }
        const float inv = 1.f / sum;
        const int par = tid & 1;
        const size_t ob = ((R0 + tid) >> 1) * 16 + par * 8;
#pragma unroll
        for (int r = 0; r < 8; ++r) {
            float k_lo = m[r], k_hi = m[r + 8], e_lo = e[r], e_hi = e[r + 8];
            asm volatile("" : "+v"(k_lo), "+v"(k_hi), "+v"(e_lo), "+v"(e_hi));
            const float key = par ? k_hi : k_lo;
            const float ev = par ? e_hi : e_lo;
            const unsigned cand = __float_as_uint(key) & 0xFFu;
            const unsigned i1 = L[pe * 16 + (cand >> 4)] & 0x7Fu, i2 = L[po * 16 + (cand & 15)] & 0x7Fu;
            idx[ob + r] = (int)(i1 * 128 + i2);
            gates[ob + r] = ev * inv;
        }
    }
}

typedef float f32x2 __attribute__((ext_vector_type(2)));
typedef float v32f __attribute__((ext_vector_type(32)));
typedef float v16f __attribute__((ext_vector_type(16)));
typedef unsigned v6u __attribute__((ext_vector_type(6)));
constexpr int EROW = 1536;
__device__ __forceinline__ void fp6_calibrate(int (&sig)[32]) {
    v16f tlo, thi;
#pragma unroll
    for (int i = 0; i < 16; ++i) { tlo[i] = (i < 8) ? 0.125f * i : 1.f + 0.125f * (i - 8); thi[i] = (i < 8) ? 2.f + 0.25f * i : 4.f + 0.5f * (i - 8); }
    asm volatile("" : "+v"(tlo), "+v"(thi));
    const v6u tw = __builtin_amdgcn_cvt_scalef32_2xpk16_fp6_f32(tlo, thi, 1.0f);
    const v32f tr = __builtin_amdgcn_cvt_scalef32_pk32_f32_fp6(tw, 1.0f);
#pragma unroll
    for (int j = 0; j < 32; ++j) {
        const float v = tr[j];
        const int k = v < 2.f ? (int)(v * 8.f + 0.5f) : (v < 4.f ? 16 + (int)((v - 2.f) * 4.f + 0.5f) : 24 + (int)((v - 4.f) * 2.f + 0.5f));
        sig[j] = __builtin_amdgcn_readfirstlane(k) & 31;
    }
}
__device__ __forceinline__ void phase_econv(const Params& P, int bid, int nb, unsigned char* smem) {
    int tid_ = VTID; asm volatile("" : "+v"(tid_));
    const int wave = tid_ >> 6, lane = tid_ & 63;
    float* scales = (float*)(P.ws + WS_ESC);
    bool fp4_natural;
    { float ta = 1.0f, tb = 2.0f; asm volatile("" : "+v"(ta), "+v"(tb));
      const unsigned tw = __builtin_amdgcn_cvt_scalef32_pk_fp4_f32(0u, ta, tb, 1.0f, 0);
      const f32x2 tr = __builtin_amdgcn_cvt_scalef32_pk_f32_fp4(tw, 1.0f, 0);
      fp4_natural = __builtin_amdgcn_readfirstlane(tr[0] == 1.0f ? 1 : 0) != 0; }
    for (int r = bid * 4 + wave; r < 32768; r += nb * 4) {
        const bool isv = r >= 16384;
        const float* src = (isv ? P.expert_v : P.expert_u) + (size_t)(r & 16383) * D + lane * 32;
        f32x4 v[8]; float am = 0.f;
#pragma unroll
        for (int i = 0; i < 8; ++i) { v[i] = *(const f32x4*)(src + i * 4); am = fmaxf(am, fmaxf(fmaxf(fabsf(v[i][0]), fabsf(v[i][1])), fmaxf(fabsf(v[i][2]), fabsf(v[i][3])))); }
        am = wave_max(am);
        {
            unsigned char* dst = (isv ? P.ws + WS_EV4 + (size_t)(r - 16384) * 1024 : P.ws + WS_EU8 + (size_t)r * 1024) + lane * 16;
            const float sc = am > 0.f ? 6.0f / (0.8f * am) : 1.f;
            unsigned w[4] = {0u, 0u, 0u, 0u};
#define FP4_PK(i, bs) { const float a = v[(i) >> 1][((i) & 1) * 2] * sc, b = v[(i) >> 1][((i) & 1) * 2 + 1] * sc; \
                w[(i) >> 2] = __builtin_amdgcn_cvt_scalef32_pk_fp4_f32(w[(i) >> 2], fp4_natural ? a : b, fp4_natural ? b : a, 1.0f, bs); }
            FP4_PK(0, 0) FP4_PK(1, 1) FP4_PK(2, 2) FP4_PK(3, 3) FP4_PK(4, 0) FP4_PK(5, 1) FP4_PK(6, 2) FP4_PK(7, 3)
            FP4_PK(8, 0) FP4_PK(9, 1) FP4_PK(10, 2) FP4_PK(11, 3) FP4_PK(12, 0) FP4_PK(13, 1) FP4_PK(14, 2) FP4_PK(15, 3)
            *(uint4*)dst = make_uint4(w[0], w[1], w[2], w[3]);
            if (lane == 0) scales[r] = am > 0.f ? (0.8f * am) * (1.f / 6.0f) : 1.f;
        }
    }
}

__device__ __forceinline__ float gelu_f(float d) { return 0.5f * d * (1.f + erff(d * 0.70710678118654752f)); }

template <bool DRY>
__device__ __forceinline__ void phase_peer(const Params& P, int bid, int nb, int unit_lo = 0, int unit_hi = 512, int unit_step = 0) {
    const bf16_t* hn = (const bf16_t*)(P.ws + WS_HN); const int* idx = (const int*)(P.ws + WS_IDX); const float* gates = (const float*)(P.ws + WS_GATES);
    bf16_t* H = (bf16_t*)(P.ws + WS_H);
    const unsigned char* EU = P.ws + WS_EU8; const unsigned char* EV = P.ws + WS_EV4; const float* SC = (const float*)(P.ws + WS_ESC);
    const int wave = VTID >> 6, lane = VTID & 63;
    if (unit_step == 0) { unit_lo = bid; unit_step = nb; }
    for (int uu = unit_lo; uu < unit_hi; uu += unit_step)
    for (int tk = 0; tk < 4; ++tk) {
        const int t = uu * 16 + wave * 4 + tk;
        v32f acc; unsigned xp[16];
#pragma unroll
        for (int q = 0; q < 4; ++q) {
            const uint4 v = *(const uint4*)(hn + (size_t)t * D + lane * 32 + q * 8);
            xp[q * 4] = v.x; xp[q * 4 + 1] = v.y; xp[q * 4 + 2] = v.z; xp[q * 4 + 3] = v.w;
        }
#pragma unroll
        for (int i = 0; i < 32; ++i) acc[i] = 0.f;
        const float rs_t = rsqrtf(((const float*)(P.ws + WS_RSS))[t] * (1.f / 2048.f) + EPS);
        const int   my_i0 = idx[(size_t)t * 128 + lane],   my_i1 = idx[(size_t)t * 128 + 64 + lane];
        const float my_g0 = gates[(size_t)t * 128 + lane], my_g1 = gates[(size_t)t * 128 + 64 + lane];
        uint4 U0, U1, U2, U3, U4, U5, U6, U7;
        uint4 V0, V1, V2, V3, V4, V5, V6, V7;
#define PEER_E(k) ((k) < 64 ? __builtin_amdgcn_readlane(my_i0, (k)) : __builtin_amdgcn_readlane(my_i1, (k) - 64))
#define PEER_LDU(j, kk) { const unsigned o_ = (unsigned)PEER_E(kk) * 1024u + lane16; U##j = *(const uint4*)(EU + o_); }
#define PEER_LDV(j, kk) { const unsigned o_ = (unsigned)PEER_E(kk) * 1024u + lane16; V##j = *(const uint4*)(EV + o_); }
#define PEER_DOT(j, dst) { const unsigned uw[4] = {U##j.x, U##j.y, U##j.z, U##j.w}; float d0 = 0.f, d1 = 0.f; \
        _Pragma("unroll") for (int q = 0; q < 4; ++q) { \
            d0 = __builtin_amdgcn_fdot2_f32_bf16(__builtin_amdgcn_cvt_scalef32_pk_bf16_fp4(uw[q], 1.0f, 0), __builtin_bit_cast(bf16v2_t, xp[q * 4]),     d0, false); \
            d1 = __builtin_amdgcn_fdot2_f32_bf16(__builtin_amdgcn_cvt_scalef32_pk_bf16_fp4(uw[q], 1.0f, 1), __builtin_bit_cast(bf16v2_t, xp[q * 4 + 1]), d1, false); \
            d0 = __builtin_amdgcn_fdot2_f32_bf16(__builtin_amdgcn_cvt_scalef32_pk_bf16_fp4(uw[q], 1.0f, 2), __builtin_bit_cast(bf16v2_t, xp[q * 4 + 2]), d0, false); \
            d1 = __builtin_amdgcn_fdot2_f32_bf16(__builtin_amdgcn_cvt_scalef32_pk_bf16_fp4(uw[q], 1.0f, 3), __builtin_bit_cast(bf16v2_t, xp[q * 4 + 3]), d1, false); } \
        dst = d0 + d1; __builtin_amdgcn_sched_barrier(0); }
#define PEER_AXPY(j, aj) { const unsigned vw[4] = {V##j.x, V##j.y, V##j.z, V##j.w}; \
        _Pragma("unroll") for (int q = 0; q < 4; ++q) { \
            const f32x2 f0 = __builtin_amdgcn_cvt_scalef32_pk_f32_fp4(vw[q], 1.0f, 0), f1 = __builtin_amdgcn_cvt_scalef32_pk_f32_fp4(vw[q], 1.0f, 1), \
                        f2 = __builtin_amdgcn_cvt_scalef32_pk_f32_fp4(vw[q], 1.0f, 2), f3 = __builtin_amdgcn_cvt_scalef32_pk_f32_fp4(vw[q], 1.0f, 3); \
            acc[q * 8] += (aj) * f0[0]; acc[q * 8 + 1] += (aj) * f0[1]; acc[q * 8 + 2] += (aj) * f1[0]; acc[q * 8 + 3] += (aj) * f1[1]; \
            acc[q * 8 + 4] += (aj) * f2[0]; acc[q * 8 + 5] += (aj) * f2[1]; acc[q * 8 + 6] += (aj) * f3[0]; acc[q * 8 + 7] += (aj) * f3[1]; } __builtin_amdgcn_sched_barrier(0); }
        const unsigned lane16 = (unsigned)lane * 16u;
        PEER_LDU(0, 0) PEER_LDU(1, 1) PEER_LDU(2, 2) PEER_LDU(3, 3) PEER_LDU(4, 4) PEER_LDU(5, 5) PEER_LDU(6, 6) PEER_LDU(7, 7)
        PEER_LDV(0, 0) PEER_LDV(1, 1) PEER_LDV(2, 2) PEER_LDV(3, 3) PEER_LDV(4, 4) PEER_LDV(5, 5) PEER_LDV(6, 6) PEER_LDV(7, 7)
        const bool b5 = (lane & 32) != 0, b4 = (lane & 16) != 0, b3 = (lane & 8) != 0;
        for (int k0 = 0; k0 < 128; k0 += 8) {
            const bool more = k0 + 8 < 128;
            const int src_lane = (k0 & 63) + (lane >> 3);
            const int e_l = __shfl(k0 < 64 ? my_i0 : my_i1, src_lane);
            const float g_l = __shfl(k0 < 64 ? my_g0 : my_g1, src_lane);
            const float su_l = SC[e_l], sv_l = SC[16384 + e_l];
            float p0, p1, p2, p3, p4, p5, p6, p7;
            PEER_DOT(0, p0)
            PEER_DOT(1, p1)
            PEER_DOT(2, p2)
            PEER_DOT(3, p3)
            PEER_DOT(4, p4)
            PEER_DOT(5, p5)
            PEER_DOT(6, p6)
            PEER_DOT(7, p7)
#define PEER_SW32(a, b, o) { const auto r_ = __builtin_amdgcn_permlane32_swap(__float_as_uint(a), __float_as_uint(b), false, false); o = __uint_as_float(r_[0]) + __uint_as_float(r_[1]); }
#define PEER_SW16(a, b, o) { const auto r_ = __builtin_amdgcn_permlane16_swap(__float_as_uint(a), __float_as_uint(b), false, false); o = __uint_as_float(r_[0]) + __uint_as_float(r_[1]); }
#define PEER_DPP(v, ctrl) __int_as_float(__builtin_amdgcn_update_dpp(0, __float_as_int(v), (ctrl), 0xF, 0xF, false))
            float q0, q1, q2, q3, r0, r1;
            PEER_SW32(p0, p4, q0) PEER_SW32(p1, p5, q1) PEER_SW32(p2, p6, q2) PEER_SW32(p3, p7, q3)
            PEER_SW16(q0, q2, r0) PEER_SW16(q1, q3, r1)
            const float keep = b3 ? r1 : r0, send = b3 ? r0 : r1;
            float dt = keep + PEER_DPP(send, 0x128);
            dt += PEER_DPP(dt, 0xB1); dt += PEER_DPP(dt, 0x4E); dt += PEER_DPP(dt, 0x141);
            const float pre = dt * su_l * rs_t;
            const int a_l = __float_as_int(gelu_f(pre) * g_l * sv_l);
            { const float a0 = __int_as_float(__builtin_amdgcn_readlane(a_l, 0));  PEER_AXPY(0, a0) if (more) { PEER_LDV(0, k0 + 8) PEER_LDU(0, k0 + 8) } }
            { const float a1 = __int_as_float(__builtin_amdgcn_readlane(a_l, 8));  PEER_AXPY(1, a1) if (more) { PEER_LDV(1, k0 + 9) PEER_LDU(1, k0 + 9) } }
            { const float a2 = __int_as_float(__builtin_amdgcn_readlane(a_l, 16)); PEER_AXPY(2, a2) if (more) { PEER_LDV(2, k0 + 10) PEER_LDU(2, k0 + 10) } }
            { const float a3 = __int_as_float(__builtin_amdgcn_readlane(a_l, 24)); PEER_AXPY(3, a3) if (more) { PEER_LDV(3, k0 + 11) PEER_LDU(3, k0 + 11) } }
            { const float a4 = __int_as_float(__builtin_amdgcn_readlane(a_l, 32)); PEER_AXPY(4, a4) if (more) { PEER_LDV(4, k0 + 12) PEER_LDU(4, k0 + 12) } }
            { const float a5 = __int_as_float(__builtin_amdgcn_readlane(a_l, 40)); PEER_AXPY(5, a5) if (more) { PEER_LDV(5, k0 + 13) PEER_LDU(5, k0 + 13) } }
            { const float a6 = __int_as_float(__builtin_amdgcn_readlane(a_l, 48)); PEER_AXPY(6, a6) if (more) { PEER_LDV(6, k0 + 14) PEER_LDU(6, k0 + 14) } }
            { const float a7 = __int_as_float(__builtin_amdgcn_readlane(a_l, 56)); PEER_AXPY(7, a7) if (more) { PEER_LDV(7, k0 + 15) PEER_LDU(7, k0 + 15) } }
        }
        if (DRY) {
#pragma unroll
            for (int i = 0; i < 32; ++i) asm volatile("" :: "v"(acc[i]));
            continue;
        }
        float ss = 0.f;
#pragma unroll
        for (int q = 0; q < 4; ++q) {
            uint4* hp = (uint4*)(H + (size_t)t * D + lane * 32 + q * 8);
            const uint4 hv = *hp; const unsigned hw[4] = {hv.x, hv.y, hv.z, hv.w}; unsigned ow[4];
#pragma unroll
            for (int j = 0; j < 4; ++j) {
                const float a = __uint_as_float(hw[j] << 16) + acc[q * 8 + 2 * j], b = __uint_as_float(hw[j] & 0xffff0000u) + acc[q * 8 + 2 * j + 1];
                acc[q * 8 + 2 * j] = a; acc[q * 8 + 2 * j + 1] = b; ss += a * a + b * b; ow[j] = pack2(a, b);
            }
            *hp = make_uint4(ow[0], ow[1], ow[2], ow[3]);
        }
        ss = wave_sum(ss);
        const float rs = rsqrtf(ss * (1.f / 2048.f) + EPS);
        bf16_t* hn3 = (bf16_t*)(P.ws + WS_HN) + (size_t)t * D + lane * 32;
#pragma unroll
        for (int q = 0; q < 4; ++q) {
            unsigned w[4];
#pragma unroll
            for (int j = 0; j < 4; ++j) { const int col = lane * 32 + q * 8 + 2 * j;
                w[j] = pack2(acc[q * 8 + 2 * j] * rs * P.norm_ple[col], acc[q * 8 + 2 * j + 1] * rs * P.norm_ple[col + 1]); }
            *(uint4*)(hn3 + q * 8) = make_uint4(w[0], w[1], w[2], w[3]);
        }
    }
}

enum { PH_PREP = 0, PH_GEMM1, PH_CHUNK1, PH_SCAN, PH_CHUNK3, PH_GEMM2, PH_GEMM3, PH_ROUTE, PH_PEER, PH_GEMM4, PH_FINAL, PH_COUNT };

#define XB_TMO      128
#define XB_XCNT(j)  (256  + 64 * (j))
#define XB_XSUB(j)  (1280 + 64 * (j))
#define XB_XGEN(j)  (2304 + 64 * (j))
#define XB_TOP      3328
#define XB_TOPGEN   3392
#define XCD_BAR_WORDS 3456
#define XB_SPIN_CAP (1u << 20)
#define LAS __attribute__((address_space(3)))
__device__ __forceinline__ unsigned xb_ld(unsigned* p)              { return __hip_atomic_load(p, __ATOMIC_RELAXED, __HIP_MEMORY_SCOPE_AGENT); }
__device__ __forceinline__ unsigned xb_add(unsigned* p, unsigned v) { return __hip_atomic_fetch_add(p, v, __ATOMIC_RELAXED, __HIP_MEMORY_SCOPE_AGENT); }
__device__ __forceinline__ unsigned xb_xcc_id() { return (unsigned)__builtin_amdgcn_s_getreg((3 << 11) | 20) & 0xFu; }
#define XB_SPIN(cond, bar) do { unsigned _sp = 0; while (cond) { __builtin_amdgcn_s_sleep(1); \
    if ((++_sp & 255u) == 0u) { if (xb_ld(&(bar)[XB_TMO])) break; if (_sp > XB_SPIN_CAP) { atomicAdd(&(bar)[XB_TMO], 1u); break; } } } } while (0)
struct XcdBarrier { unsigned* bar; unsigned x; volatile LAS unsigned* st; };
__device__ __forceinline__ XcdBarrier xcd_barrier_post(unsigned* bar, volatile LAS unsigned* st) {
    XcdBarrier b; b.bar = bar; b.x = xb_xcc_id(); b.st = st;
    if (threadIdx.x == 0) (void)xb_add(&bar[XB_XCNT(b.x)], 1u);
    return b;
}
__device__ __forceinline__ void xcd_barrier_complete(unsigned* bar, unsigned x, unsigned& nloc, unsigned& nx) {
    const unsigned G = gridDim.x * gridDim.y * gridDim.z;
    unsigned sum, cnt, mine, sp = 0u;
    for (;;) {
        sum = 0u; cnt = 0u; mine = 0u;
#pragma unroll
        for (unsigned j = 0; j < 16; ++j) { const unsigned c = xb_ld(&bar[XB_XCNT(j)]); sum += c; cnt += (c > 0u) ? 1u : 0u; mine = (j == x) ? c : mine; }
        if (sum == G) break;
        __builtin_amdgcn_s_sleep(1);
        if ((++sp & 255u) == 0u) { if (xb_ld(&bar[XB_TMO])) break; if (sp > XB_SPIN_CAP) { atomicAdd(&bar[XB_TMO], 1u); break; } }
    }
    nloc = mine > 0u ? mine : 1u; nx = cnt > 0u ? cnt : 1u;
}
__device__ __forceinline__ void xcd_barrier(const XcdBarrier& b) {
    asm volatile("s_waitcnt vmcnt(0)" ::: "memory");
    __syncthreads();
    if (threadIdx.x == 0) {
        unsigned* bar = b.bar;
        __builtin_amdgcn_s_waitcnt(0);
        unsigned nloc = b.st[0], nx = b.st[1];
        if (nloc == 0u) { xcd_barrier_complete(bar, b.x, nloc, nx); b.st[0] = nloc; b.st[1] = nx; }
        const unsigned old = xb_add(&bar[XB_XSUB(b.x)], 1u);
        const unsigned gen = old / nloc;
        if (old + 1u == (gen + 1u) * nloc) {
            __builtin_amdgcn_fence(__ATOMIC_RELEASE, "agent");
            asm volatile("s_waitcnt vmcnt(0)" ::: "memory");
            const unsigned og = xb_add(&bar[XB_TOP], 1u);
            const unsigned tg = og / nx;
            if (og + 1u == (tg + 1u) * nx) xb_add(&bar[XB_TOPGEN], 1u);
            else XB_SPIN(xb_ld(&bar[XB_TOPGEN]) == tg, bar);
            __builtin_amdgcn_fence(__ATOMIC_ACQUIRE, "agent");
            xb_add(&bar[XB_XGEN(b.x)], 1u);
            asm volatile("s_waitcnt vmcnt(0)" ::: "memory");
        } else {
            XB_SPIN(xb_ld(&bar[XB_XGEN(b.x)]) == gen, bar);
            __builtin_amdgcn_fence(__ATOMIC_ACQUIRE, "agent");
            asm volatile("s_waitcnt vmcnt(0)" ::: "memory");
        }
    }
    __syncthreads();
}

__device__ __forceinline__ void run_phase(const Params& P, int ph, int bid, int nb, unsigned char* smem, int rbid, int rnb, unsigned char* rsmem) {
    switch (ph) {
        case PH_PREP:   phase_prep(P, bid, nb, smem); break;
        case PH_GEMM1:  phase_gemm1(P, rbid, rnb, rsmem); break;
        case PH_CHUNK1: phase_chunk1(P, bid, nb, smem); break;
        case PH_SCAN:   phase_scan(P, bid, nb, smem, rbid, rnb, rsmem); break;
        case PH_CHUNK1 + 100: phase_chunk1(P, bid, nb, smem, 1); break;
        case PH_CHUNK1 + 200: phase_chunk1(P, bid, nb, smem, 2); break;
        case PH_SCAN + 100: phase_scan(P, bid, nb, smem, rbid, rnb, rsmem, 1); break;
        case PH_SCAN + 200: phase_scan(P, bid, nb, smem, rbid, rnb, rsmem, 2); break;
        case PH_CHUNK3: phase_chunk3(P, bid, nb, smem); break;
        case PH_GEMM2:  phase_gemm2(P, rbid, rnb, rsmem); break;
        case PH_GEMM3:  phase_gemm3(P, rbid, rnb, rsmem); break;
        case PH_ROUTE:
                        for (int u = bid; u < 512; u += nb) {
                            phase_route(P, u, 512, smem);
                            asm volatile("s_waitcnt vmcnt(0)" ::: "memory"); HSYNC();
                            phase_peer<false>(P, bid, nb, u, u + 1, 1);
                        }
                        break;
        case PH_PEER:   break;
        case PH_PEER + 100: phase_peer<true>(P, bid, nb); break;
        case PH_GEMM4:  phase_gemm4(P, rbid, rnb, rsmem); break;
        case PH_FINAL:  phase_final(P, bid, nb); break;
    }
}

#ifndef PROBE_A
#define PROBE_A -1
#endif
#ifndef PROBE_B
#define PROBE_B -1
#endif
constexpr int LDS_BYTES = 131072 + 16 + 256 + 16 + 128;

__global__ void __launch_bounds__(512, 2) fwd_kernel(Params P, int ph_lo, int ph_hi) {
    extern __shared__ __attribute__((aligned(16))) unsigned char rsmem[];
    const int rbid = blockIdx.x, rnb = gridDim.x;
    const int half = __builtin_amdgcn_readfirstlane((int)(threadIdx.x >> 8));
    const int bid = rbid * 2 + half, nb = rnb * 2;
    unsigned char* smem = rsmem + half * 65536;
    volatile LAS unsigned* st = (volatile LAS unsigned*)(rsmem + 131072);
    if (threadIdx.x == 0) { st[0] = 0u; st[1] = 0u; *(volatile LAS unsigned*)(rsmem + 131072 + 288) = 0u; *(volatile LAS unsigned*)(rsmem + 131072 + 288 + 64) = 0u; }
    __syncthreads();
    XcdBarrier xb = xcd_barrier_post((unsigned*)(P.ws + WS_BAR), st);
#if PROBE_A >= 0
    unsigned long long* tstamp = (unsigned long long*)(rsmem + 131072 + 16);
    xcd_barrier(xb);
    if (threadIdx.x == 0) tstamp[0] = __builtin_amdgcn_s_memrealtime();
#define RUN(ph) if (ph_lo <= (ph) && (ph) < ph_hi) { run_phase(P, (ph), bid, nb, smem, rbid, rnb, rsmem); xcd_barrier(xb); if (threadIdx.x == 0) tstamp[(ph) + 1] = __builtin_amdgcn_s_memrealtime(); }
#else
#ifndef SCAN_PROBE
#define SCAN_PROBE 0
#endif
#ifndef REPEAT_PH
#define REPEAT_PH -1
#endif
#define RUN(ph) if (ph_lo <= (ph) && (ph) < ph_hi) { if ((ph) == REPEAT_PH && (ph) == PH_PEER) { run_phase(P, PH_PEER + 100, bid, nb, smem, rbid, rnb, rsmem); xcd_barrier(xb); } run_phase(P, (ph), bid, nb, smem, rbid, rnb, rsmem); if ((ph) == REPEAT_PH && (ph) != PH_PEER) { xcd_barrier(xb); run_phase(P, ((ph) == PH_SCAN || (ph) == PH_CHUNK1) ? (ph) + SCAN_PROBE : (ph), bid, nb, smem, rbid, rnb, rsmem); } if ((ph) + 1 < ph_hi) xcd_barrier(xb); }
#endif
    RUN(PH_PREP) RUN(PH_GEMM1) RUN(PH_CHUNK1) RUN(PH_SCAN) RUN(PH_CHUNK3) RUN(PH_GEMM2) RUN(PH_GEMM3) RUN(PH_ROUTE)
    RUN(PH_GEMM4) RUN(PH_FINAL)
#if PROBE_A >= 0
    __syncthreads();
    if (rbid == 0) {
        const float da = (float)(tstamp[PROBE_A + 1] - tstamp[PROBE_A]) * 0.01f;
        if (threadIdx.x == 0) P.out[0] = da;
#if PROBE_B >= 0
        const float db = (float)(tstamp[PROBE_B + 1] - tstamp[PROBE_B]) * 0.01f * (1.f / 16.f);
        for (int i = threadIdx.x; i < 65536; i += 512) P.out[65536 + i] = db;
#endif
    }
#endif
}

extern "C" void kernel_launch(void* const* d_in, const int* in_sizes, int n_in, void* d_out, int out_size, void* d_ws, size_t ws_size, hipStream_t stream) {
    static int grid = 0;
    if (grid == 0) {
        if (n_in != 21 || out_size != T * D || ws_size < WS_END) { fprintf(stderr, "kernel_launch: unexpected shapes: n_in %d out %d ws %zu (need %zu)\n", n_in, out_size, ws_size, (size_t)WS_END); grid = -1; return; }
        if (hipFuncSetAttribute((const void*)fwd_kernel, hipFuncAttributeMaxDynamicSharedMemorySize, LDS_BYTES) != hipSuccess) { fprintf(stderr, "kernel_launch: hipFuncSetAttribute failed\n"); grid = -1; return; }
        int dev = 0, cus = 0, per_cu = 0;
        hipGetDevice(&dev); hipDeviceGetAttribute(&cus, hipDeviceAttributeMultiprocessorCount, dev);
        if (hipOccupancyMaxActiveBlocksPerMultiprocessor(&per_cu, (const void*)fwd_kernel, 512, LDS_BYTES) != hipSuccess || per_cu < 1) { fprintf(stderr, "kernel_launch: occupancy query failed (%d)\n", per_cu); grid = -1; return; }
        if (per_cu > 1) per_cu = 1;
        grid = cus * per_cu;
        fprintf(stderr, "kernel_launch: grid %d (%d CUs x %d)\n", grid, cus, per_cu);
    }
    if (grid < 0) return;
    Params P{};
    P.x = (const float*)d_in[0]; P.p = (const float*)d_in[1]; P.positions = (const int*)d_in[2]; P.norm_mix = (const float*)d_in[3]; P.w_in = (const float*)d_in[4];
    P.conv_w = (const float*)d_in[5]; P.a_log = (const float*)d_in[6]; P.dt_bias = (const float*)d_in[7]; P.dn_norm = (const float*)d_in[8]; P.ret_gn_w = (const float*)d_in[9];
    P.ret_gn_b = (const float*)d_in[10]; P.w_out = (const float*)d_in[11]; P.norm_ffn = (const float*)d_in[12]; P.w_pq = (const float*)d_in[13]; P.sub_keys = (const float*)d_in[14];
    P.expert_u = (const float*)d_in[15]; P.expert_v = (const float*)d_in[16]; P.norm_ple = (const float*)d_in[17]; P.w_ple_gate = (const float*)d_in[18]; P.w_ple_proj = (const float*)d_in[19];
    P.norm_final = (const float*)d_in[20]; P.out = (float*)d_out; P.ws = (unsigned char*)d_ws;
    (void)hipMemsetAsync((unsigned char*)d_ws + WS_BAR, 0, XCD_BAR_WORDS * 4, stream);
    int lo = 0, hi = PH_COUNT;
    void* args[] = {&P, &lo, &hi};
    hipError_t e = hipLaunchCooperativeKernel((const void*)fwd_kernel, dim3(grid), dim3(512), args, LDS_BYTES, stream);
    if (e != hipSuccess) fprintf(stderr, "kernel_launch: cooperative launch failed: %s (grid %d)\n", hipGetErrorString(e), grid);
}
```
